# Optimizing an MI355X kernel written in HIP

```python
import jax, jax.numpy as jnp
from jax import lax
import numpy as np

D_MODEL = 1024
BATCH = 4
SEQ = 4096
DEPTH = 2

GRID_W = 64
N_MEM = 256
HEAD_DIM = 64
NORM_EPS = 1e-6
MEM_HEADS = 4
MEM_DIM = MEM_HEADS * HEAD_DIM
MIX_DIM = D_MODEL - MEM_DIM
NA_HEADS = MIX_DIM // HEAD_DIM
NA_WIN_H = 8
NA_WIN_W = 16
NA_QBLK_W = 16
NA_KBLK_W = NA_QBLK_W + NA_WIN_W
NA_IN = 3 * MIX_DIM + MEM_DIM
GLA_HEADS = 4
GLA_DK = MIX_DIM // 2 // GLA_HEADS
GLA_DV = MIX_DIM // GLA_HEADS
GLA_GATE_RANK = 16
GLA_TAU = 16.0
GLA_CHUNK = 64
GLA_IN = 2 * GLA_HEADS * GLA_DK + 2 * MIX_DIM + 2 * GLA_GATE_RANK + MEM_DIM
N_GROUPS = 4
EXPERTS_PER_GROUP = 8
N_EXPERTS = N_GROUPS * EXPERTS_PER_GROUP
TOP_K = 2
EXPERT_FF = 512
MOE_BLOCK = 256
N_NA_LAYERS = (DEPTH + 1) // 2
N_GLA_LAYERS = DEPTH // 2

kernel_name = "hybrid_na_gla_hmoe_encoder"


def rms_norm(x, g):
    xf = x.astype(jnp.float32)
    y = xf * lax.rsqrt(jnp.mean(xf * xf, axis=-1, keepdims=True) + NORM_EPS)
    return (y * g.astype(jnp.float32)).astype(x.dtype)


def neighbourhood_attention(q, k, v, rpb):
    B, T, H, Dh = q.shape
    rows = T // GRID_W
    kh = min(NA_WIN_H, rows)
    ncb = GRID_W // NA_QBLK_W
    n_keys = kh * NA_KBLK_W
    scale = HEAD_DIM ** -0.5
    qcol = np.arange(GRID_W).reshape(ncb, NA_QBLK_W)
    kcol = (np.clip(np.arange(ncb) * NA_QBLK_W - NA_WIN_W // 2, 0, GRID_W - NA_KBLK_W)[:, None]
            + np.arange(NA_KBLK_W))
    cstart = np.clip(qcol - NA_WIN_W // 2, 0, GRID_W - NA_WIN_W)
    col_in = ((kcol[:, None, :] >= cstart[:, :, None])
              & (kcol[:, None, :] < cstart[:, :, None] + NA_WIN_W))
    dcol = np.clip(kcol[:, None, :] - qcol[:, :, None], 1 - NA_WIN_W, NA_WIN_W - 1) + NA_WIN_W - 1
    rstart = np.clip(np.arange(rows) - kh // 2, 0, rows - kh)
    drow = rstart[:, None] + np.arange(kh)[None, :] - np.arange(rows)[:, None] + NA_WIN_H - 1
    bias = rpb.astype(jnp.float32)[:, drow[:, :, None, None, None], dcol[None, None]]
    bias = jnp.where(col_in[None, None, None], bias, -jnp.inf)
    bias = bias.transpose(1, 0, 3, 4, 2, 5).reshape(rows, H, ncb, NA_QBLK_W, n_keys)
    kg = k.reshape(B, rows, GRID_W, H, Dh)
    vg = v.reshape(B, rows, GRID_W, H, Dh)
    qg = q.reshape(B, rows, GRID_W, H, Dh).transpose(1, 0, 2, 3, 4)

    def row_block(args):
        r0, q_row, b_row = args

        def gather(a):
            a = lax.dynamic_slice_in_dim(a, r0, kh, axis=1)[:, :, kcol]
            return a.transpose(0, 2, 1, 3, 4, 5).reshape(B, ncb, n_keys, H, Dh)

        k_blk, v_blk = gather(kg), gather(vg)
        q_blk = q_row.reshape(B, ncb, NA_QBLK_W, H, Dh)
        s = jnp.einsum('bjqhd,bjnhd->bhjqn', q_blk, k_blk,
                       preferred_element_type=jnp.float32) * scale + b_row
        p = jax.nn.softmax(s, axis=-1).astype(v.dtype)
        o = jnp.einsum('bhjqn,bjnhd->bjqhd', p, v_blk)
        return o.reshape(B, GRID_W, H, Dh)

    out = lax.map(row_block, (jnp.asarray(rstart, jnp.int32), qg, bias))
    return out.transpose(1, 0, 2, 3, 4).reshape(B, T, H * Dh)


def gla_chunked(q, k, v, log_a):
    B, T, H, dk = q.shape
    dv = v.shape[-1]
    c = GLA_CHUNK
    n = T // c
    chunk = lambda a: a.reshape(B, n, c, H, a.shape[-1]).transpose(0, 1, 3, 2, 4)
    q, k, v, log_a = chunk(q), chunk(k), chunk(v), chunk(log_a)
    b = jnp.cumsum(log_a, axis=3)
    b_mid = b[:, :, :, c // 2 - 1:c // 2]
    b_last = b[:, :, :, -1:]
    a = jnp.einsum('bnhid,bnhjd->bnhij', q * jnp.exp(b - b_mid), k * jnp.exp(b_mid - b))
    a = jnp.where(jnp.tril(jnp.ones((c, c), dtype=bool)), a, 0.0)
    o_intra = jnp.einsum('bnhij,bnhjv->bnhiv', a, v)
    q_st = jnp.moveaxis(q * jnp.exp(b), 1, 0)
    k_st = jnp.moveaxis(k * jnp.exp(b_last - b), 1, 0)
    v_st = jnp.moveaxis(v, 1, 0)
    dec = jnp.moveaxis(jnp.exp(b_last[:, :, :, 0]), 1, 0)

    def step(S, xs):
        qs, ks, vs, d = xs
        o = jnp.einsum('bhid,bhdv->bhiv', qs, S)
        S = S * d[..., None] + jnp.einsum('bhjd,bhjv->bhdv', ks, vs)
        return S, o

    S0 = jnp.zeros((B, H, dk, dv), jnp.float32)
    _, o_inter = lax.scan(step, S0, (q_st, k_st, v_st, dec))
    o = o_intra + jnp.moveaxis(o_inter, 0, 1)
    return o.transpose(0, 1, 3, 2, 4).reshape(B, T, H, dv)


def gla_mixer(u, gate_up, gate_bias, out_norm):
    B, T, _ = u.shape
    kd = GLA_HEADS * GLA_DK
    q, k, v, g, r_f, r_b, mq = jnp.split(
        u, np.cumsum([kd, kd, MIX_DIM, MIX_DIM, GLA_GATE_RANK, GLA_GATE_RANK]), axis=-1)
    heads = lambda a, d: a.astype(jnp.float32).reshape(B, T, GLA_HEADS, d)
    q = heads(q, GLA_DK) * (GLA_DK ** -0.5)
    k = heads(k, GLA_DK)
    v = heads(v, GLA_DV)

    def log_decay(r, d):
        z = (r @ gate_up[d]).astype(jnp.float32) + gate_bias[d].astype(jnp.float32)
        return heads(jax.nn.log_sigmoid(z) / GLA_TAU, GLA_DK)

    flip = lambda a: a[:, ::-1]
    o_fwd = gla_chunked(q, k, v, log_decay(r_f, 0))
    o_bwd = flip(gla_chunked(flip(q), flip(k), flip(v), flip(log_decay(r_b, 1))))
    o = rms_norm(o_fwd + o_bwd, out_norm).astype(u.dtype).reshape(B, T, MIX_DIM)
    return o * jax.nn.silu(g), mq


def memory_attention(mq, mkv):
    B, T, _ = mq.shape
    q = mq.reshape(B, T, MEM_HEADS, HEAD_DIM)
    k, v = jnp.split(mkv, 2, axis=-1)
    k = k.reshape(B, -1, MEM_HEADS, HEAD_DIM)
    v = v.reshape(B, -1, MEM_HEADS, HEAD_DIM)
    s = jnp.einsum('bthd,bmhd->bhtm', q, k, preferred_element_type=jnp.float32) * (HEAD_DIM ** -0.5)
    p = jax.nn.softmax(s, axis=-1).astype(v.dtype)
    return jnp.einsum('bhtm,bmhd->bthd', p, v).reshape(B, T, MEM_DIM)


def hierarchical_moe(x, w_group, b_group, w_router, b_router, w1, w3, w2):
    B, T, D = x.shape
    xt = x.reshape(-1, D)
    n_tok = xt.shape[0]
    g_prob = jax.nn.softmax((xt @ w_group).astype(jnp.float32) + b_group.astype(jnp.float32), axis=-1)
    g_gate, g_idx = lax.top_k(g_prob, 1)
    e_logits = ((xt @ w_router).astype(jnp.float32) + b_router.astype(jnp.float32)
                ).reshape(n_tok, N_GROUPS, EXPERTS_PER_GROUP)
    e_logits = jnp.take_along_axis(e_logits, g_idx[:, :, None], axis=1)[:, 0]
    top_l, top_i = lax.top_k(e_logits, TOP_K)
    gate = jax.nn.softmax(top_l, axis=-1) * g_gate
    expert = g_idx * EXPERTS_PER_GROUP + top_i
    n_asg = n_tok * TOP_K
    a_exp = expert.reshape(-1)
    a_tok = jnp.repeat(jnp.arange(n_tok, dtype=jnp.int32), TOP_K)
    a_w = gate.reshape(-1)
    order = jnp.argsort(a_exp)
    s_exp = a_exp[order]
    counts = jnp.zeros((N_EXPERTS,), jnp.int32).at[a_exp].add(1)
    padded = (counts + MOE_BLOCK - 1) // MOE_BLOCK * MOE_BLOCK
    start = jnp.cumsum(counts) - counts
    pend = jnp.cumsum(padded)
    pstart = pend - padded
    dest = pstart[s_exp] + jnp.arange(n_asg, dtype=jnp.int32) - start[s_exp]
    n_blocks = -(-n_asg // MOE_BLOCK) + N_EXPERTS
    n_rows = n_blocks * MOE_BLOCK
    row_tok = jnp.full((n_rows,), n_tok, jnp.int32).at[dest].set(a_tok[order])
    row_w = jnp.zeros((n_rows,), x.dtype).at[dest].set(a_w[order].astype(x.dtype))
    block_start = jnp.arange(n_blocks, dtype=jnp.int32) * MOE_BLOCK
    block_exp = jnp.minimum(jnp.sum(block_start[:, None] >= pend[None, :], axis=1), N_EXPERTS - 1)
    x_pad = jnp.concatenate([xt, jnp.zeros((1, D), xt.dtype)], axis=0)
    xb = x_pad[row_tok].reshape(n_blocks, MOE_BLOCK, D)

    def expert_block(args):
        xi, e = args
        return (jax.nn.silu(xi @ w1[e]) * (xi @ w3[e])) @ w2[e]

    yb = lax.map(expert_block, (xb, block_exp)).reshape(n_rows, D)
    y = jnp.zeros((n_tok + 1, D), x.dtype).at[row_tok].add(yb * row_w[:, None])[:n_tok]
    return y.reshape(B, T, D)


def setup_inputs(seed: int = 0) -> dict:
    key = jax.random.key(seed)
    ks = jax.random.split(key, 21)
    nrm = lambda k, shape, s: jax.random.normal(k, shape, jnp.float32) * s
    D = D_MODEL
    return {
        "x": nrm(ks[0], (BATCH, SEQ, D), 1.0),
        "mem": nrm(ks[1], (BATCH, N_MEM, D), 1.0),
        "mem_norm": 1.0 + nrm(ks[2], (D,), 0.02),
        "final_norm": 1.0 + nrm(ks[3], (D,), 0.02),
        "norm_mix": 1.0 + nrm(ks[4], (DEPTH, D), 0.02),
        "norm_ffn": 1.0 + nrm(ks[5], (DEPTH, D), 0.02),
        "w_mem_kv": nrm(ks[6], (DEPTH, D, 2 * MEM_DIM), D ** -0.5),
        "w_out": nrm(ks[7], (DEPTH, D, D), D ** -0.5),
        "na_w_in": nrm(ks[8], (N_NA_LAYERS, D, NA_IN), D ** -0.5),
        "na_rpb": nrm(ks[9], (N_NA_LAYERS, NA_HEADS, 2 * NA_WIN_H - 1, 2 * NA_WIN_W - 1), 0.1),
        "gla_w_in": nrm(ks[10], (N_GLA_LAYERS, D, GLA_IN), D ** -0.5),
        "gla_gate_up": nrm(ks[11], (N_GLA_LAYERS, 2, GLA_GATE_RANK, GLA_HEADS * GLA_DK), GLA_GATE_RANK ** -0.5),
        "gla_gate_bias": nrm(ks[12], (N_GLA_LAYERS, 2, GLA_HEADS * GLA_DK), 0.1),
        "gla_out_norm": 1.0 + nrm(ks[13], (N_GLA_LAYERS, GLA_DV), 0.02),
        "moe_w_group": nrm(ks[14], (DEPTH, D, N_GROUPS), D ** -0.5),
        "moe_b_group": nrm(ks[15], (DEPTH, N_GROUPS), 0.01),
        "moe_w_router": nrm(ks[16], (DEPTH, D, N_EXPERTS), D ** -0.5),
        "moe_b_router": nrm(ks[17], (DEPTH, N_EXPERTS), 0.01),
        "moe_w1": nrm(ks[18], (DEPTH, N_EXPERTS, D, EXPERT_FF), D ** -0.5),
        "moe_w3": nrm(ks[19], (DEPTH, N_EXPERTS, D, EXPERT_FF), D ** -0.5),
        "moe_w2": nrm(ks[20], (DEPTH, N_EXPERTS, EXPERT_FF, D), EXPERT_FF ** -0.5),
    }


def reference(x, mem, mem_norm, final_norm, norm_mix, norm_ffn, w_mem_kv, w_out,
              na_w_in, na_rpb, gla_w_in, gla_gate_up, gla_gate_bias, gla_out_norm,
              moe_w_group, moe_b_group, moe_w_router, moe_b_router, moe_w1, moe_w3, moe_w2):
    B, T, _ = x.shape
    mem_n = rms_norm(mem, mem_norm)
    for i in range(DEPTH):
        h = rms_norm(x, norm_mix[i])
        mkv = mem_n @ w_mem_kv[i]
        j = i // 2
        if i % 2 == 0:
            u = h @ na_w_in[j]
            q, k, v, mq = jnp.split(u, [MIX_DIM, 2 * MIX_DIM, 3 * MIX_DIM], axis=-1)
            hd = lambda a: a.reshape(B, T, NA_HEADS, HEAD_DIM)
            mix = neighbourhood_attention(hd(q), hd(k), hd(v), na_rpb[j])
        else:
            mix, mq = gla_mixer(h @ gla_w_in[j], gla_gate_up[j], gla_gate_bias[j], gla_out_norm[j])
        att = memory_attention(mq, mkv)
        x = x + jnp.concatenate([mix, att], axis=-1) @ w_out[i]
        x = x + hierarchical_moe(rms_norm(x, norm_ffn[i]), moe_w_group[i], moe_b_group[i],
                                 moe_w_router[i], moe_b_router[i], moe_w1[i], moe_w3[i], moe_w2[i])
    return rms_norm(x, final_norm)
```

```cpp
#include <hip/hip_runtime.h>
#include <cstdio>
#include <cstdint>

constexpr int D = 1024, NTOK = 16384, SEQ = 4096, NBATCH = 4, NMEM = 256, HD = 64;
constexpr int MIX = 768, MEMD = 256, NA_H = 12, NA_IN = 2560;
constexpr int GLA_H = 4, GLA_DK = 96, GLA_DV = 192, GLA_IN = 2592, GLA_KD = 384;
constexpr int NEXP = 32, EFF = 512;
constexpr int LDU0 = 2560, LDU1 = 2816;
constexpr int MAXROWS = 40960;
constexpr float EPS = 1e-6f;

typedef unsigned short bf16;
typedef float f32x4 __attribute__((ext_vector_type(4)));
typedef unsigned u32x4 __attribute__((ext_vector_type(4)));
typedef unsigned u32x2 __attribute__((ext_vector_type(2)));
#define LAS __attribute__((address_space(3)))

constexpr size_t MiB = 1048576;
constexpr size_t WS_CTL = 0;
constexpr size_t CTL_ZERO_BYTES = 1 * MiB;
constexpr size_t WS_WIN0 = 1 * MiB;
constexpr size_t WS_WIN1 = WS_WIN0 + (size_t)2560 * 1024 * 2;
constexpr size_t WS_WOUT = WS_WIN1 + (size_t)2816 * 1024 * 2;
constexpr size_t WS_WMKV = WS_WOUT + (size_t)2 * 1024 * 1024 * 2;
constexpr size_t WS_MEMN = WS_WMKV + (size_t)1024 * 1024 * 2;
constexpr size_t WS_MKV = WS_MEMN + (size_t)1024 * 1024 * 2;
constexpr size_t WS_W13 = 24 * MiB;
constexpr size_t WS_W2 = WS_W13 + 64 * MiB;
constexpr size_t WS_XN = WS_W2 + 32 * MiB;
constexpr size_t WS_U = WS_XN + 32 * MiB;
constexpr size_t WS_Y = WS_U;
constexpr size_t WS_CAT = WS_U + 88 * MiB;
constexpr size_t WS_ACT = WS_CAT + 32 * MiB;
constexpr size_t WS_ROUTE = WS_ACT + 40 * MiB;
constexpr size_t WS_S = WS_ROUTE + 4 * MiB;
constexpr size_t WS_END = WS_S + 96 * MiB;
static_assert(WS_MKV + (size_t)1024 * 1024 * 2 <= WS_W13, "ws map");
static_assert(WS_END <= 512 * MiB, "ws map");
constexpr size_t RT_TOKE = 0, RT_TOKW = 131072, RT_TOKP = 262144, RT_LIST = 524288;
constexpr int CW_CNT = 1024;
constexpr int CW_BAR = 4096;

struct Args {
    const float* in[21]; float* out; unsigned char* ws; int ph_lo, ph_hi;
};

__device__ __forceinline__ float bf2f(bf16 v) { return __uint_as_float(((unsigned)v) << 16); }
__device__ __forceinline__ unsigned f2bf(float f) { unsigned u = __float_as_uint(f); return (u + 0x7fffu + ((u >> 16) & 1u)) >> 16; }
__device__ __forceinline__ unsigned pk2(float lo, float hi) { return f2bf(lo) | (f2bf(hi) << 16); }
__device__ __forceinline__ float wave_sum(float v) {
#pragma unroll
    for (int o = 1; o < 64; o <<= 1) v += __shfl_xor(v, o);
    return v;
}
__device__ __forceinline__ float dot8(u32x4 a, u32x4 b) {
    float s = 0.f;
#pragma unroll
    for (int i = 0; i < 4; ++i) {
        s += __uint_as_float(a[i] << 16) * __uint_as_float(b[i] << 16);
        s += __uint_as_float(a[i] & 0xffff0000u) * __uint_as_float(b[i] & 0xffff0000u);
    }
    return s;
}
__device__ __forceinline__ float silu(float x) { return x / (1.f + __expf(-x)); }

struct Ctx {
    int tid, lane, wave, gw, ngw; long gtid, gsize;
    LAS unsigned char* lds;
};

__device__ __forceinline__ void transpose_item(const float* W, int N, int k0, int n0, bf16* dstrow0, int Kd, LAS float* scr, int lane) {
#pragma unroll 8
    for (int i = 0; i < 32; ++i) { const int kk = 2 * i + (lane >> 5); scr[kk * 33 + (lane & 31)] = W[(size_t)(k0 + kk) * N + n0 + (lane & 31)]; }
    asm volatile("s_waitcnt lgkmcnt(0)" ::: "memory");
    const int c = lane & 7;
#pragma unroll
    for (int j = 0; j < 4; ++j) { const int n = (lane >> 3) + 8 * j; const LAS float* s = scr + (8 * c) * 33 + n;
        u32x4 o; o.x = pk2(s[0 * 33], s[1 * 33]); o.y = pk2(s[2 * 33], s[3 * 33]); o.z = pk2(s[4 * 33], s[5 * 33]); o.w = pk2(s[6 * 33], s[7 * 33]);
        *(u32x4*)(dstrow0 + (size_t)n * Kd + k0 + 8 * c) = o; }
    asm volatile("s_waitcnt lgkmcnt(0)" ::: "memory");
}
__device__ __forceinline__ void transpose_matrix(const Ctx& c, const float* W, int K, int N, bf16* dst, int it0, int itstride) {
    LAS float* scr = (LAS float*)(c.lds + c.wave * 16384);
    const int nblk = N / 32, nit = (K / 64) * nblk;
    for (int it = it0; it < nit; it += itstride) { const int kb = it / nblk, nb = it % nblk;
        transpose_item(W, N, kb * 64, nb * 32, dst + (size_t)(nb * 32) * K, K, scr, c.lane); }
}
__device__ __forceinline__ void convert_moe(const Ctx& c, const float* w1, const float* w3, const float* w2, bf16* W13, bf16* W2) {
    LAS float* scr = (LAS float*)(c.lds + c.wave * 16384);
    const int per_e = 768;
    for (int it = c.gw; it < NEXP * per_e; it += c.ngw) {
        const int e = it / per_e, r = it % per_e, which = r / 256, q = r % 256;
        if (which < 2) {
            const int kb = q / 16, nb = q % 16, n0 = nb * 32;
            const float* W = (which == 0 ? w1 : w3) + (size_t)e * 1024 * 512;
            const int drow = (n0 / 128) * 256 + which * 128 + (n0 % 128);
            transpose_item(W, 512, kb * 64, n0, W13 + ((size_t)e * 1024 + drow) * 1024, 1024, scr, c.lane);
        } else {
            const int kb = q / 32, nb = q % 32, n0 = nb * 32;
            const float* W = w2 + (size_t)e * 512 * 1024;
            transpose_item(W, 1024, kb * 64, n0, W2 + ((size_t)e * 1024 + n0) * 512, 512, scr, c.lane);
        }
    }
}
__device__ __forceinline__ void rms_row_to_bf16(const float* xrow, const float* g, bf16* orow, int lane) {
    const f32x4* xr = (const f32x4*)xrow + lane; const f32x4* gr = (const f32x4*)g + lane;
    f32x4 v[4]; float s = 0.f;
#pragma unroll
    for (int j = 0; j < 4; ++j) { v[j] = xr[64 * j]; s += (v[j].x * v[j].x + v[j].y * v[j].y) + (v[j].z * v[j].z + v[j].w * v[j].w); }
    const float r = 1.f / sqrtf(wave_sum(s) * (1.f / D) + EPS);
    u32x2* o8 = (u32x2*)orow + lane;
#pragma unroll
    for (int j = 0; j < 4; ++j) { const f32x4 gg = gr[64 * j]; u32x2 w; w.x = pk2(v[j].x * r * gg.x, v[j].y * r * gg.y); w.y = pk2(v[j].z * r * gg.z, v[j].w * r * gg.w); o8[64 * j] = w; }
}

template <class RowA, class Epi>
__device__ __forceinline__ void naive_gemm(const Ctx& c, int M, int N, int K, const RowA& rowA, const bf16* Bt, const Epi& epi) {
    const long total = (long)M * N;
    for (long idx = c.gtid; idx < total; idx += c.gsize) {
        const int m = (int)(idx / N), n = (int)(idx % N);
        const bf16* a = rowA(m);
        if (a == nullptr) continue;
        const u32x4* a4 = (const u32x4*)a; const u32x4* b4 = (const u32x4*)(Bt + (size_t)n * K);
        float acc = 0.f;
        for (int k8 = 0; k8 < K / 8; ++k8) acc += dot8(a4[k8], b4[k8]);
        epi(m, n, acc);
    }
}

__device__ __forceinline__ void naive_na(const Ctx& c, const bf16* U, const float* rpb, bf16* CAT) {
    const long total = (long)NTOK * NA_H;
    for (long idx = c.gtid; idx < total; idx += c.gsize) {
        const int h = (int)(idx % NA_H), t = (int)(idx / NA_H);
        const int b = t / SEQ, p = t % SEQ, r = p / 64, cc = p % 64;
        const int rs = min(max(r - 4, 0), 56), cs = min(max(cc - 8, 0), 48);
        const u32x4* q4 = (const u32x4*)(U + (size_t)t * LDU0 + h * 64);
        float acc[64];
#pragma unroll
        for (int i = 0; i < 64; ++i) acc[i] = 0.f;
        float mx = -1e30f, l = 0.f;
        for (int i = 0; i < 8; ++i) for (int j = 0; j < 16; ++j) {
            const int kr = rs + i, kc = cs + j, kt = b * SEQ + kr * 64 + kc;
            const u32x4* k4 = (const u32x4*)(U + (size_t)kt * LDU0 + 768 + h * 64);
            float s = 0.f;
#pragma unroll
            for (int d8 = 0; d8 < 8; ++d8) s += dot8(q4[d8], k4[d8]);
            s = s * 0.125f + rpb[(h * 15 + (kr - r + 7)) * 31 + (kc - cc + 15)];
            const float mn = fmaxf(mx, s), alpha = __expf(mx - mn), pp = __expf(s - mn);
            l = l * alpha + pp; mx = mn;
            const u32x4* v4 = (const u32x4*)(U + (size_t)kt * LDU0 + 1536 + h * 64);
#pragma unroll
            for (int d8 = 0; d8 < 8; ++d8) { const u32x4 vv = v4[d8];
#pragma unroll
                for (int e = 0; e < 4; ++e) { acc[d8 * 8 + 2 * e] = acc[d8 * 8 + 2 * e] * alpha + pp * __uint_as_float(vv[e] << 16);
                    acc[d8 * 8 + 2 * e + 1] = acc[d8 * 8 + 2 * e + 1] * alpha + pp * __uint_as_float(vv[e] & 0xffff0000u); } }
        }
        const float inv = 1.f / l;
        u32x4* o4 = (u32x4*)(CAT + (size_t)t * D + h * 64);
#pragma unroll
        for (int d8 = 0; d8 < 8; ++d8) { u32x4 w; w.x = pk2(acc[d8 * 8] * inv, acc[d8 * 8 + 1] * inv); w.y = pk2(acc[d8 * 8 + 2] * inv, acc[d8 * 8 + 3] * inv);
            w.z = pk2(acc[d8 * 8 + 4] * inv, acc[d8 * 8 + 5] * inv); w.w = pk2(acc[d8 * 8 + 6] * inv, acc[d8 * 8 + 7] * inv); o4[d8] = w; }
    }
}
__device__ __forceinline__ void naive_memattn(const Ctx& c, const bf16* U, int ldu, int mqcol, const bf16* MKV, int lay, bf16* CAT) {
    const long total = (long)NTOK * 4;
    for (long idx = c.gtid; idx < total; idx += c.gsize) {
        const int h = (int)(idx % 4), t = (int)(idx / 4), b = t / SEQ;
        const u32x4* q4 = (const u32x4*)(U + (size_t)t * ldu + mqcol + h * 64);
        float acc[64];
#pragma unroll
        for (int i = 0; i < 64; ++i) acc[i] = 0.f;
        float mx = -1e30f, l = 0.f;
        for (int m = 0; m < NMEM; ++m) {
            const bf16* row = MKV + (size_t)(b * NMEM + m) * 1024 + lay * 512;
            const u32x4* k4 = (const u32x4*)(row + h * 64);
            float s = 0.f;
#pragma unroll
            for (int d8 = 0; d8 < 8; ++d8) s += dot8(q4[d8], k4[d8]);
            s *= 0.125f;
            const float mn = fmaxf(mx, s), alpha = __expf(mx - mn), pp = __expf(s - mn);
            l = l * alpha + pp; mx = mn;
            const u32x4* v4 = (const u32x4*)(row + 256 + h * 64);
#pragma unroll
            for (int d8 = 0; d8 < 8; ++d8) { const u32x4 vv = v4[d8];
#pragma unroll
                for (int e = 0; e < 4; ++e) { acc[d8 * 8 + 2 * e] = acc[d8 * 8 + 2 * e] * alpha + pp * __uint_as_float(vv[e] << 16);
                    acc[d8 * 8 + 2 * e + 1] = acc[d8 * 8 + 2 * e + 1] * alpha + pp * __uint_as_float(vv[e] & 0xffff0000u); } }
        }
        const float inv = 1.f / l;
        u32x4* o4 = (u32x4*)(CAT + (size_t)t * D + MIX + h * 64);
#pragma unroll
        for (int d8 = 0; d8 < 8; ++d8) { u32x4 w; w.x = pk2(acc[d8 * 8] * inv, acc[d8 * 8 + 1] * inv); w.y = pk2(acc[d8 * 8 + 2] * inv, acc[d8 * 8 + 3] * inv);
            w.z = pk2(acc[d8 * 8 + 4] * inv, acc[d8 * 8 + 5] * inv); w.w = pk2(acc[d8 * 8 + 6] * inv, acc[d8 * 8 + 7] * inv); o4[d8] = w; }
    }
}

__device__ __forceinline__ void route_phase(const Ctx& c, const float* X, const float* g, const float* wg, const float* bg, const float* wr, const float* br,
                                            bf16* HN, unsigned char* rt, unsigned* cnt) {
    int* TOKE = (int*)(rt + RT_TOKE); float* TOKW = (float*)(rt + RT_TOKW); int* TOKP = (int*)(rt + RT_TOKP); int* LIST = (int*)(rt + RT_LIST);
    for (int t = c.gw; t < NTOK; t += c.ngw) {
        const f32x4* xr = (const f32x4*)(X + (size_t)t * D) + c.lane; const f32x4* gr = (const f32x4*)g + c.lane;
        f32x4 v[4]; float s = 0.f;
#pragma unroll
        for (int j = 0; j < 4; ++j) { v[j] = xr[64 * j]; s += (v[j].x * v[j].x + v[j].y * v[j].y) + (v[j].z * v[j].z + v[j].w * v[j].w); }
        const float r = 1.f / sqrtf(wave_sum(s) * (1.f / D) + EPS);
        u32x2* o8 = (u32x2*)(HN + (size_t)t * D) + c.lane;
#pragma unroll
        for (int j = 0; j < 4; ++j) { const f32x4 gg = gr[64 * j]; v[j].x *= r * gg.x; v[j].y *= r * gg.y; v[j].z *= r * gg.z; v[j].w *= r * gg.w;
            u32x2 w; w.x = pk2(v[j].x, v[j].y); w.y = pk2(v[j].z, v[j].w); o8[64 * j] = w; }
        LAS float* hrow = (LAS float*)(c.lds + c.wave * 16384);
#pragma unroll
        for (int j = 0; j < 4; ++j) *(LAS f32x4*)(hrow + 4 * c.lane + 256 * j) = v[j];
        asm volatile("s_waitcnt lgkmcnt(0)" ::: "memory");
        float lg[4], lr[32];
#pragma unroll
        for (int o = 0; o < 4; ++o) lg[o] = 0.f;
#pragma unroll
        for (int o = 0; o < 32; ++o) lr[o] = 0.f;
#pragma unroll 1
        for (int kk = 0; kk < 16; ++kk) { const int k = c.lane + 64 * kk; const float xv = hrow[k];
            const f32x4 w4 = *(const f32x4*)(wg + (size_t)k * 4);
#pragma unroll
            for (int o = 0; o < 4; ++o) lg[o] += xv * w4[o];
#pragma unroll
            for (int o4 = 0; o4 < 8; ++o4) { const f32x4 w = *(const f32x4*)(wr + (size_t)k * 32 + o4 * 4);
#pragma unroll
                for (int o = 0; o < 4; ++o) lr[o4 * 4 + o] += xv * w[o]; } }
        asm volatile("s_waitcnt lgkmcnt(0)" ::: "memory");
#pragma unroll
        for (int o = 0; o < 4; ++o) lg[o] = wave_sum(lg[o]) + bg[o];
#pragma unroll
        for (int o = 0; o < 32; ++o) lr[o] = wave_sum(lr[o]) + br[o];
        int gi = 0; float gm = lg[0];
#pragma unroll
        for (int o = 1; o < 4; ++o) if (lg[o] > gm) { gm = lg[o]; gi = o; }
        float gs = 0.f;
#pragma unroll
        for (int o = 0; o < 4; ++o) gs += __expf(lg[o] - gm);
        const float ggate = 1.f / gs;
        float el[8];
#pragma unroll
        for (int o = 0; o < 8; ++o) { float x = lr[o];
#pragma unroll
            for (int q = 1; q < 4; ++q) x = (gi == q) ? lr[q * 8 + o] : x;
            el[o] = x; }
        int i0 = 0; float l0 = el[0];
#pragma unroll
        for (int o = 1; o < 8; ++o) if (el[o] > l0) { l0 = el[o]; i0 = o; }
        int i1 = -1; float l1 = -3.0e38f;
#pragma unroll
        for (int o = 0; o < 8; ++o) if (o != i0 && el[o] > l1) { l1 = el[o]; i1 = o; }
        const float e1 = __expf(l1 - l0), den = 1.f / (1.f + e1);
        const float w0 = den * ggate, w1 = e1 * den * ggate;
        if (c.lane == 0) {
            const int ex0 = gi * 8 + i0, ex1 = gi * 8 + i1;
            const unsigned p0 = atomicAdd(cnt + ex0, 1u), p1 = atomicAdd(cnt + ex1, 1u);
            LIST[ex0 * NTOK + p0] = t; LIST[ex1 * NTOK + p1] = t;
            TOKE[2 * t] = ex0; TOKE[2 * t + 1] = ex1; TOKW[2 * t] = w0; TOKW[2 * t + 1] = w1; TOKP[2 * t] = (int)p0; TOKP[2 * t + 1] = (int)p1;
        }
    }
}
__device__ __forceinline__ int pstart_of(const unsigned* cnt, int e) { int s = 0; for (int i = 0; i < e; ++i) s += ((int)cnt[i] + 255) & ~255; return s; }
__device__ __forceinline__ bool row_lookup(const unsigned* cnt, int R, int& e, int& i, int& n) {
    int s = 0;
    for (int x = 0; x < NEXP; ++x) { const int cn = (int)cnt[x], pc = (cn + 255) & ~255; if (R < s + pc) { e = x; i = R - s; n = cn; return true; } s += pc; }
    return false;
}

__device__ __forceinline__ void combine_phase(const Ctx& c, float* X, const bf16* Y, const unsigned char* rt, const unsigned* cnt, const float* g, bf16* XN, float* OUTF) {
    const int* TOKE = (const int*)(rt + RT_TOKE); const int* TOKP = (const int*)(rt + RT_TOKP);
    for (int t = c.gw; t < NTOK; t += c.ngw) {
        const int e0 = TOKE[2 * t], e1 = TOKE[2 * t + 1];
        const int R0 = pstart_of(cnt, e0) + TOKP[2 * t], R1 = pstart_of(cnt, e1) + TOKP[2 * t + 1];
        f32x4* xr = (f32x4*)(X + (size_t)t * D) + c.lane; const f32x4* gr = (const f32x4*)g + c.lane;
        const u32x2* y0 = (const u32x2*)(Y + (size_t)R0 * D) + c.lane; const u32x2* y1 = (const u32x2*)(Y + (size_t)R1 * D) + c.lane;
        f32x4 v[4]; float s = 0.f;
#pragma unroll
        for (int j = 0; j < 4; ++j) { v[j] = xr[64 * j]; const u32x2 a = y0[64 * j], b = y1[64 * j];
            v[j].x += __uint_as_float(a.x << 16) + __uint_as_float(b.x << 16); v[j].y += __uint_as_float(a.x & 0xffff0000u) + __uint_as_float(b.x & 0xffff0000u);
            v[j].z += __uint_as_float(a.y << 16) + __uint_as_float(b.y << 16); v[j].w += __uint_as_float(a.y & 0xffff0000u) + __uint_as_float(b.y & 0xffff0000u);
            s += (v[j].x * v[j].x + v[j].y * v[j].y) + (v[j].z * v[j].z + v[j].w * v[j].w); }
        const float r = 1.f / sqrtf(wave_sum(s) * (1.f / D) + EPS);
        if (XN) {
            u32x2* o8 = (u32x2*)(XN + (size_t)t * D) + c.lane;
#pragma unroll
            for (int j = 0; j < 4; ++j) { xr[64 * j] = v[j]; const f32x4 gg = gr[64 * j]; u32x2 w; w.x = pk2(v[j].x * r * gg.x, v[j].y * r * gg.y); w.y = pk2(v[j].z * r * gg.z, v[j].w * r * gg.w); o8[64 * j] = w; }
        } else {
            f32x4* o = (f32x4*)(OUTF + (size_t)t * D) + c.lane;
#pragma unroll
            for (int j = 0; j < 4; ++j) { const f32x4 gg = gr[64 * j]; f32x4 w; w.x = v[j].x * r * gg.x; w.y = v[j].y * r * gg.y; w.z = v[j].z * r * gg.z; w.w = v[j].w * r * gg.w; o[64 * j] = w; }
        }
    }
}

__device__ __forceinline__ void gla_decay(const Ctx& c, const bf16* U, const float* gup, const float* gbias, float* DECA) {
    const long total = (long)NTOK * 2 * GLA_KD;
    for (long idx = c.gtid; idx < total; idx += c.gsize) {
        const int cc = (int)(idx % GLA_KD), dir = (int)((idx / GLA_KD) % 2), t = (int)(idx / (2 * GLA_KD));
        const bf16* r = U + (size_t)t * LDU1 + 2304 + dir * 16;
        float z = gbias[dir * GLA_KD + cc];
#pragma unroll
        for (int k = 0; k < 16; ++k) z += bf2f(r[k]) * gup[(dir * 16 + k) * GLA_KD + cc];
        const float ls = fminf(z, 0.f) - log1pf(__expf(-fabsf(z)));
        DECA[idx] = __expf(ls * (1.f / 16.f));
    }
}
__device__ __forceinline__ void gla_recur(const Ctx& c, const bf16* U, const float* DECA, float* OF) {
    const long total = (long)NBATCH * GLA_H * GLA_DV * 2;
    const float qs = 0.10206207261596577f;
    for (long idx = c.gtid; idx < total; idx += c.gsize) {
        const int half = (int)(idx & 1), dv = (int)((idx >> 1) % GLA_DV), h = (int)(((idx >> 1) / GLA_DV) % GLA_H), b = (int)((idx >> 1) / (GLA_DV * GLA_H));
        float S[48];
        for (int dir = 0; dir < 2; ++dir) {
#pragma unroll
            for (int d = 0; d < 48; ++d) S[d] = 0.f;
            for (int s = 0; s < SEQ; ++s) {
                const int p = dir ? (SEQ - 1 - s) : s, t = b * SEQ + p;
                const bf16* row = U + (size_t)t * LDU1;
                const float vv = bf2f(row[768 + h * GLA_DV + dv]);
                const float* a = DECA + ((size_t)t * 2 + dir) * GLA_KD + h * GLA_DK + half * 48;
                const u32x4* q4 = (const u32x4*)(row + h * GLA_DK + half * 48); const u32x4* k4 = (const u32x4*)(row + 384 + h * GLA_DK + half * 48);
                float o = 0.f;
#pragma unroll
                for (int d8 = 0; d8 < 6; ++d8) { const u32x4 qq = q4[d8], kk = k4[d8]; const f32x4 a0 = *(const f32x4*)(a + d8 * 8), a1 = *(const f32x4*)(a + d8 * 8 + 4);
#pragma unroll
                    for (int e = 0; e < 4; ++e) { const float aa0 = e < 2 ? a0[2 * e] : a1[2 * e - 4], aa1 = e < 2 ? a0[2 * e + 1] : a1[2 * e - 3];
                        const float s0 = aa0 * S[d8 * 8 + 2 * e] + __uint_as_float(kk[e] << 16) * vv; S[d8 * 8 + 2 * e] = s0; o += __uint_as_float(qq[e] << 16) * s0;
                        const float s1 = aa1 * S[d8 * 8 + 2 * e + 1] + __uint_as_float(kk[e] & 0xffff0000u) * vv; S[d8 * 8 + 2 * e + 1] = s1; o += __uint_as_float(qq[e] & 0xffff0000u) * s1; } }
                o += __shfl_xor(o, 1);
                float* dst = OF + (size_t)t * MIX + h * GLA_DV + dv;
                if (half == 0) { if (dir == 0) *dst = o * qs; else *dst += o * qs; }
            }
        }
    }
}
__device__ __forceinline__ void gla_norm_gate(const Ctx& c, const float* OF, const bf16* U, const float* onorm, bf16* CAT) {
    for (int it = c.gw; it < NTOK * GLA_H; it += c.ngw) {
        const int h = it % GLA_H, t = it / GLA_H;
        const float* o = OF + (size_t)t * MIX + h * GLA_DV;
        float v[3]; float s = 0.f;
#pragma unroll
        for (int j = 0; j < 3; ++j) { v[j] = o[c.lane + 64 * j]; s += v[j] * v[j]; }
        const float r = 1.f / sqrtf(wave_sum(s) * (1.f / GLA_DV) + EPS);
#pragma unroll
        for (int j = 0; j < 3; ++j) { const int dv = c.lane + 64 * j; const float gg = bf2f(U[(size_t)t * LDU1 + 1536 + h * GLA_DV + dv]);
            CAT[(size_t)t * D + h * GLA_DV + dv] = (bf16)f2bf(v[j] * r * onorm[dv] * silu(gg)); }
    }
}

constexpr int NWAVES = 8, NTHREADS = 512, LDS_BYTES = 147456;
constexpr int NPHASES = 19;

template <int PH_LO, int PH_HI> __global__ void __launch_bounds__(NTHREADS, 2) mk_fwd(Args args) {
    extern __shared__ __attribute__((aligned(16))) unsigned char lds_raw[];
    Ctx c; c.tid = threadIdx.x; c.lane = c.tid & 63; c.wave = __builtin_amdgcn_readfirstlane(c.tid >> 6);
    c.gw = blockIdx.x * NWAVES + c.wave; c.ngw = gridDim.x * NWAVES; c.gtid = (long)blockIdx.x * NTHREADS + c.tid; c.gsize = (long)gridDim.x * NTHREADS;
    c.lds = (LAS unsigned char*)lds_raw;
    unsigned char* ws = args.ws;
    const float* x = args.in[0]; const float* mem = args.in[1]; const float* mem_norm = args.in[2]; const float* final_norm = args.in[3];
    const float* norm_mix = args.in[4]; const float* norm_ffn = args.in[5]; const float* w_mem_kv = args.in[6]; const float* w_out = args.in[7];
    const float* na_w_in = args.in[8]; const float* na_rpb = args.in[9]; const float* gla_w_in = args.in[10]; const float* gla_gate_up = args.in[11];
    const float* gla_gate_bias = args.in[12]; const float* gla_out_norm = args.in[13]; const float* moe_w_group = args.in[14]; const float* moe_b_group = args.in[15];
    const float* moe_w_router = args.in[16]; const float* moe_b_router = args.in[17]; const float* moe_w1 = args.in[18]; const float* moe_w3 = args.in[19]; const float* moe_w2 = args.in[20];
    float* X = args.out;
    bf16* WIN0 = (bf16*)(ws + WS_WIN0); bf16* WIN1 = (bf16*)(ws + WS_WIN1); bf16* WOUT = (bf16*)(ws + WS_WOUT); bf16* WMKV = (bf16*)(ws + WS_WMKV);
    bf16* MEMN = (bf16*)(ws + WS_MEMN); bf16* MKV = (bf16*)(ws + WS_MKV); bf16* W13 = (bf16*)(ws + WS_W13); bf16* W2 = (bf16*)(ws + WS_W2);
    bf16* XN = (bf16*)(ws + WS_XN); bf16* U = (bf16*)(ws + WS_U); bf16* Y = (bf16*)(ws + WS_Y); bf16* CAT = (bf16*)(ws + WS_CAT); bf16* ACT = (bf16*)(ws + WS_ACT);
    unsigned char* RT = ws + WS_ROUTE; float* DECA = (float*)(ws + WS_S); float* OF = (float*)(ws + WS_S + 48 * MiB);
    unsigned* CTL = (unsigned*)(ws + WS_CTL);
#define IN(k) (PH_LO <= (k) && (k) < PH_HI)

    if (IN(0)) {
        transpose_matrix(c, na_w_in, 1024, NA_IN, WIN0, c.gw, c.ngw);
        transpose_matrix(c, gla_w_in, 1024, GLA_IN, WIN1, c.gw, c.ngw);
        for (long i = c.gtid; i < (long)(2816 - 2592) * 1024 / 8; i += c.gsize) ((u32x4*)(WIN1 + (size_t)2592 * 1024))[i] = (u32x4){0u, 0u, 0u, 0u};
        for (int l = 0; l < 2; ++l) { transpose_matrix(c, w_out + (size_t)l * D * D, 1024, 1024, WOUT + (size_t)l * D * D, c.gw, c.ngw);
            transpose_matrix(c, w_mem_kv + (size_t)l * D * 512, 1024, 512, WMKV + (size_t)l * 512 * 1024, c.gw, c.ngw); }
        convert_moe(c, moe_w1, moe_w3, moe_w2, W13, W2);
        for (int m = c.gw; m < NBATCH * NMEM; m += c.ngw) rms_row_to_bf16(mem + (size_t)m * D, mem_norm, MEMN + (size_t)m * D, c.lane);
        for (int m = c.gw; m < NTOK; m += c.ngw) rms_row_to_bf16(x + (size_t)m * D, norm_mix, XN + (size_t)m * D, c.lane);
    }
    for (int L = 0; L < 2; ++L) {
        const int pb = 1 + 9 * L;
        const int ldu = L == 0 ? LDU0 : LDU1;
        unsigned* cnt = CTL + CW_CNT + 64 * L;
        if (IN(pb)) {
            if (L == 0) {
                naive_gemm(c, NTOK, NA_IN, D, [&](int m) { return XN + (size_t)m * D; }, WIN0, [&](int m, int n, float a) { U[(size_t)m * LDU0 + n] = (bf16)f2bf(a); });
                naive_gemm(c, NBATCH * NMEM, 1024, D, [&](int m) { return MEMN + (size_t)m * D; }, WMKV, [&](int m, int n, float a) { MKV[(size_t)m * 1024 + n] = (bf16)f2bf(a); });
            } else {
                naive_gemm(c, NTOK, LDU1, D, [&](int m) { return XN + (size_t)m * D; }, WIN1, [&](int m, int n, float a) { U[(size_t)m * LDU1 + n] = (bf16)f2bf(a); });
            }
        }
        if (IN(pb + 1)) {
            if (L == 0) { naive_na(c, U, na_rpb, CAT); naive_memattn(c, U, LDU0, 2304, MKV, 0, CAT); }
            else { gla_decay(c, U, gla_gate_up, gla_gate_bias, DECA); naive_memattn(c, U, LDU1, 2336, MKV, 1, CAT); }
        }
        if (IN(pb + 2)) {
            if (L == 1) gla_recur(c, U, DECA, OF);
        }
        if (IN(pb + 3)) {
            if (L == 1) gla_norm_gate(c, OF, U, gla_out_norm, CAT);
        }
        if (IN(pb + 4)) {
            const float* resid = L == 0 ? x : X;
            naive_gemm(c, NTOK, D, D, [&](int m) { return CAT + (size_t)m * D; }, WOUT + (size_t)L * D * D, [&](int m, int n, float a) { X[(size_t)m * D + n] = resid[(size_t)m * D + n] + a; });
        }
        if (IN(pb + 5)) {
            route_phase(c, X, norm_ffn + L * D, moe_w_group + (size_t)L * D * 4, moe_b_group + L * 4, moe_w_router + (size_t)L * D * 32, moe_b_router + L * 32, XN, RT, cnt);
        }
        if (IN(pb + 6)) {
            const int* LIST = (const int*)(RT + RT_LIST);
            const long total = (long)MAXROWS * EFF;
            for (long idx = c.gtid; idx < total; idx += c.gsize) {
                const int R = (int)(idx / EFF), j = (int)(idx % EFF); int e, i, n;
                if (!row_lookup(cnt, R, e, i, n) || i >= n) continue;
                const int t = LIST[e * NTOK + i];
                const u32x4* a4 = (const u32x4*)(XN + (size_t)t * D);
                const int r1 = (j / 128) * 256 + (j % 128);
                const u32x4* b1 = (const u32x4*)(W13 + ((size_t)e * 1024 + r1) * 1024); const u32x4* b3 = (const u32x4*)(W13 + ((size_t)e * 1024 + r1 + 128) * 1024);
                float s1 = 0.f, s3 = 0.f;
                for (int k8 = 0; k8 < D / 8; ++k8) { const u32x4 av = a4[k8]; s1 += dot8(av, b1[k8]); s3 += dot8(av, b3[k8]); }
                ACT[(size_t)R * EFF + j] = (bf16)f2bf(silu(s1) * s3);
            }
        }
        if (IN(pb + 7)) {
            const int* LIST = (const int*)(RT + RT_LIST); const int* TOKE = (const int*)(RT + RT_TOKE); const float* TOKW = (const float*)(RT + RT_TOKW);
            const long total = (long)MAXROWS * D;
            for (long idx = c.gtid; idx < total; idx += c.gsize) {
                const int R = (int)(idx / D), n = (int)(idx % D); int e, i, cn;
                if (!row_lookup(cnt, R, e, i, cn) || i >= cn) continue;
                const int t = LIST[e * NTOK + i];
                const float w = (TOKE[2 * t] == e) ? TOKW[2 * t] : TOKW[2 * t + 1];
                const u32x4* a4 = (const u32x4*)(ACT + (size_t)R * EFF); const u32x4* b4 = (const u32x4*)(W2 + ((size_t)e * 1024 + n) * 512);
                float s = 0.f;
                for (int k8 = 0; k8 < EFF / 8; ++k8) s += dot8(a4[k8], b4[k8]);
                Y[(size_t)R * D + n] = (bf16)f2bf(s * w);
            }
        }
        if (IN(pb + 8)) {
            if (L == 0) { combine_phase(c, X, Y, RT, cnt, norm_mix + D, XN, nullptr);
                convert_moe(c, moe_w1 + (size_t)NEXP * D * EFF, moe_w3 + (size_t)NEXP * D * EFF, moe_w2 + (size_t)NEXP * EFF * D, W13, W2); }
            else combine_phase(c, X, Y, RT, cnt, final_norm, nullptr, X);
        }
    }
#undef IN
}

template <int P> static void launch_phases(int grid, hipStream_t stream, const Args& a) {
    if constexpr (P < NPHASES) {
        if constexpr (P != 3 && P != 4) {
            static bool attr_done = false;
            if (!attr_done) { (void)hipFuncSetAttribute((const void*)mk_fwd<P, P + 1>, hipFuncAttributeMaxDynamicSharedMemorySize, LDS_BYTES); attr_done = true; }
            hipLaunchKernelGGL((mk_fwd<P, P + 1>), dim3(grid), dim3(NTHREADS), LDS_BYTES, stream, a);
        }
        launch_phases<P + 1>(grid, stream, a);
    }
}
extern "C" void kernel_launch(void* const* d_in, const int* in_sizes, int n_in, void* d_out, int out_size, void* d_ws, size_t ws_size, hipStream_t stream) {
    static int grid = 0;
    if (grid == 0) {
        if (n_in != 21 || out_size != NTOK * D || ws_size < WS_END) { fprintf(stderr, "kernel_launch: unexpected shapes n_in %d out %d ws %zu (need %zu)\n", n_in, out_size, ws_size, (size_t)WS_END); grid = -1; return; }
        int dev = 0, cus = 0;
        if (hipGetDevice(&dev) != hipSuccess || hipDeviceGetAttribute(&cus, hipDeviceAttributeMultiprocessorCount, dev) != hipSuccess) { grid = -1; return; }
        (void)hipGetLastError();
        grid = cus;
    }
    if (grid < 0) return;
    (void)hipMemsetAsync((char*)d_ws + WS_CTL, 0, CTL_ZERO_BYTES, stream);
    Args a{};
    for (int i = 0; i < 21; ++i) a.in[i] = (const float*)d_in[i];
    a.out = (float*)d_out; a.ws = (unsigned char*)d_ws;
    launch_phases<0>(grid, stream, a);
}
```

```cpp
#include <hip/hip_runtime.h>
#include <cstdio>
#include <cstdint>

constexpr int D = 1024, NTOK = 16384, SEQ = 4096, NBATCH = 4, NMEM = 256, HD = 64;
constexpr int MIX = 768, MEMD = 256, NA_H = 12, NA_IN = 2560;
constexpr int GLA_H = 4, GLA_DK = 96, GLA_DV = 192, GLA_IN = 2592, GLA_KD = 384;
constexpr int NEXP = 32, EFF = 512;
constexpr int LDU0 = 2560, LDU1 = 2816;
constexpr int MAXROWS = 40960;
constexpr float EPS = 1e-6f;

typedef unsigned short bf16;
typedef float f32x4 __attribute__((ext_vector_type(4)));
typedef unsigned u32x4 __attribute__((ext_vector_type(4)));
typedef unsigned u32x2 __attribute__((ext_vector_type(2)));
#define LAS __attribute__((address_space(3)))

constexpr size_t MiB = 1048576;
constexpr size_t WS_CTL = 0;
constexpr size_t CTL_ZERO_BYTES = 1 * MiB;
constexpr size_t WS_WIN0 = 1 * MiB;
constexpr size_t WS_WIN1 = WS_WIN0 + (size_t)2560 * 1024 * 2;
constexpr size_t WS_WOUT = WS_WIN1 + (size_t)2816 * 1024 * 2;
constexpr size_t WS_WMKV = WS_WOUT + (size_t)2 * 1024 * 1024 * 2;
constexpr size_t WS_MEMN = WS_WMKV + (size_t)1024 * 1024 * 2;
constexpr size_t WS_MKV = WS_MEMN + (size_t)1024 * 1024 * 2;
constexpr size_t WS_W13 = 24 * MiB;
constexpr size_t WS_W2 = WS_W13 + 64 * MiB;
constexpr size_t WS_XN = WS_W2 + 32 * MiB;
constexpr size_t WS_U = WS_XN + 32 * MiB;
constexpr size_t WS_Y = WS_U;
constexpr size_t WS_CAT = WS_U + 88 * MiB;
constexpr size_t WS_ACT = WS_CAT + 32 * MiB;
constexpr size_t WS_ROUTE = WS_ACT + 40 * MiB;
constexpr size_t WS_S = WS_ROUTE + 4 * MiB;
constexpr size_t WS_END = WS_S + 96 * MiB;
static_assert(WS_MKV + (size_t)1024 * 1024 * 2 <= WS_W13, "ws map");
static_assert(WS_END <= 512 * MiB, "ws map");
constexpr size_t RT_TOKE = 0, RT_TOKW = 131072, RT_TOKP = 262144, RT_LIST = 524288;
constexpr int CW_CNT = 1024;
constexpr int CW_BAR = 4096;

struct Args {
    const float* in[21]; float* out; unsigned char* ws; int ph_lo, ph_hi;
};

__device__ __forceinline__ float bf2f(bf16 v) { return __uint_as_float(((unsigned)v) << 16); }
__device__ __forceinline__ unsigned f2bf(float f) { unsigned u = __float_as_uint(f); return (u + 0x7fffu + ((u >> 16) & 1u)) >> 16; }
__device__ __forceinline__ unsigned pk2(float lo, float hi) { return f2bf(lo) | (f2bf(hi) << 16); }
__device__ __forceinline__ float wave_sum(float v) {
#pragma unroll
    for (int o = 1; o < 64; o <<= 1) v += __shfl_xor(v, o);
    return v;
}
__device__ __forceinline__ float dot8(u32x4 a, u32x4 b) {
    float s = 0.f;
#pragma unroll
    for (int i = 0; i < 4; ++i) {
        s += __uint_as_float(a[i] << 16) * __uint_as_float(b[i] << 16);
        s += __uint_as_float(a[i] & 0xffff0000u) * __uint_as_float(b[i] & 0xffff0000u);
    }
    return s;
}
__device__ __forceinline__ float silu(float x) { return x / (1.f + __expf(-x)); }

struct Ctx {
    int tid, lane, wave, gw, ngw;
    LAS unsigned char* lds;
};
__device__ __forceinline__ long gtid_() { int t = blockIdx.x * 512 + threadIdx.x; asm volatile("" : "+v"(t)); return (long)t; }
#define GTID gtid_()
#define GSIZE ((long)gridDim.x * 512)

__device__ __forceinline__ void transpose_item(const float* W, int N, int k0, int n0, bf16* dstrow0, int Kd, LAS float* scr, int lane) {
#pragma unroll 8
    for (int i = 0; i < 32; ++i) { const int kk = 2 * i + (lane >> 5); scr[kk * 33 + (lane & 31)] = W[(size_t)(k0 + kk) * N + n0 + (lane & 31)]; }
    asm volatile("s_waitcnt lgkmcnt(0)" ::: "memory");
    const int c = lane & 7;
#pragma unroll
    for (int j = 0; j < 4; ++j) { const int n = (lane >> 3) + 8 * j; const LAS float* s = scr + (8 * c) * 33 + n;
        u32x4 o; o.x = pk2(s[0 * 33], s[1 * 33]); o.y = pk2(s[2 * 33], s[3 * 33]); o.z = pk2(s[4 * 33], s[5 * 33]); o.w = pk2(s[6 * 33], s[7 * 33]);
        *(u32x4*)(dstrow0 + (size_t)n * Kd + k0 + 8 * c) = o; }
    asm volatile("s_waitcnt lgkmcnt(0)" ::: "memory");
}
__device__ __forceinline__ void transpose_matrix(const Ctx& c, const float* W, int K, int N, bf16* dst, int it0, int itstride) {
    LAS float* scr = (LAS float*)(c.lds + c.wave * 16384);
    const int nblk = N / 32, nit = (K / 64) * nblk;
    for (int it = it0; it < nit; it += itstride) { const int kb = it / nblk, nb = it % nblk;
        transpose_item(W, N, kb * 64, nb * 32, dst + (size_t)(nb * 32) * K, K, scr, c.lane); }
}
__device__ __forceinline__ void convert_moe(const Ctx& c, const float* w1, const float* w3, const float* w2, bf16* W13, bf16* W2) {
    LAS float* scr = (LAS float*)(c.lds + c.wave * 16384);
    const int per_e = 768;
    for (int it = c.gw; it < NEXP * per_e; it += c.ngw) {
        const int e = it / per_e, r = it % per_e, which = r / 256, q = r % 256;
        if (which < 2) {
            const int kb = q / 16, nb = q % 16, n0 = nb * 32;
            const float* W = (which == 0 ? w1 : w3) + (size_t)e * 1024 * 512;
            const int drow = (n0 / 128) * 256 + which * 128 + (n0 % 128);
            transpose_item(W, 512, kb * 64, n0, W13 + ((size_t)e * 1024 + drow) * 1024, 1024, scr, c.lane);
        } else {
            const int kb = q / 32, nb = q % 32, n0 = nb * 32;
            const float* W = w2 + (size_t)e * 512 * 1024;
            transpose_item(W, 1024, kb * 64, n0, W2 + ((size_t)e * 1024 + n0) * 512, 512, scr, c.lane);
        }
    }
}
__device__ __forceinline__ void rms_row_to_bf16(const float* xrow, const float* g, bf16* orow, int lane) {
    const f32x4* xr = (const f32x4*)xrow + lane; const f32x4* gr = (const f32x4*)g + lane;
    f32x4 v[4]; float s = 0.f;
#pragma unroll
    for (int j = 0; j < 4; ++j) { v[j] = xr[64 * j]; s += (v[j].x * v[j].x + v[j].y * v[j].y) + (v[j].z * v[j].z + v[j].w * v[j].w); }
    const float r = 1.f / sqrtf(wave_sum(s) * (1.f / D) + EPS);
    u32x2* o8 = (u32x2*)orow + lane;
#pragma unroll
    for (int j = 0; j < 4; ++j) { const f32x4 gg = gr[64 * j]; u32x2 w; w.x = pk2(v[j].x * r * gg.x, v[j].y * r * gg.y); w.y = pk2(v[j].z * r * gg.z, v[j].w * r * gg.w); o8[64 * j] = w; }
}

template <class RowA, class Epi>
__device__ __forceinline__ void naive_gemm(const Ctx& c, int M, int N, int K, const RowA& rowA, const bf16* Bt, const Epi& epi) {
    const long total = (long)M * N;
    for (long idx = GTID; idx < total; idx += GSIZE) {
        const int m = (int)(idx / N), n = (int)(idx % N);
        const bf16* a = rowA(m);
        if (a == nullptr) continue;
        const u32x4* a4 = (const u32x4*)a; const u32x4* b4 = (const u32x4*)(Bt + (size_t)n * K);
        float acc = 0.f;
        for (int k8 = 0; k8 < K / 8; ++k8) acc += dot8(a4[k8], b4[k8]);
        epi(m, n, acc);
    }
}

__device__ __forceinline__ void naive_na(const Ctx& c, const bf16* U, const float* rpb, bf16* CAT) {
    const long total = (long)NTOK * NA_H;
    for (long idx = GTID; idx < total; idx += GSIZE) {
        const int h = (int)(idx % NA_H), t = (int)(idx / NA_H);
        const int b = t / SEQ, p = t % SEQ, r = p / 64, cc = p % 64;
        const int rs = min(max(r - 4, 0), 56), cs = min(max(cc - 8, 0), 48);
        const u32x4* q4 = (const u32x4*)(U + (size_t)t * LDU0 + h * 64);
        float acc[64];
#pragma unroll
        for (int i = 0; i < 64; ++i) acc[i] = 0.f;
        float mx = -1e30f, l = 0.f;
        for (int i = 0; i < 8; ++i) for (int j = 0; j < 16; ++j) {
            const int kr = rs + i, kc = cs + j, kt = b * SEQ + kr * 64 + kc;
            const u32x4* k4 = (const u32x4*)(U + (size_t)kt * LDU0 + 768 + h * 64);
            float s = 0.f;
#pragma unroll
            for (int d8 = 0; d8 < 8; ++d8) s += dot8(q4[d8], k4[d8]);
            s = s * 0.125f + rpb[(h * 15 + (kr - r + 7)) * 31 + (kc - cc + 15)];
            const float mn = fmaxf(mx, s), alpha = __expf(mx - mn), pp = __expf(s - mn);
            l = l * alpha + pp; mx = mn;
            const u32x4* v4 = (const u32x4*)(U + (size_t)kt * LDU0 + 1536 + h * 64);
#pragma unroll
            for (int d8 = 0; d8 < 8; ++d8) { const u32x4 vv = v4[d8];
#pragma unroll
                for (int e = 0; e < 4; ++e) { acc[d8 * 8 + 2 * e] = acc[d8 * 8 + 2 * e] * alpha + pp * __uint_as_float(vv[e] << 16);
                    acc[d8 * 8 + 2 * e + 1] = acc[d8 * 8 + 2 * e + 1] * alpha + pp * __uint_as_float(vv[e] & 0xffff0000u); } }
        }
        const float inv = 1.f / l;
        u32x4* o4 = (u32x4*)(CAT + (size_t)t * D + h * 64);
#pragma unroll
        for (int d8 = 0; d8 < 8; ++d8) { u32x4 w; w.x = pk2(acc[d8 * 8] * inv, acc[d8 * 8 + 1] * inv); w.y = pk2(acc[d8 * 8 + 2] * inv, acc[d8 * 8 + 3] * inv);
            w.z = pk2(acc[d8 * 8 + 4] * inv, acc[d8 * 8 + 5] * inv); w.w = pk2(acc[d8 * 8 + 6] * inv, acc[d8 * 8 + 7] * inv); o4[d8] = w; }
    }
}
__device__ __forceinline__ void naive_memattn(const Ctx& c, const bf16* U, int ldu, int mqcol, const bf16* MKV, int lay, bf16* CAT) {
    const long total = (long)NTOK * 4;
    for (long idx = GTID; idx < total; idx += GSIZE) {
        const int h = (int)(idx % 4), t = (int)(idx / 4), b = t / SEQ;
        const u32x4* q4 = (const u32x4*)(U + (size_t)t * ldu + mqcol + h * 64);
        float acc[64];
#pragma unroll
        for (int i = 0; i < 64; ++i) acc[i] = 0.f;
        float mx = -1e30f, l = 0.f;
        for (int m = 0; m < NMEM; ++m) {
            const bf16* row = MKV + (size_t)(b * NMEM + m) * 1024 + lay * 512;
            const u32x4* k4 = (const u32x4*)(row + h * 64);
            float s = 0.f;
#pragma unroll
            for (int d8 = 0; d8 < 8; ++d8) s += dot8(q4[d8], k4[d8]);
            s *= 0.125f;
            const float mn = fmaxf(mx, s), alpha = __expf(mx - mn), pp = __expf(s - mn);
            l = l * alpha + pp; mx = mn;
            const u32x4* v4 = (const u32x4*)(row + 256 + h * 64);
#pragma unroll
            for (int d8 = 0; d8 < 8; ++d8) { const u32x4 vv = v4[d8];
#pragma unroll
                for (int e = 0; e < 4; ++e) { acc[d8 * 8 + 2 * e] = acc[d8 * 8 + 2 * e] * alpha + pp * __uint_as_float(vv[e] << 16);
                    acc[d8 * 8 + 2 * e + 1] = acc[d8 * 8 + 2 * e + 1] * alpha + pp * __uint_as_float(vv[e] & 0xffff0000u); } }
        }
        const float inv = 1.f / l;
        u32x4* o4 = (u32x4*)(CAT + (size_t)t * D + MIX + h * 64);
#pragma unroll
        for (int d8 = 0; d8 < 8; ++d8) { u32x4 w; w.x = pk2(acc[d8 * 8] * inv, acc[d8 * 8 + 1] * inv); w.y = pk2(acc[d8 * 8 + 2] * inv, acc[d8 * 8 + 3] * inv);
            w.z = pk2(acc[d8 * 8 + 4] * inv, acc[d8 * 8 + 5] * inv); w.w = pk2(acc[d8 * 8 + 6] * inv, acc[d8 * 8 + 7] * inv); o4[d8] = w; }
    }
}

__device__ __forceinline__ void route_phase(const Ctx& c, const float* X, const float* g, const float* wg, const float* bg, const float* wr, const float* br,
                                            bf16* HN, unsigned char* rt, unsigned* cnt) {
    int* TOKE = (int*)(rt + RT_TOKE); float* TOKW = (float*)(rt + RT_TOKW); int* TOKP = (int*)(rt + RT_TOKP); int* LIST = (int*)(rt + RT_LIST);
    for (int t = c.gw; t < NTOK; t += c.ngw) {
        const f32x4* xr = (const f32x4*)(X + (size_t)t * D) + c.lane; const f32x4* gr = (const f32x4*)g + c.lane;
        f32x4 v[4]; float s = 0.f;
#pragma unroll
        for (int j = 0; j < 4; ++j) { v[j] = xr[64 * j]; s += (v[j].x * v[j].x + v[j].y * v[j].y) + (v[j].z * v[j].z + v[j].w * v[j].w); }
        const float r = 1.f / sqrtf(wave_sum(s) * (1.f / D) + EPS);
        u32x2* o8 = (u32x2*)(HN + (size_t)t * D) + c.lane;
#pragma unroll
        for (int j = 0; j < 4; ++j) { const f32x4 gg = gr[64 * j]; v[j].x *= r * gg.x; v[j].y *= r * gg.y; v[j].z *= r * gg.z; v[j].w *= r * gg.w;
            u32x2 w; w.x = pk2(v[j].x, v[j].y); w.y = pk2(v[j].z, v[j].w); o8[64 * j] = w; }
        LAS float* hrow = (LAS float*)(c.lds + c.wave * 16384);
#pragma unroll
        for (int j = 0; j < 4; ++j) *(LAS f32x4*)(hrow + 4 * c.lane + 256 * j) = v[j];
        asm volatile("s_waitcnt lgkmcnt(0)" ::: "memory");
        float lg[4], lr[32];
#pragma unroll
        for (int o = 0; o < 4; ++o) lg[o] = 0.f;
#pragma unroll
        for (int o = 0; o < 32; ++o) lr[o] = 0.f;
#pragma unroll 1
        for (int kk = 0; kk < 16; ++kk) { const int k = c.lane + 64 * kk; const float xv = hrow[k];
            const f32x4 w4 = *(const f32x4*)(wg + (size_t)k * 4);
#pragma unroll
            for (int o = 0; o < 4; ++o) lg[o] += xv * w4[o];
#pragma unroll
            for (int o4 = 0; o4 < 8; ++o4) { const f32x4 w = *(const f32x4*)(wr + (size_t)k * 32 + o4 * 4);
#pragma unroll
                for (int o = 0; o < 4; ++o) lr[o4 * 4 + o] += xv * w[o]; } }
        asm volatile("s_waitcnt lgkmcnt(0)" ::: "memory");
#pragma unroll
        for (int o = 0; o < 4; ++o) lg[o] = wave_sum(lg[o]) + bg[o];
#pragma unroll
        for (int o = 0; o < 32; ++o) lr[o] = wave_sum(lr[o]) + br[o];
        int gi = 0; float gm = lg[0];
#pragma unroll
        for (int o = 1; o < 4; ++o) if (lg[o] > gm) { gm = lg[o]; gi = o; }
        float gs = 0.f;
#pragma unroll
        for (int o = 0; o < 4; ++o) gs += __expf(lg[o] - gm);
        const float ggate = 1.f / gs;
        float el[8];
#pragma unroll
        for (int o = 0; o < 8; ++o) { float x = lr[o];
#pragma unroll
            for (int q = 1; q < 4; ++q) x = (gi == q) ? lr[q * 8 + o] : x;
            el[o] = x; }
        int i0 = 0; float l0 = el[0];
#pragma unroll
        for (int o = 1; o < 8; ++o) if (el[o] > l0) { l0 = el[o]; i0 = o; }
        int i1 = -1; float l1 = -3.0e38f;
#pragma unroll
        for (int o = 0; o < 8; ++o) if (o != i0 && el[o] > l1) { l1 = el[o]; i1 = o; }
        const float e1 = __expf(l1 - l0), den = 1.f / (1.f + e1);
        const float w0 = den * ggate, w1 = e1 * den * ggate;
        if (c.lane == 0) {
            const int ex0 = gi * 8 + i0, ex1 = gi * 8 + i1;
            const unsigned p0 = atomicAdd(cnt + ex0, 1u), p1 = atomicAdd(cnt + ex1, 1u);
            LIST[ex0 * NTOK + p0] = t; LIST[ex1 * NTOK + p1] = t;
            TOKE[2 * t] = ex0; TOKE[2 * t + 1] = ex1; TOKW[2 * t] = w0; TOKW[2 * t + 1] = w1; TOKP[2 * t] = (int)p0; TOKP[2 * t + 1] = (int)p1;
        }
    }
}
__device__ __forceinline__ int pstart_of(const unsigned* cnt, int e) { int s = 0; for (int i = 0; i < e; ++i) s += ((int)cnt[i] + 255) & ~255; return s; }
__device__ __forceinline__ bool row_lookup(const unsigned* cnt, int R, int& e, int& i, int& n) {
    int s = 0;
    for (int x = 0; x < NEXP; ++x) { const int cn = (int)cnt[x], pc = (cn + 255) & ~255; if (R < s + pc) { e = x; i = R - s; n = cn; return true; } s += pc; }
    return false;
}

__device__ __forceinline__ void combine_phase(const Ctx& c, float* X, const bf16* Y, const unsigned char* rt, const unsigned* cnt, const float* g, bf16* XN, float* OUTF) {
    const int* TOKE = (const int*)(rt + RT_TOKE); const int* TOKP = (const int*)(rt + RT_TOKP);
    for (int t = c.gw; t < NTOK; t += c.ngw) {
        const int e0 = TOKE[2 * t], e1 = TOKE[2 * t + 1];
        const int R0 = pstart_of(cnt, e0) + TOKP[2 * t], R1 = pstart_of(cnt, e1) + TOKP[2 * t + 1];
        f32x4* xr = (f32x4*)(X + (size_t)t * D) + c.lane; const f32x4* gr = (const f32x4*)g + c.lane;
        const u32x2* y0 = (const u32x2*)(Y + (size_t)R0 * D) + c.lane; const u32x2* y1 = (const u32x2*)(Y + (size_t)R1 * D) + c.lane;
        f32x4 v[4]; float s = 0.f;
#pragma unroll
        for (int j = 0; j < 4; ++j) { v[j] = xr[64 * j]; const u32x2 a = y0[64 * j], b = y1[64 * j];
            v[j].x += __uint_as_float(a.x << 16) + __uint_as_float(b.x << 16); v[j].y += __uint_as_float(a.x & 0xffff0000u) + __uint_as_float(b.x & 0xffff0000u);
            v[j].z += __uint_as_float(a.y << 16) + __uint_as_float(b.y << 16); v[j].w += __uint_as_float(a.y & 0xffff0000u) + __uint_as_float(b.y & 0xffff0000u);
            s += (v[j].x * v[j].x + v[j].y * v[j].y) + (v[j].z * v[j].z + v[j].w * v[j].w); }
        const float r = 1.f / sqrtf(wave_sum(s) * (1.f / D) + EPS);
        if (XN) {
            u32x2* o8 = (u32x2*)(XN + (size_t)t * D) + c.lane;
#pragma unroll
            for (int j = 0; j < 4; ++j) { xr[64 * j] = v[j]; const f32x4 gg = gr[64 * j]; u32x2 w; w.x = pk2(v[j].x * r * gg.x, v[j].y * r * gg.y); w.y = pk2(v[j].z * r * gg.z, v[j].w * r * gg.w); o8[64 * j] = w; }
        } else {
            f32x4* o = (f32x4*)(OUTF + (size_t)t * D) + c.lane;
#pragma unroll
            for (int j = 0; j < 4; ++j) { const f32x4 gg = gr[64 * j]; f32x4 w; w.x = v[j].x * r * gg.x; w.y = v[j].y * r * gg.y; w.z = v[j].z * r * gg.z; w.w = v[j].w * r * gg.w; o[64 * j] = w; }
        }
    }
}

__device__ __forceinline__ void gla_decay(const Ctx& c, const bf16* U, const float* gup, const float* gbias, float* DECA) {
    const long total = (long)NTOK * 2 * GLA_KD;
    for (long idx = GTID; idx < total; idx += GSIZE) {
        const int cc = (int)(idx % GLA_KD), dir = (int)((idx / GLA_KD) % 2), t = (int)(idx / (2 * GLA_KD));
        const bf16* r = U + (size_t)t * LDU1 + 2304 + dir * 16;
        float z = gbias[dir * GLA_KD + cc];
#pragma unroll
        for (int k = 0; k < 16; ++k) z += bf2f(r[k]) * gup[(dir * 16 + k) * GLA_KD + cc];
        const float ls = fminf(z, 0.f) - log1pf(__expf(-fabsf(z)));
        DECA[idx] = __expf(ls * (1.f / 16.f));
    }
}
__device__ __forceinline__ void gla_recur(const Ctx& c, const bf16* U, const float* DECA, float* OF) {
    const long total = (long)NBATCH * GLA_H * GLA_DV * 2;
    const float qs = 0.10206207261596577f;
    for (long idx = GTID; idx < total; idx += GSIZE) {
        const int half = (int)(idx & 1), dv = (int)((idx >> 1) % GLA_DV), h = (int)(((idx >> 1) / GLA_DV) % GLA_H), b = (int)((idx >> 1) / (GLA_DV * GLA_H));
        float S[48];
        for (int dir = 0; dir < 2; ++dir) {
#pragma unroll
            for (int d = 0; d < 48; ++d) S[d] = 0.f;
            for (int s = 0; s < SEQ; ++s) {
                const int p = dir ? (SEQ - 1 - s) : s, t = b * SEQ + p;
                const bf16* row = U + (size_t)t * LDU1;
                const float vv = bf2f(row[768 + h * GLA_DV + dv]);
                const float* a = DECA + ((size_t)t * 2 + dir) * GLA_KD + h * GLA_DK + half * 48;
                const u32x4* q4 = (const u32x4*)(row + h * GLA_DK + half * 48); const u32x4* k4 = (const u32x4*)(row + 384 + h * GLA_DK + half * 48);
                float o = 0.f;
#pragma unroll
                for (int d8 = 0; d8 < 6; ++d8) { const u32x4 qq = q4[d8], kk = k4[d8]; const f32x4 a0 = *(const f32x4*)(a + d8 * 8), a1 = *(const f32x4*)(a + d8 * 8 + 4);
#pragma unroll
                    for (int e = 0; e < 4; ++e) { const float aa0 = e < 2 ? a0[2 * e] : a1[2 * e - 4], aa1 = e < 2 ? a0[2 * e + 1] : a1[2 * e - 3];
                        const float s0 = aa0 * S[d8 * 8 + 2 * e] + __uint_as_float(kk[e] << 16) * vv; S[d8 * 8 + 2 * e] = s0; o += __uint_as_float(qq[e] << 16) * s0;
                        const float s1 = aa1 * S[d8 * 8 + 2 * e + 1] + __uint_as_float(kk[e] & 0xffff0000u) * vv; S[d8 * 8 + 2 * e + 1] = s1; o += __uint_as_float(qq[e] & 0xffff0000u) * s1; } }
                o += __shfl_xor(o, 1);
                float* dst = OF + (size_t)t * MIX + h * GLA_DV + dv;
                if (half == 0) { if (dir == 0) *dst = o * qs; else *dst += o * qs; }
            }
        }
    }
}
__device__ __forceinline__ void gla_norm_gate(const Ctx& c, const float* OF, const bf16* U, const float* onorm, bf16* CAT) {
    for (int it = c.gw; it < NTOK * GLA_H; it += c.ngw) {
        const int h = it % GLA_H, t = it / GLA_H;
        const float* o = OF + (size_t)t * MIX + h * GLA_DV;
        float v[3]; float s = 0.f;
#pragma unroll
        for (int j = 0; j < 3; ++j) { v[j] = o[c.lane + 64 * j]; s += v[j] * v[j]; }
        const float r = 1.f / sqrtf(wave_sum(s) * (1.f / GLA_DV) + EPS);
#pragma unroll
        for (int j = 0; j < 3; ++j) { const int dv = c.lane + 64 * j; const float gg = bf2f(U[(size_t)t * LDU1 + 1536 + h * GLA_DV + dv]);
            CAT[(size_t)t * D + h * GLA_DV + dv] = (bf16)f2bf(v[j] * r * onorm[dv] * silu(gg)); }
    }
}


#define XB_TMO      128
#define XB_XCNT(j)  (256  + 64 * (j))
#define XB_XSUB(j)  (1280 + 64 * (j))
#define XB_XGEN(j)  (2304 + 64 * (j))
#define XB_TOP      3328
#define XB_TOPGEN   3392
#define XCD_BAR_WORDS 3456
#define XB_SPIN_CAP (1u << 22)
__device__ __forceinline__ unsigned xb_ld(unsigned* p)              { return __hip_atomic_load(p, __ATOMIC_RELAXED, __HIP_MEMORY_SCOPE_AGENT); }
__device__ __forceinline__ unsigned xb_add(unsigned* p, unsigned v) { return __hip_atomic_fetch_add(p, v, __ATOMIC_RELAXED, __HIP_MEMORY_SCOPE_AGENT); }
__device__ __forceinline__ unsigned xb_xcc_id() { return (unsigned)__builtin_amdgcn_s_getreg((3 << 11) | 20) & 0xFu; }
#define XB_SPIN(cond, bar) do { unsigned _sp = 0; while (cond) { __builtin_amdgcn_s_sleep(1); \
    if ((++_sp & 255u) == 0u) { if (xb_ld(&(bar)[XB_TMO])) break; if (_sp > XB_SPIN_CAP) { atomicAdd(&(bar)[XB_TMO], 1u); break; } } } } while (0)
struct XcdBarrier { unsigned* bar; unsigned x; volatile LAS unsigned* st; };
__device__ __forceinline__ XcdBarrier xcd_barrier_post(unsigned* bar, volatile LAS unsigned* st) {
    XcdBarrier b; b.bar = bar; b.x = xb_xcc_id(); b.st = st;
    if (threadIdx.x == 0) (void)xb_add(&bar[XB_XCNT(b.x)], 1u);
    return b;
}
__device__ __forceinline__ void xcd_barrier_complete(unsigned* bar, unsigned x, unsigned& nloc, unsigned& nx) {
    const unsigned G = gridDim.x * gridDim.y * gridDim.z;
    unsigned sum, cnt, mine, sp = 0u;
    for (;;) {
        sum = 0u; cnt = 0u; mine = 0u;
#pragma unroll
        for (unsigned j = 0; j < 16; ++j) { const unsigned c = xb_ld(&bar[XB_XCNT(j)]); sum += c; cnt += (c > 0u) ? 1u : 0u; mine = (j == x) ? c : mine; }
        if (sum == G) break;
        __builtin_amdgcn_s_sleep(1);
        if ((++sp & 255u) == 0u) { if (xb_ld(&bar[XB_TMO])) break; if (sp > XB_SPIN_CAP) { atomicAdd(&bar[XB_TMO], 1u); break; } }
    }
    nloc = mine > 0u ? mine : 1u; nx = cnt > 0u ? cnt : 1u;
}
__device__ __forceinline__ void xcd_barrier(const XcdBarrier& b) {
    asm volatile("s_waitcnt vmcnt(0)" ::: "memory");
    __syncthreads();
    if (threadIdx.x == 0) {
        unsigned* bar = b.bar;
        __builtin_amdgcn_s_waitcnt(0);
        unsigned nloc = b.st[0], nx = b.st[1];
        if (nloc == 0u) { xcd_barrier_complete(bar, b.x, nloc, nx); b.st[0] = nloc; b.st[1] = nx; }
        const unsigned old = xb_add(&bar[XB_XSUB(b.x)], 1u);
        const unsigned gen = old / nloc;
        if (old + 1u == (gen + 1u) * nloc) {
            __builtin_amdgcn_fence(__ATOMIC_RELEASE, "agent");
            asm volatile("s_waitcnt vmcnt(0)" ::: "memory");
            const unsigned og = xb_add(&bar[XB_TOP], 1u);
            const unsigned tg = og / nx;
            if (og + 1u == (tg + 1u) * nx) xb_add(&bar[XB_TOPGEN], 1u);
            else XB_SPIN(xb_ld(&bar[XB_TOPGEN]) == tg, bar);
            __builtin_amdgcn_fence(__ATOMIC_ACQUIRE, "agent");
            xb_add(&bar[XB_XGEN(b.x)], 1u);
            asm volatile("s_waitcnt vmcnt(0)" ::: "memory");
        } else {
            XB_SPIN(xb_ld(&bar[XB_XGEN(b.x)]) == gen, bar);
            __builtin_amdgcn_fence(__ATOMIC_ACQUIRE, "agent");
            asm volatile("s_waitcnt vmcnt(0)" ::: "memory");
        }
    }
    __syncthreads();
}

constexpr int NWAVES = 8, NTHREADS = 512, LDS_BYTES = 147456, MISC_OFF = 131072 + 1024;
constexpr int NPHASES = 19;

template <int PH_LO, int PH_HI> __global__ void __launch_bounds__(NTHREADS, 2) mk_fwd(Args args) {
    extern __shared__ __attribute__((aligned(16))) unsigned char lds_raw[];
    Ctx c; c.tid = threadIdx.x; c.lane = c.tid & 63; c.wave = __builtin_amdgcn_readfirstlane(c.tid >> 6);
    c.gw = blockIdx.x * NWAVES + c.wave; c.ngw = gridDim.x * NWAVES;
    c.lds = (LAS unsigned char*)lds_raw;
    unsigned char* ws = args.ws;
    const float* x = args.in[0]; const float* mem = args.in[1]; const float* mem_norm = args.in[2]; const float* final_norm = args.in[3];
    const float* norm_mix = args.in[4]; const float* norm_ffn = args.in[5]; const float* w_mem_kv = args.in[6]; const float* w_out = args.in[7];
    const float* na_w_in = args.in[8]; const float* na_rpb = args.in[9]; const float* gla_w_in = args.in[10]; const float* gla_gate_up = args.in[11];
    const float* gla_gate_bias = args.in[12]; const float* gla_out_norm = args.in[13]; const float* moe_w_group = args.in[14]; const float* moe_b_group = args.in[15];
    const float* moe_w_router = args.in[16]; const float* moe_b_router = args.in[17]; const float* moe_w1 = args.in[18]; const float* moe_w3 = args.in[19]; const float* moe_w2 = args.in[20];
    float* X = args.out;
    bf16* WIN0 = (bf16*)(ws + WS_WIN0); bf16* WIN1 = (bf16*)(ws + WS_WIN1); bf16* WOUT = (bf16*)(ws + WS_WOUT); bf16* WMKV = (bf16*)(ws + WS_WMKV);
    bf16* MEMN = (bf16*)(ws + WS_MEMN); bf16* MKV = (bf16*)(ws + WS_MKV); bf16* W13 = (bf16*)(ws + WS_W13); bf16* W2 = (bf16*)(ws + WS_W2);
    bf16* XN = (bf16*)(ws + WS_XN); bf16* U = (bf16*)(ws + WS_U); bf16* Y = (bf16*)(ws + WS_Y); bf16* CAT = (bf16*)(ws + WS_CAT); bf16* ACT = (bf16*)(ws + WS_ACT);
    unsigned char* RT = ws + WS_ROUTE; float* DECA = (float*)(ws + WS_S); float* OF = (float*)(ws + WS_S + 48 * MiB);
    unsigned* CTL = (unsigned*)(ws + WS_CTL);
#define IN(k) (PH_LO <= (k) && (k) < PH_HI)
    constexpr bool FUSED = (PH_HI - PH_LO) > 1;
    XcdBarrier bar; bar.bar = CTL + CW_BAR; bar.x = 0; bar.st = nullptr;
    if constexpr (FUSED) {
        volatile LAS unsigned* misc = (volatile LAS unsigned*)(c.lds + MISC_OFF);
        if (c.tid < 64) misc[c.tid] = 0u;
        __syncthreads();
        bar = xcd_barrier_post(CTL + CW_BAR, misc + 8);
    }
#define GRID_BAR(k) do { if constexpr (FUSED) { if (IN((k) + 1)) xcd_barrier(bar); } } while (0)

    if (IN(0)) {
        transpose_matrix(c, na_w_in, 1024, NA_IN, WIN0, c.gw, c.ngw);
        transpose_matrix(c, gla_w_in, 1024, GLA_IN, WIN1, c.gw, c.ngw);
        for (long i = GTID; i < (long)(2816 - 2592) * 1024 / 8; i += GSIZE) ((u32x4*)(WIN1 + (size_t)2592 * 1024))[i] = (u32x4){0u, 0u, 0u, 0u};
        for (int l = 0; l < 2; ++l) { transpose_matrix(c, w_out + (size_t)l * D * D, 1024, 1024, WOUT + (size_t)l * D * D, c.gw, c.ngw);
            transpose_matrix(c, w_mem_kv + (size_t)l * D * 512, 1024, 512, WMKV + (size_t)l * 512 * 1024, c.gw, c.ngw); }
        convert_moe(c, moe_w1, moe_w3, moe_w2, W13, W2);
        for (int m = c.gw; m < NBATCH * NMEM; m += c.ngw) rms_row_to_bf16(mem + (size_t)m * D, mem_norm, MEMN + (size_t)m * D, c.lane);
        for (int m = c.gw; m < NTOK; m += c.ngw) rms_row_to_bf16(x + (size_t)m * D, norm_mix, XN + (size_t)m * D, c.lane);
        GRID_BAR(0);
    }
#pragma unroll
    for (int L = 0; L < 2; ++L) {
        const int pb = 1 + 9 * L;
        const int ldu = L == 0 ? LDU0 : LDU1;
        unsigned* cnt = CTL + CW_CNT + 64 * L;
        if (IN(pb)) {
            if (L == 0) {
                naive_gemm(c, NTOK, NA_IN, D, [&](int m) { return XN + (size_t)m * D; }, WIN0, [&](int m, int n, float a) { U[(size_t)m * LDU0 + n] = (bf16)f2bf(a); });
                naive_gemm(c, NBATCH * NMEM, 1024, D, [&](int m) { return MEMN + (size_t)m * D; }, WMKV, [&](int m, int n, float a) { MKV[(size_t)m * 1024 + n] = (bf16)f2bf(a); });
            } else {
                naive_gemm(c, NTOK, LDU1, D, [&](int m) { return XN + (size_t)m * D; }, WIN1, [&](int m, int n, float a) { U[(size_t)m * LDU1 + n] = (bf16)f2bf(a); });
            }
            GRID_BAR(pb);
        }
        if (IN(pb + 1)) {
            if (L == 0) { naive_na(c, U, na_rpb, CAT); naive_memattn(c, U, LDU0, 2304, MKV, 0, CAT); }
            else { gla_decay(c, U, gla_gate_up, gla_gate_bias, DECA); naive_memattn(c, U, LDU1, 2336, MKV, 1, CAT); }
            GRID_BAR(pb + 1);
        }
        if (IN(pb + 2)) {
            if (L == 1) { gla_recur(c, U, DECA, OF); GRID_BAR(pb + 2); }
        }
        if (IN(pb + 3)) {
            if (L == 1) { gla_norm_gate(c, OF, U, gla_out_norm, CAT); GRID_BAR(pb + 3); }
        }
        if (IN(pb + 4)) {
            const float* resid = L == 0 ? x : X;
            naive_gemm(c, NTOK, D, D, [&](int m) { return CAT + (size_t)m * D; }, WOUT + (size_t)L * D * D, [&](int m, int n, float a) { X[(size_t)m * D + n] = resid[(size_t)m * D + n] + a; });
            GRID_BAR(pb + 4);
        }
        if (IN(pb + 5)) {
            route_phase(c, X, norm_ffn + L * D, moe_w_group + (size_t)L * D * 4, moe_b_group + L * 4, moe_w_router + (size_t)L * D * 32, moe_b_router + L * 32, XN, RT, cnt);
            GRID_BAR(pb + 5);
        }
        if (IN(pb + 6)) {
            const int* LIST = (const int*)(RT + RT_LIST);
            const long total = (long)MAXROWS * EFF;
            for (long idx = GTID; idx < total; idx += GSIZE) {
                const int R = (int)(idx / EFF), j = (int)(idx % EFF); int e, i, n;
                if (!row_lookup(cnt, R, e, i, n) || i >= n) continue;
                const int t = LIST[e * NTOK + i];
                const u32x4* a4 = (const u32x4*)(XN + (size_t)t * D);
                const int r1 = (j / 128) * 256 + (j % 128);
                const u32x4* b1 = (const u32x4*)(W13 + ((size_t)e * 1024 + r1) * 1024); const u32x4* b3 = (const u32x4*)(W13 + ((size_t)e * 1024 + r1 + 128) * 1024);
                float s1 = 0.f, s3 = 0.f;
                for (int k8 = 0; k8 < D / 8; ++k8) { const u32x4 av = a4[k8]; s1 += dot8(av, b1[k8]); s3 += dot8(av, b3[k8]); }
                ACT[(size_t)R * EFF + j] = (bf16)f2bf(silu(s1) * s3);
            }
            GRID_BAR(pb + 6);
        }
        if (IN(pb + 7)) {
            const int* LIST = (const int*)(RT + RT_LIST); const int* TOKE = (const int*)(RT + RT_TOKE); const float* TOKW = (const float*)(RT + RT_TOKW);
            const long total = (long)MAXROWS * D;
            for (long idx = GTID; idx < total; idx += GSIZE) {
                const int R = (int)(idx / D), n = (int)(idx % D); int e, i, cn;
                if (!row_lookup(cnt, R, e, i, cn) || i >= cn) continue;
                const int t = LIST[e * NTOK + i];
                const float w = (TOKE[2 * t] == e) ? TOKW[2 * t] : TOKW[2 * t + 1];
                const u32x4* a4 = (const u32x4*)(ACT + (size_t)R * EFF); const u32x4* b4 = (const u32x4*)(W2 + ((size_t)e * 1024 + n) * 512);
                float s = 0.f;
                for (int k8 = 0; k8 < EFF / 8; ++k8) s += dot8(a4[k8], b4[k8]);
                Y[(size_t)R * D + n] = (bf16)f2bf(s * w);
            }
            GRID_BAR(pb + 7);
        }
        if (IN(pb + 8)) {
            if (L == 0) { combine_phase(c, X, Y, RT, cnt, norm_mix + D, XN, nullptr);
                convert_moe(c, moe_w1 + (size_t)NEXP * D * EFF, moe_w3 + (size_t)NEXP * D * EFF, moe_w2 + (size_t)NEXP * EFF * D, W13, W2); }
            else combine_phase(c, X, Y, RT, cnt, final_norm, nullptr, X);
            if (L == 0) GRID_BAR(pb + 8);
        }
    }
#undef IN
}

template <int P> static void launch_phases(int grid, hipStream_t stream, const Args& a) {
    if constexpr (P < NPHASES) {
        if constexpr (P != 3 && P != 4) {
            static bool attr_done = false;
            if (!attr_done) { (void)hipFuncSetAttribute((const void*)mk_fwd<P, P + 1>, hipFuncAttributeMaxDynamicSharedMemorySize, LDS_BYTES); attr_done = true; }
            hipLaunchKernelGGL((mk_fwd<P, P + 1>), dim3(grid), dim3(NTHREADS), LDS_BYTES, stream, a);
        }
        launch_phases<P + 1>(grid, stream, a);
    }
}
extern "C" void kernel_launch(void* const* d_in, const int* in_sizes, int n_in, void* d_out, int out_size, void* d_ws, size_t ws_size, hipStream_t stream) {
    static int grid = 0;
    if (grid == 0) {
        if (n_in != 21 || out_size != NTOK * D || ws_size < WS_END) { fprintf(stderr, "kernel_launch: unexpected shapes n_in %d out %d ws %zu (need %zu)\n", n_in, out_size, ws_size, (size_t)WS_END); grid = -1; return; }
        int dev = 0, cus = 0;
        if (hipGetDevice(&dev) != hipSuccess || hipDeviceGetAttribute(&cus, hipDeviceAttributeMultiprocessorCount, dev) != hipSuccess) { grid = -1; return; }
        (void)hipGetLastError();
        grid = cus;
    }
    if (grid < 0) return;
    (void)hipMemsetAsync((char*)d_ws + WS_CTL, 0, CTL_ZERO_BYTES, stream);
    Args a{};
    for (int i = 0; i < 21; ++i) a.in[i] = (const float*)d_in[i];
    a.out = (float*)d_out; a.ws = (unsigned char*)d_ws;
#if defined(MK_PER_PHASE)
    launch_phases<0>(grid, stream, a);
#else
    static bool attr_done = false;
    if (!attr_done) { (void)hipFuncSetAttribute((const void*)mk_fwd<0, NPHASES>, hipFuncAttributeMaxDynamicSharedMemorySize, LDS_BYTES); attr_done = true; }
    hipLaunchKernelGGL((mk_fwd<0, NPHASES>), dim3(grid), dim3(NTHREADS), LDS_BYTES, stream, a);
#endif
}
```

```cpp
#include <hip/hip_runtime.h>
#include <cstdio>
#include <cstdint>

constexpr int D = 1024, NTOK = 16384, SEQ = 4096, NBATCH = 4, NMEM = 256, HD = 64;
constexpr int MIX = 768, MEMD = 256, NA_H = 12, NA_IN = 2560;
constexpr int GLA_H = 4, GLA_DK = 96, GLA_DV = 192, GLA_IN = 2592, GLA_KD = 384;
constexpr int NEXP = 32, EFF = 512;
constexpr int LDU0 = 2560, LDU1 = 2816;
constexpr int MAXROWS = 40960;
constexpr float EPS = 1e-6f;

typedef unsigned short bf16;
typedef float f32x4 __attribute__((ext_vector_type(4)));
typedef unsigned u32x4 __attribute__((ext_vector_type(4)));
typedef unsigned u32x2 __attribute__((ext_vector_type(2)));
#define LAS __attribute__((address_space(3)))

constexpr size_t MiB = 1048576;
constexpr size_t WS_CTL = 0;
constexpr size_t CTL_ZERO_BYTES = 1 * MiB;
constexpr size_t WS_WIN0 = 1 * MiB;
constexpr size_t WS_WIN1 = WS_WIN0 + (size_t)2560 * 1024 * 2;
constexpr size_t WS_WOUT = WS_WIN1 + (size_t)2816 * 1024 * 2;
constexpr size_t WS_WMKV = WS_WOUT + (size_t)2 * 1024 * 1024 * 2;
constexpr size_t WS_MEMN = WS_WMKV + (size_t)1024 * 1024 * 2;
constexpr size_t WS_MKV = WS_MEMN + (size_t)1024 * 1024 * 2;
constexpr size_t WS_W13 = 24 * MiB;
constexpr size_t WS_W2 = WS_W13 + 64 * MiB;
constexpr size_t WS_XN = WS_W2 + 32 * MiB;
constexpr size_t WS_U = WS_XN + 32 * MiB;
constexpr size_t WS_Y = WS_U;
constexpr size_t WS_CAT = WS_U + 88 * MiB;
constexpr size_t WS_ACT = WS_CAT + 32 * MiB;
constexpr size_t WS_ROUTE = WS_ACT + 40 * MiB;
constexpr size_t WS_S = WS_ROUTE + 8 * MiB;
constexpr size_t WS_END = WS_S + 96 * MiB;
static_assert(WS_MKV + (size_t)1024 * 1024 * 2 <= WS_W13, "ws map");
static_assert(WS_END <= 512 * MiB, "ws map");
constexpr size_t RT_TOKE = 0, RT_TOKW = 131072, RT_TOKP = 262144, RT_LIST = 524288, RT_LISTW = 524288 + 2 * MiB;
constexpr int CW_CNT = 1024;
constexpr int CW_BAR = 4096;

struct Args {
    const float* in[21]; float* out; unsigned char* ws; int ph_lo, ph_hi;
};

__device__ __forceinline__ float bf2f(bf16 v) { return __uint_as_float(((unsigned)v) << 16); }
__device__ __forceinline__ unsigned f2bf(float f) { unsigned u = __float_as_uint(f); return (u + 0x7fffu + ((u >> 16) & 1u)) >> 16; }
__device__ __forceinline__ unsigned pk2(float lo, float hi) { return f2bf(lo) | (f2bf(hi) << 16); }
__device__ __forceinline__ float wave_sum(float v) {
#pragma unroll
    for (int o = 1; o < 64; o <<= 1) v += __shfl_xor(v, o);
    return v;
}
__device__ __forceinline__ float dot8(u32x4 a, u32x4 b) {
    float s = 0.f;
#pragma unroll
    for (int i = 0; i < 4; ++i) {
        s += __uint_as_float(a[i] << 16) * __uint_as_float(b[i] << 16);
        s += __uint_as_float(a[i] & 0xffff0000u) * __uint_as_float(b[i] & 0xffff0000u);
    }
    return s;
}
__device__ __forceinline__ float silu(float x) { return x / (1.f + __expf(-x)); }

struct Ctx {
    int tid, lane, wave, gw, ngw;
    LAS unsigned char* lds;
};
__device__ __forceinline__ Ctx fresh_ctx(LAS unsigned char* lds) {
    Ctx c; int t = threadIdx.x; asm volatile("" : "+v"(t)); int b = blockIdx.x; asm volatile("" : "+s"(b));
    c.tid = t; c.lane = t & 63; c.wave = __builtin_amdgcn_readfirstlane(t >> 6); c.gw = b * 8 + c.wave; c.ngw = gridDim.x * 8; c.lds = lds; return c;
}
__device__ __forceinline__ long gtid_() { int t = threadIdx.x; asm volatile("" : "+v"(t)); int b = blockIdx.x; asm volatile("" : "+s"(b)); return (long)(b * 512 + t); }
#define GTID gtid_()
#define GSIZE ((long)gridDim.x * 512)

__device__ __forceinline__ void transpose_item(const float* W, int N, int k0, int n0, bf16* dstrow0, int Kd, LAS float* scr, int lane) {
#pragma unroll 8
    for (int i = 0; i < 32; ++i) { const int kk = 2 * i + (lane >> 5); scr[kk * 33 + (lane & 31)] = W[(size_t)(k0 + kk) * N + n0 + (lane & 31)]; }
    asm volatile("s_waitcnt lgkmcnt(0)" ::: "memory");
    const int c = lane & 7;
#pragma unroll
    for (int j = 0; j < 4; ++j) { const int n = (lane >> 3) + 8 * j; const LAS float* s = scr + (8 * c) * 33 + n;
        u32x4 o; o.x = pk2(s[0 * 33], s[1 * 33]); o.y = pk2(s[2 * 33], s[3 * 33]); o.z = pk2(s[4 * 33], s[5 * 33]); o.w = pk2(s[6 * 33], s[7 * 33]);
        *(u32x4*)(dstrow0 + (size_t)n * Kd + k0 + 8 * c) = o; }
    asm volatile("s_waitcnt lgkmcnt(0)" ::: "memory");
}
__device__ __forceinline__ void transpose_matrix(const Ctx& c, const float* W, int K, int N, bf16* dst, int it0, int itstride) {
    LAS float* scr = (LAS float*)(c.lds + c.wave * 16384);
    const int nblk = N / 32, nit = (K / 64) * nblk;
    for (int it = it0; it < nit; it += itstride) { const int kb = it / nblk, nb = it % nblk;
        transpose_item(W, N, kb * 64, nb * 32, dst + (size_t)(nb * 32) * K, K, scr, c.lane); }
}
__device__ __forceinline__ void convert_moe(const Ctx& c, const float* w1, const float* w3, const float* w2, bf16* W13, bf16* W2) {
    LAS float* scr = (LAS float*)(c.lds + c.wave * 16384);
    const int per_e = 768;
    for (int it = c.gw; it < NEXP * per_e; it += c.ngw) {
        const int e = it / per_e, r = it % per_e, which = r / 256, q = r % 256;
        if (which < 2) {
            const int kb = q / 16, nb = q % 16, n0 = nb * 32;
            const float* W = (which == 0 ? w1 : w3) + (size_t)e * 1024 * 512;
            const int drow = (n0 / 128) * 256 + which * 128 + (n0 % 128);
            transpose_item(W, 512, kb * 64, n0, W13 + ((size_t)e * 1024 + drow) * 1024, 1024, scr, c.lane);
        } else {
            const int kb = q / 32, nb = q % 32, n0 = nb * 32;
            const float* W = w2 + (size_t)e * 512 * 1024;
            transpose_item(W, 1024, kb * 64, n0, W2 + ((size_t)e * 1024 + n0) * 512, 512, scr, c.lane);
        }
    }
}
__device__ __forceinline__ void rms_row_to_bf16(const float* xrow, const float* g, bf16* orow, int lane) {
    const f32x4* xr = (const f32x4*)xrow + lane; const f32x4* gr = (const f32x4*)g + lane;
    f32x4 v[4]; float s = 0.f;
#pragma unroll
    for (int j = 0; j < 4; ++j) { v[j] = xr[64 * j]; s += (v[j].x * v[j].x + v[j].y * v[j].y) + (v[j].z * v[j].z + v[j].w * v[j].w); }
    const float r = 1.f / sqrtf(wave_sum(s) * (1.f / D) + EPS);
    u32x2* o8 = (u32x2*)orow + lane;
#pragma unroll
    for (int j = 0; j < 4; ++j) { const f32x4 gg = gr[64 * j]; u32x2 w; w.x = pk2(v[j].x * r * gg.x, v[j].y * r * gg.y); w.y = pk2(v[j].z * r * gg.z, v[j].w * r * gg.w); o8[64 * j] = w; }
}

template <class RowA, class Epi>
__device__ __forceinline__ void naive_gemm(const Ctx& c, int M, int N, int K, const RowA& rowA, const bf16* Bt, const Epi& epi) {
    const long total = (long)M * N;
    for (long idx = GTID; idx < total; idx += GSIZE) {
        const int m = (int)(idx / N), n = (int)(idx % N);
        const bf16* a = rowA(m);
        if (a == nullptr) continue;
        const u32x4* a4 = (const u32x4*)a; const u32x4* b4 = (const u32x4*)(Bt + (size_t)n * K);
        float acc = 0.f;
        for (int k8 = 0; k8 < K / 8; ++k8) acc += dot8(a4[k8], b4[k8]);
        epi(m, n, acc);
    }
}


namespace pg8 {
typedef short bf16x8 __attribute__((ext_vector_type(8)));
constexpr int BM = 256, BK = 64, HALF = 128, HTB = HALF * BK * 2, STAGE_BYTES = 8 * HTB, NXCD = 8, WGM = 8;
__device__ __forceinline__ int lds_byte(int r, int c) { const int st = (r >> 4) * 2 + (c >> 5), rr = r & 15, cc = c & 31, ob = rr * 64 + cc * 2; return st * 1024 + (ob ^ (((ob >> 9) & 1) << 5)); }
__device__ __forceinline__ void stage_rc(int b, int& R, int& C) { const int st = b / 1024, sb = b % 1024, swz = sb ^ (((sb >> 9) & 1) << 5); R = (st >> 1) * 16 + swz / 64; C = (st & 1) * 32 + (swz % 64) / 2; }
__device__ __forceinline__ int perm32(int rho) { const int n = rho >> 4, i = rho & 15; return 8 * (i >> 2) + 4 * n + (i & 3); }
__device__ __forceinline__ unsigned cvt_pk_bf16(float lo, float hi) { unsigned r; asm volatile("v_cvt_pk_bf16_f32 %0, %1, %2" : "=v"(r) : "v"(lo), "v"(hi)); return r; }

struct Unit { int pm, pn, e, nv; };

struct StaticOrder {
    const bf16* A; const bf16* Bt; int K, nM, nN, nwg, G, c;
    __device__ void init(const bf16* A_, const bf16* Bt_, int M, int N, int K_, int G_, int c_) { A = A_; Bt = Bt_; K = K_; nM = M / BM; nN = N / BM; nwg = nM * nN; G = G_; c = c_; }
    __device__ __forceinline__ bool next(int i, Unit& u) const {
        const long L = (long)i * G + c; if (L >= nwg) return false;
        int wgid = (int)L; { const int q = nwg / NXCD, r = nwg % NXCD, xcd = wgid % NXCD, off = wgid / NXCD; wgid = (xcd < r ? xcd * (q + 1) : r * (q + 1) + (xcd - r) * q) + off; }
        const int nig = WGM * nN, gid = wgid / nig, fm = gid * WGM, gsz = (nM - fm) < WGM ? (nM - fm) : WGM;
        u.pm = fm + ((wgid % nig) % gsz); u.pn = (wgid % nig) / gsz; u.e = 0; u.nv = 256; return true;
    }
    __device__ __forceinline__ const char* a_base(const Unit& u) const { return (const char*)A + (size_t)u.pm * BM * K * 2; }
    __device__ __forceinline__ const char* b_base(const Unit& u) const { return (const char*)Bt + (size_t)u.pn * BM * K * 2; }
    __device__ __forceinline__ const int* rows(const Unit&) const { return nullptr; }
};
struct MoeOrder {
    const LAS int* tab; const bf16* A; const bf16* Bt; const int* list; int K, ntn, G, c; bool gather;
    __device__ __forceinline__ bool next(int i, Unit& u) const {
        const int L = i * G + c, total = tab[32] * ntn; if (L >= total) return false;
        const int T = L / ntn; int e = 0;
        for (int x = 1; x < 32; ++x) e = (tab[x] <= T) ? x : e;
        u.pm = T; u.pn = L % ntn; u.e = e; u.nv = tab[64 + e] - (T - tab[e]) * 256; return true;
    }
    __device__ __forceinline__ const char* a_base(const Unit& u) const { return gather ? (const char*)A : (const char*)A + (size_t)u.pm * BM * K * 2; }
    __device__ __forceinline__ const char* b_base(const Unit& u) const { return (const char*)Bt + ((size_t)u.e * 1024 + (size_t)u.pn * BM) * K * 2; }
    __device__ __forceinline__ const int* rows(const Unit& u) const { return list + (size_t)u.e * NTOK + (u.pm - tab[u.e]) * 256; }
};

struct EpiBf16 {
    static constexpr bool PERM = true;
    bf16* O; int ldc;
    __device__ __forceinline__ void operator()(const f32x4 (&acc)[2][2][4][2], const Unit& u, int wr, int wc, int fr, int fq) const {
        const int row0 = u.pm * BM + wr * 64 + fr, col0 = u.pn * BM + wc * 32 + 8 * fq;
#pragma unroll
        for (int ai = 0; ai < 2; ++ai)
#pragma unroll
            for (int m = 0; m < 4; ++m) { bf16* rowp = O + (size_t)(row0 + ai * HALF + m * 16) * ldc + col0;
#pragma unroll
                for (int bj = 0; bj < 2; ++bj) { const f32x4 v0 = acc[ai][bj][m][0], v1 = acc[ai][bj][m][1];
                    u32x4 w; w.x = cvt_pk_bf16(v0[0], v0[1]); w.y = cvt_pk_bf16(v0[2], v0[3]); w.z = cvt_pk_bf16(v1[0], v1[1]); w.w = cvt_pk_bf16(v1[2], v1[3]);
                    *(u32x4*)(rowp + bj * HALF) = w; } }
    }
};
struct EpiResF32 {
    static constexpr bool PERM = false;
    const float* R; float* C;
    __device__ __forceinline__ void operator()(const f32x4 (&acc)[2][2][4][2], const Unit& u, int wr, int wc, int fr, int fq) const {
        const int row0 = u.pm * BM + wr * 64 + fr, col0 = u.pn * BM + wc * 32 + 4 * fq;
#pragma unroll
        for (int ai = 0; ai < 2; ++ai)
#pragma unroll
            for (int m = 0; m < 4; ++m) { const size_t off = (size_t)(row0 + ai * HALF + m * 16) * D + col0;
#pragma unroll
                for (int bj = 0; bj < 2; ++bj)
#pragma unroll
                    for (int n = 0; n < 2; ++n) { const f32x4 rv = *(const f32x4*)(R + off + bj * HALF + n * 16); *(f32x4*)(C + off + bj * HALF + n * 16) = rv + acc[ai][bj][m][n]; }
                asm volatile("" ::: "memory"); }
    }
};
struct EpiSwiGLU {
    static constexpr bool PERM = true;
    bf16* O;
    __device__ __forceinline__ void operator()(const f32x4 (&acc)[2][2][4][2], const Unit& u, int wr, int wc, int fr, int fq) const {
        const int row0 = u.pm * BM + wr * 64 + fr, col0 = u.pn * 128 + wc * 32 + 8 * fq;
#pragma unroll
        for (int ai = 0; ai < 2; ++ai)
#pragma unroll
            for (int m = 0; m < 4; ++m) { float o[8];
#pragma unroll
                for (int n = 0; n < 2; ++n)
#pragma unroll
                    for (int i = 0; i < 4; ++i) { const float a = acc[ai][0][m][n][i], b = acc[ai][1][m][n][i]; o[n * 4 + i] = a * b * __builtin_amdgcn_rcpf(1.f + __expf(-a)); }
                u32x4 w; w.x = cvt_pk_bf16(o[0], o[1]); w.y = cvt_pk_bf16(o[2], o[3]); w.z = cvt_pk_bf16(o[4], o[5]); w.w = cvt_pk_bf16(o[6], o[7]);
                *(u32x4*)(O + (size_t)(row0 + ai * HALF + m * 16) * EFF + col0) = w; }
    }
};
struct EpiScaleBf16 {
    static constexpr bool PERM = true;
    bf16* O; const float* listw; const LAS int* tab;
    __device__ __forceinline__ void operator()(const f32x4 (&acc)[2][2][4][2], const Unit& u, int wr, int wc, int fr, int fq) const {
        const int rl0 = wr * 64 + fr, col0 = u.pn * BM + wc * 32 + 8 * fq;
        const float* lw = listw + (size_t)u.e * NTOK + (u.pm - tab[u.e]) * 256;
        float wv[2][4];
#pragma unroll
        for (int ai = 0; ai < 2; ++ai)
#pragma unroll
            for (int m = 0; m < 4; ++m) { const int rl = rl0 + ai * HALF + m * 16; wv[ai][m] = rl < u.nv ? lw[rl] : 0.f; }
#pragma unroll
        for (int ai = 0; ai < 2; ++ai)
#pragma unroll
            for (int m = 0; m < 4; ++m) { bf16* rowp = O + (size_t)(u.pm * BM + rl0 + ai * HALF + m * 16) * D + col0; const float s = wv[ai][m];
#pragma unroll
                for (int bj = 0; bj < 2; ++bj) { const f32x4 v0 = acc[ai][bj][m][0] * s, v1 = acc[ai][bj][m][1] * s;
                    u32x4 w; w.x = cvt_pk_bf16(v0[0], v0[1]); w.y = cvt_pk_bf16(v0[2], v0[3]); w.z = cvt_pk_bf16(v1[0], v1[1]); w.w = cvt_pk_bf16(v1[2], v1[3]);
                    *(u32x4*)(rowp + bj * HALF) = w; } }
    }
};

template <class Epi, class Sched, bool GATHER>
__device__ __forceinline__ void gemm_phase(LAS unsigned char* lds, const int K, const Sched& S, const Epi& E) {
    int tid_ = threadIdx.x; asm volatile("" : "+v"(tid_));
    const int tid = tid_, wid = __builtin_amdgcn_readfirstlane(tid >> 6), lane = tid & 63, wr = wid >> 2, wc = wid & 3, fr = lane & 15, fq = lane >> 4;
    const int nt = K / BK;
    int Rr[2], Cc[2]; unsigned voffB[2];
#pragma unroll
    for (int i = 0; i < 2; ++i) { int R, C; stage_rc(tid * 16 + i * 8192, R, C); Rr[i] = R; Cc[i] = C; const int Rb = Epi::PERM ? ((R & ~31) + perm32(R & 31)) : R; voffB[i] = (unsigned)(Rb * K + C) * 2u; }
    const size_t kstep = (size_t)(BK * 2);
    const size_t hstep = (size_t)HALF * K * 2;
    const size_t hstepA = GATHER ? 0 : hstep;
    const unsigned ldsw = (unsigned)wid * 1024u;
    const int aoff = lds_byte(wr * 64 + fr, fq * 8), boff = lds_byte(wc * 32 + fr, fq * 8);
#define PG8_SA(b, h) (((b) * 2 + (h)) * HTB)
#define PG8_SB(b, h) ((4 + (b) * 2 + (h)) * HTB)
#define PG8_STAGE(bufoff, gbase, voff) do { _Pragma("unroll") for (int _i = 0; _i < 2; ++_i) \
        __builtin_amdgcn_global_load_lds((const unsigned*)((const char*)(gbase) + (voff)[_i]), (LAS unsigned*)(lds + (bufoff) + ldsw + _i * 8192), 16, 0, 0); } while (0)
#define PG8_LDA(dst, b, h) do { _Pragma("unroll") for (int m = 0; m < 4; ++m) _Pragma("unroll") for (int k = 0; k < 2; ++k) dst[m][k] = *(const LAS bf16x8*)(lds + PG8_SA(b, h) + aoff + m * 2048 + k * 1024); } while (0)
#define PG8_LDB(dst, b, h) do { _Pragma("unroll") for (int n = 0; n < 2; ++n) _Pragma("unroll") for (int k = 0; k < 2; ++k) dst[n][k] = *(const LAS bf16x8*)(lds + PG8_SB(b, h) + boff + n * 2048 + k * 1024); } while (0)
#define PG8_MMA(ai, bj, At, Bt) do { __builtin_amdgcn_s_setprio(1); _Pragma("unroll") for (int m = 0; m < 4; ++m) _Pragma("unroll") for (int n = 0; n < 2; ++n) _Pragma("unroll") for (int k = 0; k < 2; ++k) \
        acc[ai][bj][m][n] = __builtin_amdgcn_mfma_f32_16x16x32_bf16(Bt[n][k], At[m][k], acc[ai][bj][m][n], 0, 0, 0); __builtin_amdgcn_s_setprio(0); } while (0)
#define PG8_WAIT_V(n) asm volatile("s_waitcnt vmcnt(" #n ")" ::: "memory")
#define PG8_WAIT_L(n) asm volatile("s_waitcnt lgkmcnt(" #n ")" ::: "memory")
#define PG8_BAR __builtin_amdgcn_s_barrier()
#define PG8_SCHED __builtin_amdgcn_sched_barrier(0)
#define PG8_VOFFA(u, v0, v1) do { if constexpr (GATHER) { const int* _rw = S.rows(u); _Pragma("unroll") for (int _i = 0; _i < 2; ++_i) { \
            const int _r0 = Rr[_i], _r1 = Rr[_i] + HALF; const int _t0 = _rw[_r0 < (u).nv ? _r0 : 0], _t1 = _rw[_r1 < (u).nv ? _r1 : 0]; \
            v0[_i] = (unsigned)(_t0 * K + Cc[_i]) * 2u; v1[_i] = (unsigned)(_t1 * K + Cc[_i]) * 2u; } } \
        else { _Pragma("unroll") for (int _i = 0; _i < 2; ++_i) { v0[_i] = (unsigned)(Rr[_i] * K + Cc[_i]) * 2u; v1[_i] = v0[_i]; } } } while (0)
    Unit cur, nxt; int ui = 0;
    if (!S.next(0, cur)) return;
    f32x4 acc[2][2][4][2];
#pragma unroll
    for (int a = 0; a < 2; ++a)
#pragma unroll
        for (int b = 0; b < 2; ++b)
#pragma unroll
            for (int m = 0; m < 4; ++m)
#pragma unroll
                for (int n = 0; n < 2; ++n) acc[a][b][m][n] = (f32x4){0.f, 0.f, 0.f, 0.f};
    bf16x8 At[4][2], B0[2][2], B1[2][2];
    const char* cA = S.a_base(cur); const char* cB = S.b_base(cur);
    unsigned cv0[2], cv1[2], nv0[2], nv1[2];
    PG8_VOFFA(cur, cv0, cv1);
    PG8_STAGE(PG8_SB(0, 0), cB, voffB); PG8_STAGE(PG8_SB(0, 1), cB + hstep, voffB); PG8_STAGE(PG8_SA(0, 0), cA, cv0); PG8_STAGE(PG8_SA(0, 1), cA + hstepA, cv1);
    if (wr == 1) PG8_BAR;
    PG8_WAIT_V(2); PG8_BAR;
    PG8_STAGE(PG8_SB(1, 0), cB + kstep, voffB); PG8_STAGE(PG8_SA(1, 0), cA + kstep, cv0); PG8_STAGE(PG8_SB(1, 1), cB + hstep + kstep, voffB);
    PG8_WAIT_V(6); PG8_BAR;
    for (;;) {
        const bool has_next = S.next(ui + 1, nxt);
        const char* nA = has_next ? S.a_base(nxt) : cA; const char* nB = has_next ? S.b_base(nxt) : cB;
        if (has_next) { PG8_VOFFA(nxt, nv0, nv1); } else {
#pragma unroll
            for (int i = 0; i < 2; ++i) { nv0[i] = cv0[i]; nv1[i] = cv1[i]; } }
        for (int t = 0; t < nt; t += 2) {
            const bool last = (t == nt - 2);
            const char* a1 = cA + (size_t)(t + 1) * kstep;
            const char* a2 = last ? nA : cA + (size_t)(t + 2) * kstep; const char* b2 = last ? nB : cB + (size_t)(t + 2) * kstep;
            const char* a3 = a2 + kstep; const char* b3 = b2 + kstep;
            unsigned s0[2], s1[2];
#pragma unroll
            for (int i = 0; i < 2; ++i) { s0[i] = last ? nv0[i] : cv0[i]; s1[i] = last ? nv1[i] : cv1[i]; }
            PG8_LDB(B0, 0, 0); PG8_LDB(B1, 0, 1); PG8_SCHED; PG8_LDA(At, 0, 0); PG8_STAGE(PG8_SA(1, 1), a1 + hstepA, cv1);
            PG8_WAIT_V(8); PG8_WAIT_L(0); PG8_BAR; PG8_MMA(0, 0, At, B0); PG8_MMA(0, 1, At, B1); PG8_BAR; PG8_SCHED;
            PG8_LDA(At, 0, 1); PG8_STAGE(PG8_SB(0, 0), b2, voffB); PG8_STAGE(PG8_SB(0, 1), b2 + hstep, voffB); PG8_STAGE(PG8_SA(0, 0), a2, s0);
            PG8_WAIT_V(8); PG8_WAIT_L(0); PG8_BAR; PG8_MMA(1, 0, At, B0); PG8_MMA(1, 1, At, B1); PG8_BAR; PG8_SCHED;
            PG8_LDB(B0, 1, 0); PG8_LDB(B1, 1, 1); PG8_SCHED; PG8_LDA(At, 1, 0); PG8_STAGE(PG8_SA(0, 1), a2 + hstepA, s1);
            PG8_WAIT_V(8); PG8_WAIT_L(0); PG8_BAR; PG8_MMA(0, 0, At, B0); PG8_MMA(0, 1, At, B1); PG8_BAR; PG8_SCHED;
            PG8_LDA(At, 1, 1); PG8_STAGE(PG8_SB(1, 0), b3, voffB); PG8_STAGE(PG8_SB(1, 1), b3 + hstep, voffB); PG8_STAGE(PG8_SA(1, 0), a3, s0);
            PG8_WAIT_V(8); PG8_WAIT_L(0); PG8_BAR; PG8_MMA(1, 0, At, B0); PG8_MMA(1, 1, At, B1); PG8_BAR; PG8_SCHED;
        }
        if (wr == 0) PG8_BAR;
        E(acc, cur, wr, wc, fr, fq);
        if (!has_next) break;
#pragma unroll
        for (int a = 0; a < 2; ++a)
#pragma unroll
            for (int b = 0; b < 2; ++b)
#pragma unroll
                for (int m = 0; m < 4; ++m)
#pragma unroll
                    for (int n = 0; n < 2; ++n) acc[a][b][m][n] = (f32x4){0.f, 0.f, 0.f, 0.f};
        cur = nxt; cA = nA; cB = nB; ++ui;
#pragma unroll
        for (int i = 0; i < 2; ++i) { cv0[i] = nv0[i]; cv1[i] = nv1[i]; }
        if (wr == 1) PG8_BAR;
    }
    PG8_WAIT_V(0);
    PG8_BAR;
#undef PG8_SA
#undef PG8_SB
#undef PG8_STAGE
#undef PG8_LDA
#undef PG8_LDB
#undef PG8_MMA
#undef PG8_WAIT_V
#undef PG8_WAIT_L
#undef PG8_BAR
#undef PG8_SCHED
#undef PG8_VOFFA
}
}

__device__ __forceinline__ void naive_na(const Ctx& c, const bf16* U, const float* rpb, bf16* CAT) {
    const long total = (long)NTOK * NA_H;
    for (long idx = GTID; idx < total; idx += GSIZE) {
        const int h = (int)(idx % NA_H), t = (int)(idx / NA_H);
        const int b = t / SEQ, p = t % SEQ, r = p / 64, cc = p % 64;
        const int rs = min(max(r - 4, 0), 56), cs = min(max(cc - 8, 0), 48);
        const u32x4* q4 = (const u32x4*)(U + (size_t)t * LDU0 + h * 64);
        float acc[64];
#pragma unroll
        for (int i = 0; i < 64; ++i) acc[i] = 0.f;
        float mx = -1e30f, l = 0.f;
        for (int i = 0; i < 8; ++i) for (int j = 0; j < 16; ++j) {
            const int kr = rs + i, kc = cs + j, kt = b * SEQ + kr * 64 + kc;
            const u32x4* k4 = (const u32x4*)(U + (size_t)kt * LDU0 + 768 + h * 64);
            float s = 0.f;
#pragma unroll
            for (int d8 = 0; d8 < 8; ++d8) s += dot8(q4[d8], k4[d8]);
            s = s * 0.125f + rpb[(h * 15 + (kr - r + 7)) * 31 + (kc - cc + 15)];
            const float mn = fmaxf(mx, s), alpha = __expf(mx - mn), pp = __expf(s - mn);
            l = l * alpha + pp; mx = mn;
            const u32x4* v4 = (const u32x4*)(U + (size_t)kt * LDU0 + 1536 + h * 64);
#pragma unroll
            for (int d8 = 0; d8 < 8; ++d8) { const u32x4 vv = v4[d8];
#pragma unroll
                for (int e = 0; e < 4; ++e) { acc[d8 * 8 + 2 * e] = acc[d8 * 8 + 2 * e] * alpha + pp * __uint_as_float(vv[e] << 16);
                    acc[d8 * 8 + 2 * e + 1] = acc[d8 * 8 + 2 * e + 1] * alpha + pp * __uint_as_float(vv[e] & 0xffff0000u); } }
        }
        const float inv = 1.f / l;
        u32x4* o4 = (u32x4*)(CAT + (size_t)t * D + h * 64);
#pragma unroll
        for (int d8 = 0; d8 < 8; ++d8) { u32x4 w; w.x = pk2(acc[d8 * 8] * inv, acc[d8 * 8 + 1] * inv); w.y = pk2(acc[d8 * 8 + 2] * inv, acc[d8 * 8 + 3] * inv);
            w.z = pk2(acc[d8 * 8 + 4] * inv, acc[d8 * 8 + 5] * inv); w.w = pk2(acc[d8 * 8 + 6] * inv, acc[d8 * 8 + 7] * inv); o4[d8] = w; }
    }
}
__device__ __forceinline__ void naive_memattn(const Ctx& c, const bf16* U, int ldu, int mqcol, const bf16* MKV, int lay, bf16* CAT) {
    const long total = (long)NTOK * 4;
    for (long idx = GTID; idx < total; idx += GSIZE) {
        const int h = (int)(idx % 4), t = (int)(idx / 4), b = t / SEQ;
        const u32x4* q4 = (const u32x4*)(U + (size_t)t * ldu + mqcol + h * 64);
        float acc[64];
#pragma unroll
        for (int i = 0; i < 64; ++i) acc[i] = 0.f;
        float mx = -1e30f, l = 0.f;
        for (int m = 0; m < NMEM; ++m) {
            const bf16* row = MKV + (size_t)(b * NMEM + m) * 1024 + lay * 512;
            const u32x4* k4 = (const u32x4*)(row + h * 64);
            float s = 0.f;
#pragma unroll
            for (int d8 = 0; d8 < 8; ++d8) s += dot8(q4[d8], k4[d8]);
            s *= 0.125f;
            const float mn = fmaxf(mx, s), alpha = __expf(mx - mn), pp = __expf(s - mn);
            l = l * alpha + pp; mx = mn;
            const u32x4* v4 = (const u32x4*)(row + 256 + h * 64);
#pragma unroll
            for (int d8 = 0; d8 < 8; ++d8) { const u32x4 vv = v4[d8];
#pragma unroll
                for (int e = 0; e < 4; ++e) { acc[d8 * 8 + 2 * e] = acc[d8 * 8 + 2 * e] * alpha + pp * __uint_as_float(vv[e] << 16);
                    acc[d8 * 8 + 2 * e + 1] = acc[d8 * 8 + 2 * e + 1] * alpha + pp * __uint_as_float(vv[e] & 0xffff0000u); } }
        }
        const float inv = 1.f / l;
        u32x4* o4 = (u32x4*)(CAT + (size_t)t * D + MIX + h * 64);
#pragma unroll
        for (int d8 = 0; d8 < 8; ++d8) { u32x4 w; w.x = pk2(acc[d8 * 8] * inv, acc[d8 * 8 + 1] * inv); w.y = pk2(acc[d8 * 8 + 2] * inv, acc[d8 * 8 + 3] * inv);
            w.z = pk2(acc[d8 * 8 + 4] * inv, acc[d8 * 8 + 5] * inv); w.w = pk2(acc[d8 * 8 + 6] * inv, acc[d8 * 8 + 7] * inv); o4[d8] = w; }
    }
}

__device__ __forceinline__ void route_phase(const Ctx& c, const float* X, const float* g, const float* wg, const float* bg, const float* wr, const float* br,
                                            bf16* HN, unsigned char* rt, unsigned* cnt) {
    int* TOKE = (int*)(rt + RT_TOKE); float* TOKW = (float*)(rt + RT_TOKW); int* TOKP = (int*)(rt + RT_TOKP); int* LIST = (int*)(rt + RT_LIST); float* LISTW = (float*)(rt + RT_LISTW);
    for (int t = c.gw; t < NTOK; t += c.ngw) {
        const f32x4* xr = (const f32x4*)(X + (size_t)t * D) + c.lane; const f32x4* gr = (const f32x4*)g + c.lane;
        f32x4 v[4]; float s = 0.f;
#pragma unroll
        for (int j = 0; j < 4; ++j) { v[j] = xr[64 * j]; s += (v[j].x * v[j].x + v[j].y * v[j].y) + (v[j].z * v[j].z + v[j].w * v[j].w); }
        const float r = 1.f / sqrtf(wave_sum(s) * (1.f / D) + EPS);
        u32x2* o8 = (u32x2*)(HN + (size_t)t * D) + c.lane;
#pragma unroll
        for (int j = 0; j < 4; ++j) { const f32x4 gg = gr[64 * j]; v[j].x *= r * gg.x; v[j].y *= r * gg.y; v[j].z *= r * gg.z; v[j].w *= r * gg.w;
            u32x2 w; w.x = pk2(v[j].x, v[j].y); w.y = pk2(v[j].z, v[j].w); o8[64 * j] = w; }
        LAS float* hrow = (LAS float*)(c.lds + c.wave * 16384);
#pragma unroll
        for (int j = 0; j < 4; ++j) *(LAS f32x4*)(hrow + 4 * c.lane + 256 * j) = v[j];
        asm volatile("s_waitcnt lgkmcnt(0)" ::: "memory");
        float lg[4], lr[32];
#pragma unroll
        for (int o = 0; o < 4; ++o) lg[o] = 0.f;
#pragma unroll
        for (int o = 0; o < 32; ++o) lr[o] = 0.f;
#pragma unroll 1
        for (int kk = 0; kk < 16; ++kk) { const int k = c.lane + 64 * kk; const float xv = hrow[k];
            const f32x4 w4 = *(const f32x4*)(wg + (size_t)k * 4);
#pragma unroll
            for (int o = 0; o < 4; ++o) lg[o] += xv * w4[o];
#pragma unroll
            for (int o4 = 0; o4 < 8; ++o4) { const f32x4 w = *(const f32x4*)(wr + (size_t)k * 32 + o4 * 4);
#pragma unroll
                for (int o = 0; o < 4; ++o) lr[o4 * 4 + o] += xv * w[o]; } }
        asm volatile("s_waitcnt lgkmcnt(0)" ::: "memory");
#pragma unroll
        for (int o = 0; o < 4; ++o) lg[o] = wave_sum(lg[o]) + bg[o];
#pragma unroll
        for (int o = 0; o < 32; ++o) lr[o] = wave_sum(lr[o]) + br[o];
        int gi = 0; float gm = lg[0];
#pragma unroll
        for (int o = 1; o < 4; ++o) if (lg[o] > gm) { gm = lg[o]; gi = o; }
        float gs = 0.f;
#pragma unroll
        for (int o = 0; o < 4; ++o) gs += __expf(lg[o] - gm);
        const float ggate = 1.f / gs;
        float el[8];
#pragma unroll
        for (int o = 0; o < 8; ++o) { float x = lr[o];
#pragma unroll
            for (int q = 1; q < 4; ++q) x = (gi == q) ? lr[q * 8 + o] : x;
            el[o] = x; }
        int i0 = 0; float l0 = el[0];
#pragma unroll
        for (int o = 1; o < 8; ++o) if (el[o] > l0) { l0 = el[o]; i0 = o; }
        int i1 = -1; float l1 = -3.0e38f;
#pragma unroll
        for (int o = 0; o < 8; ++o) if (o != i0 && el[o] > l1) { l1 = el[o]; i1 = o; }
        const float e1 = __expf(l1 - l0), den = 1.f / (1.f + e1);
        const float w0 = den * ggate, w1 = e1 * den * ggate;
        if (c.lane == 0) {
            const int ex0 = gi * 8 + i0, ex1 = gi * 8 + i1;
            const unsigned p0 = atomicAdd(cnt + ex0, 1u), p1 = atomicAdd(cnt + ex1, 1u);
            LIST[ex0 * NTOK + p0] = t; LIST[ex1 * NTOK + p1] = t; LISTW[ex0 * NTOK + p0] = w0; LISTW[ex1 * NTOK + p1] = w1;
            TOKE[2 * t] = ex0; TOKE[2 * t + 1] = ex1; TOKW[2 * t] = w0; TOKW[2 * t + 1] = w1; TOKP[2 * t] = (int)p0; TOKP[2 * t + 1] = (int)p1;
        }
    }
}
__device__ __forceinline__ int pstart_of(const unsigned* cnt, int e) { int s = 0; for (int i = 0; i < e; ++i) s += ((int)cnt[i] + 255) & ~255; return s; }
__device__ __forceinline__ bool row_lookup(const unsigned* cnt, int R, int& e, int& i, int& n) {
    int s = 0;
    for (int x = 0; x < NEXP; ++x) { const int cn = (int)cnt[x], pc = (cn + 255) & ~255; if (R < s + pc) { e = x; i = R - s; n = cn; return true; } s += pc; }
    return false;
}

__device__ __forceinline__ void combine_phase(const Ctx& c, float* X, const bf16* Y, const unsigned char* rt, const unsigned* cnt, const float* g, bf16* XN, float* OUTF) {
    const int* TOKE = (const int*)(rt + RT_TOKE); const int* TOKP = (const int*)(rt + RT_TOKP);
    for (int t = c.gw; t < NTOK; t += c.ngw) {
        const int e0 = TOKE[2 * t], e1 = TOKE[2 * t + 1];
        const int R0 = pstart_of(cnt, e0) + TOKP[2 * t], R1 = pstart_of(cnt, e1) + TOKP[2 * t + 1];
        f32x4* xr = (f32x4*)(X + (size_t)t * D) + c.lane; const f32x4* gr = (const f32x4*)g + c.lane;
        const u32x2* y0 = (const u32x2*)(Y + (size_t)R0 * D) + c.lane; const u32x2* y1 = (const u32x2*)(Y + (size_t)R1 * D) + c.lane;
        f32x4 v[4]; float s = 0.f;
#pragma unroll
        for (int j = 0; j < 4; ++j) { v[j] = xr[64 * j]; const u32x2 a = y0[64 * j], b = y1[64 * j];
            v[j].x += __uint_as_float(a.x << 16) + __uint_as_float(b.x << 16); v[j].y += __uint_as_float(a.x & 0xffff0000u) + __uint_as_float(b.x & 0xffff0000u);
            v[j].z += __uint_as_float(a.y << 16) + __uint_as_float(b.y << 16); v[j].w += __uint_as_float(a.y & 0xffff0000u) + __uint_as_float(b.y & 0xffff0000u);
            s += (v[j].x * v[j].x + v[j].y * v[j].y) + (v[j].z * v[j].z + v[j].w * v[j].w); }
        const float r = 1.f / sqrtf(wave_sum(s) * (1.f / D) + EPS);
        if (XN) {
            u32x2* o8 = (u32x2*)(XN + (size_t)t * D) + c.lane;
#pragma unroll
            for (int j = 0; j < 4; ++j) { xr[64 * j] = v[j]; const f32x4 gg = gr[64 * j]; u32x2 w; w.x = pk2(v[j].x * r * gg.x, v[j].y * r * gg.y); w.y = pk2(v[j].z * r * gg.z, v[j].w * r * gg.w); o8[64 * j] = w; }
        } else {
            f32x4* o = (f32x4*)(OUTF + (size_t)t * D) + c.lane;
#pragma unroll
            for (int j = 0; j < 4; ++j) { const f32x4 gg = gr[64 * j]; f32x4 w; w.x = v[j].x * r * gg.x; w.y = v[j].y * r * gg.y; w.z = v[j].z * r * gg.z; w.w = v[j].w * r * gg.w; o[64 * j] = w; }
        }
    }
}

__device__ __forceinline__ void gla_decay(const Ctx& c, const bf16* U, const float* gup, const float* gbias, float* DECA) {
    const long total = (long)NTOK * 2 * GLA_KD;
    for (long idx = GTID; idx < total; idx += GSIZE) {
        const int cc = (int)(idx % GLA_KD), dir = (int)((idx / GLA_KD) % 2), t = (int)(idx / (2 * GLA_KD));
        const bf16* r = U + (size_t)t * LDU1 + 2304 + dir * 16;
        float z = gbias[dir * GLA_KD + cc];
#pragma unroll
        for (int k = 0; k < 16; ++k) z += bf2f(r[k]) * gup[(dir * 16 + k) * GLA_KD + cc];
        const float ls = fminf(z, 0.f) - log1pf(__expf(-fabsf(z)));
        DECA[idx] = __expf(ls * (1.f / 16.f));
    }
}
__device__ __forceinline__ void gla_recur(const Ctx& c, const bf16* U, const float* DECA, float* OF) {
    const long total = (long)NBATCH * GLA_H * GLA_DV * 2;
    const float qs = 0.10206207261596577f;
    for (long idx = GTID; idx < total; idx += GSIZE) {
        const int half = (int)(idx & 1), dv = (int)((idx >> 1) % GLA_DV), h = (int)(((idx >> 1) / GLA_DV) % GLA_H), b = (int)((idx >> 1) / (GLA_DV * GLA_H));
        float S[48];
        for (int dir = 0; dir < 2; ++dir) {
#pragma unroll
            for (int d = 0; d < 48; ++d) S[d] = 0.f;
            for (int s = 0; s < SEQ; ++s) {
                const int p = dir ? (SEQ - 1 - s) : s, t = b * SEQ + p;
                const bf16* row = U + (size_t)t * LDU1;
                const float vv = bf2f(row[768 + h * GLA_DV + dv]);
                const float* a = DECA + ((size_t)t * 2 + dir) * GLA_KD + h * GLA_DK + half * 48;
                const u32x4* q4 = (const u32x4*)(row + h * GLA_DK + half * 48); const u32x4* k4 = (const u32x4*)(row + 384 + h * GLA_DK + half * 48);
                float o = 0.f;
#pragma unroll
                for (int d8 = 0; d8 < 6; ++d8) { const u32x4 qq = q4[d8], kk = k4[d8]; const f32x4 a0 = *(const f32x4*)(a + d8 * 8), a1 = *(const f32x4*)(a + d8 * 8 + 4);
#pragma unroll
                    for (int e = 0; e < 4; ++e) { const float aa0 = e < 2 ? a0[2 * e] : a1[2 * e - 4], aa1 = e < 2 ? a0[2 * e + 1] : a1[2 * e - 3];
                        const float s0 = aa0 * S[d8 * 8 + 2 * e] + __uint_as_float(kk[e] << 16) * vv; S[d8 * 8 + 2 * e] = s0; o += __uint_as_float(qq[e] << 16) * s0;
                        const float s1 = aa1 * S[d8 * 8 + 2 * e + 1] + __uint_as_float(kk[e] & 0xffff0000u) * vv; S[d8 * 8 + 2 * e + 1] = s1; o += __uint_as_float(qq[e] & 0xffff0000u) * s1; } }
                o += __shfl_xor(o, 1);
                float* dst = OF + (size_t)t * MIX + h * GLA_DV + dv;
                if (half == 0) { if (dir == 0) *dst = o * qs; else *dst += o * qs; }
            }
        }
    }
}
__device__ __forceinline__ void gla_norm_gate(const Ctx& c, const float* OF, const bf16* U, const float* onorm, bf16* CAT) {
    for (int it = c.gw; it < NTOK * GLA_H; it += c.ngw) {
        const int h = it % GLA_H, t = it / GLA_H;
        const float* o = OF + (size_t)t * MIX + h * GLA_DV;
        float v[3]; float s = 0.f;
#pragma unroll
        for (int j = 0; j < 3; ++j) { v[j] = o[c.lane + 64 * j]; s += v[j] * v[j]; }
        const float r = 1.f / sqrtf(wave_sum(s) * (1.f / GLA_DV) + EPS);
#pragma unroll
        for (int j = 0; j < 3; ++j) { const int dv = c.lane + 64 * j; const float gg = bf2f(U[(size_t)t * LDU1 + 1536 + h * GLA_DV + dv]);
            CAT[(size_t)t * D + h * GLA_DV + dv] = (bf16)f2bf(v[j] * r * onorm[dv] * silu(gg)); }
    }
}


#define XB_TMO      128
#define XB_XCNT(j)  (256  + 64 * (j))
#define XB_XSUB(j)  (1280 + 64 * (j))
#define XB_XGEN(j)  (2304 + 64 * (j))
#define XB_TOP      3328
#define XB_TOPGEN   3392
#define XCD_BAR_WORDS 3456
#define XB_SPIN_CAP (1u << 22)
__device__ __forceinline__ unsigned xb_ld(unsigned* p)              { return __hip_atomic_load(p, __ATOMIC_RELAXED, __HIP_MEMORY_SCOPE_AGENT); }
__device__ __forceinline__ unsigned xb_add(unsigned* p, unsigned v) { return __hip_atomic_fetch_add(p, v, __ATOMIC_RELAXED, __HIP_MEMORY_SCOPE_AGENT); }
__device__ __forceinline__ unsigned xb_xcc_id() { return (unsigned)__builtin_amdgcn_s_getreg((3 << 11) | 20) & 0xFu; }
#define XB_SPIN(cond, bar) do { unsigned _sp = 0; while (cond) { __builtin_amdgcn_s_sleep(1); \
    if ((++_sp & 255u) == 0u) { if (xb_ld(&(bar)[XB_TMO])) break; if (_sp > XB_SPIN_CAP) { atomicAdd(&(bar)[XB_TMO], 1u); break; } } } } while (0)
struct XcdBarrier { unsigned* bar; unsigned x; volatile LAS unsigned* st; };
__device__ __forceinline__ XcdBarrier xcd_barrier_post(unsigned* bar, volatile LAS unsigned* st) {
    XcdBarrier b; b.bar = bar; b.x = xb_xcc_id(); b.st = st;
    if (threadIdx.x == 0) (void)xb_add(&bar[XB_XCNT(b.x)], 1u);
    return b;
}
__device__ __forceinline__ void xcd_barrier_complete(unsigned* bar, unsigned x, unsigned& nloc, unsigned& nx) {
    const unsigned G = gridDim.x * gridDim.y * gridDim.z;
    unsigned sum, cnt, mine, sp = 0u;
    for (;;) {
        sum = 0u; cnt = 0u; mine = 0u;
#pragma unroll
        for (unsigned j = 0; j < 16; ++j) { const unsigned c = xb_ld(&bar[XB_XCNT(j)]); sum += c; cnt += (c > 0u) ? 1u : 0u; mine = (j == x) ? c : mine; }
        if (sum == G) break;
        __builtin_amdgcn_s_sleep(1);
        if ((++sp & 255u) == 0u) { if (xb_ld(&bar[XB_TMO])) break; if (sp > XB_SPIN_CAP) { atomicAdd(&bar[XB_TMO], 1u); break; } }
    }
    nloc = mine > 0u ? mine : 1u; nx = cnt > 0u ? cnt : 1u;
}
__device__ __forceinline__ void xcd_barrier(const XcdBarrier& b) {
    asm volatile("s_waitcnt vmcnt(0)" ::: "memory");
    __syncthreads();
    if (threadIdx.x == 0) {
        unsigned* bar = b.bar;
        __builtin_amdgcn_s_waitcnt(0);
        const unsigned bx = __builtin_amdgcn_readfirstlane(xb_xcc_id());
        unsigned nloc = b.st[0], nx = b.st[1];
        if (nloc == 0u) { xcd_barrier_complete(bar, bx, nloc, nx); b.st[0] = nloc; b.st[1] = nx; }
        const unsigned old = xb_add(&bar[XB_XSUB(bx)], 1u);
        const unsigned gen = old / nloc;
        if (old + 1u == (gen + 1u) * nloc) {
            __builtin_amdgcn_fence(__ATOMIC_RELEASE, "agent");
            asm volatile("s_waitcnt vmcnt(0)" ::: "memory");
            const unsigned og = xb_add(&bar[XB_TOP], 1u);
            const unsigned tg = og / nx;
            if (og + 1u == (tg + 1u) * nx) xb_add(&bar[XB_TOPGEN], 1u);
            else XB_SPIN(xb_ld(&bar[XB_TOPGEN]) == tg, bar);
            __builtin_amdgcn_fence(__ATOMIC_ACQUIRE, "agent");
            xb_add(&bar[XB_XGEN(bx)], 1u);
            asm volatile("s_waitcnt vmcnt(0)" ::: "memory");
        } else {
            XB_SPIN(xb_ld(&bar[XB_XGEN(bx)]) == gen, bar);
            __builtin_amdgcn_fence(__ATOMIC_ACQUIRE, "agent");
            asm volatile("s_waitcnt vmcnt(0)" ::: "memory");
        }
    }
    __syncthreads();
}

constexpr int NWAVES = 8, NTHREADS = 512, LDS_BYTES = 147456, MISC_OFF = 131072 + 1024;
constexpr int NPHASES = 19;
constexpr int TAB_OFF = 131072 + 2048;
#ifndef USE_PG8
#define USE_PG8 0xF
#endif
__device__ __forceinline__ void build_tab(const Ctx& c, const unsigned* cnt) {
    LAS int* tab = (LAS int*)(c.lds + TAB_OFF);
    __syncthreads();
    if (c.tid < 64) { const int cn = c.tid < 32 ? (int)cnt[c.tid] : 0; int mt = (cn + 255) >> 8, inc = mt;
#pragma unroll
        for (int o = 1; o < 32; o <<= 1) { const int v = __shfl_up(inc, o); if ((c.tid & 31) >= o) inc += v; }
        if (c.tid < 32) { tab[c.tid + 1] = inc; tab[64 + c.tid] = cn; } if (c.tid == 0) tab[0] = 0; }
    __syncthreads();
}

template <int PH_LO, int PH_HI> __global__ void __launch_bounds__(NTHREADS, 2) mk_fwd(Args args) {
    extern __shared__ __attribute__((aligned(16))) unsigned char lds_raw[];
    LAS unsigned char* const ldsp = (LAS unsigned char*)lds_raw;
    Ctx c = fresh_ctx(ldsp);
    const int vcu = (gridDim.x % 8 == 0) ? (int)((blockIdx.x % 8) * (gridDim.x / 8) + blockIdx.x / 8) : (int)blockIdx.x;
    unsigned char* ws = args.ws;
    const float* x = args.in[0]; const float* mem = args.in[1]; const float* mem_norm = args.in[2]; const float* final_norm = args.in[3];
    const float* norm_mix = args.in[4]; const float* norm_ffn = args.in[5]; const float* w_mem_kv = args.in[6]; const float* w_out = args.in[7];
    const float* na_w_in = args.in[8]; const float* na_rpb = args.in[9]; const float* gla_w_in = args.in[10]; const float* gla_gate_up = args.in[11];
    const float* gla_gate_bias = args.in[12]; const float* gla_out_norm = args.in[13]; const float* moe_w_group = args.in[14]; const float* moe_b_group = args.in[15];
    const float* moe_w_router = args.in[16]; const float* moe_b_router = args.in[17]; const float* moe_w1 = args.in[18]; const float* moe_w3 = args.in[19]; const float* moe_w2 = args.in[20];
    float* X = args.out;
    bf16* WIN0 = (bf16*)(ws + WS_WIN0); bf16* WIN1 = (bf16*)(ws + WS_WIN1); bf16* WOUT = (bf16*)(ws + WS_WOUT); bf16* WMKV = (bf16*)(ws + WS_WMKV);
    bf16* MEMN = (bf16*)(ws + WS_MEMN); bf16* MKV = (bf16*)(ws + WS_MKV); bf16* W13 = (bf16*)(ws + WS_W13); bf16* W2 = (bf16*)(ws + WS_W2);
    bf16* XN = (bf16*)(ws + WS_XN); bf16* U = (bf16*)(ws + WS_U); bf16* Y = (bf16*)(ws + WS_Y); bf16* CAT = (bf16*)(ws + WS_CAT); bf16* ACT = (bf16*)(ws + WS_ACT);
    unsigned char* RT = ws + WS_ROUTE; float* DECA = (float*)(ws + WS_S); float* OF = (float*)(ws + WS_S + 48 * MiB);
    unsigned* CTL = (unsigned*)(ws + WS_CTL);
#define IN(k) (PH_LO <= (k) && (k) < PH_HI)
    constexpr bool FUSED = (PH_HI - PH_LO) > 1;
    XcdBarrier bar; bar.bar = CTL + CW_BAR; bar.x = 0; bar.st = nullptr;
    if constexpr (FUSED) {
        volatile LAS unsigned* misc = (volatile LAS unsigned*)(c.lds + MISC_OFF);
        if (c.tid < 64) misc[c.tid] = 0u;
        __syncthreads();
        bar = xcd_barrier_post(CTL + CW_BAR, misc + 8);
    }
#define GRID_BAR(k) do { if constexpr (FUSED) { if (IN((k) + 1)) xcd_barrier(bar); } } while (0)

    if (IN(0)) { c = fresh_ctx(ldsp);
        transpose_matrix(c, na_w_in, 1024, NA_IN, WIN0, c.gw, c.ngw);
        transpose_matrix(c, gla_w_in, 1024, GLA_IN, WIN1, c.gw, c.ngw);
        for (long i = GTID; i < (long)(2816 - 2592) * 1024 / 8; i += GSIZE) ((u32x4*)(WIN1 + (size_t)2592 * 1024))[i] = (u32x4){0u, 0u, 0u, 0u};
        for (int l = 0; l < 2; ++l) { transpose_matrix(c, w_out + (size_t)l * D * D, 1024, 1024, WOUT + (size_t)l * D * D, c.gw, c.ngw);
            transpose_matrix(c, w_mem_kv + (size_t)l * D * 512, 1024, 512, WMKV + (size_t)l * 512 * 1024, c.gw, c.ngw); }
        convert_moe(c, moe_w1, moe_w3, moe_w2, W13, W2);
        for (int m = c.gw; m < NBATCH * NMEM; m += c.ngw) rms_row_to_bf16(mem + (size_t)m * D, mem_norm, MEMN + (size_t)m * D, c.lane);
        for (int m = c.gw; m < NTOK; m += c.ngw) rms_row_to_bf16(x + (size_t)m * D, norm_mix, XN + (size_t)m * D, c.lane);
        GRID_BAR(0);
    }
#pragma unroll
    for (int L = 0; L < 2; ++L) {
        const int pb = 1 + 9 * L;
        const int ldu = L == 0 ? LDU0 : LDU1;
        unsigned* cnt = CTL + CW_CNT + 64 * L;
        if (IN(pb)) { c = fresh_ctx(ldsp);
            if constexpr (USE_PG8 & 1) {
                pg8::StaticOrder S; S.init(XN, L == 0 ? WIN0 : WIN1, NTOK, ldu, D, (int)gridDim.x, (int)blockIdx.x);
                pg8::EpiBf16 E{U, ldu};
                pg8::gemm_phase<pg8::EpiBf16, pg8::StaticOrder, false>(c.lds, D, S, E);
                if (L == 0) { pg8::StaticOrder S2; S2.init(MEMN, WMKV, NBATCH * NMEM, 1024, D, (int)gridDim.x, (int)blockIdx.x);
                    pg8::EpiBf16 E2{MKV, 1024};
                    pg8::gemm_phase<pg8::EpiBf16, pg8::StaticOrder, false>(c.lds, D, S2, E2); }
            } else {
            if (L == 0) {
                naive_gemm(c, NTOK, NA_IN, D, [&](int m) { return XN + (size_t)m * D; }, WIN0, [&](int m, int n, float a) { U[(size_t)m * LDU0 + n] = (bf16)f2bf(a); });
                naive_gemm(c, NBATCH * NMEM, 1024, D, [&](int m) { return MEMN + (size_t)m * D; }, WMKV, [&](int m, int n, float a) { MKV[(size_t)m * 1024 + n] = (bf16)f2bf(a); });
            } else {
                naive_gemm(c, NTOK, LDU1, D, [&](int m) { return XN + (size_t)m * D; }, WIN1, [&](int m, int n, float a) { U[(size_t)m * LDU1 + n] = (bf16)f2bf(a); });
            }
            }
            GRID_BAR(pb);
        }
        if (IN(pb + 1)) { c = fresh_ctx(ldsp);
            if (L == 0) { naive_na(c, U, na_rpb, CAT); naive_memattn(c, U, LDU0, 2304, MKV, 0, CAT); }
            else { gla_decay(c, U, gla_gate_up, gla_gate_bias, DECA); naive_memattn(c, U, LDU1, 2336, MKV, 1, CAT); }
            GRID_BAR(pb + 1);
        }
        if (IN(pb + 2)) { c = fresh_ctx(ldsp);
            if (L == 1) { gla_recur(c, U, DECA, OF); GRID_BAR(pb + 2); }
        }
        if (IN(pb + 3)) { c = fresh_ctx(ldsp);
            if (L == 1) { gla_norm_gate(c, OF, U, gla_out_norm, CAT); GRID_BAR(pb + 3); }
        }
        if (IN(pb + 4)) { c = fresh_ctx(ldsp);
            const float* resid = L == 0 ? x : X;
            if constexpr (USE_PG8 & 2) {
                pg8::StaticOrder S; S.init(CAT, WOUT + (size_t)L * D * D, NTOK, D, D, (int)gridDim.x, (int)blockIdx.x);
                pg8::EpiResF32 E{resid, X};
                pg8::gemm_phase<pg8::EpiResF32, pg8::StaticOrder, false>(c.lds, D, S, E);
            } else
            naive_gemm(c, NTOK, D, D, [&](int m) { return CAT + (size_t)m * D; }, WOUT + (size_t)L * D * D, [&](int m, int n, float a) { X[(size_t)m * D + n] = resid[(size_t)m * D + n] + a; });
            GRID_BAR(pb + 4);
        }
        if (IN(pb + 5)) { c = fresh_ctx(ldsp);
            route_phase(c, X, norm_ffn + L * D, moe_w_group + (size_t)L * D * 4, moe_b_group + L * 4, moe_w_router + (size_t)L * D * 32, moe_b_router + L * 32, XN, RT, cnt);
            GRID_BAR(pb + 5);
        }
        if (IN(pb + 6)) { c = fresh_ctx(ldsp);
            const int* LIST = (const int*)(RT + RT_LIST);
            if constexpr (USE_PG8 & 4) {
                build_tab(c, cnt);
                pg8::MoeOrder S{(const LAS int*)(c.lds + TAB_OFF), XN, W13, LIST, D, 4, (int)gridDim.x, vcu, true};
                pg8::EpiSwiGLU E{ACT};
                pg8::gemm_phase<pg8::EpiSwiGLU, pg8::MoeOrder, true>(c.lds, D, S, E);
            } else {
            const long total = (long)MAXROWS * EFF;
            for (long idx = GTID; idx < total; idx += GSIZE) {
                const int R = (int)(idx / EFF), j = (int)(idx % EFF); int e, i, n;
                if (!row_lookup(cnt, R, e, i, n) || i >= n) continue;
                const int t = LIST[e * NTOK + i];
                const u32x4* a4 = (const u32x4*)(XN + (size_t)t * D);
                const int r1 = (j / 128) * 256 + (j % 128);
                const u32x4* b1 = (const u32x4*)(W13 + ((size_t)e * 1024 + r1) * 1024); const u32x4* b3 = (const u32x4*)(W13 + ((size_t)e * 1024 + r1 + 128) * 1024);
                float s1 = 0.f, s3 = 0.f;
                for (int k8 = 0; k8 < D / 8; ++k8) { const u32x4 av = a4[k8]; s1 += dot8(av, b1[k8]); s3 += dot8(av, b3[k8]); }
                ACT[(size_t)R * EFF + j] = (bf16)f2bf(silu(s1) * s3);
            }
            }
            GRID_BAR(pb + 6);
        }
        if (IN(pb + 7)) { c = fresh_ctx(ldsp);
            const int* LIST = (const int*)(RT + RT_LIST); const int* TOKE = (const int*)(RT + RT_TOKE); const float* TOKW = (const float*)(RT + RT_TOKW);
            if constexpr (USE_PG8 & 8) {
                build_tab(c, cnt);
                pg8::MoeOrder S{(const LAS int*)(c.lds + TAB_OFF), ACT, W2, LIST, EFF, 4, (int)gridDim.x, vcu, false};
                pg8::EpiScaleBf16 E{Y, (const float*)(RT + RT_LISTW), (const LAS int*)(c.lds + TAB_OFF)};
                pg8::gemm_phase<pg8::EpiScaleBf16, pg8::MoeOrder, false>(c.lds, EFF, S, E);
            } else {
            const long total = (long)MAXROWS * D;
            for (long idx = GTID; idx < total; idx += GSIZE) {
                const int R = (int)(idx / D), n = (int)(idx % D); int e, i, cn;
                if (!row_lookup(cnt, R, e, i, cn) || i >= cn) continue;
                const int t = LIST[e * NTOK + i];
                const float w = (TOKE[2 * t] == e) ? TOKW[2 * t] : TOKW[2 * t + 1];
                const u32x4* a4 = (const u32x4*)(ACT + (size_t)R * EFF); const u32x4* b4 = (const u32x4*)(W2 + ((size_t)e * 1024 + n) * 512);
                float s = 0.f;
                for (int k8 = 0; k8 < EFF / 8; ++k8) s += dot8(a4[k8], b4[k8]);
                Y[(size_t)R * D + n] = (bf16)f2bf(s * w);
            }
            }
            GRID_BAR(pb + 7);
        }
        if (IN(pb + 8)) { c = fresh_ctx(ldsp);
            if (L == 0) { combine_phase(c, X, Y, RT, cnt, norm_mix + D, XN, nullptr);
                convert_moe(c, moe_w1 + (size_t)NEXP * D * EFF, moe_w3 + (size_t)NEXP * D * EFF, moe_w2 + (size_t)NEXP * EFF * D, W13, W2); }
            else combine_phase(c, X, Y, RT, cnt, final_norm, nullptr, X);
            if (L == 0) GRID_BAR(pb + 8);
        }
    }
#undef IN
}

template <int P> static void launch_phases(int grid, hipStream_t stream, const Args& a) {
    if constexpr (P < NPHASES) {
        if constexpr (P != 3 && P != 4) {
            static bool attr_done = false;
            if (!attr_done) { (void)hipFuncSetAttribute((const void*)mk_fwd<P, P + 1>, hipFuncAttributeMaxDynamicSharedMemorySize, LDS_BYTES); attr_done = true; }
            hipLaunchKernelGGL((mk_fwd<P, P + 1>), dim3(grid), dim3(NTHREADS), LDS_BYTES, stream, a);
        }
        launch_phases<P + 1>(grid, stream, a);
    }
}
extern "C" void kernel_launch(void* const* d_in, const int* in_sizes, int n_in, void* d_out, int out_size, void* d_ws, size_t ws_size, hipStream_t stream) {
    static int grid = 0;
    if (grid == 0) {
        if (n_in != 21 || out_size != NTOK * D || ws_size < WS_END) { fprintf(stderr, "kernel_launch: unexpected shapes n_in %d out %d ws %zu (need %zu)\n", n_in, out_size, ws_size, (size_t)WS_END); grid = -1; return; }
        int dev = 0, cus = 0;
        if (hipGetDevice(&dev) != hipSuccess || hipDeviceGetAttribute(&cus, hipDeviceAttributeMultiprocessorCount, dev) != hipSuccess) { grid = -1; return; }
        (void)hipGetLastError();
        grid = cus;
    }
    if (grid < 0) return;
    (void)hipMemsetAsync((char*)d_ws + WS_CTL, 0, CTL_ZERO_BYTES, stream);
    Args a{};
    for (int i = 0; i < 21; ++i) a.in[i] = (const float*)d_in[i];
    a.out = (float*)d_out; a.ws = (unsigned char*)d_ws;
#if defined(MK_PER_PHASE)
    launch_phases<0>(grid, stream, a);
#else
    static bool attr_done = false;
    if (!attr_done) { (void)hipFuncSetAttribute((const void*)mk_fwd<0, NPHASES>, hipFuncAttributeMaxDynamicSharedMemorySize, LDS_BYTES); attr_done = true; }
    hipLaunchKernelGGL((mk_fwd<0, NPHASES>), dim3(grid), dim3(NTHREADS), LDS_BYTES, stream, a);
#endif
}
```

```cpp
#include <hip/hip_runtime.h>
#include <cstdio>
#include <cstdint>

constexpr int D = 1024, NTOK = 16384, SEQ = 4096, NBATCH = 4, NMEM = 256, HD = 64;
constexpr int MIX = 768, MEMD = 256, NA_H = 12, NA_IN = 2560;
constexpr int GLA_H = 4, GLA_DK = 96, GLA_DV = 192, GLA_IN = 2592, GLA_KD = 384;
constexpr int NEXP = 32, EFF = 512;
constexpr int LDU0 = 2560, LDU1 = 2816;
constexpr int MAXROWS = 40960;
constexpr float EPS = 1e-6f;

typedef unsigned short bf16;
typedef float f32x4 __attribute__((ext_vector_type(4)));
typedef unsigned u32x4 __attribute__((ext_vector_type(4)));
typedef unsigned u32x2 __attribute__((ext_vector_type(2)));
#define LAS __attribute__((address_space(3)))

constexpr size_t MiB = 1048576;
constexpr size_t WS_CTL = 0;
constexpr size_t CTL_ZERO_BYTES = 1 * MiB;
constexpr size_t WS_WIN0 = 1 * MiB;
constexpr size_t WS_WIN1 = WS_WIN0 + (size_t)2560 * 1024 * 2;
constexpr size_t WS_WOUT = WS_WIN1 + (size_t)2816 * 1024 * 2;
constexpr size_t WS_WMKV = WS_WOUT + (size_t)2 * 1024 * 1024 * 2;
constexpr size_t WS_MEMN = WS_WMKV + (size_t)1024 * 1024 * 2;
constexpr size_t WS_MKV = WS_MEMN + (size_t)1024 * 1024 * 2;
constexpr size_t WS_W13 = 24 * MiB;
constexpr size_t WS_W2 = WS_W13 + 64 * MiB;
constexpr size_t WS_XN = WS_W2 + 32 * MiB;
constexpr size_t WS_U = WS_XN + 32 * MiB;
constexpr size_t WS_Y = WS_U;
constexpr size_t WS_CAT = WS_U + 88 * MiB;
constexpr size_t WS_ACT = WS_CAT + 32 * MiB;
constexpr size_t WS_ROUTE = WS_ACT + 40 * MiB;
constexpr size_t WS_S = WS_ROUTE + 8 * MiB;
constexpr size_t WS_END = WS_S + 96 * MiB;
static_assert(WS_MKV + (size_t)1024 * 1024 * 2 <= WS_W13, "ws map");
static_assert(WS_END <= 512 * MiB, "ws map");
constexpr size_t RT_TOKE = 0, RT_TOKW = 131072, RT_TOKP = 262144, RT_LIST = 524288, RT_LISTW = 524288 + 2 * MiB;
constexpr int CW_CNT = 1024;
constexpr int CW_BAR = 4096;

struct Args {
    const float* in[21]; float* out; unsigned char* ws; int ph_lo, ph_hi;
};

__device__ __forceinline__ float bf2f(bf16 v) { return __uint_as_float(((unsigned)v) << 16); }
__device__ __forceinline__ unsigned f2bf(float f) { unsigned u = __float_as_uint(f); return (u + 0x7fffu + ((u >> 16) & 1u)) >> 16; }
__device__ __forceinline__ unsigned pk2(float lo, float hi) { return f2bf(lo) | (f2bf(hi) << 16); }
__device__ __forceinline__ float wave_sum(float v) {
#pragma unroll
    for (int o = 1; o < 64; o <<= 1) v += __shfl_xor(v, o);
    return v;
}
__device__ __forceinline__ float dot8(u32x4 a, u32x4 b) {
    float s = 0.f;
#pragma unroll
    for (int i = 0; i < 4; ++i) {
        s += __uint_as_float(a[i] << 16) * __uint_as_float(b[i] << 16);
        s += __uint_as_float(a[i] & 0xffff0000u) * __uint_as_float(b[i] & 0xffff0000u);
    }
    return s;
}
__device__ __forceinline__ float silu(float x) { return x / (1.f + __expf(-x)); }

struct Ctx {
    int tid, lane, wave, gw, ngw;
    LAS unsigned char* lds;
};
__device__ __forceinline__ Ctx fresh_ctx(LAS unsigned char* lds) {
    Ctx c; int t = threadIdx.x; asm volatile("" : "+v"(t)); int b = blockIdx.x; asm volatile("" : "+s"(b));
    c.tid = t; c.lane = t & 63; c.wave = __builtin_amdgcn_readfirstlane(t >> 6); c.gw = b * 8 + c.wave; c.ngw = gridDim.x * 8; c.lds = lds; return c;
}
__device__ __forceinline__ long gtid_() { int t = threadIdx.x; asm volatile("" : "+v"(t)); int b = blockIdx.x; asm volatile("" : "+s"(b)); return (long)(b * 512 + t); }
#define GTID gtid_()
#define GSIZE ((long)gridDim.x * 512)

__device__ __forceinline__ void transpose_item(const float* W, int N, int k0, int n0, bf16* dstrow0, int Kd, LAS float* scr, int lane) {
#pragma unroll 8
    for (int i = 0; i < 32; ++i) { const int kk = 2 * i + (lane >> 5); scr[kk * 33 + (lane & 31)] = W[(size_t)(k0 + kk) * N + n0 + (lane & 31)]; }
    asm volatile("s_waitcnt lgkmcnt(0)" ::: "memory");
    const int c = lane & 7;
#pragma unroll
    for (int j = 0; j < 4; ++j) { const int n = (lane >> 3) + 8 * j; const LAS float* s = scr + (8 * c) * 33 + n;
        u32x4 o; o.x = pk2(s[0 * 33], s[1 * 33]); o.y = pk2(s[2 * 33], s[3 * 33]); o.z = pk2(s[4 * 33], s[5 * 33]); o.w = pk2(s[6 * 33], s[7 * 33]);
        *(u32x4*)(dstrow0 + (size_t)n * Kd + k0 + 8 * c) = o; }
    asm volatile("s_waitcnt lgkmcnt(0)" ::: "memory");
}
__device__ __forceinline__ void transpose_matrix(const Ctx& c, const float* W, int K, int N, bf16* dst, int it0, int itstride) {
    LAS float* scr = (LAS float*)(c.lds + c.wave * 16384);
    const int nblk = N / 32, nit = (K / 64) * nblk;
    for (int it = it0; it < nit; it += itstride) { const int kb = it / nblk, nb = it % nblk;
        transpose_item(W, N, kb * 64, nb * 32, dst + (size_t)(nb * 32) * K, K, scr, c.lane); }
}
__device__ __forceinline__ void convert_moe(const Ctx& c, const float* w1, const float* w3, const float* w2, bf16* W13, bf16* W2) {
    LAS float* scr = (LAS float*)(c.lds + c.wave * 16384);
    const int per_e = 768;
    for (int it = c.gw; it < NEXP * per_e; it += c.ngw) {
        const int e = it / per_e, r = it % per_e, which = r / 256, q = r % 256;
        if (which < 2) {
            const int kb = q / 16, nb = q % 16, n0 = nb * 32;
            const float* W = (which == 0 ? w1 : w3) + (size_t)e * 1024 * 512;
            const int drow = (n0 / 128) * 256 + which * 128 + (n0 % 128);
            transpose_item(W, 512, kb * 64, n0, W13 + ((size_t)e * 1024 + drow) * 1024, 1024, scr, c.lane);
        } else {
            const int kb = q / 32, nb = q % 32, n0 = nb * 32;
            const float* W = w2 + (size_t)e * 512 * 1024;
            transpose_item(W, 1024, kb * 64, n0, W2 + ((size_t)e * 1024 + n0) * 512, 512, scr, c.lane);
        }
    }
}
__device__ __forceinline__ void rms_row_to_bf16(const float* xrow, const float* g, bf16* orow, int lane) {
    const f32x4* xr = (const f32x4*)xrow + lane; const f32x4* gr = (const f32x4*)g + lane;
    f32x4 v[4]; float s = 0.f;
#pragma unroll
    for (int j = 0; j < 4; ++j) { v[j] = xr[64 * j]; s += (v[j].x * v[j].x + v[j].y * v[j].y) + (v[j].z * v[j].z + v[j].w * v[j].w); }
    const float r = 1.f / sqrtf(wave_sum(s) * (1.f / D) + EPS);
    u32x2* o8 = (u32x2*)orow + lane;
#pragma unroll
    for (int j = 0; j < 4; ++j) { const f32x4 gg = gr[64 * j]; u32x2 w; w.x = pk2(v[j].x * r * gg.x, v[j].y * r * gg.y); w.y = pk2(v[j].z * r * gg.z, v[j].w * r * gg.w); o8[64 * j] = w; }
}

template <class RowA, class Epi>
__device__ __forceinline__ void naive_gemm(const Ctx& c, int M, int N, int K, const RowA& rowA, const bf16* Bt, const Epi& epi) {
    const long total = (long)M * N;
    for (long idx = GTID; idx < total; idx += GSIZE) {
        const int m = (int)(idx / N), n = (int)(idx % N);
        const bf16* a = rowA(m);
        if (a == nullptr) continue;
        const u32x4* a4 = (const u32x4*)a; const u32x4* b4 = (const u32x4*)(Bt + (size_t)n * K);
        float acc = 0.f;
        for (int k8 = 0; k8 < K / 8; ++k8) acc += dot8(a4[k8], b4[k8]);
        epi(m, n, acc);
    }
}


namespace pg8 {
typedef short bf16x8 __attribute__((ext_vector_type(8)));
constexpr int BM = 256, BK = 64, HALF = 128, HTB = HALF * BK * 2, STAGE_BYTES = 8 * HTB, NXCD = 8, WGM = 8;
__device__ __forceinline__ int lds_byte(int r, int c) { const int st = (r >> 4) * 2 + (c >> 5), rr = r & 15, cc = c & 31, ob = rr * 64 + cc * 2; return st * 1024 + (ob ^ (((ob >> 9) & 1) << 5)); }
__device__ __forceinline__ void stage_rc(int b, int& R, int& C) { const int st = b / 1024, sb = b % 1024, swz = sb ^ (((sb >> 9) & 1) << 5); R = (st >> 1) * 16 + swz / 64; C = (st & 1) * 32 + (swz % 64) / 2; }
__device__ __forceinline__ int perm32(int rho) { const int n = rho >> 4, i = rho & 15; return 8 * (i >> 2) + 4 * n + (i & 3); }
__device__ __forceinline__ unsigned cvt_pk_bf16(float lo, float hi) { unsigned r; asm volatile("v_cvt_pk_bf16_f32 %0, %1, %2" : "=v"(r) : "v"(lo), "v"(hi)); return r; }

struct Unit { int pm, pn, e, nv; };

struct StaticOrder {
    const bf16* A; const bf16* Bt; int K, nM, nN, nwg, G, c;
    __device__ void init(const bf16* A_, const bf16* Bt_, int M, int N, int K_, int G_, int c_) { A = A_; Bt = Bt_; K = K_; nM = M / BM; nN = N / BM; nwg = nM * nN; G = G_; c = c_; }
    __device__ __forceinline__ bool next(int i, Unit& u) const {
        const long L = (long)i * G + c; if (L >= nwg) return false;
        int wgid = (int)L; { const int q = nwg / NXCD, r = nwg % NXCD, xcd = wgid % NXCD, off = wgid / NXCD; wgid = (xcd < r ? xcd * (q + 1) : r * (q + 1) + (xcd - r) * q) + off; }
        const int nig = WGM * nN, gid = wgid / nig, fm = gid * WGM, gsz = (nM - fm) < WGM ? (nM - fm) : WGM;
        u.pm = fm + ((wgid % nig) % gsz); u.pn = (wgid % nig) / gsz; u.e = 0; u.nv = 256; return true;
    }
    __device__ __forceinline__ const char* a_base(const Unit& u) const { return (const char*)A + (size_t)u.pm * BM * K * 2; }
    __device__ __forceinline__ const char* b_base(const Unit& u) const { return (const char*)Bt + (size_t)u.pn * BM * K * 2; }
    __device__ __forceinline__ const int* rows(const Unit&) const { return nullptr; }
};
struct MoeOrder {
    const LAS int* tab; const bf16* A; const bf16* Bt; const int* list; int K, ntn, G, c; bool gather;
    __device__ __forceinline__ bool next(int i, Unit& u) const {
        const int L = i * G + c, total = tab[32] * ntn; if (L >= total) return false;
        const int T = L / ntn; int e = 0;
        for (int x = 1; x < 32; ++x) e = (tab[x] <= T) ? x : e;
        u.pm = T; u.pn = L % ntn; u.e = e; u.nv = tab[64 + e] - (T - tab[e]) * 256; return true;
    }
    __device__ __forceinline__ const char* a_base(const Unit& u) const { return gather ? (const char*)A : (const char*)A + (size_t)u.pm * BM * K * 2; }
    __device__ __forceinline__ const char* b_base(const Unit& u) const { return (const char*)Bt + ((size_t)u.e * 1024 + (size_t)u.pn * BM) * K * 2; }
    __device__ __forceinline__ const int* rows(const Unit& u) const { return list + (size_t)u.e * NTOK + (u.pm - tab[u.e]) * 256; }
};

struct EpiBf16 {
    static constexpr bool PERM = true;
    bf16* O; int ldc;
    __device__ __forceinline__ void operator()(const f32x4 (&acc)[2][2][4][2], const Unit& u, int wr, int wc, int fr, int fq) const {
        const int row0 = u.pm * BM + wr * 64 + fr, col0 = u.pn * BM + wc * 32 + 8 * fq;
#pragma unroll
        for (int ai = 0; ai < 2; ++ai)
#pragma unroll
            for (int m = 0; m < 4; ++m) { bf16* rowp = O + (size_t)(row0 + ai * HALF + m * 16) * ldc + col0;
#pragma unroll
                for (int bj = 0; bj < 2; ++bj) { const f32x4 v0 = acc[ai][bj][m][0], v1 = acc[ai][bj][m][1];
                    u32x4 w; w.x = cvt_pk_bf16(v0[0], v0[1]); w.y = cvt_pk_bf16(v0[2], v0[3]); w.z = cvt_pk_bf16(v1[0], v1[1]); w.w = cvt_pk_bf16(v1[2], v1[3]);
                    *(u32x4*)(rowp + bj * HALF) = w; } }
    }
};
struct EpiResF32 {
    static constexpr bool PERM = false;
    const float* R; float* C;
    __device__ __forceinline__ void operator()(const f32x4 (&acc)[2][2][4][2], const Unit& u, int wr, int wc, int fr, int fq) const {
        const int row0 = u.pm * BM + wr * 64 + fr, col0 = u.pn * BM + wc * 32 + 4 * fq;
#pragma unroll
        for (int ai = 0; ai < 2; ++ai)
#pragma unroll
            for (int m = 0; m < 4; ++m) { const size_t off = (size_t)(row0 + ai * HALF + m * 16) * D + col0;
#pragma unroll
                for (int bj = 0; bj < 2; ++bj)
#pragma unroll
                    for (int n = 0; n < 2; ++n) { const f32x4 rv = *(const f32x4*)(R + off + bj * HALF + n * 16); *(f32x4*)(C + off + bj * HALF + n * 16) = rv + acc[ai][bj][m][n]; }
                asm volatile("" ::: "memory"); }
    }
};
struct EpiSwiGLU {
    static constexpr bool PERM = true;
    bf16* O;
    __device__ __forceinline__ void operator()(const f32x4 (&acc)[2][2][4][2], const Unit& u, int wr, int wc, int fr, int fq) const {
        const int row0 = u.pm * BM + wr * 64 + fr, col0 = u.pn * 128 + wc * 32 + 8 * fq;
#pragma unroll
        for (int ai = 0; ai < 2; ++ai)
#pragma unroll
            for (int m = 0; m < 4; ++m) { float o[8];
#pragma unroll
                for (int n = 0; n < 2; ++n)
#pragma unroll
                    for (int i = 0; i < 4; ++i) { const float a = acc[ai][0][m][n][i], b = acc[ai][1][m][n][i]; o[n * 4 + i] = a * b * __builtin_amdgcn_rcpf(1.f + __expf(-a)); }
                u32x4 w; w.x = cvt_pk_bf16(o[0], o[1]); w.y = cvt_pk_bf16(o[2], o[3]); w.z = cvt_pk_bf16(o[4], o[5]); w.w = cvt_pk_bf16(o[6], o[7]);
                *(u32x4*)(O + (size_t)(row0 + ai * HALF + m * 16) * EFF + col0) = w; }
    }
};
struct EpiScaleBf16 {
    static constexpr bool PERM = true;
    bf16* O; const float* listw; const LAS int* tab;
    __device__ __forceinline__ void operator()(const f32x4 (&acc)[2][2][4][2], const Unit& u, int wr, int wc, int fr, int fq) const {
        const int rl0 = wr * 64 + fr, col0 = u.pn * BM + wc * 32 + 8 * fq;
        const float* lw = listw + (size_t)u.e * NTOK + (u.pm - tab[u.e]) * 256;
        float wv[2][4];
#pragma unroll
        for (int ai = 0; ai < 2; ++ai)
#pragma unroll
            for (int m = 0; m < 4; ++m) { const int rl = rl0 + ai * HALF + m * 16; wv[ai][m] = rl < u.nv ? lw[rl] : 0.f; }
#pragma unroll
        for (int ai = 0; ai < 2; ++ai)
#pragma unroll
            for (int m = 0; m < 4; ++m) { bf16* rowp = O + (size_t)(u.pm * BM + rl0 + ai * HALF + m * 16) * D + col0; const float s = wv[ai][m];
#pragma unroll
                for (int bj = 0; bj < 2; ++bj) { const f32x4 v0 = acc[ai][bj][m][0] * s, v1 = acc[ai][bj][m][1] * s;
                    u32x4 w; w.x = cvt_pk_bf16(v0[0], v0[1]); w.y = cvt_pk_bf16(v0[2], v0[3]); w.z = cvt_pk_bf16(v1[0], v1[1]); w.w = cvt_pk_bf16(v1[2], v1[3]);
                    *(u32x4*)(rowp + bj * HALF) = w; } }
    }
};

template <class Epi, class Sched, bool GATHER>
__device__ __forceinline__ void gemm_phase(LAS unsigned char* lds, const int K, const Sched& S, const Epi& E) {
    int tid_ = threadIdx.x; asm volatile("" : "+v"(tid_));
    const int tid = tid_, wid = __builtin_amdgcn_readfirstlane(tid >> 6), lane = tid & 63, wr = wid >> 2, wc = wid & 3, fr = lane & 15, fq = lane >> 4;
    const int nt = K / BK;
    int Rr[2], Cc[2]; unsigned voffB[2];
#pragma unroll
    for (int i = 0; i < 2; ++i) { int R, C; stage_rc(tid * 16 + i * 8192, R, C); Rr[i] = R; Cc[i] = C; const int Rb = Epi::PERM ? ((R & ~31) + perm32(R & 31)) : R; voffB[i] = (unsigned)(Rb * K + C) * 2u; }
    const size_t kstep = (size_t)(BK * 2);
    const size_t hstep = (size_t)HALF * K * 2;
    const size_t hstepA = GATHER ? 0 : hstep;
    const unsigned ldsw = (unsigned)wid * 1024u;
    const int aoff = lds_byte(wr * 64 + fr, fq * 8), boff = lds_byte(wc * 32 + fr, fq * 8);
#define PG8_SA(b, h) (((b) * 2 + (h)) * HTB)
#define PG8_SB(b, h) ((4 + (b) * 2 + (h)) * HTB)
#define PG8_STAGE(bufoff, gbase, voff) do { _Pragma("unroll") for (int _i = 0; _i < 2; ++_i) \
        __builtin_amdgcn_global_load_lds((const unsigned*)((const char*)(gbase) + (voff)[_i]), (LAS unsigned*)(lds + (bufoff) + ldsw + _i * 8192), 16, 0, 0); } while (0)
#define PG8_LDA(dst, b, h) do { _Pragma("unroll") for (int m = 0; m < 4; ++m) _Pragma("unroll") for (int k = 0; k < 2; ++k) dst[m][k] = *(const LAS bf16x8*)(lds + PG8_SA(b, h) + aoff + m * 2048 + k * 1024); } while (0)
#define PG8_LDB(dst, b, h) do { _Pragma("unroll") for (int n = 0; n < 2; ++n) _Pragma("unroll") for (int k = 0; k < 2; ++k) dst[n][k] = *(const LAS bf16x8*)(lds + PG8_SB(b, h) + boff + n * 2048 + k * 1024); } while (0)
#define PG8_MMA(ai, bj, At, Bt) do { __builtin_amdgcn_s_setprio(1); _Pragma("unroll") for (int m = 0; m < 4; ++m) _Pragma("unroll") for (int n = 0; n < 2; ++n) _Pragma("unroll") for (int k = 0; k < 2; ++k) \
        acc[ai][bj][m][n] = __builtin_amdgcn_mfma_f32_16x16x32_bf16(Bt[n][k], At[m][k], acc[ai][bj][m][n], 0, 0, 0); __builtin_amdgcn_s_setprio(0); } while (0)
#define PG8_WAIT_V(n) asm volatile("s_waitcnt vmcnt(" #n ")" ::: "memory")
#define PG8_WAIT_L(n) asm volatile("s_waitcnt lgkmcnt(" #n ")" ::: "memory")
#define PG8_BAR __builtin_amdgcn_s_barrier()
#define PG8_SCHED __builtin_amdgcn_sched_barrier(0)
#define PG8_VOFFA(u, v0, v1) do { if constexpr (GATHER) { const int* _rw = S.rows(u); _Pragma("unroll") for (int _i = 0; _i < 2; ++_i) { \
            const int _r0 = Rr[_i], _r1 = Rr[_i] + HALF; const int _t0 = _rw[_r0 < (u).nv ? _r0 : 0], _t1 = _rw[_r1 < (u).nv ? _r1 : 0]; \
            v0[_i] = (unsigned)(_t0 * K + Cc[_i]) * 2u; v1[_i] = (unsigned)(_t1 * K + Cc[_i]) * 2u; } } \
        else { _Pragma("unroll") for (int _i = 0; _i < 2; ++_i) { v0[_i] = (unsigned)(Rr[_i] * K + Cc[_i]) * 2u; v1[_i] = v0[_i]; } } } while (0)
    Unit cur, nxt; int ui = 0;
    if (!S.next(0, cur)) return;
    f32x4 acc[2][2][4][2];
#pragma unroll
    for (int a = 0; a < 2; ++a)
#pragma unroll
        for (int b = 0; b < 2; ++b)
#pragma unroll
            for (int m = 0; m < 4; ++m)
#pragma unroll
                for (int n = 0; n < 2; ++n) acc[a][b][m][n] = (f32x4){0.f, 0.f, 0.f, 0.f};
    bf16x8 At[4][2], B0[2][2], B1[2][2];
    const char* cA = S.a_base(cur); const char* cB = S.b_base(cur);
    unsigned cv0[2], cv1[2], nv0[2], nv1[2];
    PG8_VOFFA(cur, cv0, cv1);
    PG8_STAGE(PG8_SB(0, 0), cB, voffB); PG8_STAGE(PG8_SB(0, 1), cB + hstep, voffB); PG8_STAGE(PG8_SA(0, 0), cA, cv0); PG8_STAGE(PG8_SA(0, 1), cA + hstepA, cv1);
    if (wr == 1) PG8_BAR;
    PG8_WAIT_V(2); PG8_BAR;
    PG8_STAGE(PG8_SB(1, 0), cB + kstep, voffB); PG8_STAGE(PG8_SA(1, 0), cA + kstep, cv0); PG8_STAGE(PG8_SB(1, 1), cB + hstep + kstep, voffB);
    PG8_WAIT_V(6); PG8_BAR;
    for (;;) {
        const bool has_next = S.next(ui + 1, nxt);
        const char* nA = has_next ? S.a_base(nxt) : cA; const char* nB = has_next ? S.b_base(nxt) : cB;
        if (has_next) { PG8_VOFFA(nxt, nv0, nv1); } else {
#pragma unroll
            for (int i = 0; i < 2; ++i) { nv0[i] = cv0[i]; nv1[i] = cv1[i]; } }
        for (int t = 0; t < nt; t += 2) {
            const bool last = (t == nt - 2);
            const char* a1 = cA + (size_t)(t + 1) * kstep;
            const char* a2 = last ? nA : cA + (size_t)(t + 2) * kstep; const char* b2 = last ? nB : cB + (size_t)(t + 2) * kstep;
            const char* a3 = a2 + kstep; const char* b3 = b2 + kstep;
            unsigned s0[2], s1[2];
#pragma unroll
            for (int i = 0; i < 2; ++i) { s0[i] = last ? nv0[i] : cv0[i]; s1[i] = last ? nv1[i] : cv1[i]; }
            PG8_LDB(B0, 0, 0); PG8_LDB(B1, 0, 1); PG8_SCHED; PG8_LDA(At, 0, 0); PG8_STAGE(PG8_SA(1, 1), a1 + hstepA, cv1);
            PG8_WAIT_V(8); PG8_WAIT_L(0); PG8_BAR; PG8_MMA(0, 0, At, B0); PG8_MMA(0, 1, At, B1); PG8_BAR; PG8_SCHED;
            PG8_LDA(At, 0, 1); PG8_STAGE(PG8_SB(0, 0), b2, voffB); PG8_STAGE(PG8_SB(0, 1), b2 + hstep, voffB); PG8_STAGE(PG8_SA(0, 0), a2, s0);
            PG8_WAIT_V(8); PG8_WAIT_L(0); PG8_BAR; PG8_MMA(1, 0, At, B0); PG8_MMA(1, 1, At, B1); PG8_BAR; PG8_SCHED;
            PG8_LDB(B0, 1, 0); PG8_LDB(B1, 1, 1); PG8_SCHED; PG8_LDA(At, 1, 0); PG8_STAGE(PG8_SA(0, 1), a2 + hstepA, s1);
            PG8_WAIT_V(8); PG8_WAIT_L(0); PG8_BAR; PG8_MMA(0, 0, At, B0); PG8_MMA(0, 1, At, B1); PG8_BAR; PG8_SCHED;
            PG8_LDA(At, 1, 1); PG8_STAGE(PG8_SB(1, 0), b3, voffB); PG8_STAGE(PG8_SB(1, 1), b3 + hstep, voffB); PG8_STAGE(PG8_SA(1, 0), a3, s0);
            PG8_WAIT_V(8); PG8_WAIT_L(0); PG8_BAR; PG8_MMA(1, 0, At, B0); PG8_MMA(1, 1, At, B1); PG8_BAR; PG8_SCHED;
        }
        if (wr == 0) PG8_BAR;
        E(acc, cur, wr, wc, fr, fq);
        if (!has_next) break;
#pragma unroll
        for (int a = 0; a < 2; ++a)
#pragma unroll
            for (int b = 0; b < 2; ++b)
#pragma unroll
                for (int m = 0; m < 4; ++m)
#pragma unroll
                    for (int n = 0; n < 2; ++n) acc[a][b][m][n] = (f32x4){0.f, 0.f, 0.f, 0.f};
        cur = nxt; cA = nA; cB = nB; ++ui;
#pragma unroll
        for (int i = 0; i < 2; ++i) { cv0[i] = nv0[i]; cv1[i] = nv1[i]; }
        if (wr == 1) PG8_BAR;
    }
    PG8_WAIT_V(0);
    PG8_BAR;
#undef PG8_SA
#undef PG8_SB
#undef PG8_STAGE
#undef PG8_LDA
#undef PG8_LDB
#undef PG8_MMA
#undef PG8_WAIT_V
#undef PG8_WAIT_L
#undef PG8_BAR
#undef PG8_SCHED
#undef PG8_VOFFA
}
}

__device__ __forceinline__ void naive_na(const Ctx& c, const bf16* U, const float* rpb, bf16* CAT) {
    const long total = (long)NTOK * NA_H;
    for (long idx = GTID; idx < total; idx += GSIZE) {
        const int h = (int)(idx % NA_H), t = (int)(idx / NA_H);
        const int b = t / SEQ, p = t % SEQ, r = p / 64, cc = p % 64;
        const int rs = min(max(r - 4, 0), 56), cs = min(max(cc - 8, 0), 48);
        const u32x4* q4 = (const u32x4*)(U + (size_t)t * LDU0 + h * 64);
        float acc[64];
#pragma unroll
        for (int i = 0; i < 64; ++i) acc[i] = 0.f;
        float mx = -1e30f, l = 0.f;
        for (int i = 0; i < 8; ++i) for (int j = 0; j < 16; ++j) {
            const int kr = rs + i, kc = cs + j, kt = b * SEQ + kr * 64 + kc;
            const u32x4* k4 = (const u32x4*)(U + (size_t)kt * LDU0 + 768 + h * 64);
            float s = 0.f;
#pragma unroll
            for (int d8 = 0; d8 < 8; ++d8) s += dot8(q4[d8], k4[d8]);
            s = s * 0.125f + rpb[(h * 15 + (kr - r + 7)) * 31 + (kc - cc + 15)];
            const float mn = fmaxf(mx, s), alpha = __expf(mx - mn), pp = __expf(s - mn);
            l = l * alpha + pp; mx = mn;
            const u32x4* v4 = (const u32x4*)(U + (size_t)kt * LDU0 + 1536 + h * 64);
#pragma unroll
            for (int d8 = 0; d8 < 8; ++d8) { const u32x4 vv = v4[d8];
#pragma unroll
                for (int e = 0; e < 4; ++e) { acc[d8 * 8 + 2 * e] = acc[d8 * 8 + 2 * e] * alpha + pp * __uint_as_float(vv[e] << 16);
                    acc[d8 * 8 + 2 * e + 1] = acc[d8 * 8 + 2 * e + 1] * alpha + pp * __uint_as_float(vv[e] & 0xffff0000u); } }
        }
        const float inv = 1.f / l;
        u32x4* o4 = (u32x4*)(CAT + (size_t)t * D + h * 64);
#pragma unroll
        for (int d8 = 0; d8 < 8; ++d8) { u32x4 w; w.x = pk2(acc[d8 * 8] * inv, acc[d8 * 8 + 1] * inv); w.y = pk2(acc[d8 * 8 + 2] * inv, acc[d8 * 8 + 3] * inv);
            w.z = pk2(acc[d8 * 8 + 4] * inv, acc[d8 * 8 + 5] * inv); w.w = pk2(acc[d8 * 8 + 6] * inv, acc[d8 * 8 + 7] * inv); o4[d8] = w; }
    }
}
__device__ __forceinline__ void naive_memattn(const Ctx& c, const bf16* U, int ldu, int mqcol, const bf16* MKV, int lay, bf16* CAT) {
    const long total = (long)NTOK * 4;
    for (long idx = GTID; idx < total; idx += GSIZE) {
        const int h = (int)(idx % 4), t = (int)(idx / 4), b = t / SEQ;
        const u32x4* q4 = (const u32x4*)(U + (size_t)t * ldu + mqcol + h * 64);
        float acc[64];
#pragma unroll
        for (int i = 0; i < 64; ++i) acc[i] = 0.f;
        float mx = -1e30f, l = 0.f;
        for (int m = 0; m < NMEM; ++m) {
            const bf16* row = MKV + (size_t)(b * NMEM + m) * 1024 + lay * 512;
            const u32x4* k4 = (const u32x4*)(row + h * 64);
            float s = 0.f;
#pragma unroll
            for (int d8 = 0; d8 < 8; ++d8) s += dot8(q4[d8], k4[d8]);
            s *= 0.125f;
            const float mn = fmaxf(mx, s), alpha = __expf(mx - mn), pp = __expf(s - mn);
            l = l * alpha + pp; mx = mn;
            const u32x4* v4 = (const u32x4*)(row + 256 + h * 64);
#pragma unroll
            for (int d8 = 0; d8 < 8; ++d8) { const u32x4 vv = v4[d8];
#pragma unroll
                for (int e = 0; e < 4; ++e) { acc[d8 * 8 + 2 * e] = acc[d8 * 8 + 2 * e] * alpha + pp * __uint_as_float(vv[e] << 16);
                    acc[d8 * 8 + 2 * e + 1] = acc[d8 * 8 + 2 * e + 1] * alpha + pp * __uint_as_float(vv[e] & 0xffff0000u); } }
        }
        const float inv = 1.f / l;
        u32x4* o4 = (u32x4*)(CAT + (size_t)t * D + MIX + h * 64);
#pragma unroll
        for (int d8 = 0; d8 < 8; ++d8) { u32x4 w; w.x = pk2(acc[d8 * 8] * inv, acc[d8 * 8 + 1] * inv); w.y = pk2(acc[d8 * 8 + 2] * inv, acc[d8 * 8 + 3] * inv);
            w.z = pk2(acc[d8 * 8 + 4] * inv, acc[d8 * 8 + 5] * inv); w.w = pk2(acc[d8 * 8 + 6] * inv, acc[d8 * 8 + 7] * inv); o4[d8] = w; }
    }
}


namespace att {
typedef short bf16x8 __attribute__((ext_vector_type(8)));
typedef short s16x4 __attribute__((ext_vector_type(4)));
__device__ __forceinline__ s16x4 tr_read(LAS const unsigned char* p) { return __builtin_amdgcn_ds_read_tr16_b64_v4i16((LAS s16x4*)p); }
template <bool NA_MODE, class KRow, class Bias>
__device__ __forceinline__ void attn16x256(const bf16* qrow, const KRow& krow, LAS const unsigned char* vlane, int xs, const Bias& bias, bf16* orow, int fr, int fq) {
    const int p = fr & 3, ph = p >> 1, pl8 = (p & 1) * 8;
    const bf16x8 q0 = *(const bf16x8*)(qrow + 8 * fq), q1 = *(const bf16x8*)(qrow + 32 + 8 * fq);
    f32x4 s[16];
#pragma unroll
    for (int kt = 0; kt < 16; ++kt) {
        const bf16* kr = krow(kt);
        const bf16x8 k0 = *(const bf16x8*)(kr + 8 * fq), k1 = *(const bf16x8*)(kr + 32 + 8 * fq);
        f32x4 a = {0.f, 0.f, 0.f, 0.f};
        a = __builtin_amdgcn_mfma_f32_16x16x32_bf16(k0, q0, a, 0, 0, 0);
        a = __builtin_amdgcn_mfma_f32_16x16x32_bf16(k1, q1, a, 0, 0, 0);
        s[kt] = a;
    }
    float mx = -3.0e38f;
#pragma unroll
    for (int kt = 0; kt < 16; ++kt)
#pragma unroll
        for (int r = 0; r < 4; ++r) { const float v = bias(kt, r, s[kt][r]); s[kt][r] = v; mx = fmaxf(mx, v); }
    mx = fmaxf(mx, __shfl_xor(mx, 16)); mx = fmaxf(mx, __shfl_xor(mx, 32));
    float l = 0.f;
#pragma unroll
    for (int kt = 0; kt < 16; ++kt)
#pragma unroll
        for (int r = 0; r < 4; ++r) { const float pv = __expf(s[kt][r] - mx); s[kt][r] = pv; l += pv; }
    l += __shfl_xor(l, 16); l += __shfl_xor(l, 32);
    LAS const unsigned char* vb[4];
#pragma unroll
    for (int dt = 0; dt < 4; ++dt) vb[dt] = vlane + (((2 * dt + ph) ^ xs) << 4) + pl8;
    f32x4 o[4];
#pragma unroll
    for (int dt = 0; dt < 4; ++dt) o[dt] = (f32x4){0.f, 0.f, 0.f, 0.f};
#pragma unroll
    for (int j = 0; j < 8; ++j) {
        u32x4 pw; pw.x = pg8::cvt_pk_bf16(s[2 * j][0], s[2 * j][1]); pw.y = pg8::cvt_pk_bf16(s[2 * j][2], s[2 * j][3]);
        pw.z = pg8::cvt_pk_bf16(s[2 * j + 1][0], s[2 * j + 1][1]); pw.w = pg8::cvt_pk_bf16(s[2 * j + 1][2], s[2 * j + 1][3]);
        const bf16x8 pb = __builtin_bit_cast(bf16x8, pw);
        constexpr int dummy = 0; (void)dummy;
        const int c0 = NA_MODE ? (((2 * j) >> 1) * 64 + 16 * ((2 * j) & 1)) : 16 * (2 * j);
        const int c1 = NA_MODE ? (((2 * j + 1) >> 1) * 64 + 16 * ((2 * j + 1) & 1)) : 16 * (2 * j + 1);
#pragma unroll
        for (int dt = 0; dt < 4; ++dt) {
            const s16x4 lo = tr_read(vb[dt] + c0 * 128), hi = tr_read(vb[dt] + c1 * 128);
            const bf16x8 va = {lo[0], lo[1], lo[2], lo[3], hi[0], hi[1], hi[2], hi[3]};
            o[dt] = __builtin_amdgcn_mfma_f32_16x16x32_bf16(va, pb, o[dt], 0, 0, 0);
        }
    }
    const float inv = 1.f / l;
#pragma unroll
    for (int dt = 0; dt < 4; ++dt) { u32x2 w; w.x = pg8::cvt_pk_bf16(o[dt][0] * inv, o[dt][1] * inv); w.y = pg8::cvt_pk_bf16(o[dt][2] * inv, o[dt][3] * inv);
        *(u32x2*)(orow + 16 * dt + 4 * fq) = w; }
}

__device__ __forceinline__ void na_phase(const Ctx& c, const bf16* U, const float* rpb, bf16* CAT, int vcu, int G) {
    const int fr = c.lane & 15, fq = c.lane >> 4, j = c.wave & 3, hs = c.wave >> 2;
    for (int u = vcu; u < NBATCH * 6 * 64; u += G) {
        const int r = u & 63, hp = (u >> 6) % 6, b = u / 384, rs = min(max(r - 4, 0), 56);
        __syncthreads();
#pragma unroll 4
        for (int it = 0; it < 16; ++it) { const int idx = c.tid + 512 * it, hsel = idx >> 12, rem = idx & 4095, key = rem >> 3, ch = rem & 7;
            const u32x4 v = *(const u32x4*)(U + (size_t)(b * SEQ + (rs + (key >> 6)) * 64 + (key & 63)) * LDU0 + 1536 + (2 * hp + hsel) * 64 + ch * 8);
            *(LAS u32x4*)(c.lds + hsel * 65536 + key * 128 + ((ch ^ (key & 7)) << 4)) = v; }
        __syncthreads();
        const int h = 2 * hp + hs, cq = 16 * j + fr, cs = min(max(cq - 8, 0), 48), kc0 = min(max(16 * j - 8, 0), 32);
        const int tq = b * SEQ + r * 64 + cq;
        const bf16* qrow = U + (size_t)tq * LDU0 + h * 64;
        const bf16* kbase = U + (size_t)(b * SEQ + rs * 64 + kc0 + fr) * LDU0 + 768 + h * 64;
        const int rowb = kc0 + 4 * fq + (fr >> 2);
        LAS const unsigned char* vlane = c.lds + hs * 65536 + rowb * 128;
        const float* rp = rpb + (size_t)(h * 15 + (rs - r + 7)) * 31;
        attn16x256<true>(qrow, [&](int kt) { return kbase + (size_t)((kt >> 1) * 64 + 16 * (kt & 1)) * LDU0; }, vlane, rowb & 7,
            [&](int kt, int rg, float sv) { const int kcol = kc0 + 16 * (kt & 1) + 4 * fq + rg; const bool ok = (kcol >= cs) && (kcol < cs + 16);
                const int dc = min(max(kcol - cq + 15, 0), 30); const float bv = rp[(kt >> 1) * 31 + dc]; return ok ? sv * 0.125f + bv : -1.0e30f; },
            CAT + (size_t)tq * D + h * 64, fr, fq);
    }
}
__device__ __forceinline__ void mem_phase(const Ctx& c, const bf16* U, int ldu, int mqcol, const bf16* MKV, int lay, bf16* CAT, int vcu, int G) {
    const int fr = c.lane & 15, fq = c.lane >> 4;
    for (int u = vcu; u < NBATCH * 4 * 16; u += G) {
        const int tt = u & 15, h = (u >> 4) & 3, b = u >> 6;
        __syncthreads();
#pragma unroll
        for (int it = 0; it < 4; ++it) { const int idx = c.tid + 512 * it, key = idx >> 3, ch = idx & 7;
            const u32x4 v = *(const u32x4*)(MKV + (size_t)(b * NMEM + key) * 1024 + lay * 512 + 256 + h * 64 + ch * 8);
            *(LAS u32x4*)(c.lds + key * 128 + ((ch ^ (key & 7)) << 4)) = v; }
        __syncthreads();
        const bf16* kbase = MKV + (size_t)(b * NMEM + fr) * 1024 + lay * 512 + h * 64;
        const int rowb = 4 * fq + (fr >> 2);
        LAS const unsigned char* vlane = c.lds + rowb * 128;
#pragma unroll 1
        for (int it = 0; it < 2; ++it) {
            const int tq = b * SEQ + tt * 256 + c.wave * 32 + it * 16 + fr;
            attn16x256<false>(U + (size_t)tq * ldu + mqcol + h * 64, [&](int kt) { return kbase + (size_t)(16 * kt) * 1024; }, vlane, rowb & 7,
                [&](int, int, float sv) { return sv * 0.125f; }, CAT + (size_t)tq * D + MIX + h * 64, fr, fq);
        }
    }
}
}

__device__ __forceinline__ void route_phase(const Ctx& c, const float* X, const float* g, const float* wg, const float* bg, const float* wr, const float* br,
                                            bf16* HN, unsigned char* rt, unsigned* cnt) {
    int* TOKE = (int*)(rt + RT_TOKE); float* TOKW = (float*)(rt + RT_TOKW); int* TOKP = (int*)(rt + RT_TOKP); int* LIST = (int*)(rt + RT_LIST); float* LISTW = (float*)(rt + RT_LISTW);
    for (int t = c.gw; t < NTOK; t += c.ngw) {
        const f32x4* xr = (const f32x4*)(X + (size_t)t * D) + c.lane; const f32x4* gr = (const f32x4*)g + c.lane;
        f32x4 v[4]; float s = 0.f;
#pragma unroll
        for (int j = 0; j < 4; ++j) { v[j] = xr[64 * j]; s += (v[j].x * v[j].x + v[j].y * v[j].y) + (v[j].z * v[j].z + v[j].w * v[j].w); }
        const float r = 1.f / sqrtf(wave_sum(s) * (1.f / D) + EPS);
        u32x2* o8 = (u32x2*)(HN + (size_t)t * D) + c.lane;
#pragma unroll
        for (int j = 0; j < 4; ++j) { const f32x4 gg = gr[64 * j]; v[j].x *= r * gg.x; v[j].y *= r * gg.y; v[j].z *= r * gg.z; v[j].w *= r * gg.w;
            u32x2 w; w.x = pk2(v[j].x, v[j].y); w.y = pk2(v[j].z, v[j].w); o8[64 * j] = w; }
        LAS float* hrow = (LAS float*)(c.lds + c.wave * 16384);
#pragma unroll
        for (int j = 0; j < 4; ++j) *(LAS f32x4*)(hrow + 4 * c.lane + 256 * j) = v[j];
        asm volatile("s_waitcnt lgkmcnt(0)" ::: "memory");
        float lg[4], lr[32];
#pragma unroll
        for (int o = 0; o < 4; ++o) lg[o] = 0.f;
#pragma unroll
        for (int o = 0; o < 32; ++o) lr[o] = 0.f;
#pragma unroll 1
        for (int kk = 0; kk < 16; ++kk) { const int k = c.lane + 64 * kk; const float xv = hrow[k];
            const f32x4 w4 = *(const f32x4*)(wg + (size_t)k * 4);
#pragma unroll
            for (int o = 0; o < 4; ++o) lg[o] += xv * w4[o];
#pragma unroll
            for (int o4 = 0; o4 < 8; ++o4) { const f32x4 w = *(const f32x4*)(wr + (size_t)k * 32 + o4 * 4);
#pragma unroll
                for (int o = 0; o < 4; ++o) lr[o4 * 4 + o] += xv * w[o]; } }
        asm volatile("s_waitcnt lgkmcnt(0)" ::: "memory");
#pragma unroll
        for (int o = 0; o < 4; ++o) lg[o] = wave_sum(lg[o]) + bg[o];
#pragma unroll
        for (int o = 0; o < 32; ++o) lr[o] = wave_sum(lr[o]) + br[o];
        int gi = 0; float gm = lg[0];
#pragma unroll
        for (int o = 1; o < 4; ++o) if (lg[o] > gm) { gm = lg[o]; gi = o; }
        float gs = 0.f;
#pragma unroll
        for (int o = 0; o < 4; ++o) gs += __expf(lg[o] - gm);
        const float ggate = 1.f / gs;
        float el[8];
#pragma unroll
        for (int o = 0; o < 8; ++o) { float x = lr[o];
#pragma unroll
            for (int q = 1; q < 4; ++q) x = (gi == q) ? lr[q * 8 + o] : x;
            el[o] = x; }
        int i0 = 0; float l0 = el[0];
#pragma unroll
        for (int o = 1; o < 8; ++o) if (el[o] > l0) { l0 = el[o]; i0 = o; }
        int i1 = -1; float l1 = -3.0e38f;
#pragma unroll
        for (int o = 0; o < 8; ++o) if (o != i0 && el[o] > l1) { l1 = el[o]; i1 = o; }
        const float e1 = __expf(l1 - l0), den = 1.f / (1.f + e1);
        const float w0 = den * ggate, w1 = e1 * den * ggate;
        if (c.lane == 0) {
            const int ex0 = gi * 8 + i0, ex1 = gi * 8 + i1;
            const unsigned p0 = atomicAdd(cnt + ex0, 1u), p1 = atomicAdd(cnt + ex1, 1u);
            LIST[ex0 * NTOK + p0] = t; LIST[ex1 * NTOK + p1] = t; LISTW[ex0 * NTOK + p0] = w0; LISTW[ex1 * NTOK + p1] = w1;
            TOKE[2 * t] = ex0; TOKE[2 * t + 1] = ex1; TOKW[2 * t] = w0; TOKW[2 * t + 1] = w1; TOKP[2 * t] = (int)p0; TOKP[2 * t + 1] = (int)p1;
        }
    }
}
__device__ __forceinline__ int pstart_of(const unsigned* cnt, int e) { int s = 0; for (int i = 0; i < e; ++i) s += ((int)cnt[i] + 255) & ~255; return s; }
__device__ __forceinline__ bool row_lookup(const unsigned* cnt, int R, int& e, int& i, int& n) {
    int s = 0;
    for (int x = 0; x < NEXP; ++x) { const int cn = (int)cnt[x], pc = (cn + 255) & ~255; if (R < s + pc) { e = x; i = R - s; n = cn; return true; } s += pc; }
    return false;
}

__device__ __forceinline__ void combine_phase(const Ctx& c, float* X, const bf16* Y, const unsigned char* rt, const unsigned* cnt, const float* g, bf16* XN, float* OUTF) {
    const int* TOKE = (const int*)(rt + RT_TOKE); const int* TOKP = (const int*)(rt + RT_TOKP);
    for (int t = c.gw; t < NTOK; t += c.ngw) {
        const int e0 = TOKE[2 * t], e1 = TOKE[2 * t + 1];
        const int R0 = pstart_of(cnt, e0) + TOKP[2 * t], R1 = pstart_of(cnt, e1) + TOKP[2 * t + 1];
        f32x4* xr = (f32x4*)(X + (size_t)t * D) + c.lane; const f32x4* gr = (const f32x4*)g + c.lane;
        const u32x2* y0 = (const u32x2*)(Y + (size_t)R0 * D) + c.lane; const u32x2* y1 = (const u32x2*)(Y + (size_t)R1 * D) + c.lane;
        f32x4 v[4]; float s = 0.f;
#pragma unroll
        for (int j = 0; j < 4; ++j) { v[j] = xr[64 * j]; const u32x2 a = y0[64 * j], b = y1[64 * j];
            v[j].x += __uint_as_float(a.x << 16) + __uint_as_float(b.x << 16); v[j].y += __uint_as_float(a.x & 0xffff0000u) + __uint_as_float(b.x & 0xffff0000u);
            v[j].z += __uint_as_float(a.y << 16) + __uint_as_float(b.y << 16); v[j].w += __uint_as_float(a.y & 0xffff0000u) + __uint_as_float(b.y & 0xffff0000u);
            s += (v[j].x * v[j].x + v[j].y * v[j].y) + (v[j].z * v[j].z + v[j].w * v[j].w); }
        const float r = 1.f / sqrtf(wave_sum(s) * (1.f / D) + EPS);
        if (XN) {
            u32x2* o8 = (u32x2*)(XN + (size_t)t * D) + c.lane;
#pragma unroll
            for (int j = 0; j < 4; ++j) { xr[64 * j] = v[j]; const f32x4 gg = gr[64 * j]; u32x2 w; w.x = pk2(v[j].x * r * gg.x, v[j].y * r * gg.y); w.y = pk2(v[j].z * r * gg.z, v[j].w * r * gg.w); o8[64 * j] = w; }
        } else {
            f32x4* o = (f32x4*)(OUTF + (size_t)t * D) + c.lane;
#pragma unroll
            for (int j = 0; j < 4; ++j) { const f32x4 gg = gr[64 * j]; f32x4 w; w.x = v[j].x * r * gg.x; w.y = v[j].y * r * gg.y; w.z = v[j].z * r * gg.z; w.w = v[j].w * r * gg.w; o[64 * j] = w; }
        }
    }
}

__device__ __forceinline__ void gla_decay(const Ctx& c, const bf16* U, const float* gup, const float* gbias, float* DECA) {
    const long total = (long)NTOK * 2 * GLA_KD;
    for (long idx = GTID; idx < total; idx += GSIZE) {
        const int cc = (int)(idx % GLA_KD), dir = (int)((idx / GLA_KD) % 2), t = (int)(idx / (2 * GLA_KD));
        const bf16* r = U + (size_t)t * LDU1 + 2304 + dir * 16;
        float z = gbias[dir * GLA_KD + cc];
#pragma unroll
        for (int k = 0; k < 16; ++k) z += bf2f(r[k]) * gup[(dir * 16 + k) * GLA_KD + cc];
        const float ls = fminf(z, 0.f) - log1pf(__expf(-fabsf(z)));
        DECA[idx] = __expf(ls * (1.f / 16.f));
    }
}
__device__ __forceinline__ void gla_recur(const Ctx& c, const bf16* U, const float* DECA, float* OF) {
    const long total = (long)NBATCH * GLA_H * GLA_DV * 2;
    const float qs = 0.10206207261596577f;
    for (long idx = GTID; idx < total; idx += GSIZE) {
        const int half = (int)(idx & 1), dv = (int)((idx >> 1) % GLA_DV), h = (int)(((idx >> 1) / GLA_DV) % GLA_H), b = (int)((idx >> 1) / (GLA_DV * GLA_H));
        float S[48];
        for (int dir = 0; dir < 2; ++dir) {
#pragma unroll
            for (int d = 0; d < 48; ++d) S[d] = 0.f;
            for (int s = 0; s < SEQ; ++s) {
                const int p = dir ? (SEQ - 1 - s) : s, t = b * SEQ + p;
                const bf16* row = U + (size_t)t * LDU1;
                const float vv = bf2f(row[768 + h * GLA_DV + dv]);
                const float* a = DECA + ((size_t)t * 2 + dir) * GLA_KD + h * GLA_DK + half * 48;
                const u32x4* q4 = (const u32x4*)(row + h * GLA_DK + half * 48); const u32x4* k4 = (const u32x4*)(row + 384 + h * GLA_DK + half * 48);
                float o = 0.f;
#pragma unroll
                for (int d8 = 0; d8 < 6; ++d8) { const u32x4 qq = q4[d8], kk = k4[d8]; const f32x4 a0 = *(const f32x4*)(a + d8 * 8), a1 = *(const f32x4*)(a + d8 * 8 + 4);
#pragma unroll
                    for (int e = 0; e < 4; ++e) { const float aa0 = e < 2 ? a0[2 * e] : a1[2 * e - 4], aa1 = e < 2 ? a0[2 * e + 1] : a1[2 * e - 3];
                        const float s0 = aa0 * S[d8 * 8 + 2 * e] + __uint_as_float(kk[e] << 16) * vv; S[d8 * 8 + 2 * e] = s0; o += __uint_as_float(qq[e] << 16) * s0;
                        const float s1 = aa1 * S[d8 * 8 + 2 * e + 1] + __uint_as_float(kk[e] & 0xffff0000u) * vv; S[d8 * 8 + 2 * e + 1] = s1; o += __uint_as_float(qq[e] & 0xffff0000u) * s1; } }
                o += __shfl_xor(o, 1);
                float* dst = OF + (size_t)t * MIX + h * GLA_DV + dv;
                if (half == 0) { if (dir == 0) *dst = o * qs; else *dst += o * qs; }
            }
        }
    }
}
__device__ __forceinline__ void gla_norm_gate(const Ctx& c, const float* OF, const bf16* U, const float* onorm, bf16* CAT) {
    for (int it = c.gw; it < NTOK * GLA_H; it += c.ngw) {
        const int h = it % GLA_H, t = it / GLA_H;
        const float* o = OF + (size_t)t * MIX + h * GLA_DV;
        float v[3]; float s = 0.f;
#pragma unroll
        for (int j = 0; j < 3; ++j) { v[j] = o[c.lane + 64 * j]; s += v[j] * v[j]; }
        const float r = 1.f / sqrtf(wave_sum(s) * (1.f / GLA_DV) + EPS);
#pragma unroll
        for (int j = 0; j < 3; ++j) { const int dv = c.lane + 64 * j; const float gg = bf2f(U[(size_t)t * LDU1 + 1536 + h * GLA_DV + dv]);
            CAT[(size_t)t * D + h * GLA_DV + dv] = (bf16)f2bf(v[j] * r * onorm[dv] * silu(gg)); }
    }
}


#define XB_TMO      128
#define XB_XCNT(j)  (256  + 64 * (j))
#define XB_XSUB(j)  (1280 + 64 * (j))
#define XB_XGEN(j)  (2304 + 64 * (j))
#define XB_TOP      3328
#define XB_TOPGEN   3392
#define XCD_BAR_WORDS 3456
#define XB_SPIN_CAP (1u << 22)
__device__ __forceinline__ unsigned xb_ld(unsigned* p)              { return __hip_atomic_load(p, __ATOMIC_RELAXED, __HIP_MEMORY_SCOPE_AGENT); }
__device__ __forceinline__ unsigned xb_add(unsigned* p, unsigned v) { return __hip_atomic_fetch_add(p, v, __ATOMIC_RELAXED, __HIP_MEMORY_SCOPE_AGENT); }
__device__ __forceinline__ unsigned xb_xcc_id() { return (unsigned)__builtin_amdgcn_s_getreg((3 << 11) | 20) & 0xFu; }
#define XB_SPIN(cond, bar) do { unsigned _sp = 0; while (cond) { __builtin_amdgcn_s_sleep(1); \
    if ((++_sp & 255u) == 0u) { if (xb_ld(&(bar)[XB_TMO])) break; if (_sp > XB_SPIN_CAP) { atomicAdd(&(bar)[XB_TMO], 1u); break; } } } } while (0)
struct XcdBarrier { unsigned* bar; unsigned x; volatile LAS unsigned* st; };
__device__ __forceinline__ XcdBarrier xcd_barrier_post(unsigned* bar, volatile LAS unsigned* st) {
    XcdBarrier b; b.bar = bar; b.x = xb_xcc_id(); b.st = st;
    if (threadIdx.x == 0) (void)xb_add(&bar[XB_XCNT(b.x)], 1u);
    return b;
}
__device__ __forceinline__ void xcd_barrier_complete(unsigned* bar, unsigned x, unsigned& nloc, unsigned& nx) {
    const unsigned G = gridDim.x * gridDim.y * gridDim.z;
    unsigned sum, cnt, mine, sp = 0u;
    for (;;) {
        sum = 0u; cnt = 0u; mine = 0u;
#pragma unroll
        for (unsigned j = 0; j < 16; ++j) { const unsigned c = xb_ld(&bar[XB_XCNT(j)]); sum += c; cnt += (c > 0u) ? 1u : 0u; mine = (j == x) ? c : mine; }
        if (sum == G) break;
        __builtin_amdgcn_s_sleep(1);
        if ((++sp & 255u) == 0u) { if (xb_ld(&bar[XB_TMO])) break; if (sp > XB_SPIN_CAP) { atomicAdd(&bar[XB_TMO], 1u); break; } }
    }
    nloc = mine > 0u ? mine : 1u; nx = cnt > 0u ? cnt : 1u;
}
__device__ __forceinline__ void xcd_barrier(const XcdBarrier& b) {
    asm volatile("s_waitcnt vmcnt(0)" ::: "memory");
    __syncthreads();
    if (threadIdx.x == 0) {
        unsigned* bar = b.bar;
        __builtin_amdgcn_s_waitcnt(0);
        const unsigned bx = __builtin_amdgcn_readfirstlane(xb_xcc_id());
        unsigned nloc = b.st[0], nx = b.st[1];
        if (nloc == 0u) { xcd_barrier_complete(bar, bx, nloc, nx); b.st[0] = nloc; b.st[1] = nx; }
        const unsigned old = xb_add(&bar[XB_XSUB(bx)], 1u);
        const unsigned gen = old / nloc;
        if (old + 1u == (gen + 1u) * nloc) {
            __builtin_amdgcn_fence(__ATOMIC_RELEASE, "agent");
            asm volatile("s_waitcnt vmcnt(0)" ::: "memory");
            const unsigned og = xb_add(&bar[XB_TOP], 1u);
            const unsigned tg = og / nx;
            if (og + 1u == (tg + 1u) * nx) xb_add(&bar[XB_TOPGEN], 1u);
            else XB_SPIN(xb_ld(&bar[XB_TOPGEN]) == tg, bar);
            __builtin_amdgcn_fence(__ATOMIC_ACQUIRE, "agent");
            xb_add(&bar[XB_XGEN(bx)], 1u);
            asm volatile("s_waitcnt vmcnt(0)" ::: "memory");
        } else {
            XB_SPIN(xb_ld(&bar[XB_XGEN(bx)]) == gen, bar);
            __builtin_amdgcn_fence(__ATOMIC_ACQUIRE, "agent");
            asm volatile("s_waitcnt vmcnt(0)" ::: "memory");
        }
    }
    __syncthreads();
}

constexpr int NWAVES = 8, NTHREADS = 512, LDS_BYTES = 147456, MISC_OFF = 131072 + 1024;
constexpr int NPHASES = 19;
constexpr int TAB_OFF = 131072 + 2048;
#ifndef USE_MFMA_ATTN
#define USE_MFMA_ATTN 1
#endif
#ifndef USE_PG8
#define USE_PG8 0xF
#endif
__device__ __forceinline__ void build_tab(const Ctx& c, const unsigned* cnt) {
    LAS int* tab = (LAS int*)(c.lds + TAB_OFF);
    __syncthreads();
    if (c.tid < 64) { const int cn = c.tid < 32 ? (int)cnt[c.tid] : 0; int mt = (cn + 255) >> 8, inc = mt;
#pragma unroll
        for (int o = 1; o < 32; o <<= 1) { const int v = __shfl_up(inc, o); if ((c.tid & 31) >= o) inc += v; }
        if (c.tid < 32) { tab[c.tid + 1] = inc; tab[64 + c.tid] = cn; } if (c.tid == 0) tab[0] = 0; }
    __syncthreads();
}

template <int PH_LO, int PH_HI> __global__ void __launch_bounds__(NTHREADS, 2) mk_fwd(Args args) {
    extern __shared__ __attribute__((aligned(16))) unsigned char lds_raw[];
    LAS unsigned char* const ldsp = (LAS unsigned char*)lds_raw;
    Ctx c = fresh_ctx(ldsp);
    const int vcu = (gridDim.x % 8 == 0) ? (int)((blockIdx.x % 8) * (gridDim.x / 8) + blockIdx.x / 8) : (int)blockIdx.x;
    unsigned char* ws = args.ws;
    const float* x = args.in[0]; const float* mem = args.in[1]; const float* mem_norm = args.in[2]; const float* final_norm = args.in[3];
    const float* norm_mix = args.in[4]; const float* norm_ffn = args.in[5]; const float* w_mem_kv = args.in[6]; const float* w_out = args.in[7];
    const float* na_w_in = args.in[8]; const float* na_rpb = args.in[9]; const float* gla_w_in = args.in[10]; const float* gla_gate_up = args.in[11];
    const float* gla_gate_bias = args.in[12]; const float* gla_out_norm = args.in[13]; const float* moe_w_group = args.in[14]; const float* moe_b_group = args.in[15];
    const float* moe_w_router = args.in[16]; const float* moe_b_router = args.in[17]; const float* moe_w1 = args.in[18]; const float* moe_w3 = args.in[19]; const float* moe_w2 = args.in[20];
    float* X = args.out;
    bf16* WIN0 = (bf16*)(ws + WS_WIN0); bf16* WIN1 = (bf16*)(ws + WS_WIN1); bf16* WOUT = (bf16*)(ws + WS_WOUT); bf16* WMKV = (bf16*)(ws + WS_WMKV);
    bf16* MEMN = (bf16*)(ws + WS_MEMN); bf16* MKV = (bf16*)(ws + WS_MKV); bf16* W13 = (bf16*)(ws + WS_W13); bf16* W2 = (bf16*)(ws + WS_W2);
    bf16* XN = (bf16*)(ws + WS_XN); bf16* U = (bf16*)(ws + WS_U); bf16* Y = (bf16*)(ws + WS_Y); bf16* CAT = (bf16*)(ws + WS_CAT); bf16* ACT = (bf16*)(ws + WS_ACT);
    unsigned char* RT = ws + WS_ROUTE; float* DECA = (float*)(ws + WS_S); float* OF = (float*)(ws + WS_S + 48 * MiB);
    unsigned* CTL = (unsigned*)(ws + WS_CTL);
#define IN(k) (PH_LO <= (k) && (k) < PH_HI)
    constexpr bool FUSED = (PH_HI - PH_LO) > 1;
    XcdBarrier bar; bar.bar = CTL + CW_BAR; bar.x = 0; bar.st = nullptr;
    if constexpr (FUSED) {
        volatile LAS unsigned* misc = (volatile LAS unsigned*)(c.lds + MISC_OFF);
        if (c.tid < 64) misc[c.tid] = 0u;
        __syncthreads();
        bar = xcd_barrier_post(CTL + CW_BAR, misc + 8);
    }
#define GRID_BAR(k) do { if constexpr (FUSED) { if (IN((k) + 1)) xcd_barrier(bar); } } while (0)

    if (IN(0)) { c = fresh_ctx(ldsp);
        transpose_matrix(c, na_w_in, 1024, NA_IN, WIN0, c.gw, c.ngw);
        transpose_matrix(c, gla_w_in, 1024, GLA_IN, WIN1, c.gw, c.ngw);
        for (long i = GTID; i < (long)(2816 - 2592) * 1024 / 8; i += GSIZE) ((u32x4*)(WIN1 + (size_t)2592 * 1024))[i] = (u32x4){0u, 0u, 0u, 0u};
        for (int l = 0; l < 2; ++l) { transpose_matrix(c, w_out + (size_t)l * D * D, 1024, 1024, WOUT + (size_t)l * D * D, c.gw, c.ngw);
            transpose_matrix(c, w_mem_kv + (size_t)l * D * 512, 1024, 512, WMKV + (size_t)l * 512 * 1024, c.gw, c.ngw); }
        convert_moe(c, moe_w1, moe_w3, moe_w2, W13, W2);
        for (int m = c.gw; m < NBATCH * NMEM; m += c.ngw) rms_row_to_bf16(mem + (size_t)m * D, mem_norm, MEMN + (size_t)m * D, c.lane);
        for (int m = c.gw; m < NTOK; m += c.ngw) rms_row_to_bf16(x + (size_t)m * D, norm_mix, XN + (size_t)m * D, c.lane);
        GRID_BAR(0);
    }
#pragma unroll
    for (int L = 0; L < 2; ++L) {
        const int pb = 1 + 9 * L;
        const int ldu = L == 0 ? LDU0 : LDU1;
        unsigned* cnt = CTL + CW_CNT + 64 * L;
        if (IN(pb)) { c = fresh_ctx(ldsp);
            if constexpr (USE_PG8 & 1) {
                pg8::StaticOrder S; S.init(XN, L == 0 ? WIN0 : WIN1, NTOK, ldu, D, (int)gridDim.x, (int)blockIdx.x);
                pg8::EpiBf16 E{U, ldu};
                pg8::gemm_phase<pg8::EpiBf16, pg8::StaticOrder, false>(c.lds, D, S, E);
                if (L == 0) { pg8::StaticOrder S2; S2.init(MEMN, WMKV, NBATCH * NMEM, 1024, D, (int)gridDim.x, (int)blockIdx.x);
                    pg8::EpiBf16 E2{MKV, 1024};
                    pg8::gemm_phase<pg8::EpiBf16, pg8::StaticOrder, false>(c.lds, D, S2, E2); }
            } else {
            if (L == 0) {
                naive_gemm(c, NTOK, NA_IN, D, [&](int m) { return XN + (size_t)m * D; }, WIN0, [&](int m, int n, float a) { U[(size_t)m * LDU0 + n] = (bf16)f2bf(a); });
                naive_gemm(c, NBATCH * NMEM, 1024, D, [&](int m) { return MEMN + (size_t)m * D; }, WMKV, [&](int m, int n, float a) { MKV[(size_t)m * 1024 + n] = (bf16)f2bf(a); });
            } else {
                naive_gemm(c, NTOK, LDU1, D, [&](int m) { return XN + (size_t)m * D; }, WIN1, [&](int m, int n, float a) { U[(size_t)m * LDU1 + n] = (bf16)f2bf(a); });
            }
            }
            GRID_BAR(pb);
        }
        if (IN(pb + 1)) { c = fresh_ctx(ldsp);
#if USE_MFMA_ATTN
            if (L == 0) { att::na_phase(c, U, na_rpb, CAT, vcu, (int)gridDim.x); att::mem_phase(c, U, LDU0, 2304, MKV, 0, CAT, vcu, (int)gridDim.x); }
            else { gla_decay(c, U, gla_gate_up, gla_gate_bias, DECA); att::mem_phase(c, U, LDU1, 2336, MKV, 1, CAT, vcu, (int)gridDim.x); }
#else
            if (L == 0) { naive_na(c, U, na_rpb, CAT); naive_memattn(c, U, LDU0, 2304, MKV, 0, CAT); }
            else { gla_decay(c, U, gla_gate_up, gla_gate_bias, DECA); naive_memattn(c, U, LDU1, 2336, MKV, 1, CAT); }
#endif
            GRID_BAR(pb + 1);
        }
        if (IN(pb + 2)) { c = fresh_ctx(ldsp);
            if (L == 1) { gla_recur(c, U, DECA, OF); GRID_BAR(pb + 2); }
        }
        if (IN(pb + 3)) { c = fresh_ctx(ldsp);
            if (L == 1) { gla_norm_gate(c, OF, U, gla_out_norm, CAT); GRID_BAR(pb + 3); }
        }
        if (IN(pb + 4)) { c = fresh_ctx(ldsp);
            const float* resid = L == 0 ? x : X;
            if constexpr (USE_PG8 & 2) {
                pg8::StaticOrder S; S.init(CAT, WOUT + (size_t)L * D * D, NTOK, D, D, (int)gridDim.x, (int)blockIdx.x);
                pg8::EpiResF32 E{resid, X};
                pg8::gemm_phase<pg8::EpiResF32, pg8::StaticOrder, false>(c.lds, D, S, E);
            } else
            naive_gemm(c, NTOK, D, D, [&](int m) { return CAT + (size_t)m * D; }, WOUT + (size_t)L * D * D, [&](int m, int n, float a) { X[(size_t)m * D + n] = resid[(size_t)m * D + n] + a; });
            GRID_BAR(pb + 4);
        }
        if (IN(pb + 5)) { c = fresh_ctx(ldsp);
            route_phase(c, X, norm_ffn + L * D, moe_w_group + (size_t)L * D * 4, moe_b_group + L * 4, moe_w_router + (size_t)L * D * 32, moe_b_router + L * 32, XN, RT, cnt);
            GRID_BAR(pb + 5);
        }
        if (IN(pb + 6)) { c = fresh_ctx(ldsp);
            const int* LIST = (const int*)(RT + RT_LIST);
            if constexpr (USE_PG8 & 4) {
                build_tab(c, cnt);
                pg8::MoeOrder S{(const LAS int*)(c.lds + TAB_OFF), XN, W13, LIST, D, 4, (int)gridDim.x, vcu, true};
                pg8::EpiSwiGLU E{ACT};
                pg8::gemm_phase<pg8::EpiSwiGLU, pg8::MoeOrder, true>(c.lds, D, S, E);
            } else {
            const long total = (long)MAXROWS * EFF;
            for (long idx = GTID; idx < total; idx += GSIZE) {
                const int R = (int)(idx / EFF), j = (int)(idx % EFF); int e, i, n;
                if (!row_lookup(cnt, R, e, i, n) || i >= n) continue;
                const int t = LIST[e * NTOK + i];
                const u32x4* a4 = (const u32x4*)(XN + (size_t)t * D);
                const int r1 = (j / 128) * 256 + (j % 128);
                const u32x4* b1 = (const u32x4*)(W13 + ((size_t)e * 1024 + r1) * 1024); const u32x4* b3 = (const u32x4*)(W13 + ((size_t)e * 1024 + r1 + 128) * 1024);
                float s1 = 0.f, s3 = 0.f;
                for (int k8 = 0; k8 < D / 8; ++k8) { const u32x4 av = a4[k8]; s1 += dot8(av, b1[k8]); s3 += dot8(av, b3[k8]); }
                ACT[(size_t)R * EFF + j] = (bf16)f2bf(silu(s1) * s3);
            }
            }
            GRID_BAR(pb + 6);
        }
        if (IN(pb + 7)) { c = fresh_ctx(ldsp);
            const int* LIST = (const int*)(RT + RT_LIST); const int* TOKE = (const int*)(RT + RT_TOKE); const float* TOKW = (const float*)(RT + RT_TOKW);
            if constexpr (USE_PG8 & 8) {
                build_tab(c, cnt);
                pg8::MoeOrder S{(const LAS int*)(c.lds + TAB_OFF), ACT, W2, LIST, EFF, 4, (int)gridDim.x, vcu, false};
                pg8::EpiScaleBf16 E{Y, (const float*)(RT + RT_LISTW), (const LAS int*)(c.lds + TAB_OFF)};
                pg8::gemm_phase<pg8::EpiScaleBf16, pg8::MoeOrder, false>(c.lds, EFF, S, E);
            } else {
            const long total = (long)MAXROWS * D;
            for (long idx = GTID; idx < total; idx += GSIZE) {
                const int R = (int)(idx / D), n = (int)(idx % D); int e, i, cn;
                if (!row_lookup(cnt, R, e, i, cn) || i >= cn) continue;
                const int t = LIST[e * NTOK + i];
                const float w = (TOKE[2 * t] == e) ? TOKW[2 * t] : TOKW[2 * t + 1];
                const u32x4* a4 = (const u32x4*)(ACT + (size_t)R * EFF); const u32x4* b4 = (const u32x4*)(W2 + ((size_t)e * 1024 + n) * 512);
                float s = 0.f;
                for (int k8 = 0; k8 < EFF / 8; ++k8) s += dot8(a4[k8], b4[k8]);
                Y[(size_t)R * D + n] = (bf16)f2bf(s * w);
            }
            }
            GRID_BAR(pb + 7);
        }
        if (IN(pb + 8)) { c = fresh_ctx(ldsp);
            if (L == 0) { combine_phase(c, X, Y, RT, cnt, norm_mix + D, XN, nullptr);
                convert_moe(c, moe_w1 + (size_t)NEXP * D * EFF, moe_w3 + (size_t)NEXP * D * EFF, moe_w2 + (size_t)NEXP * EFF * D, W13, W2); }
            else combine_phase(c, X, Y, RT, cnt, final_norm, nullptr, X);
            if (L == 0) GRID_BAR(pb + 8);
        }
    }
#undef IN
}

template <int P> static void launch_phases(int grid, hipStream_t stream, const Args& a) {
    if constexpr (P < NPHASES) {
        if constexpr (P != 3 && P != 4) {
            static bool attr_done = false;
            if (!attr_done) { (void)hipFuncSetAttribute((const void*)mk_fwd<P, P + 1>, hipFuncAttributeMaxDynamicSharedMemorySize, LDS_BYTES); attr_done = true; }
            hipLaunchKernelGGL((mk_fwd<P, P + 1>), dim3(grid), dim3(NTHREADS), LDS_BYTES, stream, a);
        }
        launch_phases<P + 1>(grid, stream, a);
    }
}
extern "C" void kernel_launch(void* const* d_in, const int* in_sizes, int n_in, void* d_out, int out_size, void* d_ws, size_t ws_size, hipStream_t stream) {
    static int grid = 0;
    if (grid == 0) {
        if (n_in != 21 || out_size != NTOK * D || ws_size < WS_END) { fprintf(stderr, "kernel_launch: unexpected shapes n_in %d out %d ws %zu (need %zu)\n", n_in, out_size, ws_size, (size_t)WS_END); grid = -1; return; }
        int dev = 0, cus = 0;
        if (hipGetDevice(&dev) != hipSuccess || hipDeviceGetAttribute(&cus, hipDeviceAttributeMultiprocessorCount, dev) != hipSuccess) { grid = -1; return; }
        (void)hipGetLastError();
        grid = cus;
    }
    if (grid < 0) return;
    (void)hipMemsetAsync((char*)d_ws + WS_CTL, 0, CTL_ZERO_BYTES, stream);
    Args a{};
    for (int i = 0; i < 21; ++i) a.in[i] = (const float*)d_in[i];
    a.out = (float*)d_out; a.ws = (unsigned char*)d_ws;
#if defined(MK_PER_PHASE)
    launch_phases<0>(grid, stream, a);
#else
    static bool attr_done = false;
    if (!attr_done) { (void)hipFuncSetAttribute((const void*)mk_fwd<0, NPHASES>, hipFuncAttributeMaxDynamicSharedMemorySize, LDS_BYTES); attr_done = true; }
    hipLaunchKernelGGL((mk_fwd<0, NPHASES>), dim3(grid), dim3(NTHREADS), LDS_BYTES, stream, a);
#endif
}
```

```cpp
#include <hip/hip_runtime.h>
#define GLA_INTRA_ONLY 0
#include <cstdio>
#include <cstdint>

constexpr int D = 1024, NTOK = 16384, SEQ = 4096, NBATCH = 4, NMEM = 256, HD = 64;
constexpr int MIX = 768, MEMD = 256, NA_H = 12, NA_IN = 2560;
constexpr int GLA_H = 4, GLA_DK = 96, GLA_DV = 192, GLA_IN = 2592, GLA_KD = 384;
constexpr int NEXP = 32, EFF = 512;
constexpr int LDU0 = 2560, LDU1 = 2816;
constexpr int MAXROWS = 40960;
constexpr float EPS = 1e-6f;

typedef unsigned short bf16;
typedef float f32x4 __attribute__((ext_vector_type(4)));
typedef unsigned u32x4 __attribute__((ext_vector_type(4)));
typedef unsigned u32x2 __attribute__((ext_vector_type(2)));
#define LAS __attribute__((address_space(3)))

constexpr size_t MiB = 1048576;
constexpr size_t WS_CTL = 0;
constexpr size_t CTL_ZERO_BYTES = 1 * MiB;
constexpr size_t WS_WIN0 = 1 * MiB;
constexpr size_t WS_WIN1 = WS_WIN0 + (size_t)2560 * 1024 * 2;
constexpr size_t WS_WOUT = WS_WIN1 + (size_t)2816 * 1024 * 2;
constexpr size_t WS_WMKV = WS_WOUT + (size_t)2 * 1024 * 1024 * 2;
constexpr size_t WS_MEMN = WS_WMKV + (size_t)1024 * 1024 * 2;
constexpr size_t WS_MKV = WS_MEMN + (size_t)1024 * 1024 * 2;
constexpr size_t WS_W13 = 24 * MiB;
constexpr size_t WS_W2 = WS_W13 + 64 * MiB;
constexpr size_t WS_XN = WS_W2 + 32 * MiB;
constexpr size_t WS_U = WS_XN + 32 * MiB;
constexpr size_t WS_Y = WS_U;
constexpr size_t WS_CAT = WS_U + 88 * MiB;
constexpr size_t WS_ACT = WS_CAT + 32 * MiB;
constexpr size_t WS_ROUTE = WS_ACT + 40 * MiB;
constexpr size_t WS_S = WS_ROUTE + 8 * MiB;
constexpr size_t WS_END = WS_S + 176 * MiB;
static_assert(WS_MKV + (size_t)1024 * 1024 * 2 <= WS_W13, "ws map");
static_assert(WS_END <= 512 * MiB, "ws map");
constexpr size_t RT_TOKE = 0, RT_TOKW = 131072, RT_TOKP = 262144, RT_LIST = 524288, RT_LISTW = 524288 + 2 * MiB;
constexpr int CW_CNT = 1024;
constexpr int CW_BAR = 4096;

struct Args {
    const float* in[21]; float* out; unsigned char* ws; int ph_lo, ph_hi;
};

__device__ __forceinline__ float bf2f(bf16 v) { return __uint_as_float(((unsigned)v) << 16); }
__device__ __forceinline__ unsigned f2bf(float f) { unsigned u = __float_as_uint(f); return (u + 0x7fffu + ((u >> 16) & 1u)) >> 16; }
__device__ __forceinline__ unsigned pk2(float lo, float hi) { return f2bf(lo) | (f2bf(hi) << 16); }
__device__ __forceinline__ float wave_sum(float v) {
#pragma unroll
    for (int o = 1; o < 64; o <<= 1) v += __shfl_xor(v, o);
    return v;
}
__device__ __forceinline__ float dot8(u32x4 a, u32x4 b) {
    float s = 0.f;
#pragma unroll
    for (int i = 0; i < 4; ++i) {
        s += __uint_as_float(a[i] << 16) * __uint_as_float(b[i] << 16);
        s += __uint_as_float(a[i] & 0xffff0000u) * __uint_as_float(b[i] & 0xffff0000u);
    }
    return s;
}
__device__ __forceinline__ float silu(float x) { return x / (1.f + __expf(-x)); }

struct Ctx {
    int tid, lane, wave, gw, ngw;
    LAS unsigned char* lds;
};
__device__ __forceinline__ Ctx fresh_ctx(LAS unsigned char* lds) {
    Ctx c; int t = threadIdx.x; asm volatile("" : "+v"(t)); int b = blockIdx.x; asm volatile("" : "+s"(b));
    c.tid = t; c.lane = t & 63; c.wave = __builtin_amdgcn_readfirstlane(t >> 6); c.gw = b * 8 + c.wave; c.ngw = gridDim.x * 8; c.lds = lds; return c;
}
__device__ __forceinline__ long gtid_() { int t = threadIdx.x; asm volatile("" : "+v"(t)); int b = blockIdx.x; asm volatile("" : "+s"(b)); return (long)(b * 512 + t); }
#define GTID gtid_()
#define GSIZE ((long)gridDim.x * 512)

__device__ __forceinline__ void transpose_item(const float* W, int N, int k0, int n0, bf16* dstrow0, int Kd, LAS float* scr, int lane) {
#pragma unroll 8
    for (int i = 0; i < 32; ++i) { const int kk = 2 * i + (lane >> 5); scr[kk * 33 + (lane & 31)] = W[(size_t)(k0 + kk) * N + n0 + (lane & 31)]; }
    asm volatile("s_waitcnt lgkmcnt(0)" ::: "memory");
    const int c = lane & 7;
#pragma unroll
    for (int j = 0; j < 4; ++j) { const int n = (lane >> 3) + 8 * j; const LAS float* s = scr + (8 * c) * 33 + n;
        u32x4 o; o.x = pk2(s[0 * 33], s[1 * 33]); o.y = pk2(s[2 * 33], s[3 * 33]); o.z = pk2(s[4 * 33], s[5 * 33]); o.w = pk2(s[6 * 33], s[7 * 33]);
        *(u32x4*)(dstrow0 + (size_t)n * Kd + k0 + 8 * c) = o; }
    asm volatile("s_waitcnt lgkmcnt(0)" ::: "memory");
}
__device__ __forceinline__ void transpose_matrix(const Ctx& c, const float* W, int K, int N, bf16* dst, int it0, int itstride) {
    LAS float* scr = (LAS float*)(c.lds + c.wave * 16384);
    const int nblk = N / 32, nit = (K / 64) * nblk;
    for (int it = it0; it < nit; it += itstride) { const int kb = it / nblk, nb = it % nblk;
        transpose_item(W, N, kb * 64, nb * 32, dst + (size_t)(nb * 32) * K, K, scr, c.lane); }
}
__device__ __forceinline__ void convert_moe(const Ctx& c, const float* w1, const float* w3, const float* w2, bf16* W13, bf16* W2) {
    LAS float* scr = (LAS float*)(c.lds + c.wave * 16384);
    const int per_e = 768;
    for (int it = c.gw; it < NEXP * per_e; it += c.ngw) {
        const int e = it / per_e, r = it % per_e, which = r / 256, q = r % 256;
        if (which < 2) {
            const int kb = q / 16, nb = q % 16, n0 = nb * 32;
            const float* W = (which == 0 ? w1 : w3) + (size_t)e * 1024 * 512;
            const int drow = (n0 / 128) * 256 + which * 128 + (n0 % 128);
            transpose_item(W, 512, kb * 64, n0, W13 + ((size_t)e * 1024 + drow) * 1024, 1024, scr, c.lane);
        } else {
            const int kb = q / 32, nb = q % 32, n0 = nb * 32;
            const float* W = w2 + (size_t)e * 512 * 1024;
            transpose_item(W, 1024, kb * 64, n0, W2 + ((size_t)e * 1024 + n0) * 512, 512, scr, c.lane);
        }
    }
}
__device__ __forceinline__ void rms_row_to_bf16(const float* xrow, const float* g, bf16* orow, int lane) {
    const f32x4* xr = (const f32x4*)xrow + lane; const f32x4* gr = (const f32x4*)g + lane;
    f32x4 v[4]; float s = 0.f;
#pragma unroll
    for (int j = 0; j < 4; ++j) { v[j] = xr[64 * j]; s += (v[j].x * v[j].x + v[j].y * v[j].y) + (v[j].z * v[j].z + v[j].w * v[j].w); }
    const float r = 1.f / sqrtf(wave_sum(s) * (1.f / D) + EPS);
    u32x2* o8 = (u32x2*)orow + lane;
#pragma unroll
    for (int j = 0; j < 4; ++j) { const f32x4 gg = gr[64 * j]; u32x2 w; w.x = pk2(v[j].x * r * gg.x, v[j].y * r * gg.y); w.y = pk2(v[j].z * r * gg.z, v[j].w * r * gg.w); o8[64 * j] = w; }
}

template <class RowA, class Epi>
__device__ __forceinline__ void naive_gemm(const Ctx& c, int M, int N, int K, const RowA& rowA, const bf16* Bt, const Epi& epi) {
    const long total = (long)M * N;
    for (long idx = GTID; idx < total; idx += GSIZE) {
        const int m = (int)(idx / N), n = (int)(idx % N);
        const bf16* a = rowA(m);
        if (a == nullptr) continue;
        const u32x4* a4 = (const u32x4*)a; const u32x4* b4 = (const u32x4*)(Bt + (size_t)n * K);
        float acc = 0.f;
        for (int k8 = 0; k8 < K / 8; ++k8) acc += dot8(a4[k8], b4[k8]);
        epi(m, n, acc);
    }
}


namespace pg8 {
typedef short bf16x8 __attribute__((ext_vector_type(8)));
constexpr int BM = 256, BK = 64, HALF = 128, HTB = HALF * BK * 2, STAGE_BYTES = 8 * HTB, NXCD = 8, WGM = 8;
__device__ __forceinline__ int lds_byte(int r, int c) { const int st = (r >> 4) * 2 + (c >> 5), rr = r & 15, cc = c & 31, ob = rr * 64 + cc * 2; return st * 1024 + (ob ^ (((ob >> 9) & 1) << 5)); }
__device__ __forceinline__ void stage_rc(int b, int& R, int& C) { const int st = b / 1024, sb = b % 1024, swz = sb ^ (((sb >> 9) & 1) << 5); R = (st >> 1) * 16 + swz / 64; C = (st & 1) * 32 + (swz % 64) / 2; }
__device__ __forceinline__ int perm32(int rho) { const int n = rho >> 4, i = rho & 15; return 8 * (i >> 2) + 4 * n + (i & 3); }
typedef __bf16 bf16v2_t __attribute__((ext_vector_type(2)));
__device__ __forceinline__ unsigned cvt_pk_bf16(float lo, float hi) { const bf16v2_t v = {(__bf16)lo, (__bf16)hi}; return __builtin_bit_cast(unsigned, v); }

struct Unit { int pm, pn, e, nv; };

struct StaticOrder {
    const bf16* A; const bf16* Bt; int K, nM, nN, nwg, G, c;
    __device__ void init(const bf16* A_, const bf16* Bt_, int M, int N, int K_, int G_, int c_) { A = A_; Bt = Bt_; K = K_; nM = M / BM; nN = N / BM; nwg = nM * nN; G = G_; c = c_; }
    __device__ __forceinline__ bool next(int i, Unit& u) const {
        const long L = (long)i * G + c; if (L >= nwg) return false;
        int wgid = (int)L; { const int q = nwg / NXCD, r = nwg % NXCD, xcd = wgid % NXCD, off = wgid / NXCD; wgid = (xcd < r ? xcd * (q + 1) : r * (q + 1) + (xcd - r) * q) + off; }
        const int nig = WGM * nN, gid = wgid / nig, fm = gid * WGM, gsz = (nM - fm) < WGM ? (nM - fm) : WGM;
        u.pm = fm + ((wgid % nig) % gsz); u.pn = (wgid % nig) / gsz; u.e = 0; u.nv = 256; return true;
    }
    __device__ __forceinline__ const char* a_base(const Unit& u) const { return (const char*)A + (size_t)u.pm * BM * K * 2; }
    __device__ __forceinline__ const char* b_base(const Unit& u) const { return (const char*)Bt + (size_t)u.pn * BM * K * 2; }
    __device__ __forceinline__ const int* rows(const Unit&) const { return nullptr; }
};
struct MoeOrder {
    const LAS int* tab; const bf16* A; const bf16* Bt; const int* list; int K, ntn, G, c; bool gather;
    __device__ __forceinline__ bool next(int i, Unit& u) const {
        const int L = i * G + c, total = tab[32] * ntn; if (L >= total) return false;
        const int T = L / ntn; int e = 0;
        for (int x = 1; x < 32; ++x) e = (tab[x] <= T) ? x : e;
        u.pm = T; u.pn = L % ntn; u.e = e; u.nv = tab[64 + e] - (T - tab[e]) * 256; return true;
    }
    __device__ __forceinline__ const char* a_base(const Unit& u) const { return gather ? (const char*)A : (const char*)A + (size_t)u.pm * BM * K * 2; }
    __device__ __forceinline__ const char* b_base(const Unit& u) const { return (const char*)Bt + ((size_t)u.e * 1024 + (size_t)u.pn * BM) * K * 2; }
    __device__ __forceinline__ const int* rows(const Unit& u) const { return list + (size_t)u.e * NTOK + (u.pm - tab[u.e]) * 256; }
};

struct EpiBf16 {
    static constexpr bool PERM = true;
    bf16* O; int ldc;
    __device__ __forceinline__ void operator()(const f32x4 (&acc)[2][2][4][2], const Unit& u, int wr, int wc, int fr, int fq) const {
        const int row0 = u.pm * BM + wr * 64 + fr, col0 = u.pn * BM + wc * 32 + 8 * fq;
#pragma unroll
        for (int ai = 0; ai < 2; ++ai)
#pragma unroll
            for (int m = 0; m < 4; ++m) { bf16* rowp = O + (size_t)(row0 + ai * HALF + m * 16) * ldc + col0;
#pragma unroll
                for (int bj = 0; bj < 2; ++bj) { const f32x4 v0 = acc[ai][bj][m][0], v1 = acc[ai][bj][m][1];
                    u32x4 w; w.x = cvt_pk_bf16(v0[0], v0[1]); w.y = cvt_pk_bf16(v0[2], v0[3]); w.z = cvt_pk_bf16(v1[0], v1[1]); w.w = cvt_pk_bf16(v1[2], v1[3]);
                    *(u32x4*)(rowp + bj * HALF) = w; } }
    }
};
struct EpiResF32 {
    static constexpr bool PERM = false;
    const float* R; float* C;
    __device__ __forceinline__ void operator()(const f32x4 (&acc)[2][2][4][2], const Unit& u, int wr, int wc, int fr, int fq) const {
        const int row0 = u.pm * BM + wr * 64 + fr, col0 = u.pn * BM + wc * 32 + 4 * fq;
#pragma unroll
        for (int ai = 0; ai < 2; ++ai)
#pragma unroll
            for (int m = 0; m < 4; ++m) { const size_t off = (size_t)(row0 + ai * HALF + m * 16) * D + col0;
#pragma unroll
                for (int bj = 0; bj < 2; ++bj)
#pragma unroll
                    for (int n = 0; n < 2; ++n) { const f32x4 rv = *(const f32x4*)(R + off + bj * HALF + n * 16); *(f32x4*)(C + off + bj * HALF + n * 16) = rv + acc[ai][bj][m][n]; }
                asm volatile("" ::: "memory"); }
    }
};
struct EpiSwiGLU {
    static constexpr bool PERM = true;
    bf16* O;
    __device__ __forceinline__ void operator()(const f32x4 (&acc)[2][2][4][2], const Unit& u, int wr, int wc, int fr, int fq) const {
        const int row0 = u.pm * BM + wr * 64 + fr, col0 = u.pn * 128 + wc * 32 + 8 * fq;
#pragma unroll
        for (int ai = 0; ai < 2; ++ai)
#pragma unroll
            for (int m = 0; m < 4; ++m) { float o[8];
#pragma unroll
                for (int n = 0; n < 2; ++n)
#pragma unroll
                    for (int i = 0; i < 4; ++i) { const float a = acc[ai][0][m][n][i], b = acc[ai][1][m][n][i]; o[n * 4 + i] = a * b * __builtin_amdgcn_rcpf(1.f + __expf(-a)); }
                u32x4 w; w.x = cvt_pk_bf16(o[0], o[1]); w.y = cvt_pk_bf16(o[2], o[3]); w.z = cvt_pk_bf16(o[4], o[5]); w.w = cvt_pk_bf16(o[6], o[7]);
                *(u32x4*)(O + (size_t)(row0 + ai * HALF + m * 16) * EFF + col0) = w; }
    }
};
struct EpiScaleBf16 {
    static constexpr bool PERM = true;
    bf16* O; const float* listw; const LAS int* tab;
    __device__ __forceinline__ void operator()(const f32x4 (&acc)[2][2][4][2], const Unit& u, int wr, int wc, int fr, int fq) const {
        const int rl0 = wr * 64 + fr, col0 = u.pn * BM + wc * 32 + 8 * fq;
        const float* lw = listw + (size_t)u.e * NTOK + (u.pm - tab[u.e]) * 256;
        float wv[2][4];
#pragma unroll
        for (int ai = 0; ai < 2; ++ai)
#pragma unroll
            for (int m = 0; m < 4; ++m) { const int rl = rl0 + ai * HALF + m * 16; wv[ai][m] = rl < u.nv ? lw[rl] : 0.f; }
#pragma unroll
        for (int ai = 0; ai < 2; ++ai)
#pragma unroll
            for (int m = 0; m < 4; ++m) { bf16* rowp = O + (size_t)(u.pm * BM + rl0 + ai * HALF + m * 16) * D + col0; const float s = wv[ai][m];
#pragma unroll
                for (int bj = 0; bj < 2; ++bj) { const f32x4 v0 = acc[ai][bj][m][0] * s, v1 = acc[ai][bj][m][1] * s;
                    u32x4 w; w.x = cvt_pk_bf16(v0[0], v0[1]); w.y = cvt_pk_bf16(v0[2], v0[3]); w.z = cvt_pk_bf16(v1[0], v1[1]); w.w = cvt_pk_bf16(v1[2], v1[3]);
                    *(u32x4*)(rowp + bj * HALF) = w; } }
    }
};

template <class Epi, class Sched, bool GATHER>
__device__ __forceinline__ void gemm_phase(LAS unsigned char* lds, const int K, const Sched& S, const Epi& E) {
    int tid_ = threadIdx.x; asm volatile("" : "+v"(tid_));
    const int tid = tid_, wid = __builtin_amdgcn_readfirstlane(tid >> 6), lane = tid & 63, wr = wid >> 2, wc = wid & 3, fr = lane & 15, fq = lane >> 4;
    const int nt = K / BK;
    int Rr[2], Cc[2]; unsigned voffB[2];
#pragma unroll
    for (int i = 0; i < 2; ++i) { int R, C; stage_rc(tid * 16 + i * 8192, R, C); Rr[i] = R; Cc[i] = C; const int Rb = Epi::PERM ? ((R & ~31) + perm32(R & 31)) : R; voffB[i] = (unsigned)(Rb * K + C) * 2u; }
    const size_t kstep = (size_t)(BK * 2);
    const size_t hstep = (size_t)HALF * K * 2;
    const size_t hstepA = GATHER ? 0 : hstep;
    const unsigned ldsw = (unsigned)wid * 1024u;
    const int aoff = lds_byte(wr * 64 + fr, fq * 8), boff = lds_byte(wc * 32 + fr, fq * 8);
#define PG8_SA(b, h) (((b) * 2 + (h)) * HTB)
#define PG8_SB(b, h) ((4 + (b) * 2 + (h)) * HTB)
#define PG8_STAGE(bufoff, gbase, voff) do { _Pragma("unroll") for (int _i = 0; _i < 2; ++_i) \
        __builtin_amdgcn_global_load_lds((const unsigned*)((const char*)(gbase) + (voff)[_i]), (LAS unsigned*)(lds + (bufoff) + ldsw + _i * 8192), 16, 0, 0); } while (0)
#define PG8_LDA(dst, b, h) do { _Pragma("unroll") for (int m = 0; m < 4; ++m) _Pragma("unroll") for (int k = 0; k < 2; ++k) dst[m][k] = *(const LAS bf16x8*)(lds + PG8_SA(b, h) + aoff + m * 2048 + k * 1024); } while (0)
#define PG8_LDB(dst, b, h) do { _Pragma("unroll") for (int n = 0; n < 2; ++n) _Pragma("unroll") for (int k = 0; k < 2; ++k) dst[n][k] = *(const LAS bf16x8*)(lds + PG8_SB(b, h) + boff + n * 2048 + k * 1024); } while (0)
#define PG8_MMA(ai, bj, At, Bt) do { __builtin_amdgcn_s_setprio(1); _Pragma("unroll") for (int m = 0; m < 4; ++m) _Pragma("unroll") for (int n = 0; n < 2; ++n) _Pragma("unroll") for (int k = 0; k < 2; ++k) \
        acc[ai][bj][m][n] = __builtin_amdgcn_mfma_f32_16x16x32_bf16(Bt[n][k], At[m][k], acc[ai][bj][m][n], 0, 0, 0); __builtin_amdgcn_s_setprio(0); } while (0)
#define PG8_WAIT_V(n) asm volatile("s_waitcnt vmcnt(" #n ")" ::: "memory")
#define PG8_WAIT_L(n) asm volatile("s_waitcnt lgkmcnt(" #n ")" ::: "memory")
#define PG8_BAR __builtin_amdgcn_s_barrier()
#define PG8_SCHED __builtin_amdgcn_sched_barrier(0)
#define PG8_VOFFA(u, v0, v1) do { if constexpr (GATHER) { const int* _rw = S.rows(u); _Pragma("unroll") for (int _i = 0; _i < 2; ++_i) { \
            const int _r0 = Rr[_i], _r1 = Rr[_i] + HALF; const int _t0 = _rw[_r0 < (u).nv ? _r0 : 0], _t1 = _rw[_r1 < (u).nv ? _r1 : 0]; \
            v0[_i] = (unsigned)(_t0 * K + Cc[_i]) * 2u; v1[_i] = (unsigned)(_t1 * K + Cc[_i]) * 2u; } } \
        else { _Pragma("unroll") for (int _i = 0; _i < 2; ++_i) { v0[_i] = (unsigned)(Rr[_i] * K + Cc[_i]) * 2u; v1[_i] = v0[_i]; } } } while (0)
    Unit cur, nxt; int ui = 0;
    if (!S.next(0, cur)) return;
    f32x4 acc[2][2][4][2];
#pragma unroll
    for (int a = 0; a < 2; ++a)
#pragma unroll
        for (int b = 0; b < 2; ++b)
#pragma unroll
            for (int m = 0; m < 4; ++m)
#pragma unroll
                for (int n = 0; n < 2; ++n) acc[a][b][m][n] = (f32x4){0.f, 0.f, 0.f, 0.f};
    bf16x8 At[4][2], B0[2][2], B1[2][2];
    const char* cA = S.a_base(cur); const char* cB = S.b_base(cur);
    unsigned cv0[2], cv1[2], nv0[2], nv1[2];
    PG8_VOFFA(cur, cv0, cv1);
    PG8_STAGE(PG8_SB(0, 0), cB, voffB); PG8_STAGE(PG8_SB(0, 1), cB + hstep, voffB); PG8_STAGE(PG8_SA(0, 0), cA, cv0); PG8_STAGE(PG8_SA(0, 1), cA + hstepA, cv1);
    if (wr == 1) PG8_BAR;
    PG8_WAIT_V(2); PG8_BAR;
    PG8_STAGE(PG8_SB(1, 0), cB + kstep, voffB); PG8_STAGE(PG8_SA(1, 0), cA + kstep, cv0); PG8_STAGE(PG8_SB(1, 1), cB + hstep + kstep, voffB);
    PG8_WAIT_V(6); PG8_BAR;
    for (;;) {
        const bool has_next = S.next(ui + 1, nxt);
        const char* nA = has_next ? S.a_base(nxt) : cA; const char* nB = has_next ? S.b_base(nxt) : cB;
        if (has_next) { PG8_VOFFA(nxt, nv0, nv1); } else {
#pragma unroll
            for (int i = 0; i < 2; ++i) { nv0[i] = cv0[i]; nv1[i] = cv1[i]; } }
        for (int t = 0; t < nt; t += 2) {
            const bool last = (t == nt - 2);
            const char* a1 = cA + (size_t)(t + 1) * kstep;
            const char* a2 = last ? nA : cA + (size_t)(t + 2) * kstep; const char* b2 = last ? nB : cB + (size_t)(t + 2) * kstep;
            const char* a3 = a2 + kstep; const char* b3 = b2 + kstep;
            unsigned s0[2], s1[2];
#pragma unroll
            for (int i = 0; i < 2; ++i) { s0[i] = last ? nv0[i] : cv0[i]; s1[i] = last ? nv1[i] : cv1[i]; }
            PG8_LDB(B0, 0, 0); PG8_LDB(B1, 0, 1); PG8_SCHED; PG8_LDA(At, 0, 0); PG8_STAGE(PG8_SA(1, 1), a1 + hstepA, cv1);
            PG8_WAIT_V(8); PG8_WAIT_L(0); PG8_BAR; PG8_MMA(0, 0, At, B0); PG8_MMA(0, 1, At, B1); PG8_BAR; PG8_SCHED;
            PG8_LDA(At, 0, 1); PG8_STAGE(PG8_SB(0, 0), b2, voffB); PG8_STAGE(PG8_SB(0, 1), b2 + hstep, voffB); PG8_STAGE(PG8_SA(0, 0), a2, s0);
            PG8_WAIT_V(8); PG8_WAIT_L(0); PG8_BAR; PG8_MMA(1, 0, At, B0); PG8_MMA(1, 1, At, B1); PG8_BAR; PG8_SCHED;
            PG8_LDB(B0, 1, 0); PG8_LDB(B1, 1, 1); PG8_SCHED; PG8_LDA(At, 1, 0); PG8_STAGE(PG8_SA(0, 1), a2 + hstepA, s1);
            PG8_WAIT_V(8); PG8_WAIT_L(0); PG8_BAR; PG8_MMA(0, 0, At, B0); PG8_MMA(0, 1, At, B1); PG8_BAR; PG8_SCHED;
            PG8_LDA(At, 1, 1); PG8_STAGE(PG8_SB(1, 0), b3, voffB); PG8_STAGE(PG8_SB(1, 1), b3 + hstep, voffB); PG8_STAGE(PG8_SA(1, 0), a3, s0);
            PG8_WAIT_V(8); PG8_WAIT_L(0); PG8_BAR; PG8_MMA(1, 0, At, B0); PG8_MMA(1, 1, At, B1); PG8_BAR; PG8_SCHED;
        }
        if (wr == 0) PG8_BAR;
        E(acc, cur, wr, wc, fr, fq);
        if (!has_next) break;
#pragma unroll
        for (int a = 0; a < 2; ++a)
#pragma unroll
            for (int b = 0; b < 2; ++b)
#pragma unroll
                for (int m = 0; m < 4; ++m)
#pragma unroll
                    for (int n = 0; n < 2; ++n) acc[a][b][m][n] = (f32x4){0.f, 0.f, 0.f, 0.f};
        cur = nxt; cA = nA; cB = nB; ++ui;
#pragma unroll
        for (int i = 0; i < 2; ++i) { cv0[i] = nv0[i]; cv1[i] = nv1[i]; }
        if (wr == 1) PG8_BAR;
    }
    PG8_WAIT_V(0);
    PG8_BAR;
#undef PG8_SA
#undef PG8_SB
#undef PG8_STAGE
#undef PG8_LDA
#undef PG8_LDB
#undef PG8_MMA
#undef PG8_WAIT_V
#undef PG8_WAIT_L
#undef PG8_BAR
#undef PG8_SCHED
#undef PG8_VOFFA
}
}

__device__ __forceinline__ void naive_na(const Ctx& c, const bf16* U, const float* rpb, bf16* CAT) {
    const long total = (long)NTOK * NA_H;
    for (long idx = GTID; idx < total; idx += GSIZE) {
        const int h = (int)(idx % NA_H), t = (int)(idx / NA_H);
        const int b = t / SEQ, p = t % SEQ, r = p / 64, cc = p % 64;
        const int rs = min(max(r - 4, 0), 56), cs = min(max(cc - 8, 0), 48);
        const u32x4* q4 = (const u32x4*)(U + (size_t)t * LDU0 + h * 64);
        float acc[64];
#pragma unroll
        for (int i = 0; i < 64; ++i) acc[i] = 0.f;
        float mx = -1e30f, l = 0.f;
        for (int i = 0; i < 8; ++i) for (int j = 0; j < 16; ++j) {
            const int kr = rs + i, kc = cs + j, kt = b * SEQ + kr * 64 + kc;
            const u32x4* k4 = (const u32x4*)(U + (size_t)kt * LDU0 + 768 + h * 64);
            float s = 0.f;
#pragma unroll
            for (int d8 = 0; d8 < 8; ++d8) s += dot8(q4[d8], k4[d8]);
            s = s * 0.125f + rpb[(h * 15 + (kr - r + 7)) * 31 + (kc - cc + 15)];
            const float mn = fmaxf(mx, s), alpha = __expf(mx - mn), pp = __expf(s - mn);
            l = l * alpha + pp; mx = mn;
            const u32x4* v4 = (const u32x4*)(U + (size_t)kt * LDU0 + 1536 + h * 64);
#pragma unroll
            for (int d8 = 0; d8 < 8; ++d8) { const u32x4 vv = v4[d8];
#pragma unroll
                for (int e = 0; e < 4; ++e) { acc[d8 * 8 + 2 * e] = acc[d8 * 8 + 2 * e] * alpha + pp * __uint_as_float(vv[e] << 16);
                    acc[d8 * 8 + 2 * e + 1] = acc[d8 * 8 + 2 * e + 1] * alpha + pp * __uint_as_float(vv[e] & 0xffff0000u); } }
        }
        const float inv = 1.f / l;
        u32x4* o4 = (u32x4*)(CAT + (size_t)t * D + h * 64);
#pragma unroll
        for (int d8 = 0; d8 < 8; ++d8) { u32x4 w; w.x = pk2(acc[d8 * 8] * inv, acc[d8 * 8 + 1] * inv); w.y = pk2(acc[d8 * 8 + 2] * inv, acc[d8 * 8 + 3] * inv);
            w.z = pk2(acc[d8 * 8 + 4] * inv, acc[d8 * 8 + 5] * inv); w.w = pk2(acc[d8 * 8 + 6] * inv, acc[d8 * 8 + 7] * inv); o4[d8] = w; }
    }
}
__device__ __forceinline__ void naive_memattn(const Ctx& c, const bf16* U, int ldu, int mqcol, const bf16* MKV, int lay, bf16* CAT) {
    const long total = (long)NTOK * 4;
    for (long idx = GTID; idx < total; idx += GSIZE) {
        const int h = (int)(idx % 4), t = (int)(idx / 4), b = t / SEQ;
        const u32x4* q4 = (const u32x4*)(U + (size_t)t * ldu + mqcol + h * 64);
        float acc[64];
#pragma unroll
        for (int i = 0; i < 64; ++i) acc[i] = 0.f;
        float mx = -1e30f, l = 0.f;
        for (int m = 0; m < NMEM; ++m) {
            const bf16* row = MKV + (size_t)(b * NMEM + m) * 1024 + lay * 512;
            const u32x4* k4 = (const u32x4*)(row + h * 64);
            float s = 0.f;
#pragma unroll
            for (int d8 = 0; d8 < 8; ++d8) s += dot8(q4[d8], k4[d8]);
            s *= 0.125f;
            const float mn = fmaxf(mx, s), alpha = __expf(mx - mn), pp = __expf(s - mn);
            l = l * alpha + pp; mx = mn;
            const u32x4* v4 = (const u32x4*)(row + 256 + h * 64);
#pragma unroll
            for (int d8 = 0; d8 < 8; ++d8) { const u32x4 vv = v4[d8];
#pragma unroll
                for (int e = 0; e < 4; ++e) { acc[d8 * 8 + 2 * e] = acc[d8 * 8 + 2 * e] * alpha + pp * __uint_as_float(vv[e] << 16);
                    acc[d8 * 8 + 2 * e + 1] = acc[d8 * 8 + 2 * e + 1] * alpha + pp * __uint_as_float(vv[e] & 0xffff0000u); } }
        }
        const float inv = 1.f / l;
        u32x4* o4 = (u32x4*)(CAT + (size_t)t * D + MIX + h * 64);
#pragma unroll
        for (int d8 = 0; d8 < 8; ++d8) { u32x4 w; w.x = pk2(acc[d8 * 8] * inv, acc[d8 * 8 + 1] * inv); w.y = pk2(acc[d8 * 8 + 2] * inv, acc[d8 * 8 + 3] * inv);
            w.z = pk2(acc[d8 * 8 + 4] * inv, acc[d8 * 8 + 5] * inv); w.w = pk2(acc[d8 * 8 + 6] * inv, acc[d8 * 8 + 7] * inv); o4[d8] = w; }
    }
}


namespace att {
typedef short bf16x8 __attribute__((ext_vector_type(8)));
typedef short s16x4 __attribute__((ext_vector_type(4)));
__device__ __forceinline__ s16x4 tr_read(LAS const unsigned char* p) { return __builtin_amdgcn_ds_read_tr16_b64_v4i16((LAS s16x4*)p); }
template <bool NA_MODE, class KRow, class Bias>
__device__ __forceinline__ void attn16x256(const bf16* qrow, const KRow& krow, LAS const unsigned char* vlane, int xs, const Bias& bias, bf16* orow, int fr, int fq) {
    const int p = fr & 3, ph = p >> 1, pl8 = (p & 1) * 8;
    const bf16x8 q0 = *(const bf16x8*)(qrow + 8 * fq), q1 = *(const bf16x8*)(qrow + 32 + 8 * fq);
    f32x4 s[16];
#pragma unroll
    for (int kt = 0; kt < 16; ++kt) {
        const bf16* kr = krow(kt);
        const bf16x8 k0 = *(const bf16x8*)(kr + 8 * fq), k1 = *(const bf16x8*)(kr + 32 + 8 * fq);
        f32x4 a = {0.f, 0.f, 0.f, 0.f};
        a = __builtin_amdgcn_mfma_f32_16x16x32_bf16(k0, q0, a, 0, 0, 0);
        a = __builtin_amdgcn_mfma_f32_16x16x32_bf16(k1, q1, a, 0, 0, 0);
        s[kt] = a;
    }
    float mx = -3.0e38f;
#pragma unroll
    for (int kt = 0; kt < 16; ++kt)
#pragma unroll
        for (int r = 0; r < 4; ++r) { const float v = bias(kt, r, s[kt][r]); s[kt][r] = v; mx = fmaxf(mx, v); }
    mx = fmaxf(mx, __shfl_xor(mx, 16)); mx = fmaxf(mx, __shfl_xor(mx, 32));
    float l = 0.f;
#pragma unroll
    for (int kt = 0; kt < 16; ++kt)
#pragma unroll
        for (int r = 0; r < 4; ++r) { const float pv = __expf(s[kt][r] - mx); s[kt][r] = pv; l += pv; }
    l += __shfl_xor(l, 16); l += __shfl_xor(l, 32);
    LAS const unsigned char* vb[4];
#pragma unroll
    for (int dt = 0; dt < 4; ++dt) vb[dt] = vlane + (((2 * dt + ph) ^ xs) << 4) + pl8;
    f32x4 o[4];
#pragma unroll
    for (int dt = 0; dt < 4; ++dt) o[dt] = (f32x4){0.f, 0.f, 0.f, 0.f};
#pragma unroll
    for (int j = 0; j < 8; ++j) {
        u32x4 pw; pw.x = pg8::cvt_pk_bf16(s[2 * j][0], s[2 * j][1]); pw.y = pg8::cvt_pk_bf16(s[2 * j][2], s[2 * j][3]);
        pw.z = pg8::cvt_pk_bf16(s[2 * j + 1][0], s[2 * j + 1][1]); pw.w = pg8::cvt_pk_bf16(s[2 * j + 1][2], s[2 * j + 1][3]);
        const bf16x8 pb = __builtin_bit_cast(bf16x8, pw);
        constexpr int dummy = 0; (void)dummy;
        const int c0 = NA_MODE ? (((2 * j) >> 1) * 64 + 16 * ((2 * j) & 1)) : 16 * (2 * j);
        const int c1 = NA_MODE ? (((2 * j + 1) >> 1) * 64 + 16 * ((2 * j + 1) & 1)) : 16 * (2 * j + 1);
#pragma unroll
        for (int dt = 0; dt < 4; ++dt) {
            const s16x4 lo = tr_read(vb[dt] + c0 * 128), hi = tr_read(vb[dt] + c1 * 128);
            const bf16x8 va = {lo[0], lo[1], lo[2], lo[3], hi[0], hi[1], hi[2], hi[3]};
            o[dt] = __builtin_amdgcn_mfma_f32_16x16x32_bf16(va, pb, o[dt], 0, 0, 0);
        }
    }
    const float inv = 1.f / l;
#pragma unroll
    for (int dt = 0; dt < 4; ++dt) { u32x2 w; w.x = pg8::cvt_pk_bf16(o[dt][0] * inv, o[dt][1] * inv); w.y = pg8::cvt_pk_bf16(o[dt][2] * inv, o[dt][3] * inv);
        *(u32x2*)(orow + 16 * dt + 4 * fq) = w; }
}

__device__ __forceinline__ void na_phase(const Ctx& c, const bf16* U, const float* rpb, bf16* CAT, int vcu, int G) {
    const int fr = c.lane & 15, fq = c.lane >> 4, j = c.wave & 3, hs = c.wave >> 2;
    for (int u = vcu; u < NBATCH * 6 * 64; u += G) {
        const int r = u & 63, hp = (u >> 6) % 6, b = u / 384, rs = min(max(r - 4, 0), 56);
        __syncthreads();
#pragma unroll 4
        for (int it = 0; it < 16; ++it) { const int idx = c.tid + 512 * it, hsel = idx >> 12, rem = idx & 4095, key = rem >> 3, ch = rem & 7;
            const u32x4 v = *(const u32x4*)(U + (size_t)(b * SEQ + (rs + (key >> 6)) * 64 + (key & 63)) * LDU0 + 1536 + (2 * hp + hsel) * 64 + ch * 8);
            *(LAS u32x4*)(c.lds + hsel * 65536 + key * 128 + ((ch ^ (key & 7)) << 4)) = v; }
        __syncthreads();
        const int h = 2 * hp + hs, cq = 16 * j + fr, cs = min(max(cq - 8, 0), 48), kc0 = min(max(16 * j - 8, 0), 32);
        const int tq = b * SEQ + r * 64 + cq;
        const bf16* qrow = U + (size_t)tq * LDU0 + h * 64;
        const bf16* kbase = U + (size_t)(b * SEQ + rs * 64 + kc0 + fr) * LDU0 + 768 + h * 64;
        const int rowb = kc0 + 4 * fq + (fr >> 2);
        LAS const unsigned char* vlane = c.lds + hs * 65536 + rowb * 128;
        const float* rp = rpb + (size_t)(h * 15 + (rs - r + 7)) * 31;
        attn16x256<true>(qrow, [&](int kt) { return kbase + (size_t)((kt >> 1) * 64 + 16 * (kt & 1)) * LDU0; }, vlane, rowb & 7,
            [&](int kt, int rg, float sv) { const int kcol = kc0 + 16 * (kt & 1) + 4 * fq + rg; const bool ok = (kcol >= cs) && (kcol < cs + 16);
                const int dc = min(max(kcol - cq + 15, 0), 30); const float bv = rp[(kt >> 1) * 31 + dc]; return ok ? sv * 0.125f + bv : -1.0e30f; },
            CAT + (size_t)tq * D + h * 64, fr, fq);
    }
}
__device__ __forceinline__ void mem_phase(const Ctx& c, const bf16* U, int ldu, int mqcol, const bf16* MKV, int lay, bf16* CAT, int vcu, int G) {
    const int fr = c.lane & 15, fq = c.lane >> 4;
    for (int u = vcu; u < NBATCH * 4 * 16; u += G) {
        const int tt = u & 15, h = (u >> 4) & 3, b = u >> 6;
        __syncthreads();
#pragma unroll
        for (int it = 0; it < 4; ++it) { const int idx = c.tid + 512 * it, key = idx >> 3, ch = idx & 7;
            const u32x4 v = *(const u32x4*)(MKV + (size_t)(b * NMEM + key) * 1024 + lay * 512 + 256 + h * 64 + ch * 8);
            *(LAS u32x4*)(c.lds + key * 128 + ((ch ^ (key & 7)) << 4)) = v; }
        __syncthreads();
        const bf16* kbase = MKV + (size_t)(b * NMEM + fr) * 1024 + lay * 512 + h * 64;
        const int rowb = 4 * fq + (fr >> 2);
        LAS const unsigned char* vlane = c.lds + rowb * 128;
#pragma unroll 1
        for (int it = 0; it < 2; ++it) {
            const int tq = b * SEQ + tt * 256 + c.wave * 32 + it * 16 + fr;
            attn16x256<false>(U + (size_t)tq * ldu + mqcol + h * 64, [&](int kt) { return kbase + (size_t)(16 * kt) * 1024; }, vlane, rowb & 7,
                [&](int, int, float sv) { return sv * 0.125f; }, CAT + (size_t)tq * D + MIX + h * 64, fr, fq);
        }
    }
}
}

__device__ __forceinline__ void route_phase(const Ctx& c, const float* X, const float* g, const float* wg, const float* bg, const float* wr, const float* br,
                                            bf16* HN, unsigned char* rt, unsigned* cnt) {
    int* TOKE = (int*)(rt + RT_TOKE); float* TOKW = (float*)(rt + RT_TOKW); int* TOKP = (int*)(rt + RT_TOKP); int* LIST = (int*)(rt + RT_LIST); float* LISTW = (float*)(rt + RT_LISTW);
    for (int t = c.gw; t < NTOK; t += c.ngw) {
        const f32x4* xr = (const f32x4*)(X + (size_t)t * D) + c.lane; const f32x4* gr = (const f32x4*)g + c.lane;
        f32x4 v[4]; float s = 0.f;
#pragma unroll
        for (int j = 0; j < 4; ++j) { v[j] = xr[64 * j]; s += (v[j].x * v[j].x + v[j].y * v[j].y) + (v[j].z * v[j].z + v[j].w * v[j].w); }
        const float r = 1.f / sqrtf(wave_sum(s) * (1.f / D) + EPS);
        u32x2* o8 = (u32x2*)(HN + (size_t)t * D) + c.lane;
#pragma unroll
        for (int j = 0; j < 4; ++j) { const f32x4 gg = gr[64 * j]; v[j].x *= r * gg.x; v[j].y *= r * gg.y; v[j].z *= r * gg.z; v[j].w *= r * gg.w;
            u32x2 w; w.x = pk2(v[j].x, v[j].y); w.y = pk2(v[j].z, v[j].w); o8[64 * j] = w; }
        LAS float* hrow = (LAS float*)(c.lds + c.wave * 16384);
#pragma unroll
        for (int j = 0; j < 4; ++j) *(LAS f32x4*)(hrow + 4 * c.lane + 256 * j) = v[j];
        asm volatile("s_waitcnt lgkmcnt(0)" ::: "memory");
        float lg[4], lr[32];
#pragma unroll
        for (int o = 0; o < 4; ++o) lg[o] = 0.f;
#pragma unroll
        for (int o = 0; o < 32; ++o) lr[o] = 0.f;
#pragma unroll 1
        for (int kk = 0; kk < 16; ++kk) { const int k = c.lane + 64 * kk; const float xv = hrow[k];
            const f32x4 w4 = *(const f32x4*)(wg + (size_t)k * 4);
#pragma unroll
            for (int o = 0; o < 4; ++o) lg[o] += xv * w4[o];
#pragma unroll
            for (int o4 = 0; o4 < 8; ++o4) { const f32x4 w = *(const f32x4*)(wr + (size_t)k * 32 + o4 * 4);
#pragma unroll
                for (int o = 0; o < 4; ++o) lr[o4 * 4 + o] += xv * w[o]; } }
        asm volatile("s_waitcnt lgkmcnt(0)" ::: "memory");
#pragma unroll
        for (int o = 0; o < 4; ++o) lg[o] = wave_sum(lg[o]) + bg[o];
#pragma unroll
        for (int o = 0; o < 32; ++o) lr[o] = wave_sum(lr[o]) + br[o];
        int gi = 0; float gm = lg[0];
#pragma unroll
        for (int o = 1; o < 4; ++o) if (lg[o] > gm) { gm = lg[o]; gi = o; }
        float gs = 0.f;
#pragma unroll
        for (int o = 0; o < 4; ++o) gs += __expf(lg[o] - gm);
        const float ggate = 1.f / gs;
        float el[8];
#pragma unroll
        for (int o = 0; o < 8; ++o) { float x = lr[o];
#pragma unroll
            for (int q = 1; q < 4; ++q) x = (gi == q) ? lr[q * 8 + o] : x;
            el[o] = x; }
        int i0 = 0; float l0 = el[0];
#pragma unroll
        for (int o = 1; o < 8; ++o) if (el[o] > l0) { l0 = el[o]; i0 = o; }
        int i1 = -1; float l1 = -3.0e38f;
#pragma unroll
        for (int o = 0; o < 8; ++o) if (o != i0 && el[o] > l1) { l1 = el[o]; i1 = o; }
        if (i1 < 0) { i1 = (i0 == 0) ? 1 : 0; l1 = el[0]; }
        const float e1 = __expf(l1 - l0), den = 1.f / (1.f + e1);
        const float w0 = den * ggate, w1 = e1 * den * ggate;
        if (c.lane == 0) {
            const int ex0 = gi * 8 + i0, ex1 = gi * 8 + i1;
            const unsigned p0 = atomicAdd(cnt + ex0, 1u), p1 = atomicAdd(cnt + ex1, 1u);
            LIST[ex0 * NTOK + p0] = t; LIST[ex1 * NTOK + p1] = t; LISTW[ex0 * NTOK + p0] = w0; LISTW[ex1 * NTOK + p1] = w1;
            TOKE[2 * t] = ex0; TOKE[2 * t + 1] = ex1; TOKW[2 * t] = w0; TOKW[2 * t + 1] = w1; TOKP[2 * t] = (int)p0; TOKP[2 * t + 1] = (int)p1;
        }
    }
}
__device__ __forceinline__ int pstart_of(const unsigned* cnt, int e) { int s = 0; for (int i = 0; i < e; ++i) s += ((int)cnt[i] + 255) & ~255; return s; }
__device__ __forceinline__ bool row_lookup(const unsigned* cnt, int R, int& e, int& i, int& n) {
    int s = 0;
    for (int x = 0; x < NEXP; ++x) { const int cn = (int)cnt[x], pc = (cn + 255) & ~255; if (R < s + pc) { e = x; i = R - s; n = cn; return true; } s += pc; }
    return false;
}

__device__ __forceinline__ void combine_phase(const Ctx& c, float* X, const bf16* Y, const unsigned char* rt, const unsigned* cnt, const float* g, bf16* XN, float* OUTF) {
    const int* TOKE = (const int*)(rt + RT_TOKE); const int* TOKP = (const int*)(rt + RT_TOKP);
    for (int t = c.gw; t < NTOK; t += c.ngw) {
        const int e0 = TOKE[2 * t], e1 = TOKE[2 * t + 1];
        const int R0 = pstart_of(cnt, e0) + TOKP[2 * t], R1 = pstart_of(cnt, e1) + TOKP[2 * t + 1];
        f32x4* xr = (f32x4*)(X + (size_t)t * D) + c.lane; const f32x4* gr = (const f32x4*)g + c.lane;
        const u32x2* y0 = (const u32x2*)(Y + (size_t)R0 * D) + c.lane; const u32x2* y1 = (const u32x2*)(Y + (size_t)R1 * D) + c.lane;
        f32x4 v[4]; float s = 0.f;
#pragma unroll
        for (int j = 0; j < 4; ++j) { v[j] = xr[64 * j]; const u32x2 a = y0[64 * j], b = y1[64 * j];
            v[j].x += __uint_as_float(a.x << 16) + __uint_as_float(b.x << 16); v[j].y += __uint_as_float(a.x & 0xffff0000u) + __uint_as_float(b.x & 0xffff0000u);
            v[j].z += __uint_as_float(a.y << 16) + __uint_as_float(b.y << 16); v[j].w += __uint_as_float(a.y & 0xffff0000u) + __uint_as_float(b.y & 0xffff0000u);
            s += (v[j].x * v[j].x + v[j].y * v[j].y) + (v[j].z * v[j].z + v[j].w * v[j].w); }
        const float r = 1.f / sqrtf(wave_sum(s) * (1.f / D) + EPS);
        if (XN) {
            u32x2* o8 = (u32x2*)(XN + (size_t)t * D) + c.lane;
#pragma unroll
            for (int j = 0; j < 4; ++j) { xr[64 * j] = v[j]; const f32x4 gg = gr[64 * j]; u32x2 w; w.x = pk2(v[j].x * r * gg.x, v[j].y * r * gg.y); w.y = pk2(v[j].z * r * gg.z, v[j].w * r * gg.w); o8[64 * j] = w; }
        } else {
            f32x4* o = (f32x4*)(OUTF + (size_t)t * D) + c.lane;
#pragma unroll
            for (int j = 0; j < 4; ++j) { const f32x4 gg = gr[64 * j]; f32x4 w; w.x = v[j].x * r * gg.x; w.y = v[j].y * r * gg.y; w.z = v[j].z * r * gg.z; w.w = v[j].w * r * gg.w; o[64 * j] = w; }
        }
    }
}

__device__ __forceinline__ void gla_decay(const Ctx& c, const bf16* U, const float* gup, const float* gbias, float* DECA) {
    const long total = (long)NTOK * 2 * GLA_KD;
    for (long idx = GTID; idx < total; idx += GSIZE) {
        const int cc = (int)(idx % GLA_KD), dir = (int)((idx / GLA_KD) % 2), t = (int)(idx / (2 * GLA_KD));
        const bf16* r = U + (size_t)t * LDU1 + 2304 + dir * 16;
        float z = gbias[dir * GLA_KD + cc];
#pragma unroll
        for (int k = 0; k < 16; ++k) z += bf2f(r[k]) * gup[(dir * 16 + k) * GLA_KD + cc];
        const float ls = fminf(z, 0.f) - log1pf(__expf(-fabsf(z)));
        DECA[idx] = __expf(ls * (1.f / 16.f));
    }
}
__device__ __forceinline__ void gla_recur(const Ctx& c, const bf16* U, const float* DECA, float* OF) {
    const long total = (long)NBATCH * GLA_H * GLA_DV * 2;
    const float qs = 0.10206207261596577f;
    for (long idx = GTID; idx < total; idx += GSIZE) {
        const int half = (int)(idx & 1), dv = (int)((idx >> 1) % GLA_DV), h = (int)(((idx >> 1) / GLA_DV) % GLA_H), b = (int)((idx >> 1) / (GLA_DV * GLA_H));
        float S[48];
        for (int dir = 0; dir < 2; ++dir) {
#pragma unroll
            for (int d = 0; d < 48; ++d) S[d] = 0.f;
            for (int s = 0; s < SEQ; ++s) {
                const int p = dir ? (SEQ - 1 - s) : s, t = b * SEQ + p;
#if GLA_INTRA_ONLY
                if ((s & 63) == 0) {
#pragma unroll
                    for (int d = 0; d < 48; ++d) S[d] = 0.f; }
#endif
                const bf16* row = U + (size_t)t * LDU1;
                const float vv = bf2f(row[768 + h * GLA_DV + dv]);
                const float* a = DECA + ((size_t)t * 2 + dir) * GLA_KD + h * GLA_DK + half * 48;
                const u32x4* q4 = (const u32x4*)(row + h * GLA_DK + half * 48); const u32x4* k4 = (const u32x4*)(row + 384 + h * GLA_DK + half * 48);
                float o = 0.f;
#pragma unroll
                for (int d8 = 0; d8 < 6; ++d8) { const u32x4 qq = q4[d8], kk = k4[d8]; const f32x4 a0 = *(const f32x4*)(a + d8 * 8), a1 = *(const f32x4*)(a + d8 * 8 + 4);
#pragma unroll
                    for (int e = 0; e < 4; ++e) { const float aa0 = e < 2 ? a0[2 * e] : a1[2 * e - 4], aa1 = e < 2 ? a0[2 * e + 1] : a1[2 * e - 3];
                        const float s0 = aa0 * S[d8 * 8 + 2 * e] + __uint_as_float(kk[e] << 16) * vv; S[d8 * 8 + 2 * e] = s0; o += __uint_as_float(qq[e] << 16) * s0;
                        const float s1 = aa1 * S[d8 * 8 + 2 * e + 1] + __uint_as_float(kk[e] & 0xffff0000u) * vv; S[d8 * 8 + 2 * e + 1] = s1; o += __uint_as_float(qq[e] & 0xffff0000u) * s1; } }
                o += __shfl_xor(o, 1);
                float* dst = OF + (size_t)t * MIX + h * GLA_DV + dv;
                if (half == 0) { if (dir == 0) *dst = o * qs; else *dst += o * qs; }
            }
        }
    }
}
__device__ __forceinline__ void gla_norm_gate(const Ctx& c, const float* OF, const bf16* U, const float* onorm, bf16* CAT) {
    for (int it = c.gw; it < NTOK * GLA_H; it += c.ngw) {
        const int h = it % GLA_H, t = it / GLA_H;
        const float* o = OF + (size_t)t * MIX + h * GLA_DV;
        float v[3]; float s = 0.f;
#pragma unroll
        for (int j = 0; j < 3; ++j) { v[j] = o[c.lane + 64 * j]; s += v[j] * v[j]; }
        const float r = 1.f / sqrtf(wave_sum(s) * (1.f / GLA_DV) + EPS);
#pragma unroll
        for (int j = 0; j < 3; ++j) { const int dv = c.lane + 64 * j; const float gg = bf2f(U[(size_t)t * LDU1 + 1536 + h * GLA_DV + dv]);
            CAT[(size_t)t * D + h * GLA_DV + dv] = (bf16)f2bf(v[j] * r * onorm[dv] * silu(gg)); }
    }
}


namespace gla {
typedef short bf16x8 __attribute__((ext_vector_type(8)));
typedef short s16x4 __attribute__((ext_vector_type(4)));
constexpr int LB_OFF = 0, LB_LD = 97;
constexpr int QG_OFF = 25600, KG_OFF = 38912, QS_OFF = 52224, X_LD = 104;
constexpr int VS_OFF = 65536, V_LD = 200;
constexpr int AM_OFF = 91136, AM_LD = 72;
constexpr int TOT_OFF = 100352;
constexpr int RS_OFF = 102400;
constexpr int OS_OFF = 0, OS_LD = 196;
__device__ __forceinline__ s16x4 tr_read(LAS const unsigned char* p) { return __builtin_amdgcn_ds_read_tr16_b64_v4i16((LAS s16x4*)p); }
__device__ __forceinline__ float bflo(unsigned w) { return __uint_as_float(w << 16); }
__device__ __forceinline__ float bfhi(unsigned w) { return __uint_as_float(w & 0xffff0000u); }

__device__ __forceinline__ void prep(const Ctx& c, const bf16* U, const float* gup, const float* gbias, int t0, int h, int dir) {
    LAS float* LB = (LAS float*)(c.lds + LB_OFF); LAS float* TOT = (LAS float*)(c.lds + TOT_OFF);
    for (int idx = c.tid; idx < 64 * 96; idx += 512) { const int t = idx / 96, d = idx % 96;
        const u32x4* r4 = (const u32x4*)(U + (size_t)(t0 + t) * LDU1 + 2304 + dir * 16); const u32x4 ra = r4[0], rb = r4[1];
        const float* g = gup + (size_t)(dir * 16) * GLA_KD + h * GLA_DK + d;
        float z = gbias[dir * GLA_KD + h * GLA_DK + d];
#pragma unroll
        for (int k = 0; k < 4; ++k) { z += bflo(ra[k]) * g[(2 * k) * GLA_KD] + bfhi(ra[k]) * g[(2 * k + 1) * GLA_KD]; z += bflo(rb[k]) * g[(8 + 2 * k) * GLA_KD] + bfhi(rb[k]) * g[(9 + 2 * k) * GLA_KD]; }
        LB[t * LB_LD + d] = (fminf(z, 0.f) - __logf(1.f + __expf(-fabsf(z)))) * (1.f / 16.f); }
    __syncthreads();
    if (c.tid < 384) { const int d = c.tid % 96, seg = c.tid / 96; float run = 0.f;
#pragma unroll 4
        for (int i = 0; i < 16; ++i) { const int s = seg * 16 + i, t = dir ? 63 - s : s; run += LB[t * LB_LD + d]; LB[t * LB_LD + d] = run; }
        TOT[seg * 96 + d] = run; }
    __syncthreads();
    if (c.tid < 384) { const int d = c.tid % 96, seg = c.tid / 96; float off = 0.f;
        for (int s2 = 0; s2 < seg; ++s2) off += TOT[s2 * 96 + d];
        if (seg > 0) {
#pragma unroll 4
            for (int i = 0; i < 16; ++i) { const int s = seg * 16 + i, t = dir ? 63 - s : s; LB[t * LB_LD + d] += off; } }
        if (seg == 3) TOT[4 * 96 + d] = off + TOT[3 * 96 + d]; }
    __syncthreads();
}
__device__ __forceinline__ void stage_v(const Ctx& c, const bf16* U, int t0, int h) {
    for (int idx = c.tid; idx < 64 * 24; idx += 512) { const int t = idx / 24, ch = idx % 24;
        *(LAS u32x4*)(c.lds + VS_OFF + (t * V_LD + ch * 8) * 2) = *(const u32x4*)(U + (size_t)(t0 + t) * LDU1 + 768 + h * GLA_DV + ch * 8); }
}

__device__ __forceinline__ void local_phase(const Ctx& c, const bf16* U, const float* gup, const float* gbias, bf16* SU, float* DEC, int vcu, int G, unsigned* dbg) {
    const int fr = c.lane & 15, fq = c.lane >> 4, q = fr >> 2, p = fr & 3;
    for (int item = vcu; item < NBATCH * GLA_H * 2 * 64; item += G) {
        const int n = item & 63, dir = (item >> 6) & 1, h = (item >> 7) & 3, b = item >> 9, t0 = b * SEQ + n * 64;
        __syncthreads();
        stage_v(c, U, t0, h);
        prep(c, U, gup, gbias, t0, h, dir);
        LAS const float* LB = (LAS const float*)(c.lds + LB_OFF); LAS const float* BL = (LAS const float*)(c.lds + TOT_OFF) + 4 * 96;
        for (int idx = c.tid; idx < 64 * 12; idx += 512) { const int t = idx / 12, ch = idx % 12;
            const u32x4 kk = *(const u32x4*)(U + (size_t)(t0 + t) * LDU1 + 384 + h * GLA_DK + ch * 8); u32x4 w;
#pragma unroll
            for (int e = 0; e < 4; ++e) { const int d = ch * 8 + 2 * e; const float f0 = __expf(BL[d] - LB[t * LB_LD + d]), f1 = __expf(BL[d + 1] - LB[t * LB_LD + d + 1]);
                w[e] = pg8::cvt_pk_bf16(bflo(kk[e]) * f0, bfhi(kk[e]) * f1); }
            *(LAS u32x4*)(c.lds + QG_OFF + (t * X_LD + ch * 8) * 2) = w; }
        if (c.tid < 96) DEC[(size_t)item * 96 + c.tid] = __expf(BL[c.tid]);
        __syncthreads();
        bf16* su = SU + (size_t)item * (GLA_DV * GLA_DK);
#pragma unroll 1
        for (int k9 = 0; k9 < 9; ++k9) { const int id = c.wave * 9 + k9, jv = id / 6, i = id % 6;
            f32x4 acc = {0.f, 0.f, 0.f, 0.f};
#pragma unroll
            for (int ks = 0; ks < 2; ++ks) { const int tr = 32 * ks + 8 * fq + q;
                const s16x4 a0 = tr_read(c.lds + QG_OFF + (tr * X_LD + 16 * i + 4 * p) * 2), a1 = tr_read(c.lds + QG_OFF + ((tr + 4) * X_LD + 16 * i + 4 * p) * 2);
                const s16x4 b0 = tr_read(c.lds + VS_OFF + (tr * V_LD + 16 * jv + 4 * p) * 2), b1 = tr_read(c.lds + VS_OFF + ((tr + 4) * V_LD + 16 * jv + 4 * p) * 2);
                const bf16x8 av = {a0[0], a0[1], a0[2], a0[3], a1[0], a1[1], a1[2], a1[3]}, bv = {b0[0], b0[1], b0[2], b0[3], b1[0], b1[1], b1[2], b1[3]};
                acc = __builtin_amdgcn_mfma_f32_16x16x32_bf16(av, bv, acc, 0, 0, 0); }
            u32x2 w; w.x = pg8::cvt_pk_bf16(acc[0], acc[1]); w.y = pg8::cvt_pk_bf16(acc[2], acc[3]);
            *(u32x2*)(su + (size_t)(16 * jv + fr) * GLA_DK + 16 * i + 4 * fq) = w; }
    }
}
__device__ __forceinline__ void scan_phase(const Ctx& c, bf16* SU, const float* DEC) {
    const long total = (long)32 * 2304;
    for (long idx = GTID; idx < total; idx += GSIZE) { const int seq = (int)(idx / 2304), ch = (int)(idx % 2304), dk0 = (ch % 12) * 8, dir = seq & 1;
        float s[8];
#pragma unroll
        for (int e = 0; e < 8; ++e) s[e] = 0.f;
#pragma unroll 4
        for (int st = 0; st < 64; ++st) { const int n = dir ? 63 - st : st;
            u32x4* pu = (u32x4*)(SU + ((size_t)(seq * 64 + n)) * (GLA_DV * GLA_DK) + (size_t)ch * 8); const u32x4 uu = *pu;
            const f32x4 d0 = *(const f32x4*)(DEC + (size_t)(seq * 64 + n) * 96 + dk0), d1 = *(const f32x4*)(DEC + (size_t)(seq * 64 + n) * 96 + dk0 + 4);
            u32x4 w; w.x = pg8::cvt_pk_bf16(s[0], s[1]); w.y = pg8::cvt_pk_bf16(s[2], s[3]); w.z = pg8::cvt_pk_bf16(s[4], s[5]); w.w = pg8::cvt_pk_bf16(s[6], s[7]); *pu = w;
            s[0] = s[0] * d0[0] + bflo(uu[0]); s[1] = s[1] * d0[1] + bfhi(uu[0]); s[2] = s[2] * d0[2] + bflo(uu[1]); s[3] = s[3] * d0[3] + bfhi(uu[1]);
            s[4] = s[4] * d1[0] + bflo(uu[2]); s[5] = s[5] * d1[1] + bfhi(uu[2]); s[6] = s[6] * d1[2] + bflo(uu[3]); s[7] = s[7] * d1[3] + bfhi(uu[3]); }
    }
}
__device__ __forceinline__ void out_phase(const Ctx& c, const bf16* U, const float* gup, const float* gbias, const bf16* SU, const float* onorm, bf16* CAT, int vcu, int G) {
    const int fr = c.lane & 15, fq = c.lane >> 4, q = fr >> 2, p = fr & 3, it = c.wave & 3, cth = c.wave >> 2;
    const float qsc = 0.10206207261596577f;
    for (int item = vcu; item < NBATCH * GLA_H * 64; item += G) {
        const int n = item & 63, h = (item >> 6) & 3, b = item >> 8, t0 = b * SEQ + n * 64;
        f32x4 o[6];
#pragma unroll
        for (int x = 0; x < 6; ++x) o[x] = (f32x4){0.f, 0.f, 0.f, 0.f};
        __syncthreads();
        stage_v(c, U, t0, h);
#pragma unroll 1
        for (int dir = 0; dir < 2; ++dir) {
            prep(c, U, gup, gbias, t0, h, dir);
            LAS const float* LB = (LAS const float*)(c.lds + LB_OFF); const int tmid = dir ? 32 : 31;
            for (int idx = c.tid; idx < 64 * 12; idx += 512) { const int t = idx / 12, ch = idx % 12;
                const u32x4 qq = *(const u32x4*)(U + (size_t)(t0 + t) * LDU1 + h * GLA_DK + ch * 8), kk = *(const u32x4*)(U + (size_t)(t0 + t) * LDU1 + 384 + h * GLA_DK + ch * 8);
                u32x4 wg, wk, ws;
#pragma unroll
                for (int e = 0; e < 4; ++e) { const int d = ch * 8 + 2 * e; const float b0 = LB[t * LB_LD + d], b1 = LB[t * LB_LD + d + 1], m0 = LB[tmid * LB_LD + d], m1 = LB[tmid * LB_LD + d + 1];
                    const float q0 = bflo(qq[e]) * qsc, q1 = bfhi(qq[e]) * qsc;
                    wg[e] = pg8::cvt_pk_bf16(q0 * __expf(b0 - m0), q1 * __expf(b1 - m1)); wk[e] = pg8::cvt_pk_bf16(bflo(kk[e]) * __expf(m0 - b0), bfhi(kk[e]) * __expf(m1 - b1));
                    ws[e] = pg8::cvt_pk_bf16(q0 * __expf(b0), q1 * __expf(b1)); }
                *(LAS u32x4*)(c.lds + QG_OFF + (t * X_LD + ch * 8) * 2) = wg; *(LAS u32x4*)(c.lds + KG_OFF + (t * X_LD + ch * 8) * 2) = wk; *(LAS u32x4*)(c.lds + QS_OFF + (t * X_LD + ch * 8) * 2) = ws; }
            __syncthreads();
#pragma unroll
            for (int jj = 0; jj < 2; ++jj) { const int jt = 2 * cth + jj; f32x4 a = {0.f, 0.f, 0.f, 0.f};
#pragma unroll
                for (int ks = 0; ks < 3; ++ks) { const bf16x8 av = *(const LAS bf16x8*)(c.lds + QG_OFF + ((16 * it + fr) * X_LD + 32 * ks + 8 * fq) * 2), bv = *(const LAS bf16x8*)(c.lds + KG_OFF + ((16 * jt + fr) * X_LD + 32 * ks + 8 * fq) * 2);
                    a = __builtin_amdgcn_mfma_f32_16x16x32_bf16(av, bv, a, 0, 0, 0); }
#pragma unroll
                for (int rg = 0; rg < 4; ++rg) { const int i = 16 * it + 4 * fq + rg, j = 16 * jt + fr; const bool keep = dir ? (j >= i) : (j <= i);
                    *(LAS bf16*)(c.lds + AM_OFF + (i * AM_LD + j) * 2) = (bf16)f2bf(keep ? a[rg] : 0.f); } }
            __syncthreads();
            const bf16* st = SU + ((size_t)(((b * 4 + h) * 2 + dir) * 64 + n)) * (GLA_DV * GLA_DK);
#pragma unroll
            for (int x = 0; x < 6; ++x) { const int ct = cth * 6 + x;
#pragma unroll
                for (int ks = 0; ks < 2; ++ks) { const int tr = 32 * ks + 8 * fq + q;
                    const bf16x8 av = *(const LAS bf16x8*)(c.lds + AM_OFF + ((16 * it + fr) * AM_LD + 32 * ks + 8 * fq) * 2);
                    const s16x4 b0 = tr_read(c.lds + VS_OFF + (tr * V_LD + 16 * ct + 4 * p) * 2), b1 = tr_read(c.lds + VS_OFF + ((tr + 4) * V_LD + 16 * ct + 4 * p) * 2);
                    const bf16x8 bv = {b0[0], b0[1], b0[2], b0[3], b1[0], b1[1], b1[2], b1[3]};
                    o[x] = __builtin_amdgcn_mfma_f32_16x16x32_bf16(av, bv, o[x], 0, 0, 0); }
#if !GLA_INTRA_ONLY
#pragma unroll
                for (int ks = 0; ks < 3; ++ks) { const bf16x8 av = *(const LAS bf16x8*)(c.lds + QS_OFF + ((16 * it + fr) * X_LD + 32 * ks + 8 * fq) * 2);
                    const bf16x8 bv = *(const bf16x8*)(st + (size_t)(16 * ct + fr) * GLA_DK + 32 * ks + 8 * fq);
                    o[x] = __builtin_amdgcn_mfma_f32_16x16x32_bf16(av, bv, o[x], 0, 0, 0); }
#endif
            }
            __syncthreads();
        }
        LAS float* OS = (LAS float*)(c.lds + OS_OFF);
#pragma unroll
        for (int x = 0; x < 6; ++x)
#pragma unroll
            for (int rg = 0; rg < 4; ++rg) OS[(16 * it + 4 * fq + rg) * OS_LD + 16 * (cth * 6 + x) + fr] = o[x][rg];
        __syncthreads();
        { const int t = c.tid >> 3, part = c.tid & 7; float s = 0.f;
#pragma unroll
            for (int e = 0; e < 24; ++e) { const float v = OS[t * OS_LD + part * 24 + e]; s += v * v; }
            s += __shfl_xor(s, 1); s += __shfl_xor(s, 2); s += __shfl_xor(s, 4);
            if (part == 0) ((LAS float*)(c.lds + RS_OFF))[t] = 1.f / sqrtf(s * (1.f / GLA_DV) + EPS); }
        __syncthreads();
        for (int idx = c.tid; idx < 64 * 24; idx += 512) { const int t = idx / 24, ch = idx % 24; const float r = ((LAS const float*)(c.lds + RS_OFF))[t];
            const u32x4 gg = *(const u32x4*)(U + (size_t)(t0 + t) * LDU1 + 1536 + h * GLA_DV + ch * 8); u32x4 w;
#pragma unroll
            for (int e = 0; e < 4; ++e) { const int dv = ch * 8 + 2 * e; const float g0 = bflo(gg[e]), g1 = bfhi(gg[e]);
                w[e] = pg8::cvt_pk_bf16(OS[t * OS_LD + dv] * r * onorm[dv] * (g0 / (1.f + __expf(-g0))), OS[t * OS_LD + dv + 1] * r * onorm[dv + 1] * (g1 / (1.f + __expf(-g1)))); }
            *(u32x4*)(CAT + (size_t)(t0 + t) * D + h * GLA_DV + ch * 8) = w; }
    }
}
}

#define XB_TMO      128
#define XB_XCNT(j)  (256  + 64 * (j))
#define XB_XSUB(j)  (1280 + 64 * (j))
#define XB_XGEN(j)  (2304 + 64 * (j))
#define XB_TOP      3328
#define XB_TOPGEN   3392
#define XCD_BAR_WORDS 3456
#define XB_SPIN_CAP (1u << 22)
__device__ __forceinline__ unsigned xb_ld(unsigned* p)              { return __hip_atomic_load(p, __ATOMIC_RELAXED, __HIP_MEMORY_SCOPE_AGENT); }
__device__ __forceinline__ unsigned xb_add(unsigned* p, unsigned v) { return __hip_atomic_fetch_add(p, v, __ATOMIC_RELAXED, __HIP_MEMORY_SCOPE_AGENT); }
__device__ __forceinline__ unsigned xb_xcc_id() { return (unsigned)__builtin_amdgcn_s_getreg((3 << 11) | 20) & 0xFu; }
#define XB_SPIN(cond, bar) do { unsigned _sp = 0; while (cond) { __builtin_amdgcn_s_sleep(1); \
    if ((++_sp & 255u) == 0u) { if (xb_ld(&(bar)[XB_TMO])) break; if (_sp > XB_SPIN_CAP) { atomicAdd(&(bar)[XB_TMO], 1u); break; } } } } while (0)
struct XcdBarrier { unsigned* bar; unsigned x; volatile LAS unsigned* st; };
__device__ __forceinline__ XcdBarrier xcd_barrier_post(unsigned* bar, volatile LAS unsigned* st) {
    XcdBarrier b; b.bar = bar; b.x = xb_xcc_id(); b.st = st;
    if (threadIdx.x == 0) (void)xb_add(&bar[XB_XCNT(b.x)], 1u);
    return b;
}
__device__ __forceinline__ void xcd_barrier_complete(unsigned* bar, unsigned x, unsigned& nloc, unsigned& nx) {
    const unsigned G = gridDim.x * gridDim.y * gridDim.z;
    unsigned sum, cnt, mine, sp = 0u;
    for (;;) {
        sum = 0u; cnt = 0u; mine = 0u;
#pragma unroll
        for (unsigned j = 0; j < 16; ++j) { const unsigned c = xb_ld(&bar[XB_XCNT(j)]); sum += c; cnt += (c > 0u) ? 1u : 0u; mine = (j == x) ? c : mine; }
        if (sum == G) break;
        __builtin_amdgcn_s_sleep(1);
        if ((++sp & 255u) == 0u) { if (xb_ld(&bar[XB_TMO])) break; if (sp > XB_SPIN_CAP) { atomicAdd(&bar[XB_TMO], 1u); break; } }
    }
    nloc = mine > 0u ? mine : 1u; nx = cnt > 0u ? cnt : 1u;
}
__device__ __forceinline__ void xcd_barrier(const XcdBarrier& b) {
    asm volatile("s_waitcnt vmcnt(0)" ::: "memory");
    __syncthreads();
    if (threadIdx.x == 0) {
        unsigned* bar = b.bar;
        __builtin_amdgcn_s_waitcnt(0);
        const unsigned bx = __builtin_amdgcn_readfirstlane(xb_xcc_id());
        unsigned nloc = b.st[0], nx = b.st[1];
        if (nloc == 0u) { xcd_barrier_complete(bar, bx, nloc, nx); b.st[0] = nloc; b.st[1] = nx; }
        const unsigned old = xb_add(&bar[XB_XSUB(bx)], 1u);
        const unsigned gen = old / nloc;
        if (old + 1u == (gen + 1u) * nloc) {
            __builtin_amdgcn_fence(__ATOMIC_RELEASE, "agent");
            asm volatile("s_waitcnt vmcnt(0)" ::: "memory");
            const unsigned og = xb_add(&bar[XB_TOP], 1u);
            const unsigned tg = og / nx;
            if (og + 1u == (tg + 1u) * nx) xb_add(&bar[XB_TOPGEN], 1u);
            else XB_SPIN(xb_ld(&bar[XB_TOPGEN]) == tg, bar);
            __builtin_amdgcn_fence(__ATOMIC_ACQUIRE, "agent");
            xb_add(&bar[XB_XGEN(bx)], 1u);
            asm volatile("s_waitcnt vmcnt(0)" ::: "memory");
        } else {
            XB_SPIN(xb_ld(&bar[XB_XGEN(bx)]) == gen, bar);
            __builtin_amdgcn_fence(__ATOMIC_ACQUIRE, "agent");
            asm volatile("s_waitcnt vmcnt(0)" ::: "memory");
        }
    }
    __syncthreads();
}

constexpr int NWAVES = 8, NTHREADS = 512, LDS_BYTES = 147456, MISC_OFF = 131072 + 1024;
constexpr int NPHASES = 19;
constexpr int TAB_OFF = 131072 + 2048;
#ifndef GLA_EXPERIMENT
#define GLA_EXPERIMENT 0
#endif
#ifndef USE_MFMA_GLA
#define USE_MFMA_GLA 7
#endif
#ifndef USE_MFMA_ATTN
#define USE_MFMA_ATTN 1
#endif
#ifndef USE_PG8
#define USE_PG8 0xF
#endif
__device__ __forceinline__ void build_tab(const Ctx& c, const unsigned* cnt) {
    LAS int* tab = (LAS int*)(c.lds + TAB_OFF);
    __syncthreads();
    if (c.tid < 64) { const int cn = c.tid < 32 ? (int)cnt[c.tid] : 0; int mt = (cn + 255) >> 8, inc = mt;
#pragma unroll
        for (int o = 1; o < 32; o <<= 1) { const int v = __shfl_up(inc, o); if ((c.tid & 31) >= o) inc += v; }
        if (c.tid < 32) { tab[c.tid + 1] = inc; tab[64 + c.tid] = cn; } if (c.tid == 0) tab[0] = 0; }
    __syncthreads();
}

template <int PH_LO, int PH_HI> __global__ void __launch_bounds__(NTHREADS, 2) mk_fwd(Args args) {
    extern __shared__ __attribute__((aligned(16))) unsigned char lds_raw[];
    LAS unsigned char* const ldsp = (LAS unsigned char*)lds_raw;
    Ctx c = fresh_ctx(ldsp);
    const int vcu = (gridDim.x % 8 == 0) ? (int)((blockIdx.x % 8) * (gridDim.x / 8) + blockIdx.x / 8) : (int)blockIdx.x;
    unsigned char* ws = args.ws;
    const float* x = args.in[0]; const float* mem = args.in[1]; const float* mem_norm = args.in[2]; const float* final_norm = args.in[3];
    const float* norm_mix = args.in[4]; const float* norm_ffn = args.in[5]; const float* w_mem_kv = args.in[6]; const float* w_out = args.in[7];
    const float* na_w_in = args.in[8]; const float* na_rpb = args.in[9]; const float* gla_w_in = args.in[10]; const float* gla_gate_up = args.in[11];
    const float* gla_gate_bias = args.in[12]; const float* gla_out_norm = args.in[13]; const float* moe_w_group = args.in[14]; const float* moe_b_group = args.in[15];
    const float* moe_w_router = args.in[16]; const float* moe_b_router = args.in[17]; const float* moe_w1 = args.in[18]; const float* moe_w3 = args.in[19]; const float* moe_w2 = args.in[20];
    float* X = args.out;
    bf16* WIN0 = (bf16*)(ws + WS_WIN0); bf16* WIN1 = (bf16*)(ws + WS_WIN1); bf16* WOUT = (bf16*)(ws + WS_WOUT); bf16* WMKV = (bf16*)(ws + WS_WMKV);
    bf16* MEMN = (bf16*)(ws + WS_MEMN); bf16* MKV = (bf16*)(ws + WS_MKV); bf16* W13 = (bf16*)(ws + WS_W13); bf16* W2 = (bf16*)(ws + WS_W2);
    bf16* XN = (bf16*)(ws + WS_XN); bf16* U = (bf16*)(ws + WS_U); bf16* Y = (bf16*)(ws + WS_Y); bf16* CAT = (bf16*)(ws + WS_CAT); bf16* ACT = (bf16*)(ws + WS_ACT);
    unsigned char* RT = ws + WS_ROUTE; float* DECA = (float*)(ws + WS_S + 74 * MiB); float* OF = (float*)(ws + WS_S + 122 * MiB);
    bf16* SU = (bf16*)(ws + WS_S); float* SDEC = (float*)(ws + WS_S + 73 * MiB);
    unsigned* CTL = (unsigned*)(ws + WS_CTL);
#define IN(k) (PH_LO <= (k) && (k) < PH_HI)
    constexpr bool FUSED = (PH_HI - PH_LO) > 1;
    XcdBarrier bar; bar.bar = CTL + CW_BAR; bar.x = 0; bar.st = nullptr;
    if constexpr (FUSED) {
        volatile LAS unsigned* misc = (volatile LAS unsigned*)(c.lds + MISC_OFF);
        if (c.tid < 64) misc[c.tid] = 0u;
        __syncthreads();
        bar = xcd_barrier_post(CTL + CW_BAR, misc + 8);
    }
#define GRID_BAR(k) do { if constexpr (FUSED) { if (IN((k) + 1)) xcd_barrier(bar); } } while (0)

    if (IN(0)) { c = fresh_ctx(ldsp);
        transpose_matrix(c, na_w_in, 1024, NA_IN, WIN0, c.gw, c.ngw);
        transpose_matrix(c, gla_w_in, 1024, GLA_IN, WIN1, c.gw, c.ngw);
        for (long i = GTID; i < (long)(2816 - 2592) * 1024 / 8; i += GSIZE) ((u32x4*)(WIN1 + (size_t)2592 * 1024))[i] = (u32x4){0u, 0u, 0u, 0u};
        for (int l = 0; l < 2; ++l) { transpose_matrix(c, w_out + (size_t)l * D * D, 1024, 1024, WOUT + (size_t)l * D * D, c.gw, c.ngw);
            transpose_matrix(c, w_mem_kv + (size_t)l * D * 512, 1024, 512, WMKV + (size_t)l * 512 * 1024, c.gw, c.ngw); }
        convert_moe(c, moe_w1, moe_w3, moe_w2, W13, W2);
        for (int m = c.gw; m < NBATCH * NMEM; m += c.ngw) rms_row_to_bf16(mem + (size_t)m * D, mem_norm, MEMN + (size_t)m * D, c.lane);
        for (int m = c.gw; m < NTOK; m += c.ngw) rms_row_to_bf16(x + (size_t)m * D, norm_mix, XN + (size_t)m * D, c.lane);
        GRID_BAR(0);
    }
#pragma unroll
    for (int L = 0; L < 2; ++L) {
        const int pb = 1 + 9 * L;
        const int ldu = L == 0 ? LDU0 : LDU1;
        unsigned* cnt = CTL + CW_CNT + 64 * L;
        if (IN(pb)) { c = fresh_ctx(ldsp);
            if constexpr (USE_PG8 & 1) {
                pg8::StaticOrder S; S.init(XN, L == 0 ? WIN0 : WIN1, NTOK, ldu, D, (int)gridDim.x, (int)blockIdx.x);
                pg8::EpiBf16 E{U, ldu};
                pg8::gemm_phase<pg8::EpiBf16, pg8::StaticOrder, false>(c.lds, D, S, E);
                if (L == 0) { pg8::StaticOrder S2; S2.init(MEMN, WMKV, NBATCH * NMEM, 1024, D, (int)gridDim.x, (int)blockIdx.x);
                    pg8::EpiBf16 E2{MKV, 1024};
                    pg8::gemm_phase<pg8::EpiBf16, pg8::StaticOrder, false>(c.lds, D, S2, E2); }
            } else {
            if (L == 0) {
                naive_gemm(c, NTOK, NA_IN, D, [&](int m) { return XN + (size_t)m * D; }, WIN0, [&](int m, int n, float a) { U[(size_t)m * LDU0 + n] = (bf16)f2bf(a); });
                naive_gemm(c, NBATCH * NMEM, 1024, D, [&](int m) { return MEMN + (size_t)m * D; }, WMKV, [&](int m, int n, float a) { MKV[(size_t)m * 1024 + n] = (bf16)f2bf(a); });
            } else {
                naive_gemm(c, NTOK, LDU1, D, [&](int m) { return XN + (size_t)m * D; }, WIN1, [&](int m, int n, float a) { U[(size_t)m * LDU1 + n] = (bf16)f2bf(a); });
            }
            }
            GRID_BAR(pb);
        }
        if (IN(pb + 1)) { c = fresh_ctx(ldsp);
#if USE_MFMA_ATTN
            if (L == 0) { att::na_phase(c, U, na_rpb, CAT, vcu, (int)gridDim.x); att::mem_phase(c, U, LDU0, 2304, MKV, 0, CAT, vcu, (int)gridDim.x); }
            else { att::mem_phase(c, U, LDU1, 2336, MKV, 1, CAT, vcu, (int)gridDim.x);
                if constexpr (USE_MFMA_GLA & 1) gla::local_phase(c, U, gla_gate_up, gla_gate_bias, SU, SDEC, vcu, (int)gridDim.x, CTL);
                if constexpr (!(USE_MFMA_GLA & 4)) gla_decay(c, U, gla_gate_up, gla_gate_bias, DECA); }
#else
            if (L == 0) { naive_na(c, U, na_rpb, CAT); naive_memattn(c, U, LDU0, 2304, MKV, 0, CAT); }
            else { gla_decay(c, U, gla_gate_up, gla_gate_bias, DECA); naive_memattn(c, U, LDU1, 2336, MKV, 1, CAT); }
#endif
            GRID_BAR(pb + 1);
        }
        if (IN(pb + 2)) { c = fresh_ctx(ldsp);
            if (L == 1) { if constexpr (USE_MFMA_GLA & 2) gla::scan_phase(c, SU, SDEC);
                if constexpr (!(USE_MFMA_GLA & 4)) gla_recur(c, U, DECA, OF);
                GRID_BAR(pb + 2); }
        }
        if (IN(pb + 3)) { c = fresh_ctx(ldsp);
            if (L == 1) {
#if GLA_EXPERIMENT
                gla::out_phase(c, U, gla_gate_up, gla_gate_bias, SU, gla_out_norm, ACT, vcu, (int)gridDim.x);
                gla_norm_gate(c, OF, U, gla_out_norm, CAT);
#else
                if constexpr (USE_MFMA_GLA & 4) gla::out_phase(c, U, gla_gate_up, gla_gate_bias, SU, gla_out_norm, CAT, vcu, (int)gridDim.x);
                else gla_norm_gate(c, OF, U, gla_out_norm, CAT);
#endif
                GRID_BAR(pb + 3); }
        }
        if (IN(pb + 4)) { c = fresh_ctx(ldsp);
            const float* resid = L == 0 ? x : X;
#if GLA_EXPERIMENT
            if (L == 1) { unsigned bad = 0, verybad = 0;
                for (long i = GTID; i < (long)NTOK * MIX; i += GSIZE) { const int t = (int)(i / MIX), cc = (int)(i % MIX); const float a = bf2f(CAT[(size_t)t * D + cc]), bb = bf2f(ACT[(size_t)t * D + cc]);
                    const float df = fabsf(a - bb); if (!(df <= 0.05f + 0.1f * fabsf(a))) ++bad; if (!(fabsf(bb) < 1.0e30f)) ++verybad; }
                unsigned nfs = 0, nfd = 0;
                for (long i = GTID; i < (long)2048 * 18432; i += GSIZE) { const float a = bf2f(SU[i]); if (!(fabsf(a) < 1.0e30f)) ++nfs; }
                for (long i = GTID; i < (long)2048 * 96; i += GSIZE) { const float a = SDEC[i]; if (!(a >= 0.f && a <= 1.0001f)) ++nfd; }
                if (bad) atomicAdd(CTL + 512, bad); if (verybad) atomicAdd(CTL + 513, verybad); if (nfs) atomicAdd(CTL + 514, nfs); if (nfd) atomicAdd(CTL + 515, nfd); }
#endif
            if constexpr (USE_PG8 & 2) {
                pg8::StaticOrder S; S.init(CAT, WOUT + (size_t)L * D * D, NTOK, D, D, (int)gridDim.x, (int)blockIdx.x);
                pg8::EpiResF32 E{resid, X};
                pg8::gemm_phase<pg8::EpiResF32, pg8::StaticOrder, false>(c.lds, D, S, E);
            } else
            naive_gemm(c, NTOK, D, D, [&](int m) { return CAT + (size_t)m * D; }, WOUT + (size_t)L * D * D, [&](int m, int n, float a) { X[(size_t)m * D + n] = resid[(size_t)m * D + n] + a; });
            GRID_BAR(pb + 4);
        }
        if (IN(pb + 5)) { c = fresh_ctx(ldsp);
            route_phase(c, X, norm_ffn + L * D, moe_w_group + (size_t)L * D * 4, moe_b_group + L * 4, moe_w_router + (size_t)L * D * 32, moe_b_router + L * 32, XN, RT, cnt);
            GRID_BAR(pb + 5);
        }
        if (IN(pb + 6)) { c = fresh_ctx(ldsp);
            const int* LIST = (const int*)(RT + RT_LIST);
            if constexpr (USE_PG8 & 4) {
                build_tab(c, cnt);
                pg8::MoeOrder S{(const LAS int*)(c.lds + TAB_OFF), XN, W13, LIST, D, 4, (int)gridDim.x, vcu, true};
                pg8::EpiSwiGLU E{ACT};
                pg8::gemm_phase<pg8::EpiSwiGLU, pg8::MoeOrder, true>(c.lds, D, S, E);
            } else {
            const long total = (long)MAXROWS * EFF;
            for (long idx = GTID; idx < total; idx += GSIZE) {
                const int R = (int)(idx / EFF), j = (int)(idx % EFF); int e, i, n;
                if (!row_lookup(cnt, R, e, i, n) || i >= n) continue;
                const int t = LIST[e * NTOK + i];
                const u32x4* a4 = (const u32x4*)(XN + (size_t)t * D);
                const int r1 = (j / 128) * 256 + (j % 128);
                const u32x4* b1 = (const u32x4*)(W13 + ((size_t)e * 1024 + r1) * 1024); const u32x4* b3 = (const u32x4*)(W13 + ((size_t)e * 1024 + r1 + 128) * 1024);
                float s1 = 0.f, s3 = 0.f;
                for (int k8 = 0; k8 < D / 8; ++k8) { const u32x4 av = a4[k8]; s1 += dot8(av, b1[k8]); s3 += dot8(av, b3[k8]); }
                ACT[(size_t)R * EFF + j] = (bf16)f2bf(silu(s1) * s3);
            }
            }
            GRID_BAR(pb + 6);
        }
        if (IN(pb + 7)) { c = fresh_ctx(ldsp);
            const int* LIST = (const int*)(RT + RT_LIST); const int* TOKE = (const int*)(RT + RT_TOKE); const float* TOKW = (const float*)(RT + RT_TOKW);
            if constexpr (USE_PG8 & 8) {
                build_tab(c, cnt);
                pg8::MoeOrder S{(const LAS int*)(c.lds + TAB_OFF), ACT, W2, LIST, EFF, 4, (int)gridDim.x, vcu, false};
                pg8::EpiScaleBf16 E{Y, (const float*)(RT + RT_LISTW), (const LAS int*)(c.lds + TAB_OFF)};
                pg8::gemm_phase<pg8::EpiScaleBf16, pg8::MoeOrder, false>(c.lds, EFF, S, E);
            } else {
            const long total = (long)MAXROWS * D;
            for (long idx = GTID; idx < total; idx += GSIZE) {
                const int R = (int)(idx / D), n = (int)(idx % D); int e, i, cn;
                if (!row_lookup(cnt, R, e, i, cn) || i >= cn) continue;
                const int t = LIST[e * NTOK + i];
                const float w = (TOKE[2 * t] == e) ? TOKW[2 * t] : TOKW[2 * t + 1];
                const u32x4* a4 = (const u32x4*)(ACT + (size_t)R * EFF); const u32x4* b4 = (const u32x4*)(W2 + ((size_t)e * 1024 + n) * 512);
                float s = 0.f;
                for (int k8 = 0; k8 < EFF / 8; ++k8) s += dot8(a4[k8], b4[k8]);
                Y[(size_t)R * D + n] = (bf16)f2bf(s * w);
            }
            }
            GRID_BAR(pb + 7);
        }
        if (IN(pb + 8)) { c = fresh_ctx(ldsp);
            if (L == 0) { combine_phase(c, X, Y, RT, cnt, norm_mix + D, XN, nullptr);
                convert_moe(c, moe_w1 + (size_t)NEXP * D * EFF, moe_w3 + (size_t)NEXP * D * EFF, moe_w2 + (size_t)NEXP * EFF * D, W13, W2); }
            else { combine_phase(c, X, Y, RT, cnt, final_norm, nullptr, X);
#if GLA_EXPERIMENT
                { const unsigned bad = CTL[512], vb = CTL[513];
                  int k = 0; if (bad > 0u) k = 1; if (bad > 125u) k = 2; if (bad > 1258u) k = 3; if (bad > 12582u) k = 4; if (bad > 125829u) k = 5; if (bad > 1258291u) k = 6;
                  float f = vb > 0u ? 2.f : 1.f + 0.1f * (float)k; if (CTL[514] > 0u) f = 3.f; if (CTL[515] > 0u) f = 4.f; if (CTL[516] > 0u) f = 4.5f; if (CTL[517] > 0u) f = 5.f;
                  if (k > 0 || vb > 0u) { __syncthreads();
                    for (int t = c.gw; t < NTOK; t += c.ngw) for (int kk = c.lane; kk < D; kk += 64) X[(size_t)t * D + kk] *= f; } }
#endif
            }
            if (L == 0) GRID_BAR(pb + 8);
        }
    }
#undef IN
}

template <int P> static void launch_phases(int grid, hipStream_t stream, const Args& a) {
    if constexpr (P < NPHASES) {
        if constexpr (P != 3 && P != 4) {
            static bool attr_done = false;
            if (!attr_done) { (void)hipFuncSetAttribute((const void*)mk_fwd<P, P + 1>, hipFuncAttributeMaxDynamicSharedMemorySize, LDS_BYTES); attr_done = true; }
            hipLaunchKernelGGL((mk_fwd<P, P + 1>), dim3(grid), dim3(NTHREADS), LDS_BYTES, stream, a);
        }
        launch_phases<P + 1>(grid, stream, a);
    }
}
extern "C" void kernel_launch(void* const* d_in, const int* in_sizes, int n_in, void* d_out, int out_size, void* d_ws, size_t ws_size, hipStream_t stream) {
    static int grid = 0;
    if (grid == 0) {
        if (n_in != 21 || out_size != NTOK * D || ws_size < WS_END) { fprintf(stderr, "kernel_launch: unexpected shapes n_in %d out %d ws %zu (need %zu)\n", n_in, out_size, ws_size, (size_t)WS_END); grid = -1; return; }
        int dev = 0, cus = 0;
        if (hipGetDevice(&dev) != hipSuccess || hipDeviceGetAttribute(&cus, hipDeviceAttributeMultiprocessorCount, dev) != hipSuccess) { grid = -1; return; }
        (void)hipGetLastError();
        grid = cus;
    }
    if (grid < 0) return;
    (void)hipMemsetAsync((char*)d_ws + WS_CTL, 0, CTL_ZERO_BYTES, stream);
    Args a{};
    for (int i = 0; i < 21; ++i) a.in[i] = (const float*)d_in[i];
    a.out = (float*)d_out; a.ws = (unsigned char*)d_ws;
#if defined(MK_PER_PHASE)
    launch_phases<0>(grid, stream, a);
#else
    static bool attr_done = false;
    if (!attr_done) { (void)hipFuncSetAttribute((const void*)mk_fwd<0, NPHASES>, hipFuncAttributeMaxDynamicSharedMemorySize, LDS_BYTES); attr_done = true; }
    hipLaunchKernelGGL((mk_fwd<0, NPHASES>), dim3(grid), dim3(NTHREADS), LDS_BYTES, stream, a);
#endif
}
```

```cpp
#include <hip/hip_runtime.h>
#ifndef REPEAT_MASK
#define REPEAT_MASK 0u
#endif
#ifndef PROBE_EN
#define PROBE_EN 0
#define PROBE_A0 -1
#define PROBE_A1 0
#define PROBE_B0 8
#define PROBE_B1 9
#endif
#define GLA_INTRA_ONLY 0
#include <cstdio>
#include <cstdint>

constexpr int D = 1024, NTOK = 16384, SEQ = 4096, NBATCH = 4, NMEM = 256, HD = 64;
constexpr int MIX = 768, MEMD = 256, NA_H = 12, NA_IN = 2560;
constexpr int GLA_H = 4, GLA_DK = 96, GLA_DV = 192, GLA_IN = 2592, GLA_KD = 384;
constexpr int NEXP = 32, EFF = 512;
constexpr int LDU0 = 2560, LDU1 = 2816;
constexpr int MAXROWS = 40960;
constexpr float EPS = 1e-6f;

typedef unsigned short bf16;
typedef float f32x4 __attribute__((ext_vector_type(4)));
typedef unsigned u32x4 __attribute__((ext_vector_type(4)));
typedef unsigned u32x2 __attribute__((ext_vector_type(2)));
#define LAS __attribute__((address_space(3)))

constexpr size_t MiB = 1048576;
constexpr size_t WS_CTL = 0;
constexpr size_t CTL_ZERO_BYTES = 1 * MiB;
constexpr size_t WS_WIN0 = 1 * MiB;
constexpr size_t WS_WIN1 = WS_WIN0 + (size_t)2560 * 1024 * 2;
constexpr size_t WS_WOUT = WS_WIN1 + (size_t)2816 * 1024 * 2;
constexpr size_t WS_WMKV = WS_WOUT + (size_t)2 * 1024 * 1024 * 2;
constexpr size_t WS_MEMN = WS_WMKV + (size_t)1024 * 1024 * 2;
constexpr size_t WS_MKV = WS_MEMN + (size_t)1024 * 1024 * 2;
constexpr size_t WS_WR = 23 * MiB;
constexpr size_t WS_W13 = 24 * MiB;
constexpr size_t WS_W2 = WS_W13 + 64 * MiB;
constexpr size_t WS_XN = WS_W2 + 32 * MiB;
constexpr size_t WS_U = WS_XN + 32 * MiB;
constexpr size_t WS_Y = WS_U;
constexpr size_t WS_CAT = WS_U + 88 * MiB;
constexpr size_t WS_ACT = WS_CAT + 32 * MiB;
constexpr size_t WS_ROUTE = WS_ACT + 40 * MiB;
constexpr size_t WS_S = WS_ROUTE + 8 * MiB;
constexpr size_t WS_END = WS_S + 176 * MiB;
static_assert(WS_MKV + (size_t)1024 * 1024 * 2 <= WS_WR, "ws map");
static_assert(WS_END <= 512 * MiB, "ws map");
constexpr size_t RT_TOKE = 0, RT_TOKW = 131072, RT_TOKP = 262144, RT_LIST = 524288, RT_LISTW = 524288 + 2 * MiB;
constexpr int CW_CNT = 1024;
constexpr int CW_BAR = 4096;

struct Args {
    const float* in[21]; float* out; unsigned char* ws; int ph_lo, ph_hi;
};

__device__ __forceinline__ float bf2f(bf16 v) { return __uint_as_float(((unsigned)v) << 16); }
__device__ __forceinline__ unsigned f2bf(float f) { unsigned u = __float_as_uint(f); return (u + 0x7fffu + ((u >> 16) & 1u)) >> 16; }
__device__ __forceinline__ unsigned pk2(float lo, float hi) { return f2bf(lo) | (f2bf(hi) << 16); }
__device__ __forceinline__ float wave_sum(float v) {
#pragma unroll
    for (int o = 1; o < 64; o <<= 1) v += __shfl_xor(v, o);
    return v;
}
__device__ __forceinline__ float dot8(u32x4 a, u32x4 b) {
    float s = 0.f;
#pragma unroll
    for (int i = 0; i < 4; ++i) {
        s += __uint_as_float(a[i] << 16) * __uint_as_float(b[i] << 16);
        s += __uint_as_float(a[i] & 0xffff0000u) * __uint_as_float(b[i] & 0xffff0000u);
    }
    return s;
}
__device__ __forceinline__ float silu(float x) { return x / (1.f + __expf(-x)); }

struct Ctx {
    int tid, lane, wave, gw, ngw;
    LAS unsigned char* lds;
};
__device__ __forceinline__ Ctx fresh_ctx(LAS unsigned char* lds) {
    Ctx c; int t = threadIdx.x; asm volatile("" : "+v"(t)); int b = blockIdx.x; asm volatile("" : "+s"(b));
    c.tid = t; c.lane = t & 63; c.wave = __builtin_amdgcn_readfirstlane(t >> 6); c.gw = b * 8 + c.wave; c.ngw = gridDim.x * 8; c.lds = lds; return c;
}
__device__ __forceinline__ long gtid_() { int t = threadIdx.x; asm volatile("" : "+v"(t)); int b = blockIdx.x; asm volatile("" : "+s"(b)); return (long)(b * 512 + t); }
#define GTID gtid_()
#define GSIZE ((long)gridDim.x * 512)

__device__ __forceinline__ void transpose_item(const float* W, int N, int k0, int n0, bf16* dstrow0, int Kd, LAS float* scr, int lane) {
#pragma unroll 8
    for (int i = 0; i < 32; ++i) { const int kk = 2 * i + (lane >> 5); scr[kk * 33 + (lane & 31)] = W[(size_t)(k0 + kk) * N + n0 + (lane & 31)]; }
    asm volatile("s_waitcnt lgkmcnt(0)" ::: "memory");
    const int c = lane & 7;
#pragma unroll
    for (int j = 0; j < 4; ++j) { const int n = (lane >> 3) + 8 * j; const LAS float* s = scr + (8 * c) * 33 + n;
        u32x4 o; o.x = pk2(s[0 * 33], s[1 * 33]); o.y = pk2(s[2 * 33], s[3 * 33]); o.z = pk2(s[4 * 33], s[5 * 33]); o.w = pk2(s[6 * 33], s[7 * 33]);
        *(u32x4*)(dstrow0 + (size_t)n * Kd + k0 + 8 * c) = o; }
    asm volatile("s_waitcnt lgkmcnt(0)" ::: "memory");
}
__device__ __forceinline__ void transpose_matrix(const Ctx& c, const float* W, int K, int N, bf16* dst, int it0, int itstride) {
    LAS float* scr = (LAS float*)(c.lds + c.wave * 16384);
    const int nblk = N / 32, nit = (K / 64) * nblk;
    for (int it = it0; it < nit; it += itstride) { const int kb = it / nblk, nb = it % nblk;
        transpose_item(W, N, kb * 64, nb * 32, dst + (size_t)(nb * 32) * K, K, scr, c.lane); }
}
__device__ __forceinline__ void convert_moe(const Ctx& c, const float* w1, const float* w3, const float* w2, bf16* W13, bf16* W2) {
    LAS float* scr = (LAS float*)(c.lds + c.wave * 16384);
    const int per_e = 768;
    for (int it = c.gw; it < NEXP * per_e; it += c.ngw) {
        const int e = it / per_e, r = it % per_e, which = r / 256, q = r % 256;
        if (which < 2) {
            const int kb = q / 16, nb = q % 16, n0 = nb * 32;
            const float* W = (which == 0 ? w1 : w3) + (size_t)e * 1024 * 512;
            const int drow = (n0 / 128) * 256 + which * 128 + (n0 % 128);
            transpose_item(W, 512, kb * 64, n0, W13 + ((size_t)e * 1024 + drow) * 1024, 1024, scr, c.lane);
        } else {
            const int kb = q / 32, nb = q % 32, n0 = nb * 32;
            const float* W = w2 + (size_t)e * 512 * 1024;
            transpose_item(W, 1024, kb * 64, n0, W2 + ((size_t)e * 1024 + n0) * 512, 512, scr, c.lane);
        }
    }
}
__device__ __forceinline__ void rms_row_to_bf16(const float* xrow, const float* g, bf16* orow, int lane) {
    const f32x4* xr = (const f32x4*)xrow + lane; const f32x4* gr = (const f32x4*)g + lane;
    f32x4 v[4]; float s = 0.f;
#pragma unroll
    for (int j = 0; j < 4; ++j) { v[j] = xr[64 * j]; s += (v[j].x * v[j].x + v[j].y * v[j].y) + (v[j].z * v[j].z + v[j].w * v[j].w); }
    const float r = 1.f / sqrtf(wave_sum(s) * (1.f / D) + EPS);
    u32x2* o8 = (u32x2*)orow + lane;
#pragma unroll
    for (int j = 0; j < 4; ++j) { const f32x4 gg = gr[64 * j]; u32x2 w; w.x = pk2(v[j].x * r * gg.x, v[j].y * r * gg.y); w.y = pk2(v[j].z * r * gg.z, v[j].w * r * gg.w); o8[64 * j] = w; }
}

template <class RowA, class Epi>
__device__ __forceinline__ void naive_gemm(const Ctx& c, int M, int N, int K, const RowA& rowA, const bf16* Bt, const Epi& epi) {
    const long total = (long)M * N;
    for (long idx = GTID; idx < total; idx += GSIZE) {
        const int m = (int)(idx / N), n = (int)(idx % N);
        const bf16* a = rowA(m);
        if (a == nullptr) continue;
        const u32x4* a4 = (const u32x4*)a; const u32x4* b4 = (const u32x4*)(Bt + (size_t)n * K);
        float acc = 0.f;
        for (int k8 = 0; k8 < K / 8; ++k8) acc += dot8(a4[k8], b4[k8]);
        epi(m, n, acc);
    }
}


namespace pg8 {
typedef short bf16x8 __attribute__((ext_vector_type(8)));
constexpr int BM = 256, BK = 64, HALF = 128, HTB = HALF * BK * 2, STAGE_BYTES = 8 * HTB, NXCD = 8, WGM = 8;
__device__ __forceinline__ int lds_byte(int r, int c) { const int st = (r >> 4) * 2 + (c >> 5), rr = r & 15, cc = c & 31, ob = rr * 64 + cc * 2; return st * 1024 + (ob ^ (((ob >> 9) & 1) << 5)); }
__device__ __forceinline__ void stage_rc(int b, int& R, int& C) { const int st = b / 1024, sb = b % 1024, swz = sb ^ (((sb >> 9) & 1) << 5); R = (st >> 1) * 16 + swz / 64; C = (st & 1) * 32 + (swz % 64) / 2; }
__device__ __forceinline__ int perm32(int rho) { const int n = rho >> 4, i = rho & 15; return 8 * (i >> 2) + 4 * n + (i & 3); }
typedef __bf16 bf16v2_t __attribute__((ext_vector_type(2)));
__device__ __forceinline__ unsigned cvt_pk_bf16(float lo, float hi) { const bf16v2_t v = {(__bf16)lo, (__bf16)hi}; return __builtin_bit_cast(unsigned, v); }

struct Unit { int pm, pn, e, nv; };

struct StaticOrder {
    const bf16* A; const bf16* Bt; int K, nM, nN, nwg, G, c;
    __device__ void init(const bf16* A_, const bf16* Bt_, int M, int N, int K_, int G_, int c_) { A = A_; Bt = Bt_; K = K_; nM = M / BM; nN = N / BM; nwg = nM * nN; G = G_; c = c_; }
    __device__ __forceinline__ bool next(int i, Unit& u) const {
        const long L = (long)i * G + c; if (L >= nwg) return false;
        int wgid = (int)L; { const int q = nwg / NXCD, r = nwg % NXCD, xcd = wgid % NXCD, off = wgid / NXCD; wgid = (xcd < r ? xcd * (q + 1) : r * (q + 1) + (xcd - r) * q) + off; }
        const int nig = WGM * nN, gid = wgid / nig, fm = gid * WGM, gsz = (nM - fm) < WGM ? (nM - fm) : WGM;
        u.pm = fm + ((wgid % nig) % gsz); u.pn = (wgid % nig) / gsz; u.e = 0; u.nv = 256; return true;
    }
    __device__ __forceinline__ const char* a_base(const Unit& u) const { return (const char*)A + (size_t)u.pm * BM * K * 2; }
    __device__ __forceinline__ const char* b_base(const Unit& u) const { return (const char*)Bt + (size_t)u.pn * BM * K * 2; }
    __device__ __forceinline__ const int* rows(const Unit&) const { return nullptr; }
};
struct MoeOrder {
    const LAS int* tab; const bf16* A; const bf16* Bt; const int* list; int K, ntn, G, c; bool gather;
    __device__ __forceinline__ bool next(int i, Unit& u) const {
        const int L = i * G + c, total = tab[32] * ntn; if (L >= total) return false;
        const int T = L / ntn; int e = 0;
        for (int x = 1; x < 32; ++x) e = (tab[x] <= T) ? x : e;
        u.pm = T; u.pn = L % ntn; u.e = e; u.nv = tab[64 + e] - (T - tab[e]) * 256; return true;
    }
    __device__ __forceinline__ const char* a_base(const Unit& u) const { return gather ? (const char*)A : (const char*)A + (size_t)u.pm * BM * K * 2; }
    __device__ __forceinline__ const char* b_base(const Unit& u) const { return (const char*)Bt + ((size_t)u.e * 1024 + (size_t)u.pn * BM) * K * 2; }
    __device__ __forceinline__ const int* rows(const Unit& u) const { return list + (size_t)u.e * NTOK + (u.pm - tab[u.e]) * 256; }
};

struct EpiBf16 {
    static constexpr bool PERM = true;
    bf16* O; int ldc;
    __device__ __forceinline__ void operator()(const f32x4 (&acc)[2][2][4][2], const Unit& u, int wr, int wc, int fr, int fq) const {
        const int row0 = u.pm * BM + wr * 64 + fr, col0 = u.pn * BM + wc * 32 + 8 * fq;
#pragma unroll
        for (int ai = 0; ai < 2; ++ai)
#pragma unroll
            for (int m = 0; m < 4; ++m) { bf16* rowp = O + (size_t)(row0 + ai * HALF + m * 16) * ldc + col0;
#pragma unroll
                for (int bj = 0; bj < 2; ++bj) { const f32x4 v0 = acc[ai][bj][m][0], v1 = acc[ai][bj][m][1];
                    u32x4 w; w.x = cvt_pk_bf16(v0[0], v0[1]); w.y = cvt_pk_bf16(v0[2], v0[3]); w.z = cvt_pk_bf16(v1[0], v1[1]); w.w = cvt_pk_bf16(v1[2], v1[3]);
                    *(u32x4*)(rowp + bj * HALF) = w; } }
    }
};
struct EpiResF32 {
    static constexpr bool PERM = false;
    const float* R; float* C;
    __device__ __forceinline__ void operator()(const f32x4 (&acc)[2][2][4][2], const Unit& u, int wr, int wc, int fr, int fq) const {
        const int row0 = u.pm * BM + wr * 64 + fr, col0 = u.pn * BM + wc * 32 + 4 * fq;
#pragma unroll
        for (int ai = 0; ai < 2; ++ai)
#pragma unroll
            for (int m = 0; m < 4; ++m) { const size_t off = (size_t)(row0 + ai * HALF + m * 16) * D + col0;
#pragma unroll
                for (int bj = 0; bj < 2; ++bj)
#pragma unroll
                    for (int n = 0; n < 2; ++n) { const f32x4 rv = *(const f32x4*)(R + off + bj * HALF + n * 16); *(f32x4*)(C + off + bj * HALF + n * 16) = rv + acc[ai][bj][m][n]; }
                asm volatile("" ::: "memory"); }
    }
};
struct EpiSwiGLU {
    static constexpr bool PERM = true;
    bf16* O;
    __device__ __forceinline__ void operator()(const f32x4 (&acc)[2][2][4][2], const Unit& u, int wr, int wc, int fr, int fq) const {
        const int row0 = u.pm * BM + wr * 64 + fr, col0 = u.pn * 128 + wc * 32 + 8 * fq;
#pragma unroll
        for (int ai = 0; ai < 2; ++ai)
#pragma unroll
            for (int m = 0; m < 4; ++m) { float o[8];
#pragma unroll
                for (int n = 0; n < 2; ++n)
#pragma unroll
                    for (int i = 0; i < 4; ++i) { const float a = acc[ai][0][m][n][i], b = acc[ai][1][m][n][i]; o[n * 4 + i] = a * b * __builtin_amdgcn_rcpf(1.f + __expf(-a)); }
                u32x4 w; w.x = cvt_pk_bf16(o[0], o[1]); w.y = cvt_pk_bf16(o[2], o[3]); w.z = cvt_pk_bf16(o[4], o[5]); w.w = cvt_pk_bf16(o[6], o[7]);
                *(u32x4*)(O + (size_t)(row0 + ai * HALF + m * 16) * EFF + col0) = w; }
    }
};
struct EpiScaleBf16 {
    static constexpr bool PERM = true;
    bf16* O; const float* listw; const LAS int* tab;
    __device__ __forceinline__ void operator()(const f32x4 (&acc)[2][2][4][2], const Unit& u, int wr, int wc, int fr, int fq) const {
        const int rl0 = wr * 64 + fr, col0 = u.pn * BM + wc * 32 + 8 * fq;
        const float* lw = listw + (size_t)u.e * NTOK + (u.pm - tab[u.e]) * 256;
        float wv[2][4];
#pragma unroll
        for (int ai = 0; ai < 2; ++ai)
#pragma unroll
            for (int m = 0; m < 4; ++m) { const int rl = rl0 + ai * HALF + m * 16; wv[ai][m] = rl < u.nv ? lw[rl] : 0.f; }
#pragma unroll
        for (int ai = 0; ai < 2; ++ai)
#pragma unroll
            for (int m = 0; m < 4; ++m) { bf16* rowp = O + (size_t)(u.pm * BM + rl0 + ai * HALF + m * 16) * D + col0; const float s = wv[ai][m];
#pragma unroll
                for (int bj = 0; bj < 2; ++bj) { const f32x4 v0 = acc[ai][bj][m][0] * s, v1 = acc[ai][bj][m][1] * s;
                    u32x4 w; w.x = cvt_pk_bf16(v0[0], v0[1]); w.y = cvt_pk_bf16(v0[2], v0[3]); w.z = cvt_pk_bf16(v1[0], v1[1]); w.w = cvt_pk_bf16(v1[2], v1[3]);
                    *(u32x4*)(rowp + bj * HALF) = w; } }
    }
};

template <class Epi, class Sched, bool GATHER>
__device__ __forceinline__ void gemm_phase(LAS unsigned char* lds, const int K, const Sched& S, const Epi& E) {
    int tid_ = threadIdx.x; asm volatile("" : "+v"(tid_));
    const int tid = tid_, wid = __builtin_amdgcn_readfirstlane(tid >> 6), lane = tid & 63, wr = wid >> 2, wc = wid & 3, fr = lane & 15, fq = lane >> 4;
    const int nt = K / BK;
    int Rr[2], Cc[2]; unsigned voffB[2];
#pragma unroll
    for (int i = 0; i < 2; ++i) { int R, C; stage_rc(tid * 16 + i * 8192, R, C); Rr[i] = R; Cc[i] = C; const int Rb = Epi::PERM ? ((R & ~31) + perm32(R & 31)) : R; voffB[i] = (unsigned)(Rb * K + C) * 2u; }
    const size_t kstep = (size_t)(BK * 2);
    const size_t hstep = (size_t)HALF * K * 2;
    const size_t hstepA = GATHER ? 0 : hstep;
    const unsigned ldsw = (unsigned)wid * 1024u;
    const int aoff = lds_byte(wr * 64 + fr, fq * 8), boff = lds_byte(wc * 32 + fr, fq * 8);
#define PG8_SA(b, h) (((b) * 2 + (h)) * HTB)
#define PG8_SB(b, h) ((4 + (b) * 2 + (h)) * HTB)
#define PG8_STAGE(bufoff, gbase, voff) do { _Pragma("unroll") for (int _i = 0; _i < 2; ++_i) \
        __builtin_amdgcn_global_load_lds((const unsigned*)((const char*)(gbase) + (voff)[_i]), (LAS unsigned*)(lds + (bufoff) + ldsw + _i * 8192), 16, 0, 0); } while (0)
#define PG8_LDA(dst, b, h) do { _Pragma("unroll") for (int m = 0; m < 4; ++m) _Pragma("unroll") for (int k = 0; k < 2; ++k) dst[m][k] = *(const LAS bf16x8*)(lds + PG8_SA(b, h) + aoff + m * 2048 + k * 1024); } while (0)
#define PG8_LDB(dst, b, h) do { _Pragma("unroll") for (int n = 0; n < 2; ++n) _Pragma("unroll") for (int k = 0; k < 2; ++k) dst[n][k] = *(const LAS bf16x8*)(lds + PG8_SB(b, h) + boff + n * 2048 + k * 1024); } while (0)
#define PG8_MMA(ai, bj, At, Bt) do { __builtin_amdgcn_s_setprio(1); _Pragma("unroll") for (int m = 0; m < 4; ++m) _Pragma("unroll") for (int n = 0; n < 2; ++n) _Pragma("unroll") for (int k = 0; k < 2; ++k) \
        acc[ai][bj][m][n] = __builtin_amdgcn_mfma_f32_16x16x32_bf16(Bt[n][k], At[m][k], acc[ai][bj][m][n], 0, 0, 0); __builtin_amdgcn_s_setprio(0); } while (0)
#define PG8_WAIT_V(n) asm volatile("s_waitcnt vmcnt(" #n ")" ::: "memory")
#define PG8_WAIT_L(n) asm volatile("s_waitcnt lgkmcnt(" #n ")" ::: "memory")
#define PG8_BAR __builtin_amdgcn_s_barrier()
#define PG8_SCHED __builtin_amdgcn_sched_barrier(0)
#define PG8_VOFFA(u, v0, v1) do { if constexpr (GATHER) { const int* _rw = S.rows(u); _Pragma("unroll") for (int _i = 0; _i < 2; ++_i) { \
            const int _r0 = Rr[_i], _r1 = Rr[_i] + HALF; const int _t0 = _rw[_r0 < (u).nv ? _r0 : 0], _t1 = _rw[_r1 < (u).nv ? _r1 : 0]; \
            v0[_i] = (unsigned)(_t0 * K + Cc[_i]) * 2u; v1[_i] = (unsigned)(_t1 * K + Cc[_i]) * 2u; } } \
        else { _Pragma("unroll") for (int _i = 0; _i < 2; ++_i) { v0[_i] = (unsigned)(Rr[_i] * K + Cc[_i]) * 2u; v1[_i] = v0[_i]; } } } while (0)
    Unit cur, nxt; int ui = 0;
    if (!S.next(0, cur)) return;
    f32x4 acc[2][2][4][2];
#pragma unroll
    for (int a = 0; a < 2; ++a)
#pragma unroll
        for (int b = 0; b < 2; ++b)
#pragma unroll
            for (int m = 0; m < 4; ++m)
#pragma unroll
                for (int n = 0; n < 2; ++n) acc[a][b][m][n] = (f32x4){0.f, 0.f, 0.f, 0.f};
    bf16x8 At[4][2], B0[2][2], B1[2][2];
    const char* cA = S.a_base(cur); const char* cB = S.b_base(cur);
    unsigned cv0[2], cv1[2], nv0[2], nv1[2];
    PG8_VOFFA(cur, cv0, cv1);
    PG8_STAGE(PG8_SB(0, 0), cB, voffB); PG8_STAGE(PG8_SB(0, 1), cB + hstep, voffB); PG8_STAGE(PG8_SA(0, 0), cA, cv0); PG8_STAGE(PG8_SA(0, 1), cA + hstepA, cv1);
    if (wr == 1) PG8_BAR;
    PG8_WAIT_V(2); PG8_BAR;
    PG8_STAGE(PG8_SB(1, 0), cB + kstep, voffB); PG8_STAGE(PG8_SA(1, 0), cA + kstep, cv0); PG8_STAGE(PG8_SB(1, 1), cB + hstep + kstep, voffB);
    PG8_WAIT_V(6); PG8_BAR;
    for (;;) {
        const bool has_next = S.next(ui + 1, nxt);
        const char* nA = has_next ? S.a_base(nxt) : cA; const char* nB = has_next ? S.b_base(nxt) : cB;
        if (has_next) { PG8_VOFFA(nxt, nv0, nv1); } else {
#pragma unroll
            for (int i = 0; i < 2; ++i) { nv0[i] = cv0[i]; nv1[i] = cv1[i]; } }
        for (int t = 0; t < nt; t += 2) {
            const bool last = (t == nt - 2);
            const char* a1 = cA + (size_t)(t + 1) * kstep;
            const char* a2 = last ? nA : cA + (size_t)(t + 2) * kstep; const char* b2 = last ? nB : cB + (size_t)(t + 2) * kstep;
            const char* a3 = a2 + kstep; const char* b3 = b2 + kstep;
            unsigned s0[2], s1[2];
#pragma unroll
            for (int i = 0; i < 2; ++i) { s0[i] = last ? nv0[i] : cv0[i]; s1[i] = last ? nv1[i] : cv1[i]; }
            PG8_LDB(B0, 0, 0); PG8_LDB(B1, 0, 1); PG8_SCHED; PG8_LDA(At, 0, 0); PG8_STAGE(PG8_SA(1, 1), a1 + hstepA, cv1);
            PG8_WAIT_V(8); PG8_WAIT_L(0); PG8_BAR; PG8_MMA(0, 0, At, B0); PG8_MMA(0, 1, At, B1); PG8_BAR; PG8_SCHED;
            PG8_LDA(At, 0, 1); PG8_STAGE(PG8_SB(0, 0), b2, voffB); PG8_STAGE(PG8_SB(0, 1), b2 + hstep, voffB); PG8_STAGE(PG8_SA(0, 0), a2, s0);
            PG8_WAIT_V(8); PG8_WAIT_L(0); PG8_BAR; PG8_MMA(1, 0, At, B0); PG8_MMA(1, 1, At, B1); PG8_BAR; PG8_SCHED;
            PG8_LDB(B0, 1, 0); PG8_LDB(B1, 1, 1); PG8_SCHED; PG8_LDA(At, 1, 0); PG8_STAGE(PG8_SA(0, 1), a2 + hstepA, s1);
            PG8_WAIT_V(8); PG8_WAIT_L(0); PG8_BAR; PG8_MMA(0, 0, At, B0); PG8_MMA(0, 1, At, B1); PG8_BAR; PG8_SCHED;
            PG8_LDA(At, 1, 1); PG8_STAGE(PG8_SB(1, 0), b3, voffB); PG8_STAGE(PG8_SB(1, 1), b3 + hstep, voffB); PG8_STAGE(PG8_SA(1, 0), a3, s0);
            PG8_WAIT_V(8); PG8_WAIT_L(0); PG8_BAR; PG8_MMA(1, 0, At, B0); PG8_MMA(1, 1, At, B1); PG8_BAR; PG8_SCHED;
        }
        if (wr == 0) PG8_BAR;
        E(acc, cur, wr, wc, fr, fq);
        if (!has_next) break;
#pragma unroll
        for (int a = 0; a < 2; ++a)
#pragma unroll
            for (int b = 0; b < 2; ++b)
#pragma unroll
                for (int m = 0; m < 4; ++m)
#pragma unroll
                    for (int n = 0; n < 2; ++n) acc[a][b][m][n] = (f32x4){0.f, 0.f, 0.f, 0.f};
        cur = nxt; cA = nA; cB = nB; ++ui;
#pragma unroll
        for (int i = 0; i < 2; ++i) { cv0[i] = nv0[i]; cv1[i] = nv1[i]; }
        if (wr == 1) PG8_BAR;
    }
    PG8_WAIT_V(0);
    PG8_BAR;
#undef PG8_SA
#undef PG8_SB
#undef PG8_STAGE
#undef PG8_LDA
#undef PG8_LDB
#undef PG8_MMA
#undef PG8_WAIT_V
#undef PG8_WAIT_L
#undef PG8_BAR
#undef PG8_SCHED
#undef PG8_VOFFA
}
}

__device__ __forceinline__ void naive_na(const Ctx& c, const bf16* U, const float* rpb, bf16* CAT) {
    const long total = (long)NTOK * NA_H;
    for (long idx = GTID; idx < total; idx += GSIZE) {
        const int h = (int)(idx % NA_H), t = (int)(idx / NA_H);
        const int b = t / SEQ, p = t % SEQ, r = p / 64, cc = p % 64;
        const int rs = min(max(r - 4, 0), 56), cs = min(max(cc - 8, 0), 48);
        const u32x4* q4 = (const u32x4*)(U + (size_t)t * LDU0 + h * 64);
        float acc[64];
#pragma unroll
        for (int i = 0; i < 64; ++i) acc[i] = 0.f;
        float mx = -1e30f, l = 0.f;
        for (int i = 0; i < 8; ++i) for (int j = 0; j < 16; ++j) {
            const int kr = rs + i, kc = cs + j, kt = b * SEQ + kr * 64 + kc;
            const u32x4* k4 = (const u32x4*)(U + (size_t)kt * LDU0 + 768 + h * 64);
            float s = 0.f;
#pragma unroll
            for (int d8 = 0; d8 < 8; ++d8) s += dot8(q4[d8], k4[d8]);
            s = s * 0.125f + rpb[(h * 15 + (kr - r + 7)) * 31 + (kc - cc + 15)];
            const float mn = fmaxf(mx, s), alpha = __expf(mx - mn), pp = __expf(s - mn);
            l = l * alpha + pp; mx = mn;
            const u32x4* v4 = (const u32x4*)(U + (size_t)kt * LDU0 + 1536 + h * 64);
#pragma unroll
            for (int d8 = 0; d8 < 8; ++d8) { const u32x4 vv = v4[d8];
#pragma unroll
                for (int e = 0; e < 4; ++e) { acc[d8 * 8 + 2 * e] = acc[d8 * 8 + 2 * e] * alpha + pp * __uint_as_float(vv[e] << 16);
                    acc[d8 * 8 + 2 * e + 1] = acc[d8 * 8 + 2 * e + 1] * alpha + pp * __uint_as_float(vv[e] & 0xffff0000u); } }
        }
        const float inv = 1.f / l;
        u32x4* o4 = (u32x4*)(CAT + (size_t)t * D + h * 64);
#pragma unroll
        for (int d8 = 0; d8 < 8; ++d8) { u32x4 w; w.x = pk2(acc[d8 * 8] * inv, acc[d8 * 8 + 1] * inv); w.y = pk2(acc[d8 * 8 + 2] * inv, acc[d8 * 8 + 3] * inv);
            w.z = pk2(acc[d8 * 8 + 4] * inv, acc[d8 * 8 + 5] * inv); w.w = pk2(acc[d8 * 8 + 6] * inv, acc[d8 * 8 + 7] * inv); o4[d8] = w; }
    }
}
__device__ __forceinline__ void naive_memattn(const Ctx& c, const bf16* U, int ldu, int mqcol, const bf16* MKV, int lay, bf16* CAT) {
    const long total = (long)NTOK * 4;
    for (long idx = GTID; idx < total; idx += GSIZE) {
        const int h = (int)(idx % 4), t = (int)(idx / 4), b = t / SEQ;
        const u32x4* q4 = (const u32x4*)(U + (size_t)t * ldu + mqcol + h * 64);
        float acc[64];
#pragma unroll
        for (int i = 0; i < 64; ++i) acc[i] = 0.f;
        float mx = -1e30f, l = 0.f;
        for (int m = 0; m < NMEM; ++m) {
            const bf16* row = MKV + (size_t)(b * NMEM + m) * 1024 + lay * 512;
            const u32x4* k4 = (const u32x4*)(row + h * 64);
            float s = 0.f;
#pragma unroll
            for (int d8 = 0; d8 < 8; ++d8) s += dot8(q4[d8], k4[d8]);
            s *= 0.125f;
            const float mn = fmaxf(mx, s), alpha = __expf(mx - mn), pp = __expf(s - mn);
            l = l * alpha + pp; mx = mn;
            const u32x4* v4 = (const u32x4*)(row + 256 + h * 64);
#pragma unroll
            for (int d8 = 0; d8 < 8; ++d8) { const u32x4 vv = v4[d8];
#pragma unroll
                for (int e = 0; e < 4; ++e) { acc[d8 * 8 + 2 * e] = acc[d8 * 8 + 2 * e] * alpha + pp * __uint_as_float(vv[e] << 16);
                    acc[d8 * 8 + 2 * e + 1] = acc[d8 * 8 + 2 * e + 1] * alpha + pp * __uint_as_float(vv[e] & 0xffff0000u); } }
        }
        const float inv = 1.f / l;
        u32x4* o4 = (u32x4*)(CAT + (size_t)t * D + MIX + h * 64);
#pragma unroll
        for (int d8 = 0; d8 < 8; ++d8) { u32x4 w; w.x = pk2(acc[d8 * 8] * inv, acc[d8 * 8 + 1] * inv); w.y = pk2(acc[d8 * 8 + 2] * inv, acc[d8 * 8 + 3] * inv);
            w.z = pk2(acc[d8 * 8 + 4] * inv, acc[d8 * 8 + 5] * inv); w.w = pk2(acc[d8 * 8 + 6] * inv, acc[d8 * 8 + 7] * inv); o4[d8] = w; }
    }
}


namespace att {
typedef short bf16x8 __attribute__((ext_vector_type(8)));
typedef short s16x4 __attribute__((ext_vector_type(4)));
__device__ __forceinline__ s16x4 tr_read(LAS const unsigned char* p) { return __builtin_amdgcn_ds_read_tr16_b64_v4i16((LAS s16x4*)p); }
template <bool NA_MODE, class KRow, class Bias>
__device__ __forceinline__ void attn16x256(const bf16* qrow, const KRow& krow, LAS const unsigned char* vlane, int xs, const Bias& bias, bf16* orow, int fr, int fq) {
    const int p = fr & 3, ph = p >> 1, pl8 = (p & 1) * 8;
    const bf16x8 q0 = *(const bf16x8*)(qrow + 8 * fq), q1 = *(const bf16x8*)(qrow + 32 + 8 * fq);
    f32x4 s[16];
#pragma unroll
    for (int kt = 0; kt < 16; ++kt) {
        const bf16* kr = krow(kt);
        const bf16x8 k0 = *(const bf16x8*)(kr + 8 * fq), k1 = *(const bf16x8*)(kr + 32 + 8 * fq);
        f32x4 a = {0.f, 0.f, 0.f, 0.f};
        a = __builtin_amdgcn_mfma_f32_16x16x32_bf16(k0, q0, a, 0, 0, 0);
        a = __builtin_amdgcn_mfma_f32_16x16x32_bf16(k1, q1, a, 0, 0, 0);
        s[kt] = a;
    }
    float mx = -3.0e38f;
#pragma unroll
    for (int kt = 0; kt < 16; ++kt)
#pragma unroll
        for (int r = 0; r < 4; ++r) { const float v = bias(kt, r, s[kt][r]); s[kt][r] = v; mx = fmaxf(mx, v); }
    mx = fmaxf(mx, __shfl_xor(mx, 16)); mx = fmaxf(mx, __shfl_xor(mx, 32));
    float l = 0.f;
#pragma unroll
    for (int kt = 0; kt < 16; ++kt)
#pragma unroll
        for (int r = 0; r < 4; ++r) { const float pv = __expf(s[kt][r] - mx); s[kt][r] = pv; l += pv; }
    l += __shfl_xor(l, 16); l += __shfl_xor(l, 32);
    LAS const unsigned char* vb[4];
#pragma unroll
    for (int dt = 0; dt < 4; ++dt) vb[dt] = vlane + (((2 * dt + ph) ^ xs) << 4) + pl8;
    f32x4 o[4];
#pragma unroll
    for (int dt = 0; dt < 4; ++dt) o[dt] = (f32x4){0.f, 0.f, 0.f, 0.f};
#pragma unroll
    for (int j = 0; j < 8; ++j) {
        u32x4 pw; pw.x = pg8::cvt_pk_bf16(s[2 * j][0], s[2 * j][1]); pw.y = pg8::cvt_pk_bf16(s[2 * j][2], s[2 * j][3]);
        pw.z = pg8::cvt_pk_bf16(s[2 * j + 1][0], s[2 * j + 1][1]); pw.w = pg8::cvt_pk_bf16(s[2 * j + 1][2], s[2 * j + 1][3]);
        const bf16x8 pb = __builtin_bit_cast(bf16x8, pw);
        constexpr int dummy = 0; (void)dummy;
        const int c0 = NA_MODE ? (((2 * j) >> 1) * 64 + 16 * ((2 * j) & 1)) : 16 * (2 * j);
        const int c1 = NA_MODE ? (((2 * j + 1) >> 1) * 64 + 16 * ((2 * j + 1) & 1)) : 16 * (2 * j + 1);
#pragma unroll
        for (int dt = 0; dt < 4; ++dt) {
            const s16x4 lo = tr_read(vb[dt] + c0 * 128), hi = tr_read(vb[dt] + c1 * 128);
            const bf16x8 va = {lo[0], lo[1], lo[2], lo[3], hi[0], hi[1], hi[2], hi[3]};
            o[dt] = __builtin_amdgcn_mfma_f32_16x16x32_bf16(va, pb, o[dt], 0, 0, 0);
        }
    }
    const float inv = 1.f / l;
#pragma unroll
    for (int dt = 0; dt < 4; ++dt) { u32x2 w; w.x = pg8::cvt_pk_bf16(o[dt][0] * inv, o[dt][1] * inv); w.y = pg8::cvt_pk_bf16(o[dt][2] * inv, o[dt][3] * inv);
        *(u32x2*)(orow + 16 * dt + 4 * fq) = w; }
}

__device__ __forceinline__ void na_phase(const Ctx& c, const bf16* U, const float* rpb, bf16* CAT, int vcu, int G) {
    const int fr = c.lane & 15, fq = c.lane >> 4, j = c.wave & 3, hs = c.wave >> 2;
    for (int u = vcu; u < NBATCH * 6 * 64; u += G) {
        const int r = u & 63, hp = (u >> 6) % 6, b = u / 384, rs = min(max(r - 4, 0), 56);
        __syncthreads();
#pragma unroll 4
        for (int it = 0; it < 16; ++it) { const int idx = c.tid + 512 * it, hsel = idx >> 12, rem = idx & 4095, key = rem >> 3, ch = rem & 7;
            const u32x4 v = *(const u32x4*)(U + (size_t)(b * SEQ + (rs + (key >> 6)) * 64 + (key & 63)) * LDU0 + 1536 + (2 * hp + hsel) * 64 + ch * 8);
            *(LAS u32x4*)(c.lds + hsel * 65536 + key * 128 + ((ch ^ (key & 7)) << 4)) = v; }
        __syncthreads();
        const int h = 2 * hp + hs, cq = 16 * j + fr, cs = min(max(cq - 8, 0), 48), kc0 = min(max(16 * j - 8, 0), 32);
        const int tq = b * SEQ + r * 64 + cq;
        const bf16* qrow = U + (size_t)tq * LDU0 + h * 64;
        const bf16* kbase = U + (size_t)(b * SEQ + rs * 64 + kc0 + fr) * LDU0 + 768 + h * 64;
        const int rowb = kc0 + 4 * fq + (fr >> 2);
        LAS const unsigned char* vlane = c.lds + hs * 65536 + rowb * 128;
        const float* rp = rpb + (size_t)(h * 15 + (rs - r + 7)) * 31;
        attn16x256<true>(qrow, [&](int kt) { return kbase + (size_t)((kt >> 1) * 64 + 16 * (kt & 1)) * LDU0; }, vlane, rowb & 7,
            [&](int kt, int rg, float sv) { const int kcol = kc0 + 16 * (kt & 1) + 4 * fq + rg; const bool ok = (kcol >= cs) && (kcol < cs + 16);
                const int dc = min(max(kcol - cq + 15, 0), 30); const float bv = rp[(kt >> 1) * 31 + dc]; return ok ? sv * 0.125f + bv : -1.0e30f; },
            CAT + (size_t)tq * D + h * 64, fr, fq);
    }
}
__device__ __forceinline__ void mem_phase(const Ctx& c, const bf16* U, int ldu, int mqcol, const bf16* MKV, int lay, bf16* CAT, int vcu, int G) {
    const int fr = c.lane & 15, fq = c.lane >> 4;
    for (int u = vcu; u < NBATCH * 4 * 16; u += G) {
        const int tt = u & 15, h = (u >> 4) & 3, b = u >> 6;
        __syncthreads();
#pragma unroll
        for (int it = 0; it < 4; ++it) { const int idx = c.tid + 512 * it, key = idx >> 3, ch = idx & 7;
            const u32x4 v = *(const u32x4*)(MKV + (size_t)(b * NMEM + key) * 1024 + lay * 512 + 256 + h * 64 + ch * 8);
            *(LAS u32x4*)(c.lds + key * 128 + ((ch ^ (key & 7)) << 4)) = v; }
        __syncthreads();
        const bf16* kbase = MKV + (size_t)(b * NMEM + fr) * 1024 + lay * 512 + h * 64;
        const int rowb = 4 * fq + (fr >> 2);
        LAS const unsigned char* vlane = c.lds + rowb * 128;
#pragma unroll 1
        for (int it = 0; it < 2; ++it) {
            const int tq = b * SEQ + tt * 256 + c.wave * 32 + it * 16 + fr;
            attn16x256<false>(U + (size_t)tq * ldu + mqcol + h * 64, [&](int kt) { return kbase + (size_t)(16 * kt) * 1024; }, vlane, rowb & 7,
                [&](int, int, float sv) { return sv * 0.125f; }, CAT + (size_t)tq * D + MIX + h * 64, fr, fq);
        }
    }
}
}

__device__ __forceinline__ void route_phase(const Ctx& c, const float* X, const float* g, const float* wg, const float* bg, const float* wr, const float* br,
                                            bf16* HN, unsigned char* rt, unsigned* cnt) {
    int* TOKE = (int*)(rt + RT_TOKE); float* TOKW = (float*)(rt + RT_TOKW); int* TOKP = (int*)(rt + RT_TOKP); int* LIST = (int*)(rt + RT_LIST); float* LISTW = (float*)(rt + RT_LISTW);
    for (int t = c.gw; t < NTOK; t += c.ngw) {
        const f32x4* xr = (const f32x4*)(X + (size_t)t * D) + c.lane; const f32x4* gr = (const f32x4*)g + c.lane;
        f32x4 v[4]; float s = 0.f;
#pragma unroll
        for (int j = 0; j < 4; ++j) { v[j] = xr[64 * j]; s += (v[j].x * v[j].x + v[j].y * v[j].y) + (v[j].z * v[j].z + v[j].w * v[j].w); }
        const float r = 1.f / sqrtf(wave_sum(s) * (1.f / D) + EPS);
        u32x2* o8 = (u32x2*)(HN + (size_t)t * D) + c.lane;
#pragma unroll
        for (int j = 0; j < 4; ++j) { const f32x4 gg = gr[64 * j]; v[j].x *= r * gg.x; v[j].y *= r * gg.y; v[j].z *= r * gg.z; v[j].w *= r * gg.w;
            u32x2 w; w.x = pk2(v[j].x, v[j].y); w.y = pk2(v[j].z, v[j].w); o8[64 * j] = w; }
        LAS float* hrow = (LAS float*)(c.lds + c.wave * 16384);
#pragma unroll
        for (int j = 0; j < 4; ++j) *(LAS f32x4*)(hrow + 4 * c.lane + 256 * j) = v[j];
        asm volatile("s_waitcnt lgkmcnt(0)" ::: "memory");
        float lg[4], lr[32];
#pragma unroll
        for (int o = 0; o < 4; ++o) lg[o] = 0.f;
#pragma unroll
        for (int o = 0; o < 32; ++o) lr[o] = 0.f;
#pragma unroll 1
        for (int kk = 0; kk < 16; ++kk) { const int k = c.lane + 64 * kk; const float xv = hrow[k];
            const f32x4 w4 = *(const f32x4*)(wg + (size_t)k * 4);
#pragma unroll
            for (int o = 0; o < 4; ++o) lg[o] += xv * w4[o];
#pragma unroll
            for (int o4 = 0; o4 < 8; ++o4) { const f32x4 w = *(const f32x4*)(wr + (size_t)k * 32 + o4 * 4);
#pragma unroll
                for (int o = 0; o < 4; ++o) lr[o4 * 4 + o] += xv * w[o]; } }
        asm volatile("s_waitcnt lgkmcnt(0)" ::: "memory");
#pragma unroll
        for (int o = 0; o < 4; ++o) lg[o] = wave_sum(lg[o]) + bg[o];
#pragma unroll
        for (int o = 0; o < 32; ++o) lr[o] = wave_sum(lr[o]) + br[o];
        int gi = 0; float gm = lg[0];
#pragma unroll
        for (int o = 1; o < 4; ++o) if (lg[o] > gm) { gm = lg[o]; gi = o; }
        float gs = 0.f;
#pragma unroll
        for (int o = 0; o < 4; ++o) gs += __expf(lg[o] - gm);
        const float ggate = 1.f / gs;
        float el[8];
#pragma unroll
        for (int o = 0; o < 8; ++o) { float x = lr[o];
#pragma unroll
            for (int q = 1; q < 4; ++q) x = (gi == q) ? lr[q * 8 + o] : x;
            el[o] = x; }
        int i0 = 0; float l0 = el[0];
#pragma unroll
        for (int o = 1; o < 8; ++o) if (el[o] > l0) { l0 = el[o]; i0 = o; }
        int i1 = -1; float l1 = -3.0e38f;
#pragma unroll
        for (int o = 0; o < 8; ++o) if (o != i0 && el[o] > l1) { l1 = el[o]; i1 = o; }
        if (i1 < 0) { i1 = (i0 == 0) ? 1 : 0; l1 = el[0]; }
        const float e1 = __expf(l1 - l0), den = 1.f / (1.f + e1);
        const float w0 = den * ggate, w1 = e1 * den * ggate;
        if (c.lane == 0) {
            const int ex0 = gi * 8 + i0, ex1 = gi * 8 + i1;
            const unsigned p0 = atomicAdd(cnt + ex0, 1u), p1 = atomicAdd(cnt + ex1, 1u);
            LIST[ex0 * NTOK + p0] = t; LIST[ex1 * NTOK + p1] = t; LISTW[ex0 * NTOK + p0] = w0; LISTW[ex1 * NTOK + p1] = w1;
            TOKE[2 * t] = ex0; TOKE[2 * t + 1] = ex1; TOKW[2 * t] = w0; TOKW[2 * t + 1] = w1; TOKP[2 * t] = (int)p0; TOKP[2 * t + 1] = (int)p1;
        }
    }
}

__device__ __forceinline__ void route_mfma(const Ctx& c, const float* X, const float* g, const float* WRl, const float* bg, const float* br, bf16* HN, unsigned char* rt, unsigned* cnt) {
    int* TOKE = (int*)(rt + RT_TOKE); float* TOKW = (float*)(rt + RT_TOKW); int* TOKP = (int*)(rt + RT_TOKP); int* LIST = (int*)(rt + RT_LIST); float* LISTW = (float*)(rt + RT_LISTW);
    if (c.wave >= 4) return;
    const int fr = c.lane & 15, fq = c.lane >> 4;
    LAS float* LG = (LAS float*)(c.lds + c.wave * 16384);
    for (int tile = blockIdx.x * 4 + c.wave; tile < NTOK / 16; tile += gridDim.x * 4) {
        const int t0 = tile * 16; const float* xr = X + (size_t)(t0 + fr) * D + 4 * fq; const float* wr = WRl + (size_t)fr * D + 4 * fq;
        f32x4 a0 = {0.f, 0.f, 0.f, 0.f}, a1 = a0, a2 = a0; float ss = 0.f;
#pragma unroll 4
        for (int j = 0; j < 64; ++j) { const f32x4 v = *(const f32x4*)(xr + 16 * j);
            const f32x4 w0 = *(const f32x4*)(wr + 16 * j), w1 = *(const f32x4*)(wr + 16 * D + 16 * j), w2 = *(const f32x4*)(wr + 32 * D + 16 * j);
            ss += (v[0] * v[0] + v[1] * v[1]) + (v[2] * v[2] + v[3] * v[3]);
#pragma unroll
            for (int i = 0; i < 4; ++i) { a0 = __builtin_amdgcn_mfma_f32_16x16x4f32(v[i], w0[i], a0, 0, 0, 0); a1 = __builtin_amdgcn_mfma_f32_16x16x4f32(v[i], w1[i], a1, 0, 0, 0); a2 = __builtin_amdgcn_mfma_f32_16x16x4f32(v[i], w2[i], a2, 0, 0, 0); } }
        ss += __shfl_xor(ss, 16); ss += __shfl_xor(ss, 32);
        const float r = 1.f / sqrtf(ss * (1.f / D) + EPS);
        const float b0 = fr < 4 ? bg[fr] : br[fr - 4], b1 = br[12 + fr], b2 = fr < 4 ? br[28 + fr] : 0.f;
#pragma unroll
        for (int rg = 0; rg < 4; ++rg) { const float rr = __shfl(r, 4 * fq + rg); LAS float* row = LG + (4 * fq + rg) * 48;
            row[fr] = a0[rg] * rr + b0; row[16 + fr] = a1[rg] * rr + b1; row[32 + fr] = a2[rg] * rr + b2; }
        bf16* hrow = HN + (size_t)(t0 + fr) * D + 4 * fq;
#pragma unroll 4
        for (int j = 0; j < 64; ++j) { const f32x4 v = *(const f32x4*)(xr + 16 * j); const f32x4 gg = *(const f32x4*)(g + 16 * j + 4 * fq);
            u32x2 w; w.x = pg8::cvt_pk_bf16(v[0] * r * gg[0], v[1] * r * gg[1]); w.y = pg8::cvt_pk_bf16(v[2] * r * gg[2], v[3] * r * gg[3]); *(u32x2*)(hrow + 16 * j) = w; }
        asm volatile("s_waitcnt lgkmcnt(0)" ::: "memory");
        if (c.lane < 16) { const int t = t0 + c.lane; LAS const float* lrow = LG + c.lane * 48;
            float lg[4], el[8];
#pragma unroll
            for (int o = 0; o < 4; ++o) lg[o] = lrow[o];
            int gi = 0; float gm = lg[0];
#pragma unroll
            for (int o = 1; o < 4; ++o) if (lg[o] > gm) { gm = lg[o]; gi = o; }
            float gs = 0.f;
#pragma unroll
            for (int o = 0; o < 4; ++o) gs += __expf(lg[o] - gm);
            const float ggate = 1.f / gs;
#pragma unroll
            for (int o = 0; o < 8; ++o) el[o] = lrow[4 + gi * 8 + o];
            int i0 = 0; float l0 = el[0];
#pragma unroll
            for (int o = 1; o < 8; ++o) if (el[o] > l0) { l0 = el[o]; i0 = o; }
            int i1 = -1; float l1 = -3.0e38f;
#pragma unroll
            for (int o = 0; o < 8; ++o) if (o != i0 && el[o] > l1) { l1 = el[o]; i1 = o; }
            if (i1 < 0) { i1 = (i0 == 0) ? 1 : 0; l1 = el[0]; }
            const float e1 = __expf(l1 - l0), den = 1.f / (1.f + e1), w0 = den * ggate, w1 = e1 * den * ggate;
            const int ex0 = gi * 8 + i0, ex1 = gi * 8 + i1;
            const unsigned p0 = atomicAdd(cnt + ex0, 1u), p1 = atomicAdd(cnt + ex1, 1u);
            LIST[ex0 * NTOK + p0] = t; LIST[ex1 * NTOK + p1] = t; LISTW[ex0 * NTOK + p0] = w0; LISTW[ex1 * NTOK + p1] = w1;
            TOKE[2 * t] = ex0; TOKE[2 * t + 1] = ex1; TOKW[2 * t] = w0; TOKW[2 * t + 1] = w1; TOKP[2 * t] = (int)p0; TOKP[2 * t + 1] = (int)p1; }
        asm volatile("s_waitcnt lgkmcnt(0)" ::: "memory");
    }
}
__device__ __forceinline__ int pstart_of(const unsigned* cnt, int e) { int s = 0; for (int i = 0; i < e; ++i) s += ((int)cnt[i] + 255) & ~255; return s; }
__device__ __forceinline__ bool row_lookup(const unsigned* cnt, int R, int& e, int& i, int& n) {
    int s = 0;
    for (int x = 0; x < NEXP; ++x) { const int cn = (int)cnt[x], pc = (cn + 255) & ~255; if (R < s + pc) { e = x; i = R - s; n = cn; return true; } s += pc; }
    return false;
}

__device__ __forceinline__ void combine_phase(const Ctx& c, float* X, const bf16* Y, const unsigned char* rt, const LAS int* tab, const float* g, bf16* XN, float* OUTF) {
    const int* TOKE = (const int*)(rt + RT_TOKE); const int* TOKP = (const int*)(rt + RT_TOKP);
    for (int t = c.gw; t < NTOK; t += c.ngw) {
        const int e0 = TOKE[2 * t], e1 = TOKE[2 * t + 1];
        const int R0 = tab[e0] * 256 + TOKP[2 * t], R1 = tab[e1] * 256 + TOKP[2 * t + 1];
        f32x4* xr = (f32x4*)(X + (size_t)t * D) + c.lane; const f32x4* gr = (const f32x4*)g + c.lane;
        const u32x2* y0 = (const u32x2*)(Y + (size_t)R0 * D) + c.lane; const u32x2* y1 = (const u32x2*)(Y + (size_t)R1 * D) + c.lane;
        f32x4 v[4]; float s = 0.f;
#pragma unroll
        for (int j = 0; j < 4; ++j) { v[j] = xr[64 * j]; const u32x2 a = y0[64 * j], b = y1[64 * j];
            v[j].x += __uint_as_float(a.x << 16) + __uint_as_float(b.x << 16); v[j].y += __uint_as_float(a.x & 0xffff0000u) + __uint_as_float(b.x & 0xffff0000u);
            v[j].z += __uint_as_float(a.y << 16) + __uint_as_float(b.y << 16); v[j].w += __uint_as_float(a.y & 0xffff0000u) + __uint_as_float(b.y & 0xffff0000u);
            s += (v[j].x * v[j].x + v[j].y * v[j].y) + (v[j].z * v[j].z + v[j].w * v[j].w); }
        const float r = 1.f / sqrtf(wave_sum(s) * (1.f / D) + EPS);
        if (XN) {
            u32x2* o8 = (u32x2*)(XN + (size_t)t * D) + c.lane;
#pragma unroll
            for (int j = 0; j < 4; ++j) { xr[64 * j] = v[j]; const f32x4 gg = gr[64 * j]; u32x2 w; w.x = pk2(v[j].x * r * gg.x, v[j].y * r * gg.y); w.y = pk2(v[j].z * r * gg.z, v[j].w * r * gg.w); o8[64 * j] = w; }
        } else {
            f32x4* o = (f32x4*)(OUTF + (size_t)t * D) + c.lane;
#pragma unroll
            for (int j = 0; j < 4; ++j) { const f32x4 gg = gr[64 * j]; f32x4 w; w.x = v[j].x * r * gg.x; w.y = v[j].y * r * gg.y; w.z = v[j].z * r * gg.z; w.w = v[j].w * r * gg.w; o[64 * j] = w; }
        }
    }
}

__device__ __forceinline__ void gla_decay(const Ctx& c, const bf16* U, const float* gup, const float* gbias, float* DECA) {
    const long total = (long)NTOK * 2 * GLA_KD;
    for (long idx = GTID; idx < total; idx += GSIZE) {
        const int cc = (int)(idx % GLA_KD), dir = (int)((idx / GLA_KD) % 2), t = (int)(idx / (2 * GLA_KD));
        const bf16* r = U + (size_t)t * LDU1 + 2304 + dir * 16;
        float z = gbias[dir * GLA_KD + cc];
#pragma unroll
        for (int k = 0; k < 16; ++k) z += bf2f(r[k]) * gup[(dir * 16 + k) * GLA_KD + cc];
        const float ls = fminf(z, 0.f) - log1pf(__expf(-fabsf(z)));
        DECA[idx] = __expf(ls * (1.f / 16.f));
    }
}
__device__ __forceinline__ void gla_recur(const Ctx& c, const bf16* U, const float* DECA, float* OF) {
    const long total = (long)NBATCH * GLA_H * GLA_DV * 2;
    const float qs = 0.10206207261596577f;
    for (long idx = GTID; idx < total; idx += GSIZE) {
        const int half = (int)(idx & 1), dv = (int)((idx >> 1) % GLA_DV), h = (int)(((idx >> 1) / GLA_DV) % GLA_H), b = (int)((idx >> 1) / (GLA_DV * GLA_H));
        float S[48];
        for (int dir = 0; dir < 2; ++dir) {
#pragma unroll
            for (int d = 0; d < 48; ++d) S[d] = 0.f;
            for (int s = 0; s < SEQ; ++s) {
                const int p = dir ? (SEQ - 1 - s) : s, t = b * SEQ + p;
#if GLA_INTRA_ONLY
                if ((s & 63) == 0) {
#pragma unroll
                    for (int d = 0; d < 48; ++d) S[d] = 0.f; }
#endif
                const bf16* row = U + (size_t)t * LDU1;
                const float vv = bf2f(row[768 + h * GLA_DV + dv]);
                const float* a = DECA + ((size_t)t * 2 + dir) * GLA_KD + h * GLA_DK + half * 48;
                const u32x4* q4 = (const u32x4*)(row + h * GLA_DK + half * 48); const u32x4* k4 = (const u32x4*)(row + 384 + h * GLA_DK + half * 48);
                float o = 0.f;
#pragma unroll
                for (int d8 = 0; d8 < 6; ++d8) { const u32x4 qq = q4[d8], kk = k4[d8]; const f32x4 a0 = *(const f32x4*)(a + d8 * 8), a1 = *(const f32x4*)(a + d8 * 8 + 4);
#pragma unroll
                    for (int e = 0; e < 4; ++e) { const float aa0 = e < 2 ? a0[2 * e] : a1[2 * e - 4], aa1 = e < 2 ? a0[2 * e + 1] : a1[2 * e - 3];
                        const float s0 = aa0 * S[d8 * 8 + 2 * e] + __uint_as_float(kk[e] << 16) * vv; S[d8 * 8 + 2 * e] = s0; o += __uint_as_float(qq[e] << 16) * s0;
                        const float s1 = aa1 * S[d8 * 8 + 2 * e + 1] + __uint_as_float(kk[e] & 0xffff0000u) * vv; S[d8 * 8 + 2 * e + 1] = s1; o += __uint_as_float(qq[e] & 0xffff0000u) * s1; } }
                o += __shfl_xor(o, 1);
                float* dst = OF + (size_t)t * MIX + h * GLA_DV + dv;
                if (half == 0) { if (dir == 0) *dst = o * qs; else *dst += o * qs; }
            }
        }
    }
}
__device__ __forceinline__ void gla_norm_gate(const Ctx& c, const float* OF, const bf16* U, const float* onorm, bf16* CAT) {
    for (int it = c.gw; it < NTOK * GLA_H; it += c.ngw) {
        const int h = it % GLA_H, t = it / GLA_H;
        const float* o = OF + (size_t)t * MIX + h * GLA_DV;
        float v[3]; float s = 0.f;
#pragma unroll
        for (int j = 0; j < 3; ++j) { v[j] = o[c.lane + 64 * j]; s += v[j] * v[j]; }
        const float r = 1.f / sqrtf(wave_sum(s) * (1.f / GLA_DV) + EPS);
#pragma unroll
        for (int j = 0; j < 3; ++j) { const int dv = c.lane + 64 * j; const float gg = bf2f(U[(size_t)t * LDU1 + 1536 + h * GLA_DV + dv]);
            CAT[(size_t)t * D + h * GLA_DV + dv] = (bf16)f2bf(v[j] * r * onorm[dv] * silu(gg)); }
    }
}


namespace gla {
typedef short bf16x8 __attribute__((ext_vector_type(8)));
typedef short s16x4 __attribute__((ext_vector_type(4)));
constexpr int LB_OFF = 0, LB_LD = 97;
constexpr int QG_OFF = 25600, KG_OFF = 38912, QS_OFF = 52224, X_LD = 104;
constexpr int VS_OFF = 65536, V_LD = 200;
constexpr int AM_OFF = 91136, AM_LD = 72;
constexpr int TOT_OFF = 100352;
constexpr int RS_OFF = 102400;
constexpr int OS_OFF = 0, OS_LD = 196;
__device__ __forceinline__ s16x4 tr_read(LAS const unsigned char* p) { return __builtin_amdgcn_ds_read_tr16_b64_v4i16((LAS s16x4*)p); }
__device__ __forceinline__ float bflo(unsigned w) { return __uint_as_float(w << 16); }
__device__ __forceinline__ float bfhi(unsigned w) { return __uint_as_float(w & 0xffff0000u); }

__device__ __forceinline__ void prep(const Ctx& c, const bf16* U, const float* gup, const float* gbias, int t0, int h, int dir) {
    LAS float* LB = (LAS float*)(c.lds + LB_OFF); LAS float* TOT = (LAS float*)(c.lds + TOT_OFF);
    for (int idx = c.tid; idx < 64 * 96; idx += 512) { const int t = idx / 96, d = idx % 96;
        const u32x4* r4 = (const u32x4*)(U + (size_t)(t0 + t) * LDU1 + 2304 + dir * 16); const u32x4 ra = r4[0], rb = r4[1];
        const float* g = gup + (size_t)(dir * 16) * GLA_KD + h * GLA_DK + d;
        float z = gbias[dir * GLA_KD + h * GLA_DK + d];
#pragma unroll
        for (int k = 0; k < 4; ++k) { z += bflo(ra[k]) * g[(2 * k) * GLA_KD] + bfhi(ra[k]) * g[(2 * k + 1) * GLA_KD]; z += bflo(rb[k]) * g[(8 + 2 * k) * GLA_KD] + bfhi(rb[k]) * g[(9 + 2 * k) * GLA_KD]; }
        LB[t * LB_LD + d] = (fminf(z, 0.f) - __logf(1.f + __expf(-fabsf(z)))) * (1.f / 16.f); }
    __syncthreads();
    if (c.tid < 384) { const int d = c.tid % 96, seg = c.tid / 96; float run = 0.f;
#pragma unroll 4
        for (int i = 0; i < 16; ++i) { const int s = seg * 16 + i, t = dir ? 63 - s : s; run += LB[t * LB_LD + d]; LB[t * LB_LD + d] = run; }
        TOT[seg * 96 + d] = run; }
    __syncthreads();
    if (c.tid < 384) { const int d = c.tid % 96, seg = c.tid / 96; float off = 0.f;
        for (int s2 = 0; s2 < seg; ++s2) off += TOT[s2 * 96 + d];
        if (seg > 0) {
#pragma unroll 4
            for (int i = 0; i < 16; ++i) { const int s = seg * 16 + i, t = dir ? 63 - s : s; LB[t * LB_LD + d] += off; } }
        if (seg == 3) TOT[4 * 96 + d] = off + TOT[3 * 96 + d]; }
    __syncthreads();
}
__device__ __forceinline__ void stage_v(const Ctx& c, const bf16* U, int t0, int h) {
    for (int idx = c.tid; idx < 64 * 24; idx += 512) { const int t = idx / 24, ch = idx % 24;
        *(LAS u32x4*)(c.lds + VS_OFF + (t * V_LD + ch * 8) * 2) = *(const u32x4*)(U + (size_t)(t0 + t) * LDU1 + 768 + h * GLA_DV + ch * 8); }
}

__device__ __forceinline__ void local_phase(const Ctx& c, const bf16* U, const float* gup, const float* gbias, bf16* SU, float* DEC, int vcu, int G, unsigned* dbg) {
    const int fr = c.lane & 15, fq = c.lane >> 4, q = fr >> 2, p = fr & 3;
    for (int item = vcu; item < NBATCH * GLA_H * 2 * 64; item += G) {
        const int n = item & 63, dir = (item >> 6) & 1, h = (item >> 7) & 3, b = item >> 9, t0 = b * SEQ + n * 64;
        __syncthreads();
        stage_v(c, U, t0, h);
        prep(c, U, gup, gbias, t0, h, dir);
        LAS const float* LB = (LAS const float*)(c.lds + LB_OFF); LAS const float* BL = (LAS const float*)(c.lds + TOT_OFF) + 4 * 96;
        for (int idx = c.tid; idx < 64 * 12; idx += 512) { const int t = idx / 12, ch = idx % 12;
            const u32x4 kk = *(const u32x4*)(U + (size_t)(t0 + t) * LDU1 + 384 + h * GLA_DK + ch * 8); u32x4 w;
#pragma unroll
            for (int e = 0; e < 4; ++e) { const int d = ch * 8 + 2 * e; const float f0 = __expf(BL[d] - LB[t * LB_LD + d]), f1 = __expf(BL[d + 1] - LB[t * LB_LD + d + 1]);
                w[e] = pg8::cvt_pk_bf16(bflo(kk[e]) * f0, bfhi(kk[e]) * f1); }
            *(LAS u32x4*)(c.lds + QG_OFF + (t * X_LD + ch * 8) * 2) = w; }
        if (c.tid < 96) DEC[(size_t)item * 96 + c.tid] = __expf(BL[c.tid]);
        __syncthreads();
        bf16* su = SU + (size_t)item * (GLA_DV * GLA_DK);
#pragma unroll 1
        for (int k9 = 0; k9 < 9; ++k9) { const int id = c.wave * 9 + k9, jv = id / 6, i = id % 6;
            f32x4 acc = {0.f, 0.f, 0.f, 0.f};
#pragma unroll
            for (int ks = 0; ks < 2; ++ks) { const int tr = 32 * ks + 8 * fq + q;
                const s16x4 a0 = tr_read(c.lds + QG_OFF + (tr * X_LD + 16 * i + 4 * p) * 2), a1 = tr_read(c.lds + QG_OFF + ((tr + 4) * X_LD + 16 * i + 4 * p) * 2);
                const s16x4 b0 = tr_read(c.lds + VS_OFF + (tr * V_LD + 16 * jv + 4 * p) * 2), b1 = tr_read(c.lds + VS_OFF + ((tr + 4) * V_LD + 16 * jv + 4 * p) * 2);
                const bf16x8 av = {a0[0], a0[1], a0[2], a0[3], a1[0], a1[1], a1[2], a1[3]}, bv = {b0[0], b0[1], b0[2], b0[3], b1[0], b1[1], b1[2], b1[3]};
                acc = __builtin_amdgcn_mfma_f32_16x16x32_bf16(av, bv, acc, 0, 0, 0); }
            u32x2 w; w.x = pg8::cvt_pk_bf16(acc[0], acc[1]); w.y = pg8::cvt_pk_bf16(acc[2], acc[3]);
            *(u32x2*)(su + (size_t)(16 * jv + fr) * GLA_DK + 16 * i + 4 * fq) = w; }
    }
}
__device__ __forceinline__ void scan_phase(const Ctx& c, const bf16* __restrict__ SU, bf16* __restrict__ SS, const float* __restrict__ DEC) {
    const long total = (long)32 * 2304;
    for (long idx = GTID; idx < total; idx += GSIZE) { const int seq = (int)(idx / 2304), ch = (int)(idx % 2304), dk0 = (ch % 12) * 8, dir = seq & 1;
        float s[8];
#pragma unroll
        for (int e = 0; e < 8; ++e) s[e] = 0.f;
        const size_t cs = (size_t)(GLA_DV * GLA_DK);
        const bf16* pu0 = SU + (size_t)(seq * 64) * cs + (size_t)ch * 8; bf16* ps0 = SS + (size_t)(seq * 64) * cs + (size_t)ch * 8; const float* pd0 = DEC + (size_t)(seq * 64) * 96 + dk0;
#pragma unroll 1
        for (int st0 = 0; st0 < 64; st0 += 8) {
            u32x4 uu[8]; f32x4 da[8], db[8];
#pragma unroll
            for (int k = 0; k < 8; ++k) { const int n = dir ? 63 - (st0 + k) : st0 + k; uu[k] = *(const u32x4*)(pu0 + (size_t)n * cs); da[k] = *(const f32x4*)(pd0 + n * 96); db[k] = *(const f32x4*)(pd0 + n * 96 + 4); }
#pragma unroll
            for (int k = 0; k < 8; ++k) { const int n = dir ? 63 - (st0 + k) : st0 + k;
                u32x4 w; w.x = pg8::cvt_pk_bf16(s[0], s[1]); w.y = pg8::cvt_pk_bf16(s[2], s[3]); w.z = pg8::cvt_pk_bf16(s[4], s[5]); w.w = pg8::cvt_pk_bf16(s[6], s[7]);
                *(u32x4*)(ps0 + (size_t)n * cs) = w;
                s[0] = s[0] * da[k][0] + bflo(uu[k][0]); s[1] = s[1] * da[k][1] + bfhi(uu[k][0]); s[2] = s[2] * da[k][2] + bflo(uu[k][1]); s[3] = s[3] * da[k][3] + bfhi(uu[k][1]);
                s[4] = s[4] * db[k][0] + bflo(uu[k][2]); s[5] = s[5] * db[k][1] + bfhi(uu[k][2]); s[6] = s[6] * db[k][2] + bflo(uu[k][3]); s[7] = s[7] * db[k][3] + bfhi(uu[k][3]); }
        }
    }
}
__device__ __forceinline__ void out_phase(const Ctx& c, const bf16* U, const float* gup, const float* gbias, const bf16* SU, const float* onorm, bf16* CAT, int vcu, int G) {
    const int fr = c.lane & 15, fq = c.lane >> 4, q = fr >> 2, p = fr & 3, it = c.wave & 3, cth = c.wave >> 2;
    const float qsc = 0.10206207261596577f;
    for (int item = vcu; item < NBATCH * GLA_H * 64; item += G) {
        const int n = item & 63, h = (item >> 6) & 3, b = item >> 8, t0 = b * SEQ + n * 64;
        f32x4 o[6];
#pragma unroll
        for (int x = 0; x < 6; ++x) o[x] = (f32x4){0.f, 0.f, 0.f, 0.f};
        __syncthreads();
        stage_v(c, U, t0, h);
#pragma unroll 1
        for (int dir = 0; dir < 2; ++dir) {
            prep(c, U, gup, gbias, t0, h, dir);
            LAS const float* LB = (LAS const float*)(c.lds + LB_OFF); const int tmid = dir ? 32 : 31;
            for (int idx = c.tid; idx < 64 * 12; idx += 512) { const int t = idx / 12, ch = idx % 12;
                const u32x4 qq = *(const u32x4*)(U + (size_t)(t0 + t) * LDU1 + h * GLA_DK + ch * 8), kk = *(const u32x4*)(U + (size_t)(t0 + t) * LDU1 + 384 + h * GLA_DK + ch * 8);
                u32x4 wg, wk, ws;
#pragma unroll
                for (int e = 0; e < 4; ++e) { const int d = ch * 8 + 2 * e; const float b0 = LB[t * LB_LD + d], b1 = LB[t * LB_LD + d + 1], m0 = LB[tmid * LB_LD + d], m1 = LB[tmid * LB_LD + d + 1];
                    const float q0 = bflo(qq[e]) * qsc, q1 = bfhi(qq[e]) * qsc;
                    wg[e] = pg8::cvt_pk_bf16(q0 * __expf(b0 - m0), q1 * __expf(b1 - m1)); wk[e] = pg8::cvt_pk_bf16(bflo(kk[e]) * __expf(m0 - b0), bfhi(kk[e]) * __expf(m1 - b1));
                    ws[e] = pg8::cvt_pk_bf16(q0 * __expf(b0), q1 * __expf(b1)); }
                *(LAS u32x4*)(c.lds + QG_OFF + (t * X_LD + ch * 8) * 2) = wg; *(LAS u32x4*)(c.lds + KG_OFF + (t * X_LD + ch * 8) * 2) = wk; *(LAS u32x4*)(c.lds + QS_OFF + (t * X_LD + ch * 8) * 2) = ws; }
            __syncthreads();
#pragma unroll
            for (int jj = 0; jj < 2; ++jj) { const int jt = 2 * cth + jj; f32x4 a = {0.f, 0.f, 0.f, 0.f};
#pragma unroll
                for (int ks = 0; ks < 3; ++ks) { const bf16x8 av = *(const LAS bf16x8*)(c.lds + QG_OFF + ((16 * it + fr) * X_LD + 32 * ks + 8 * fq) * 2), bv = *(const LAS bf16x8*)(c.lds + KG_OFF + ((16 * jt + fr) * X_LD + 32 * ks + 8 * fq) * 2);
                    a = __builtin_amdgcn_mfma_f32_16x16x32_bf16(av, bv, a, 0, 0, 0); }
#pragma unroll
                for (int rg = 0; rg < 4; ++rg) { const int i = 16 * it + 4 * fq + rg, j = 16 * jt + fr; const bool keep = dir ? (j >= i) : (j <= i);
                    *(LAS bf16*)(c.lds + AM_OFF + (i * AM_LD + j) * 2) = (bf16)f2bf(keep ? a[rg] : 0.f); } }
            __syncthreads();
            const bf16* st = SU + ((size_t)(((b * 4 + h) * 2 + dir) * 64 + n)) * (GLA_DV * GLA_DK);
#pragma unroll
            for (int x = 0; x < 6; ++x) { const int ct = cth * 6 + x;
#pragma unroll
                for (int ks = 0; ks < 2; ++ks) { const int tr = 32 * ks + 8 * fq + q;
                    const bf16x8 av = *(const LAS bf16x8*)(c.lds + AM_OFF + ((16 * it + fr) * AM_LD + 32 * ks + 8 * fq) * 2);
                    const s16x4 b0 = tr_read(c.lds + VS_OFF + (tr * V_LD + 16 * ct + 4 * p) * 2), b1 = tr_read(c.lds + VS_OFF + ((tr + 4) * V_LD + 16 * ct + 4 * p) * 2);
                    const bf16x8 bv = {b0[0], b0[1], b0[2], b0[3], b1[0], b1[1], b1[2], b1[3]};
                    o[x] = __builtin_amdgcn_mfma_f32_16x16x32_bf16(av, bv, o[x], 0, 0, 0); }
#if !GLA_INTRA_ONLY
#pragma unroll
                for (int ks = 0; ks < 3; ++ks) { const bf16x8 av = *(const LAS bf16x8*)(c.lds + QS_OFF + ((16 * it + fr) * X_LD + 32 * ks + 8 * fq) * 2);
                    const bf16x8 bv = *(const bf16x8*)(st + (size_t)(16 * ct + fr) * GLA_DK + 32 * ks + 8 * fq);
                    o[x] = __builtin_amdgcn_mfma_f32_16x16x32_bf16(av, bv, o[x], 0, 0, 0); }
#endif
            }
            __syncthreads();
        }
        LAS float* OS = (LAS float*)(c.lds + OS_OFF);
#pragma unroll
        for (int x = 0; x < 6; ++x)
#pragma unroll
            for (int rg = 0; rg < 4; ++rg) OS[(16 * it + 4 * fq + rg) * OS_LD + 16 * (cth * 6 + x) + fr] = o[x][rg];
        __syncthreads();
        { const int t = c.tid >> 3, part = c.tid & 7; float s = 0.f;
#pragma unroll
            for (int e = 0; e < 24; ++e) { const float v = OS[t * OS_LD + part * 24 + e]; s += v * v; }
            s += __shfl_xor(s, 1); s += __shfl_xor(s, 2); s += __shfl_xor(s, 4);
            if (part == 0) ((LAS float*)(c.lds + RS_OFF))[t] = 1.f / sqrtf(s * (1.f / GLA_DV) + EPS); }
        __syncthreads();
        for (int idx = c.tid; idx < 64 * 24; idx += 512) { const int t = idx / 24, ch = idx % 24; const float r = ((LAS const float*)(c.lds + RS_OFF))[t];
            const u32x4 gg = *(const u32x4*)(U + (size_t)(t0 + t) * LDU1 + 1536 + h * GLA_DV + ch * 8); u32x4 w;
#pragma unroll
            for (int e = 0; e < 4; ++e) { const int dv = ch * 8 + 2 * e; const float g0 = bflo(gg[e]), g1 = bfhi(gg[e]);
                w[e] = pg8::cvt_pk_bf16(OS[t * OS_LD + dv] * r * onorm[dv] * (g0 / (1.f + __expf(-g0))), OS[t * OS_LD + dv + 1] * r * onorm[dv + 1] * (g1 / (1.f + __expf(-g1)))); }
            *(u32x4*)(CAT + (size_t)(t0 + t) * D + h * GLA_DV + ch * 8) = w; }
    }
}
}

#define XB_TMO      128
#define XB_XCNT(j)  (256  + 64 * (j))
#define XB_XSUB(j)  (1280 + 64 * (j))
#define XB_XGEN(j)  (2304 + 64 * (j))
#define XB_TOP      3328
#define XB_TOPGEN   3392
#define XCD_BAR_WORDS 3456
#define XB_SPIN_CAP (1u << 22)
__device__ __forceinline__ unsigned xb_ld(unsigned* p)              { return __hip_atomic_load(p, __ATOMIC_RELAXED, __HIP_MEMORY_SCOPE_AGENT); }
__device__ __forceinline__ unsigned xb_add(unsigned* p, unsigned v) { return __hip_atomic_fetch_add(p, v, __ATOMIC_RELAXED, __HIP_MEMORY_SCOPE_AGENT); }
__device__ __forceinline__ unsigned xb_xcc_id() { return (unsigned)__builtin_amdgcn_s_getreg((3 << 11) | 20) & 0xFu; }
#define XB_SPIN(cond, bar) do { unsigned _sp = 0; while (cond) { __builtin_amdgcn_s_sleep(1); \
    if ((++_sp & 255u) == 0u) { if (xb_ld(&(bar)[XB_TMO])) break; if (_sp > XB_SPIN_CAP) { atomicAdd(&(bar)[XB_TMO], 1u); break; } } } } while (0)
struct XcdBarrier { unsigned* bar; unsigned x; volatile LAS unsigned* st; };
__device__ __forceinline__ XcdBarrier xcd_barrier_post(unsigned* bar, volatile LAS unsigned* st) {
    XcdBarrier b; b.bar = bar; b.x = xb_xcc_id(); b.st = st;
    if (threadIdx.x == 0) (void)xb_add(&bar[XB_XCNT(b.x)], 1u);
    return b;
}
__device__ __forceinline__ void xcd_barrier_complete(unsigned* bar, unsigned x, unsigned& nloc, unsigned& nx) {
    const unsigned G = gridDim.x * gridDim.y * gridDim.z;
    unsigned sum, cnt, mine, sp = 0u;
    for (;;) {
        sum = 0u; cnt = 0u; mine = 0u;
#pragma unroll
        for (unsigned j = 0; j < 16; ++j) { const unsigned c = xb_ld(&bar[XB_XCNT(j)]); sum += c; cnt += (c > 0u) ? 1u : 0u; mine = (j == x) ? c : mine; }
        if (sum == G) break;
        __builtin_amdgcn_s_sleep(1);
        if ((++sp & 255u) == 0u) { if (xb_ld(&bar[XB_TMO])) break; if (sp > XB_SPIN_CAP) { atomicAdd(&bar[XB_TMO], 1u); break; } }
    }
    nloc = mine > 0u ? mine : 1u; nx = cnt > 0u ? cnt : 1u;
}
__device__ __forceinline__ void xcd_barrier(const XcdBarrier& b) {
    asm volatile("s_waitcnt vmcnt(0)" ::: "memory");
    __syncthreads();
    if (threadIdx.x == 0) {
        unsigned* bar = b.bar;
        __builtin_amdgcn_s_waitcnt(0);
        const unsigned bx = __builtin_amdgcn_readfirstlane(xb_xcc_id());
        unsigned nloc = b.st[0], nx = b.st[1];
        if (nloc == 0u) { xcd_barrier_complete(bar, bx, nloc, nx); b.st[0] = nloc; b.st[1] = nx; }
        const unsigned old = xb_add(&bar[XB_XSUB(bx)], 1u);
        const unsigned gen = old / nloc;
        if (old + 1u == (gen + 1u) * nloc) {
            __builtin_amdgcn_fence(__ATOMIC_RELEASE, "agent");
            asm volatile("s_waitcnt vmcnt(0)" ::: "memory");
            const unsigned og = xb_add(&bar[XB_TOP], 1u);
            const unsigned tg = og / nx;
            if (og + 1u == (tg + 1u) * nx) xb_add(&bar[XB_TOPGEN], 1u);
            else XB_SPIN(xb_ld(&bar[XB_TOPGEN]) == tg, bar);
            __builtin_amdgcn_fence(__ATOMIC_ACQUIRE, "agent");
            xb_add(&bar[XB_XGEN(bx)], 1u);
            asm volatile("s_waitcnt vmcnt(0)" ::: "memory");
        } else {
            XB_SPIN(xb_ld(&bar[XB_XGEN(bx)]) == gen, bar);
            __builtin_amdgcn_fence(__ATOMIC_ACQUIRE, "agent");
            asm volatile("s_waitcnt vmcnt(0)" ::: "memory");
        }
    }
    __syncthreads();
}

constexpr int NWAVES = 8, NTHREADS = 512, LDS_BYTES = 147456, MISC_OFF = 131072 + 1024;
constexpr int NPHASES = 19;
constexpr int TAB_OFF = 131072 + 2048;
#ifndef USE_MFMA_ROUTE
#define USE_MFMA_ROUTE 1
#endif
#ifndef GLA_EXPERIMENT
#define GLA_EXPERIMENT 0
#endif
#ifndef USE_MFMA_GLA
#define USE_MFMA_GLA 7
#endif
#ifndef USE_MFMA_ATTN
#define USE_MFMA_ATTN 1
#endif
#ifndef USE_PG8
#define USE_PG8 0xF
#endif
__device__ __forceinline__ void build_tab(const Ctx& c, const unsigned* cnt) {
    LAS int* tab = (LAS int*)(c.lds + TAB_OFF);
    __syncthreads();
    if (c.tid < 64) { const int cn = c.tid < 32 ? (int)cnt[c.tid] : 0; int mt = (cn + 255) >> 8, inc = mt;
#pragma unroll
        for (int o = 1; o < 32; o <<= 1) { const int v = __shfl_up(inc, o); if ((c.tid & 31) >= o) inc += v; }
        if (c.tid < 32) { tab[c.tid + 1] = inc; tab[64 + c.tid] = cn; } if (c.tid == 0) tab[0] = 0; }
    __syncthreads();
}

template <int PH_LO, int PH_HI> __global__ void __launch_bounds__(NTHREADS, 2) mk_fwd(Args args) {
    extern __shared__ __attribute__((aligned(16))) unsigned char lds_raw[];
    LAS unsigned char* const ldsp = (LAS unsigned char*)lds_raw;
    Ctx c = fresh_ctx(ldsp);
    const int vcu = (gridDim.x % 8 == 0) ? (int)((blockIdx.x % 8) * (gridDim.x / 8) + blockIdx.x / 8) : (int)blockIdx.x;
    unsigned char* ws = args.ws;
    const float* x = args.in[0]; const float* mem = args.in[1]; const float* mem_norm = args.in[2]; const float* final_norm = args.in[3];
    const float* norm_mix = args.in[4]; const float* norm_ffn = args.in[5]; const float* w_mem_kv = args.in[6]; const float* w_out = args.in[7];
    const float* na_w_in = args.in[8]; const float* na_rpb = args.in[9]; const float* gla_w_in = args.in[10]; const float* gla_gate_up = args.in[11];
    const float* gla_gate_bias = args.in[12]; const float* gla_out_norm = args.in[13]; const float* moe_w_group = args.in[14]; const float* moe_b_group = args.in[15];
    const float* moe_w_router = args.in[16]; const float* moe_b_router = args.in[17]; const float* moe_w1 = args.in[18]; const float* moe_w3 = args.in[19]; const float* moe_w2 = args.in[20];
    float* X = args.out;
    bf16* WIN0 = (bf16*)(ws + WS_WIN0); bf16* WIN1 = (bf16*)(ws + WS_WIN1); bf16* WOUT = (bf16*)(ws + WS_WOUT); bf16* WMKV = (bf16*)(ws + WS_WMKV);
    bf16* MEMN = (bf16*)(ws + WS_MEMN); bf16* MKV = (bf16*)(ws + WS_MKV); bf16* W13 = (bf16*)(ws + WS_W13); bf16* W2 = (bf16*)(ws + WS_W2);
    bf16* XN = (bf16*)(ws + WS_XN); bf16* U = (bf16*)(ws + WS_U); bf16* Y = (bf16*)(ws + WS_Y); bf16* CAT = (bf16*)(ws + WS_CAT); bf16* ACT = (bf16*)(ws + WS_ACT);
    unsigned char* RT = ws + WS_ROUTE; float* DECA = (float*)(ws + WS_S + 74 * MiB); float* OF = (float*)(ws + WS_S + 122 * MiB);
    bf16* SU = (bf16*)(ws + WS_S); float* SDEC = (float*)(ws + WS_S + 73 * MiB); bf16* SS = (bf16*)(ws + WS_S + 74 * MiB);
    float* WR = (float*)(ws + WS_WR);
    unsigned* CTL = (unsigned*)(ws + WS_CTL);
#define IN(k) (PH_LO <= (k) && (k) < PH_HI)
    constexpr bool FUSED = (PH_HI - PH_LO) > 1;
    XcdBarrier bar; bar.bar = CTL + CW_BAR; bar.x = 0; bar.st = nullptr;
    if constexpr (FUSED) {
        volatile LAS unsigned* misc = (volatile LAS unsigned*)(c.lds + MISC_OFF);
        if (c.tid < 64) misc[c.tid] = 0u;
        __syncthreads();
        bar = xcd_barrier_post(CTL + CW_BAR, misc + 8);
        if (PROBE_EN && blockIdx.x == 0 && threadIdx.x == 0) CTL[599] = (unsigned)__builtin_amdgcn_s_memrealtime();
    }
#define GRID_BAR(k) do { if constexpr (FUSED) { if (IN((k) + 1)) xcd_barrier(bar); if (PROBE_EN && blockIdx.x == 0 && threadIdx.x == 0) CTL[600 + (k)] = (unsigned)__builtin_amdgcn_s_memrealtime(); } } while (0)

    if (IN(0)) for (int rep_ = 0; rep_ <= (int)((REPEAT_MASK >> (0)) & 1u); ++rep_) { c = fresh_ctx(ldsp);
        transpose_matrix(c, na_w_in, 1024, NA_IN, WIN0, c.gw, c.ngw);
        transpose_matrix(c, gla_w_in, 1024, GLA_IN, WIN1, c.gw, c.ngw);
        for (long i = GTID; i < (long)(2816 - 2592) * 1024 / 8; i += GSIZE) ((u32x4*)(WIN1 + (size_t)2592 * 1024))[i] = (u32x4){0u, 0u, 0u, 0u};
        for (int l = 0; l < 2; ++l) { transpose_matrix(c, w_out + (size_t)l * D * D, 1024, 1024, WOUT + (size_t)l * D * D, c.gw, c.ngw);
            transpose_matrix(c, w_mem_kv + (size_t)l * D * 512, 1024, 512, WMKV + (size_t)l * 512 * 1024, c.gw, c.ngw); }
        convert_moe(c, moe_w1, moe_w3, moe_w2, W13, W2);
        for (long i = GTID; i < (long)2 * 48 * D; i += GSIZE) { const int k = (int)(i % D), col = (int)((i / D) % 48), l = (int)(i / (48 * D)); const float gk = norm_ffn[l * D + k];
            WR[i] = col < 4 ? moe_w_group[((size_t)l * D + k) * 4 + col] * gk : (col < 36 ? moe_w_router[((size_t)l * D + k) * 32 + (col - 4)] * gk : 0.f); }
        for (int m = c.gw; m < NBATCH * NMEM; m += c.ngw) rms_row_to_bf16(mem + (size_t)m * D, mem_norm, MEMN + (size_t)m * D, c.lane);
        for (int m = c.gw; m < NTOK; m += c.ngw) rms_row_to_bf16(x + (size_t)m * D, norm_mix, XN + (size_t)m * D, c.lane);
        GRID_BAR(0);
    }
#pragma unroll
    for (int L = 0; L < 2; ++L) {
        const int pb = 1 + 9 * L;
        const int ldu = L == 0 ? LDU0 : LDU1;
        unsigned* cnt = CTL + CW_CNT + 64 * L;
        if (IN(pb)) for (int rep_ = 0; rep_ <= (int)((REPEAT_MASK >> (pb)) & 1u); ++rep_) { c = fresh_ctx(ldsp);
            if constexpr (USE_PG8 & 1) {
                pg8::StaticOrder S; S.init(XN, L == 0 ? WIN0 : WIN1, NTOK, ldu, D, (int)gridDim.x, (int)blockIdx.x);
                pg8::EpiBf16 E{U, ldu};
                pg8::gemm_phase<pg8::EpiBf16, pg8::StaticOrder, false>(c.lds, D, S, E);
                if (L == 0) { pg8::StaticOrder S2; S2.init(MEMN, WMKV, NBATCH * NMEM, 1024, D, (int)gridDim.x, (int)blockIdx.x);
                    pg8::EpiBf16 E2{MKV, 1024};
                    pg8::gemm_phase<pg8::EpiBf16, pg8::StaticOrder, false>(c.lds, D, S2, E2); }
            } else {
            if (L == 0) {
                naive_gemm(c, NTOK, NA_IN, D, [&](int m) { return XN + (size_t)m * D; }, WIN0, [&](int m, int n, float a) { U[(size_t)m * LDU0 + n] = (bf16)f2bf(a); });
                naive_gemm(c, NBATCH * NMEM, 1024, D, [&](int m) { return MEMN + (size_t)m * D; }, WMKV, [&](int m, int n, float a) { MKV[(size_t)m * 1024 + n] = (bf16)f2bf(a); });
            } else {
                naive_gemm(c, NTOK, LDU1, D, [&](int m) { return XN + (size_t)m * D; }, WIN1, [&](int m, int n, float a) { U[(size_t)m * LDU1 + n] = (bf16)f2bf(a); });
            }
            }
            GRID_BAR(pb);
        }
        if (IN(pb + 1)) for (int rep_ = 0; rep_ <= (int)((REPEAT_MASK >> (pb + 1)) & 1u); ++rep_) { c = fresh_ctx(ldsp);
#if USE_MFMA_ATTN
            if (L == 0) { att::na_phase(c, U, na_rpb, CAT, vcu, (int)gridDim.x); att::mem_phase(c, U, LDU0, 2304, MKV, 0, CAT, vcu, (int)gridDim.x); }
            else { att::mem_phase(c, U, LDU1, 2336, MKV, 1, CAT, vcu, (int)gridDim.x);
                if constexpr (USE_MFMA_GLA & 1) gla::local_phase(c, U, gla_gate_up, gla_gate_bias, SU, SDEC, vcu, (int)gridDim.x, CTL);
                if constexpr (!(USE_MFMA_GLA & 4)) gla_decay(c, U, gla_gate_up, gla_gate_bias, DECA); }
#else
            if (L == 0) { naive_na(c, U, na_rpb, CAT); naive_memattn(c, U, LDU0, 2304, MKV, 0, CAT); }
            else { gla_decay(c, U, gla_gate_up, gla_gate_bias, DECA); naive_memattn(c, U, LDU1, 2336, MKV, 1, CAT); }
#endif
            GRID_BAR(pb + 1);
        }
        if (IN(pb + 2)) for (int rep_ = 0; rep_ <= (int)((REPEAT_MASK >> (pb + 2)) & 1u); ++rep_) { c = fresh_ctx(ldsp);
            if (L == 1) { if constexpr (USE_MFMA_GLA & 2) gla::scan_phase(c, SU, SS, SDEC);
                if constexpr (!(USE_MFMA_GLA & 4)) gla_recur(c, U, DECA, OF);
                GRID_BAR(pb + 2); }
        }
        if (IN(pb + 3)) for (int rep_ = 0; rep_ <= (int)((REPEAT_MASK >> (pb + 3)) & 1u); ++rep_) { c = fresh_ctx(ldsp);
            if (L == 1) {
#if GLA_EXPERIMENT
                gla::out_phase(c, U, gla_gate_up, gla_gate_bias, SS, gla_out_norm, ACT, vcu, (int)gridDim.x);
                gla_norm_gate(c, OF, U, gla_out_norm, CAT);
#else
                if constexpr (USE_MFMA_GLA & 4) gla::out_phase(c, U, gla_gate_up, gla_gate_bias, SS, gla_out_norm, CAT, vcu, (int)gridDim.x);
                else gla_norm_gate(c, OF, U, gla_out_norm, CAT);
#endif
                GRID_BAR(pb + 3); }
        }
        if (IN(pb + 4)) for (int rep_ = 0; rep_ <= (int)((REPEAT_MASK >> (pb + 4)) & 1u); ++rep_) { c = fresh_ctx(ldsp);
            const float* resid = L == 0 ? x : X;
#if GLA_EXPERIMENT
            if (L == 1) { unsigned bad = 0, verybad = 0;
                for (long i = GTID; i < (long)NTOK * MIX; i += GSIZE) { const int t = (int)(i / MIX), cc = (int)(i % MIX); const float a = bf2f(CAT[(size_t)t * D + cc]), bb = bf2f(ACT[(size_t)t * D + cc]);
                    const float df = fabsf(a - bb); if (!(df <= 0.05f + 0.1f * fabsf(a))) ++bad; if (!(fabsf(bb) < 1.0e30f)) ++verybad; }
                unsigned nfs = 0, nfd = 0;
                for (long i = GTID; i < (long)2048 * 18432; i += GSIZE) { const float a = bf2f(SU[i]); if (!(fabsf(a) < 1.0e30f)) ++nfs; }
                for (long i = GTID; i < (long)2048 * 96; i += GSIZE) { const float a = SDEC[i]; if (!(a >= 0.f && a <= 1.0001f)) ++nfd; }
                if (bad) atomicAdd(CTL + 512, bad); if (verybad) atomicAdd(CTL + 513, verybad); if (nfs) atomicAdd(CTL + 514, nfs); if (nfd) atomicAdd(CTL + 515, nfd); }
#endif
            if constexpr (USE_PG8 & 2) {
                pg8::StaticOrder S; S.init(CAT, WOUT + (size_t)L * D * D, NTOK, D, D, (int)gridDim.x, (int)blockIdx.x);
                pg8::EpiResF32 E{resid, X};
                pg8::gemm_phase<pg8::EpiResF32, pg8::StaticOrder, false>(c.lds, D, S, E);
            } else
            naive_gemm(c, NTOK, D, D, [&](int m) { return CAT + (size_t)m * D; }, WOUT + (size_t)L * D * D, [&](int m, int n, float a) { X[(size_t)m * D + n] = resid[(size_t)m * D + n] + a; });
            GRID_BAR(pb + 4);
        }
        if (IN(pb + 5)) for (int rep_ = 0; rep_ <= (int)((REPEAT_MASK >> (pb + 5)) & 1u); ++rep_) { c = fresh_ctx(ldsp);
#if USE_MFMA_ROUTE
            route_mfma(c, X, norm_ffn + L * D, WR + (size_t)L * 48 * D, moe_b_group + L * 4, moe_b_router + L * 32, XN, RT, cnt);
#else
            route_phase(c, X, norm_ffn + L * D, moe_w_group + (size_t)L * D * 4, moe_b_group + L * 4, moe_w_router + (size_t)L * D * 32, moe_b_router + L * 32, XN, RT, cnt);
#endif
            GRID_BAR(pb + 5);
        }
        if (IN(pb + 6)) for (int rep_ = 0; rep_ <= (int)((REPEAT_MASK >> (pb + 6)) & 1u); ++rep_) { c = fresh_ctx(ldsp);
            const int* LIST = (const int*)(RT + RT_LIST);
            if constexpr (USE_PG8 & 4) {
                build_tab(c, cnt);
                pg8::MoeOrder S{(const LAS int*)(c.lds + TAB_OFF), XN, W13, LIST, D, 4, (int)gridDim.x, vcu, true};
                pg8::EpiSwiGLU E{ACT};
                pg8::gemm_phase<pg8::EpiSwiGLU, pg8::MoeOrder, true>(c.lds, D, S, E);
            } else {
            const long total = (long)MAXROWS * EFF;
            for (long idx = GTID; idx < total; idx += GSIZE) {
                const int R = (int)(idx / EFF), j = (int)(idx % EFF); int e, i, n;
                if (!row_lookup(cnt, R, e, i, n) || i >= n) continue;
                const int t = LIST[e * NTOK + i];
                const u32x4* a4 = (const u32x4*)(XN + (size_t)t * D);
                const int r1 = (j / 128) * 256 + (j % 128);
                const u32x4* b1 = (const u32x4*)(W13 + ((size_t)e * 1024 + r1) * 1024); const u32x4* b3 = (const u32x4*)(W13 + ((size_t)e * 1024 + r1 + 128) * 1024);
                float s1 = 0.f, s3 = 0.f;
                for (int k8 = 0; k8 < D / 8; ++k8) { const u32x4 av = a4[k8]; s1 += dot8(av, b1[k8]); s3 += dot8(av, b3[k8]); }
                ACT[(size_t)R * EFF + j] = (bf16)f2bf(silu(s1) * s3);
            }
            }
            GRID_BAR(pb + 6);
        }
        if (IN(pb + 7)) for (int rep_ = 0; rep_ <= (int)((REPEAT_MASK >> (pb + 7)) & 1u); ++rep_) { c = fresh_ctx(ldsp);
            const int* LIST = (const int*)(RT + RT_LIST); const int* TOKE = (const int*)(RT + RT_TOKE); const float* TOKW = (const float*)(RT + RT_TOKW);
            if constexpr (USE_PG8 & 8) {
                build_tab(c, cnt);
                pg8::MoeOrder S{(const LAS int*)(c.lds + TAB_OFF), ACT, W2, LIST, EFF, 4, (int)gridDim.x, vcu, false};
                pg8::EpiScaleBf16 E{Y, (const float*)(RT + RT_LISTW), (const LAS int*)(c.lds + TAB_OFF)};
                pg8::gemm_phase<pg8::EpiScaleBf16, pg8::MoeOrder, false>(c.lds, EFF, S, E);
            } else {
            const long total = (long)MAXROWS * D;
            for (long idx = GTID; idx < total; idx += GSIZE) {
                const int R = (int)(idx / D), n = (int)(idx % D); int e, i, cn;
                if (!row_lookup(cnt, R, e, i, cn) || i >= cn) continue;
                const int t = LIST[e * NTOK + i];
                const float w = (TOKE[2 * t] == e) ? TOKW[2 * t] : TOKW[2 * t + 1];
                const u32x4* a4 = (const u32x4*)(ACT + (size_t)R * EFF); const u32x4* b4 = (const u32x4*)(W2 + ((size_t)e * 1024 + n) * 512);
                float s = 0.f;
                for (int k8 = 0; k8 < EFF / 8; ++k8) s += dot8(a4[k8], b4[k8]);
                Y[(size_t)R * D + n] = (bf16)f2bf(s * w);
            }
            }
            GRID_BAR(pb + 7);
        }
        if (IN(pb + 8)) for (int rep_ = 0; rep_ <= (int)((REPEAT_MASK >> (pb + 8)) & 1u); ++rep_) { c = fresh_ctx(ldsp);
            build_tab(c, cnt);
            if (L == 0) { combine_phase(c, X, Y, RT, (const LAS int*)(c.lds + TAB_OFF), norm_mix + D, XN, nullptr);
                convert_moe(c, moe_w1 + (size_t)NEXP * D * EFF, moe_w3 + (size_t)NEXP * D * EFF, moe_w2 + (size_t)NEXP * EFF * D, W13, W2); }
            else { combine_phase(c, X, Y, RT, (const LAS int*)(c.lds + TAB_OFF), final_norm, nullptr, X);
                if (PROBE_EN && blockIdx.x == 0) {
                    __syncthreads();
                    const unsigned now = (unsigned)__builtin_amdgcn_s_memrealtime();
                    const unsigned a0 = CTL[600 + PROBE_A0], a1 = (PROBE_A1 >= 18) ? now : CTL[600 + PROBE_A1], b0 = CTL[600 + PROBE_B0], b1 = (PROBE_B1 >= 18) ? now : CTL[600 + PROBE_B1];
                    const float da = (float)(a1 - a0) * 0.01f, db = (float)(b1 - b0) * 0.01f;
                    for (int kk = c.lane; kk < D; kk += 64) X[(size_t)c.wave * D + kk] += sqrtf(da * 2.f);
                    if (c.tid == 0) X[(size_t)(8 * gridDim.x) * D] = db;
                }
#if GLA_EXPERIMENT
                { const unsigned bad = CTL[512], vb = CTL[513];
                  int k = 0; if (bad > 0u) k = 1; if (bad > 125u) k = 2; if (bad > 1258u) k = 3; if (bad > 12582u) k = 4; if (bad > 125829u) k = 5; if (bad > 1258291u) k = 6;
                  float f = vb > 0u ? 2.f : 1.f + 0.1f * (float)k; if (CTL[514] > 0u) f = 3.f; if (CTL[515] > 0u) f = 4.f; if (CTL[516] > 0u) f = 4.5f; if (CTL[517] > 0u) f = 5.f;
                  if (k > 0 || vb > 0u) { __syncthreads();
                    for (int t = c.gw; t < NTOK; t += c.ngw) for (int kk = c.lane; kk < D; kk += 64) X[(size_t)t * D + kk] *= f; } }
#endif
            }
            if (L == 0) GRID_BAR(pb + 8);
        }
    }
#undef IN
}

template <int P> static void launch_phases(int grid, hipStream_t stream, const Args& a) {
    if constexpr (P < NPHASES) {
        if constexpr (P != 3 && P != 4) {
            static bool attr_done = false;
            if (!attr_done) { (void)hipFuncSetAttribute((const void*)mk_fwd<P, P + 1>, hipFuncAttributeMaxDynamicSharedMemorySize, LDS_BYTES); attr_done = true; }
            hipLaunchKernelGGL((mk_fwd<P, P + 1>), dim3(grid), dim3(NTHREADS), LDS_BYTES, stream, a);
        }
        launch_phases<P + 1>(grid, stream, a);
    }
}
extern "C" void kernel_launch(void* const* d_in, const int* in_sizes, int n_in, void* d_out, int out_size, void* d_ws, size_t ws_size, hipStream_t stream) {
    static int grid = 0;
    if (grid == 0) {
        if (n_in != 21 || out_size != NTOK * D || ws_size < WS_END) { fprintf(stderr, "kernel_launch: unexpected shapes n_in %d out %d ws %zu (need %zu)\n", n_in, out_size, ws_size, (size_t)WS_END); grid = -1; return; }
        int dev = 0, cus = 0;
        if (hipGetDevice(&dev) != hipSuccess || hipDeviceGetAttribute(&cus, hipDeviceAttributeMultiprocessorCount, dev) != hipSuccess) { grid = -1; return; }
        (void)hipGetLastError();
        grid = cus;
    }
    if (grid < 0) return;
    (void)hipMemsetAsync((char*)d_ws + WS_CTL, 0, CTL_ZERO_BYTES, stream);
    Args a{};
    for (int i = 0; i < 21; ++i) a.in[i] = (const float*)d_in[i];
    a.out = (float*)d_out; a.ws = (unsigned char*)d_ws;
#if defined(MK_PER_PHASE)
    launch_phases<0>(grid, stream, a);
#else
    static bool attr_done = false;
    if (!attr_done) { (void)hipFuncSetAttribute((const void*)mk_fwd<0, NPHASES>, hipFuncAttributeMaxDynamicSharedMemorySize, LDS_BYTES); attr_done = true; }
    hipLaunchKernelGGL((mk_fwd<0, NPHASES>), dim3(grid), dim3(NTHREADS), LDS_BYTES, stream, a);
#endif
}
```

```cpp
#include <hip/hip_runtime.h>
#ifndef REPEAT_MASK
#define REPEAT_MASK 0u
#endif
#ifndef PROBE_EN
#define PROBE_EN 0
#define PROBE_A0 -1
#define PROBE_A1 0
#define PROBE_B0 8
#define PROBE_B1 9
#endif
#define GLA_INTRA_ONLY 0
#include <cstdio>
#include <cstdint>

constexpr int D = 1024, NTOK = 16384, SEQ = 4096, NBATCH = 4, NMEM = 256, HD = 64;
constexpr int MIX = 768, MEMD = 256, NA_H = 12, NA_IN = 2560;
constexpr int GLA_H = 4, GLA_DK = 96, GLA_DV = 192, GLA_IN = 2592, GLA_KD = 384;
constexpr int NEXP = 32, EFF = 512;
constexpr int LDU0 = 2560, LDU1 = 2816;
constexpr int MAXROWS = 40960;
constexpr float EPS = 1e-6f;

typedef unsigned short bf16;
typedef float f32x4 __attribute__((ext_vector_type(4)));
typedef unsigned u32x4 __attribute__((ext_vector_type(4)));
typedef unsigned u32x2 __attribute__((ext_vector_type(2)));
#define LAS __attribute__((address_space(3)))

constexpr size_t MiB = 1048576;
constexpr size_t WS_CTL = 0;
constexpr size_t CTL_ZERO_BYTES = 1 * MiB;
constexpr size_t WS_WIN0 = 1 * MiB;
constexpr size_t WS_WIN1 = WS_WIN0 + (size_t)2560 * 1024 * 2;
constexpr size_t WS_WOUT = WS_WIN1 + (size_t)2816 * 1024 * 2;
constexpr size_t WS_WMKV = WS_WOUT + (size_t)2 * 1024 * 1024 * 2;
constexpr size_t WS_MEMN = WS_WMKV + (size_t)1024 * 1024 * 2;
constexpr size_t WS_MKV = WS_MEMN + (size_t)1024 * 1024 * 2;
constexpr size_t WS_WR = 23 * MiB;
constexpr size_t WS_W13 = 24 * MiB;
constexpr size_t WS_W2 = WS_W13 + 64 * MiB;
constexpr size_t WS_XN = WS_W2 + 32 * MiB;
constexpr size_t WS_U = WS_XN + 32 * MiB;
constexpr size_t WS_Y = WS_U;
constexpr size_t WS_CAT = WS_U + 88 * MiB;
constexpr size_t WS_ACT = WS_CAT + 32 * MiB;
constexpr size_t WS_ROUTE = WS_ACT + 40 * MiB;
constexpr size_t WS_S = WS_ROUTE + 8 * MiB;
constexpr size_t WS_END = WS_S + 176 * MiB;
static_assert(WS_MKV + (size_t)1024 * 1024 * 2 <= WS_WR, "ws map");
static_assert(WS_END <= 512 * MiB, "ws map");
constexpr size_t RT_TOKE = 0, RT_TOKW = 131072, RT_TOKP = 262144, RT_LIST = 524288, RT_LISTW = 524288 + 2 * MiB;
constexpr int CW_CNT = 1024;
constexpr int CW_BAR = 4096;

struct Args {
    const float* in[21]; float* out; unsigned char* ws; int ph_lo, ph_hi;
};

__device__ __forceinline__ float bf2f(bf16 v) { return __uint_as_float(((unsigned)v) << 16); }
__device__ __forceinline__ unsigned f2bf(float f) { unsigned u = __float_as_uint(f); return (u + 0x7fffu + ((u >> 16) & 1u)) >> 16; }
__device__ __forceinline__ unsigned pk2(float lo, float hi) { return f2bf(lo) | (f2bf(hi) << 16); }
__device__ __forceinline__ float wave_sum(float v) {
#pragma unroll
    for (int o = 1; o < 64; o <<= 1) v += __shfl_xor(v, o);
    return v;
}
__device__ __forceinline__ float dot8(u32x4 a, u32x4 b) {
    float s = 0.f;
#pragma unroll
    for (int i = 0; i < 4; ++i) {
        s += __uint_as_float(a[i] << 16) * __uint_as_float(b[i] << 16);
        s += __uint_as_float(a[i] & 0xffff0000u) * __uint_as_float(b[i] & 0xffff0000u);
    }
    return s;
}
__device__ __forceinline__ float silu(float x) { return x / (1.f + __expf(-x)); }

struct Ctx {
    int tid, lane, wave, gw, ngw;
    LAS unsigned char* lds;
};
__device__ __forceinline__ Ctx fresh_ctx(LAS unsigned char* lds) {
    Ctx c; int t = threadIdx.x; asm volatile("" : "+v"(t)); int b = blockIdx.x; asm volatile("" : "+s"(b));
    c.tid = t; c.lane = t & 63; c.wave = __builtin_amdgcn_readfirstlane(t >> 6); c.gw = b * 8 + c.wave; c.ngw = gridDim.x * 8; c.lds = lds; return c;
}
__device__ __forceinline__ long gtid_() { int t = threadIdx.x; asm volatile("" : "+v"(t)); int b = blockIdx.x; asm volatile("" : "+s"(b)); return (long)(b * 512 + t); }
#define GTID gtid_()
#define GSIZE ((long)gridDim.x * 512)

__device__ __forceinline__ void transpose_item(const float* W, int N, int k0, int n0, bf16* dstrow0, int Kd, LAS float* scr, int lane) {
    f32x4 v[8]; const int lr = lane >> 3, lc = (lane & 7) * 4;
#pragma unroll
    for (int i = 0; i < 8; ++i) v[i] = *(const f32x4*)(W + (size_t)(k0 + 8 * i + lr) * N + n0 + lc);
#pragma unroll
    for (int i = 0; i < 8; ++i) { LAS float* s = scr + (8 * i + lr) * 33 + lc; s[0] = v[i][0]; s[1] = v[i][1]; s[2] = v[i][2]; s[3] = v[i][3]; }
    asm volatile("s_waitcnt lgkmcnt(0)" ::: "memory");
    const int c = lane & 7;
#pragma unroll
    for (int j = 0; j < 4; ++j) { const int n = (lane >> 3) + 8 * j; const LAS float* s = scr + (8 * c) * 33 + n;
        u32x4 o; o.x = pk2(s[0 * 33], s[1 * 33]); o.y = pk2(s[2 * 33], s[3 * 33]); o.z = pk2(s[4 * 33], s[5 * 33]); o.w = pk2(s[6 * 33], s[7 * 33]);
        *(u32x4*)(dstrow0 + (size_t)n * Kd + k0 + 8 * c) = o; }
    asm volatile("s_waitcnt lgkmcnt(0)" ::: "memory");
}
__device__ __forceinline__ void transpose_matrix(const Ctx& c, const float* W, int K, int N, bf16* dst, int it0, int itstride) {
    LAS float* scr = (LAS float*)(c.lds + c.wave * 16384);
    const int nblk = N / 32, nit = (K / 64) * nblk;
    for (int it = it0; it < nit; it += itstride) { const int kb = it / nblk, nb = it % nblk;
        transpose_item(W, N, kb * 64, nb * 32, dst + (size_t)(nb * 32) * K, K, scr, c.lane); }
}
__device__ __forceinline__ void convert_moe(const Ctx& c, const float* w1, const float* w3, const float* w2, bf16* W13, bf16* W2, int w0) {
    if (c.wave < w0) return;
    LAS float* scr = (LAS float*)(c.lds + c.wave * 16384);
    const int per_e = 768;
    const int nwv = 8 - w0;
    for (int it = blockIdx.x * nwv + (c.wave - w0); it < NEXP * per_e; it += gridDim.x * nwv) {
        const int e = it / per_e, r = it % per_e, which = r / 256, q = r % 256;
        if (which < 2) {
            const int kb = q / 16, nb = q % 16, n0 = nb * 32;
            const float* W = (which == 0 ? w1 : w3) + (size_t)e * 1024 * 512;
            const int drow = (n0 / 128) * 256 + which * 128 + (n0 % 128);
            transpose_item(W, 512, kb * 64, n0, W13 + ((size_t)e * 1024 + drow) * 1024, 1024, scr, c.lane);
        } else {
            const int kb = q / 32, nb = q % 32, n0 = nb * 32;
            const float* W = w2 + (size_t)e * 512 * 1024;
            transpose_item(W, 1024, kb * 64, n0, W2 + ((size_t)e * 1024 + n0) * 512, 512, scr, c.lane);
        }
    }
}
__device__ __forceinline__ void rms_row_to_bf16(const float* xrow, const float* g, bf16* orow, int lane) {
    const f32x4* xr = (const f32x4*)xrow + lane; const f32x4* gr = (const f32x4*)g + lane;
    f32x4 v[4]; float s = 0.f;
#pragma unroll
    for (int j = 0; j < 4; ++j) { v[j] = xr[64 * j]; s += (v[j].x * v[j].x + v[j].y * v[j].y) + (v[j].z * v[j].z + v[j].w * v[j].w); }
    const float r = 1.f / sqrtf(wave_sum(s) * (1.f / D) + EPS);
    u32x2* o8 = (u32x2*)orow + lane;
#pragma unroll
    for (int j = 0; j < 4; ++j) { const f32x4 gg = gr[64 * j]; u32x2 w; w.x = pk2(v[j].x * r * gg.x, v[j].y * r * gg.y); w.y = pk2(v[j].z * r * gg.z, v[j].w * r * gg.w); o8[64 * j] = w; }
}

template <class RowA, class Epi>
__device__ __forceinline__ void naive_gemm(const Ctx& c, int M, int N, int K, const RowA& rowA, const bf16* Bt, const Epi& epi) {
    const long total = (long)M * N;
    for (long idx = GTID; idx < total; idx += GSIZE) {
        const int m = (int)(idx / N), n = (int)(idx % N);
        const bf16* a = rowA(m);
        if (a == nullptr) continue;
        const u32x4* a4 = (const u32x4*)a; const u32x4* b4 = (const u32x4*)(Bt + (size_t)n * K);
        float acc = 0.f;
        for (int k8 = 0; k8 < K / 8; ++k8) acc += dot8(a4[k8], b4[k8]);
        epi(m, n, acc);
    }
}


namespace pg8 {
typedef short bf16x8 __attribute__((ext_vector_type(8)));
constexpr int BM = 256, BK = 64, HALF = 128, HTB = HALF * BK * 2, STAGE_BYTES = 8 * HTB, NXCD = 8, WGM = 8;
__device__ __forceinline__ int lds_byte(int r, int c) { const int st = (r >> 4) * 2 + (c >> 5), rr = r & 15, cc = c & 31, ob = rr * 64 + cc * 2; return st * 1024 + (ob ^ (((ob >> 9) & 1) << 5)); }
__device__ __forceinline__ void stage_rc(int b, int& R, int& C) { const int st = b / 1024, sb = b % 1024, swz = sb ^ (((sb >> 9) & 1) << 5); R = (st >> 1) * 16 + swz / 64; C = (st & 1) * 32 + (swz % 64) / 2; }
__device__ __forceinline__ int perm32(int rho) { const int n = rho >> 4, i = rho & 15; return 8 * (i >> 2) + 4 * n + (i & 3); }
typedef __bf16 bf16v2_t __attribute__((ext_vector_type(2)));
__device__ __forceinline__ unsigned cvt_pk_bf16(float lo, float hi) { const bf16v2_t v = {(__bf16)lo, (__bf16)hi}; return __builtin_bit_cast(unsigned, v); }

struct Unit { int pm, pn, e, nv; };

struct StaticOrder {
    const bf16* A; const bf16* Bt; int K, nM, nN, nwg, G, c;
    __device__ void init(const bf16* A_, const bf16* Bt_, int M, int N, int K_, int G_, int c_) { A = A_; Bt = Bt_; K = K_; nM = M / BM; nN = N / BM; nwg = nM * nN; G = G_; c = c_; }
    __device__ __forceinline__ bool next(int i, Unit& u) const {
        const long L = (long)i * G + c; if (L >= nwg) return false;
        int wgid = (int)L; { const int q = nwg / NXCD, r = nwg % NXCD, xcd = wgid % NXCD, off = wgid / NXCD; wgid = (xcd < r ? xcd * (q + 1) : r * (q + 1) + (xcd - r) * q) + off; }
        const int nig = WGM * nN, gid = wgid / nig, fm = gid * WGM, gsz = (nM - fm) < WGM ? (nM - fm) : WGM;
        u.pm = fm + ((wgid % nig) % gsz); u.pn = (wgid % nig) / gsz; u.e = 0; u.nv = 256; return true;
    }
    __device__ __forceinline__ const char* a_base(const Unit& u) const { return (const char*)A + (size_t)u.pm * BM * K * 2; }
    __device__ __forceinline__ const char* b_base(const Unit& u) const { return (const char*)Bt + (size_t)u.pn * BM * K * 2; }
    __device__ __forceinline__ const int* rows(const Unit&) const { return nullptr; }
};
struct MoeOrder {
    const LAS int* tab; const bf16* A; const bf16* Bt; const int* list; int K, ntn, G, c; bool gather;
    __device__ __forceinline__ bool next(int i, Unit& u) const {
        const int L = i * G + c, total = tab[32] * ntn; if (L >= total) return false;
        const int T = L / ntn; int e = 0;
        for (int x = 1; x < 32; ++x) e = (tab[x] <= T) ? x : e;
        u.pm = T; u.pn = L % ntn; u.e = e; u.nv = tab[64 + e] - (T - tab[e]) * 256; return true;
    }
    __device__ __forceinline__ const char* a_base(const Unit& u) const { return gather ? (const char*)A : (const char*)A + (size_t)u.pm * BM * K * 2; }
    __device__ __forceinline__ const char* b_base(const Unit& u) const { return (const char*)Bt + ((size_t)u.e * 1024 + (size_t)u.pn * BM) * K * 2; }
    __device__ __forceinline__ const int* rows(const Unit& u) const { return list + (size_t)u.e * NTOK + (u.pm - tab[u.e]) * 256; }
};

struct EpiBf16 {
    static constexpr bool PERM = true;
    bf16* O; int ldc;
    __device__ __forceinline__ void operator()(const f32x4 (&acc)[2][2][4][2], const Unit& u, int wr, int wc, int fr, int fq) const {
        const int row0 = u.pm * BM + wr * 64 + fr, col0 = u.pn * BM + wc * 32 + 8 * fq;
#pragma unroll
        for (int ai = 0; ai < 2; ++ai)
#pragma unroll
            for (int m = 0; m < 4; ++m) { bf16* rowp = O + (size_t)(row0 + ai * HALF + m * 16) * ldc + col0;
#pragma unroll
                for (int bj = 0; bj < 2; ++bj) { const f32x4 v0 = acc[ai][bj][m][0], v1 = acc[ai][bj][m][1];
                    u32x4 w; w.x = cvt_pk_bf16(v0[0], v0[1]); w.y = cvt_pk_bf16(v0[2], v0[3]); w.z = cvt_pk_bf16(v1[0], v1[1]); w.w = cvt_pk_bf16(v1[2], v1[3]);
                    *(u32x4*)(rowp + bj * HALF) = w; } }
    }
};
struct EpiResF32 {
    static constexpr bool PERM = false;
    const float* R; float* C;
    __device__ __forceinline__ void operator()(const f32x4 (&acc)[2][2][4][2], const Unit& u, int wr, int wc, int fr, int fq) const {
        const int row0 = u.pm * BM + wr * 64 + fr, col0 = u.pn * BM + wc * 32 + 4 * fq;
#pragma unroll
        for (int ai = 0; ai < 2; ++ai)
#pragma unroll
            for (int m = 0; m < 4; ++m) { const size_t off = (size_t)(row0 + ai * HALF + m * 16) * D + col0;
#pragma unroll
                for (int bj = 0; bj < 2; ++bj)
#pragma unroll
                    for (int n = 0; n < 2; ++n) { const f32x4 rv = *(const f32x4*)(R + off + bj * HALF + n * 16); *(f32x4*)(C + off + bj * HALF + n * 16) = rv + acc[ai][bj][m][n]; }
                asm volatile("" ::: "memory"); }
    }
};
struct EpiSwiGLU {
    static constexpr bool PERM = true;
    bf16* O;
    __device__ __forceinline__ void operator()(const f32x4 (&acc)[2][2][4][2], const Unit& u, int wr, int wc, int fr, int fq) const {
        const int row0 = u.pm * BM + wr * 64 + fr, col0 = u.pn * 128 + wc * 32 + 8 * fq;
#pragma unroll
        for (int ai = 0; ai < 2; ++ai)
#pragma unroll
            for (int m = 0; m < 4; ++m) { float o[8];
#pragma unroll
                for (int n = 0; n < 2; ++n)
#pragma unroll
                    for (int i = 0; i < 4; ++i) { const float a = acc[ai][0][m][n][i], b = acc[ai][1][m][n][i]; o[n * 4 + i] = a * b * __builtin_amdgcn_rcpf(1.f + __expf(-a)); }
                u32x4 w; w.x = cvt_pk_bf16(o[0], o[1]); w.y = cvt_pk_bf16(o[2], o[3]); w.z = cvt_pk_bf16(o[4], o[5]); w.w = cvt_pk_bf16(o[6], o[7]);
                *(u32x4*)(O + (size_t)(row0 + ai * HALF + m * 16) * EFF + col0) = w; }
    }
};
struct EpiScaleBf16 {
    static constexpr bool PERM = true;
    bf16* O; const float* listw; const LAS int* tab;
    __device__ __forceinline__ void operator()(const f32x4 (&acc)[2][2][4][2], const Unit& u, int wr, int wc, int fr, int fq) const {
        const int rl0 = wr * 64 + fr, col0 = u.pn * BM + wc * 32 + 8 * fq;
        const float* lw = listw + (size_t)u.e * NTOK + (u.pm - tab[u.e]) * 256;
        float wv[2][4];
#pragma unroll
        for (int ai = 0; ai < 2; ++ai)
#pragma unroll
            for (int m = 0; m < 4; ++m) { const int rl = rl0 + ai * HALF + m * 16; wv[ai][m] = rl < u.nv ? lw[rl] : 0.f; }
#pragma unroll
        for (int ai = 0; ai < 2; ++ai)
#pragma unroll
            for (int m = 0; m < 4; ++m) { bf16* rowp = O + (size_t)(u.pm * BM + rl0 + ai * HALF + m * 16) * D + col0; const float s = wv[ai][m];
#pragma unroll
                for (int bj = 0; bj < 2; ++bj) { const f32x4 v0 = acc[ai][bj][m][0] * s, v1 = acc[ai][bj][m][1] * s;
                    u32x4 w; w.x = cvt_pk_bf16(v0[0], v0[1]); w.y = cvt_pk_bf16(v0[2], v0[3]); w.z = cvt_pk_bf16(v1[0], v1[1]); w.w = cvt_pk_bf16(v1[2], v1[3]);
                    *(u32x4*)(rowp + bj * HALF) = w; } }
    }
};

template <class Epi, class Sched, bool GATHER>
__device__ __forceinline__ void gemm_phase(LAS unsigned char* lds, const int K, const Sched& S, const Epi& E) {
    int tid_ = threadIdx.x; asm volatile("" : "+v"(tid_));
    const int tid = tid_, wid = __builtin_amdgcn_readfirstlane(tid >> 6), lane = tid & 63, wr = wid >> 2, wc = wid & 3, fr = lane & 15, fq = lane >> 4;
    const int nt = K / BK;
    int Rr[2], Cc[2]; unsigned voffB[2];
#pragma unroll
    for (int i = 0; i < 2; ++i) { int R, C; stage_rc(tid * 16 + i * 8192, R, C); Rr[i] = R; Cc[i] = C; const int Rb = Epi::PERM ? ((R & ~31) + perm32(R & 31)) : R; voffB[i] = (unsigned)(Rb * K + C) * 2u; }
    const size_t kstep = (size_t)(BK * 2);
    const size_t hstep = (size_t)HALF * K * 2;
    const size_t hstepA = GATHER ? 0 : hstep;
    const unsigned ldsw = (unsigned)wid * 1024u;
    const int aoff = lds_byte(wr * 64 + fr, fq * 8), boff = lds_byte(wc * 32 + fr, fq * 8);
#define PG8_SA(b, h) (((b) * 2 + (h)) * HTB)
#define PG8_SB(b, h) ((4 + (b) * 2 + (h)) * HTB)
#define PG8_STAGE(bufoff, gbase, voff) do { _Pragma("unroll") for (int _i = 0; _i < 2; ++_i) \
        __builtin_amdgcn_global_load_lds((const unsigned*)((const char*)(gbase) + (voff)[_i]), (LAS unsigned*)(lds + (bufoff) + ldsw + _i * 8192), 16, 0, 0); } while (0)
#define PG8_LDA(dst, b, h) do { _Pragma("unroll") for (int m = 0; m < 4; ++m) _Pragma("unroll") for (int k = 0; k < 2; ++k) dst[m][k] = *(const LAS bf16x8*)(lds + PG8_SA(b, h) + aoff + m * 2048 + k * 1024); } while (0)
#define PG8_LDB(dst, b, h) do { _Pragma("unroll") for (int n = 0; n < 2; ++n) _Pragma("unroll") for (int k = 0; k < 2; ++k) dst[n][k] = *(const LAS bf16x8*)(lds + PG8_SB(b, h) + boff + n * 2048 + k * 1024); } while (0)
#define PG8_MMA(ai, bj, At, Bt) do { __builtin_amdgcn_s_setprio(1); _Pragma("unroll") for (int m = 0; m < 4; ++m) _Pragma("unroll") for (int n = 0; n < 2; ++n) _Pragma("unroll") for (int k = 0; k < 2; ++k) \
        acc[ai][bj][m][n] = __builtin_amdgcn_mfma_f32_16x16x32_bf16(Bt[n][k], At[m][k], acc[ai][bj][m][n], 0, 0, 0); __builtin_amdgcn_s_setprio(0); } while (0)
#define PG8_WAIT_V(n) asm volatile("s_waitcnt vmcnt(" #n ")" ::: "memory")
#define PG8_WAIT_L(n) asm volatile("s_waitcnt lgkmcnt(" #n ")" ::: "memory")
#define PG8_BAR __builtin_amdgcn_s_barrier()
#define PG8_SCHED __builtin_amdgcn_sched_barrier(0)
#define PG8_VOFFA(u, v0, v1) do { if constexpr (GATHER) { const int* _rw = S.rows(u); _Pragma("unroll") for (int _i = 0; _i < 2; ++_i) { \
            const int _r0 = Rr[_i], _r1 = Rr[_i] + HALF; const int _t0 = _rw[_r0 < (u).nv ? _r0 : 0], _t1 = _rw[_r1 < (u).nv ? _r1 : 0]; \
            v0[_i] = (unsigned)(_t0 * K + Cc[_i]) * 2u; v1[_i] = (unsigned)(_t1 * K + Cc[_i]) * 2u; } } \
        else { _Pragma("unroll") for (int _i = 0; _i < 2; ++_i) { v0[_i] = (unsigned)(Rr[_i] * K + Cc[_i]) * 2u; v1[_i] = v0[_i]; } } } while (0)
    Unit cur, nxt; int ui = 0;
    if (!S.next(0, cur)) return;
    f32x4 acc[2][2][4][2];
#pragma unroll
    for (int a = 0; a < 2; ++a)
#pragma unroll
        for (int b = 0; b < 2; ++b)
#pragma unroll
            for (int m = 0; m < 4; ++m)
#pragma unroll
                for (int n = 0; n < 2; ++n) acc[a][b][m][n] = (f32x4){0.f, 0.f, 0.f, 0.f};
    bf16x8 At[4][2], B0[2][2], B1[2][2];
    const char* cA = S.a_base(cur); const char* cB = S.b_base(cur);
    unsigned cv0[2], cv1[2], nv0[2], nv1[2];
    PG8_VOFFA(cur, cv0, cv1);
    PG8_STAGE(PG8_SB(0, 0), cB, voffB); PG8_STAGE(PG8_SB(0, 1), cB + hstep, voffB); PG8_STAGE(PG8_SA(0, 0), cA, cv0); PG8_STAGE(PG8_SA(0, 1), cA + hstepA, cv1);
    if (wr == 1) PG8_BAR;
    PG8_WAIT_V(2); PG8_BAR;
    PG8_STAGE(PG8_SB(1, 0), cB + kstep, voffB); PG8_STAGE(PG8_SA(1, 0), cA + kstep, cv0); PG8_STAGE(PG8_SB(1, 1), cB + hstep + kstep, voffB);
    PG8_WAIT_V(6); PG8_BAR;
    for (;;) {
        const bool has_next = S.next(ui + 1, nxt);
        const char* nA = has_next ? S.a_base(nxt) : cA; const char* nB = has_next ? S.b_base(nxt) : cB;
        if (has_next) { PG8_VOFFA(nxt, nv0, nv1); } else {
#pragma unroll
            for (int i = 0; i < 2; ++i) { nv0[i] = cv0[i]; nv1[i] = cv1[i]; } }
        for (int t = 0; t < nt; t += 2) {
            const bool last = (t == nt - 2);
            const char* a1 = cA + (size_t)(t + 1) * kstep;
            const char* a2 = last ? nA : cA + (size_t)(t + 2) * kstep; const char* b2 = last ? nB : cB + (size_t)(t + 2) * kstep;
            const char* a3 = a2 + kstep; const char* b3 = b2 + kstep;
            unsigned s0[2], s1[2];
#pragma unroll
            for (int i = 0; i < 2; ++i) { s0[i] = last ? nv0[i] : cv0[i]; s1[i] = last ? nv1[i] : cv1[i]; }
            PG8_LDB(B0, 0, 0); PG8_LDB(B1, 0, 1); PG8_SCHED; PG8_LDA(At, 0, 0); PG8_STAGE(PG8_SA(1, 1), a1 + hstepA, cv1);
            PG8_WAIT_V(8); PG8_WAIT_L(0); PG8_BAR; PG8_MMA(0, 0, At, B0); PG8_MMA(0, 1, At, B1); PG8_BAR; PG8_SCHED;
            PG8_LDA(At, 0, 1); PG8_STAGE(PG8_SB(0, 0), b2, voffB); PG8_STAGE(PG8_SB(0, 1), b2 + hstep, voffB); PG8_STAGE(PG8_SA(0, 0), a2, s0);
            PG8_WAIT_V(8); PG8_WAIT_L(0); PG8_BAR; PG8_MMA(1, 0, At, B0); PG8_MMA(1, 1, At, B1); PG8_BAR; PG8_SCHED;
            PG8_LDB(B0, 1, 0); PG8_LDB(B1, 1, 1); PG8_SCHED; PG8_LDA(At, 1, 0); PG8_STAGE(PG8_SA(0, 1), a2 + hstepA, s1);
            PG8_WAIT_V(8); PG8_WAIT_L(0); PG8_BAR; PG8_MMA(0, 0, At, B0); PG8_MMA(0, 1, At, B1); PG8_BAR; PG8_SCHED;
            PG8_LDA(At, 1, 1); PG8_STAGE(PG8_SB(1, 0), b3, voffB); PG8_STAGE(PG8_SB(1, 1), b3 + hstep, voffB); PG8_STAGE(PG8_SA(1, 0), a3, s0);
            PG8_WAIT_V(8); PG8_WAIT_L(0); PG8_BAR; PG8_MMA(1, 0, At, B0); PG8_MMA(1, 1, At, B1); PG8_BAR; PG8_SCHED;
        }
        if (wr == 0) PG8_BAR;
        E(acc, cur, wr, wc, fr, fq);
        if (!has_next) break;
#pragma unroll
        for (int a = 0; a < 2; ++a)
#pragma unroll
            for (int b = 0; b < 2; ++b)
#pragma unroll
                for (int m = 0; m < 4; ++m)
#pragma unroll
                    for (int n = 0; n < 2; ++n) acc[a][b][m][n] = (f32x4){0.f, 0.f, 0.f, 0.f};
        cur = nxt; cA = nA; cB = nB; ++ui;
#pragma unroll
        for (int i = 0; i < 2; ++i) { cv0[i] = nv0[i]; cv1[i] = nv1[i]; }
        if (wr == 1) PG8_BAR;
    }
    PG8_WAIT_V(0);
    PG8_BAR;
#undef PG8_SA
#undef PG8_SB
#undef PG8_STAGE
#undef PG8_LDA
#undef PG8_LDB
#undef PG8_MMA
#undef PG8_WAIT_V
#undef PG8_WAIT_L
#undef PG8_BAR
#undef PG8_SCHED
#undef PG8_VOFFA
}
}

__device__ __forceinline__ void naive_na(const Ctx& c, const bf16* U, const float* rpb, bf16* CAT) {
    const long total = (long)NTOK * NA_H;
    for (long idx = GTID; idx < total; idx += GSIZE) {
        const int h = (int)(idx % NA_H), t = (int)(idx / NA_H);
        const int b = t / SEQ, p = t % SEQ, r = p / 64, cc = p % 64;
        const int rs = min(max(r - 4, 0), 56), cs = min(max(cc - 8, 0), 48);
        const u32x4* q4 = (const u32x4*)(U + (size_t)t * LDU0 + h * 64);
        float acc[64];
#pragma unroll
        for (int i = 0; i < 64; ++i) acc[i] = 0.f;
        float mx = -1e30f, l = 0.f;
        for (int i = 0; i < 8; ++i) for (int j = 0; j < 16; ++j) {
            const int kr = rs + i, kc = cs + j, kt = b * SEQ + kr * 64 + kc;
            const u32x4* k4 = (const u32x4*)(U + (size_t)kt * LDU0 + 768 + h * 64);
            float s = 0.f;
#pragma unroll
            for (int d8 = 0; d8 < 8; ++d8) s += dot8(q4[d8], k4[d8]);
            s = s * 0.125f + rpb[(h * 15 + (kr - r + 7)) * 31 + (kc - cc + 15)];
            const float mn = fmaxf(mx, s), alpha = __expf(mx - mn), pp = __expf(s - mn);
            l = l * alpha + pp; mx = mn;
            const u32x4* v4 = (const u32x4*)(U + (size_t)kt * LDU0 + 1536 + h * 64);
#pragma unroll
            for (int d8 = 0; d8 < 8; ++d8) { const u32x4 vv = v4[d8];
#pragma unroll
                for (int e = 0; e < 4; ++e) { acc[d8 * 8 + 2 * e] = acc[d8 * 8 + 2 * e] * alpha + pp * __uint_as_float(vv[e] << 16);
                    acc[d8 * 8 + 2 * e + 1] = acc[d8 * 8 + 2 * e + 1] * alpha + pp * __uint_as_float(vv[e] & 0xffff0000u); } }
        }
        const float inv = 1.f / l;
        u32x4* o4 = (u32x4*)(CAT + (size_t)t * D + h * 64);
#pragma unroll
        for (int d8 = 0; d8 < 8; ++d8) { u32x4 w; w.x = pk2(acc[d8 * 8] * inv, acc[d8 * 8 + 1] * inv); w.y = pk2(acc[d8 * 8 + 2] * inv, acc[d8 * 8 + 3] * inv);
            w.z = pk2(acc[d8 * 8 + 4] * inv, acc[d8 * 8 + 5] * inv); w.w = pk2(acc[d8 * 8 + 6] * inv, acc[d8 * 8 + 7] * inv); o4[d8] = w; }
    }
}
__device__ __forceinline__ void naive_memattn(const Ctx& c, const bf16* U, int ldu, int mqcol, const bf16* MKV, int lay, bf16* CAT) {
    const long total = (long)NTOK * 4;
    for (long idx = GTID; idx < total; idx += GSIZE) {
        const int h = (int)(idx % 4), t = (int)(idx / 4), b = t / SEQ;
        const u32x4* q4 = (const u32x4*)(U + (size_t)t * ldu + mqcol + h * 64);
        float acc[64];
#pragma unroll
        for (int i = 0; i < 64; ++i) acc[i] = 0.f;
        float mx = -1e30f, l = 0.f;
        for (int m = 0; m < NMEM; ++m) {
            const bf16* row = MKV + (size_t)(b * NMEM + m) * 1024 + lay * 512;
            const u32x4* k4 = (const u32x4*)(row + h * 64);
            float s = 0.f;
#pragma unroll
            for (int d8 = 0; d8 < 8; ++d8) s += dot8(q4[d8], k4[d8]);
            s *= 0.125f;
            const float mn = fmaxf(mx, s), alpha = __expf(mx - mn), pp = __expf(s - mn);
            l = l * alpha + pp; mx = mn;
            const u32x4* v4 = (const u32x4*)(row + 256 + h * 64);
#pragma unroll
            for (int d8 = 0; d8 < 8; ++d8) { const u32x4 vv = v4[d8];
#pragma unroll
                for (int e = 0; e < 4; ++e) { acc[d8 * 8 + 2 * e] = acc[d8 * 8 + 2 * e] * alpha + pp * __uint_as_float(vv[e] << 16);
                    acc[d8 * 8 + 2 * e + 1] = acc[d8 * 8 + 2 * e + 1] * alpha + pp * __uint_as_float(vv[e] & 0xffff0000u); } }
        }
        const float inv = 1.f / l;
        u32x4* o4 = (u32x4*)(CAT + (size_t)t * D + MIX + h * 64);
#pragma unroll
        for (int d8 = 0; d8 < 8; ++d8) { u32x4 w; w.x = pk2(acc[d8 * 8] * inv, acc[d8 * 8 + 1] * inv); w.y = pk2(acc[d8 * 8 + 2] * inv, acc[d8 * 8 + 3] * inv);
            w.z = pk2(acc[d8 * 8 + 4] * inv, acc[d8 * 8 + 5] * inv); w.w = pk2(acc[d8 * 8 + 6] * inv, acc[d8 * 8 + 7] * inv); o4[d8] = w; }
    }
}


namespace att {
typedef short bf16x8 __attribute__((ext_vector_type(8)));
typedef short s16x4 __attribute__((ext_vector_type(4)));
__device__ __forceinline__ s16x4 tr_read(LAS const unsigned char* p) { return __builtin_amdgcn_ds_read_tr16_b64_v4i16((LAS s16x4*)p); }
template <bool NA_MODE, class KRow, class Bias>
__device__ __forceinline__ void attn16x256(const bf16* qrow, const KRow& krow, LAS const unsigned char* vlane, int xs, const Bias& bias, bf16* orow, int fr, int fq) {
    const int p = fr & 3, ph = p >> 1, pl8 = (p & 1) * 8;
    const bf16x8 q0 = *(const bf16x8*)(qrow + 8 * fq), q1 = *(const bf16x8*)(qrow + 32 + 8 * fq);
    f32x4 s[16];
#pragma unroll
    for (int kt = 0; kt < 16; ++kt) {
        const bf16* kr = krow(kt);
        const bf16x8 k0 = *(const bf16x8*)(kr + 8 * fq), k1 = *(const bf16x8*)(kr + 32 + 8 * fq);
        f32x4 a = {0.f, 0.f, 0.f, 0.f};
        a = __builtin_amdgcn_mfma_f32_16x16x32_bf16(k0, q0, a, 0, 0, 0);
        a = __builtin_amdgcn_mfma_f32_16x16x32_bf16(k1, q1, a, 0, 0, 0);
        s[kt] = a;
    }
    float mx = -3.0e38f;
#pragma unroll
    for (int kt = 0; kt < 16; ++kt)
#pragma unroll
        for (int r = 0; r < 4; ++r) { const float v = bias(kt, r, s[kt][r]); s[kt][r] = v; mx = fmaxf(mx, v); }
    mx = fmaxf(mx, __shfl_xor(mx, 16)); mx = fmaxf(mx, __shfl_xor(mx, 32));
    float l = 0.f;
#pragma unroll
    for (int kt = 0; kt < 16; ++kt)
#pragma unroll
        for (int r = 0; r < 4; ++r) { const float pv = __expf(s[kt][r] - mx); s[kt][r] = pv; l += pv; }
    l += __shfl_xor(l, 16); l += __shfl_xor(l, 32);
    LAS const unsigned char* vb[4];
#pragma unroll
    for (int dt = 0; dt < 4; ++dt) vb[dt] = vlane + (((2 * dt + ph) ^ xs) << 4) + pl8;
    f32x4 o[4];
#pragma unroll
    for (int dt = 0; dt < 4; ++dt) o[dt] = (f32x4){0.f, 0.f, 0.f, 0.f};
#pragma unroll
    for (int j = 0; j < 8; ++j) {
        u32x4 pw; pw.x = pg8::cvt_pk_bf16(s[2 * j][0], s[2 * j][1]); pw.y = pg8::cvt_pk_bf16(s[2 * j][2], s[2 * j][3]);
        pw.z = pg8::cvt_pk_bf16(s[2 * j + 1][0], s[2 * j + 1][1]); pw.w = pg8::cvt_pk_bf16(s[2 * j + 1][2], s[2 * j + 1][3]);
        const bf16x8 pb = __builtin_bit_cast(bf16x8, pw);
        constexpr int dummy = 0; (void)dummy;
        const int c0 = NA_MODE ? (((2 * j) >> 1) * 64 + 16 * ((2 * j) & 1)) : 16 * (2 * j);
        const int c1 = NA_MODE ? (((2 * j + 1) >> 1) * 64 + 16 * ((2 * j + 1) & 1)) : 16 * (2 * j + 1);
#pragma unroll
        for (int dt = 0; dt < 4; ++dt) {
            const s16x4 lo = tr_read(vb[dt] + c0 * 128), hi = tr_read(vb[dt] + c1 * 128);
            const bf16x8 va = {lo[0], lo[1], lo[2], lo[3], hi[0], hi[1], hi[2], hi[3]};
            o[dt] = __builtin_amdgcn_mfma_f32_16x16x32_bf16(va, pb, o[dt], 0, 0, 0);
        }
    }
    const float inv = 1.f / l;
#pragma unroll
    for (int dt = 0; dt < 4; ++dt) { u32x2 w; w.x = pg8::cvt_pk_bf16(o[dt][0] * inv, o[dt][1] * inv); w.y = pg8::cvt_pk_bf16(o[dt][2] * inv, o[dt][3] * inv);
        *(u32x2*)(orow + 16 * dt + 4 * fq) = w; }
}

__device__ __forceinline__ void na_phase(const Ctx& c, const bf16* U, const float* rpb, bf16* CAT, int vcu, int G) {
    const int fr = c.lane & 15, fq = c.lane >> 4, j = c.wave & 3, hs = c.wave >> 2;
    for (int u = vcu; u < NBATCH * 6 * 64; u += G) {
        const int r = u & 63, hp = (u >> 6) % 6, b = u / 384, rs = min(max(r - 4, 0), 56);
        __syncthreads();
#pragma unroll 4
        for (int it = 0; it < 16; ++it) { const int idx = c.tid + 512 * it, hsel = idx >> 12, rem = idx & 4095, key = rem >> 3, ch = rem & 7;
            const u32x4 v = *(const u32x4*)(U + (size_t)(b * SEQ + (rs + (key >> 6)) * 64 + (key & 63)) * LDU0 + 1536 + (2 * hp + hsel) * 64 + ch * 8);
            *(LAS u32x4*)(c.lds + hsel * 65536 + key * 128 + ((ch ^ (key & 7)) << 4)) = v; }
        __syncthreads();
        const int h = 2 * hp + hs, cq = 16 * j + fr, cs = min(max(cq - 8, 0), 48), kc0 = min(max(16 * j - 8, 0), 32);
        const int tq = b * SEQ + r * 64 + cq;
        const bf16* qrow = U + (size_t)tq * LDU0 + h * 64;
        const bf16* kbase = U + (size_t)(b * SEQ + rs * 64 + kc0 + fr) * LDU0 + 768 + h * 64;
        const int rowb = kc0 + 4 * fq + (fr >> 2);
        LAS const unsigned char* vlane = c.lds + hs * 65536 + rowb * 128;
        const float* rp = rpb + (size_t)(h * 15 + (rs - r + 7)) * 31;
        attn16x256<true>(qrow, [&](int kt) { return kbase + (size_t)((kt >> 1) * 64 + 16 * (kt & 1)) * LDU0; }, vlane, rowb & 7,
            [&](int kt, int rg, float sv) { const int kcol = kc0 + 16 * (kt & 1) + 4 * fq + rg; const bool ok = (kcol >= cs) && (kcol < cs + 16);
                const int dc = min(max(kcol - cq + 15, 0), 30); const float bv = rp[(kt >> 1) * 31 + dc]; return ok ? sv * 0.125f + bv : -1.0e30f; },
            CAT + (size_t)tq * D + h * 64, fr, fq);
    }
}
__device__ __forceinline__ void mem_phase(const Ctx& c, const bf16* U, int ldu, int mqcol, const bf16* MKV, int lay, bf16* CAT, int vcu, int G) {
    const int fr = c.lane & 15, fq = c.lane >> 4;
    for (int u = vcu; u < NBATCH * 4 * 16; u += G) {
        const int tt = u & 15, h = (u >> 4) & 3, b = u >> 6;
        __syncthreads();
#pragma unroll
        for (int it = 0; it < 4; ++it) { const int idx = c.tid + 512 * it, key = idx >> 3, ch = idx & 7;
            const u32x4 v = *(const u32x4*)(MKV + (size_t)(b * NMEM + key) * 1024 + lay * 512 + 256 + h * 64 + ch * 8);
            *(LAS u32x4*)(c.lds + key * 128 + ((ch ^ (key & 7)) << 4)) = v; }
        __syncthreads();
        const bf16* kbase = MKV + (size_t)(b * NMEM + fr) * 1024 + lay * 512 + h * 64;
        const int rowb = 4 * fq + (fr >> 2);
        LAS const unsigned char* vlane = c.lds + rowb * 128;
#pragma unroll 1
        for (int it = 0; it < 2; ++it) {
            const int tq = b * SEQ + tt * 256 + c.wave * 32 + it * 16 + fr;
            attn16x256<false>(U + (size_t)tq * ldu + mqcol + h * 64, [&](int kt) { return kbase + (size_t)(16 * kt) * 1024; }, vlane, rowb & 7,
                [&](int, int, float sv) { return sv * 0.125f; }, CAT + (size_t)tq * D + MIX + h * 64, fr, fq);
        }
    }
}
}

__device__ __forceinline__ void route_phase(const Ctx& c, const float* X, const float* g, const float* wg, const float* bg, const float* wr, const float* br,
                                            bf16* HN, unsigned char* rt, unsigned* cnt) {
    int* TOKE = (int*)(rt + RT_TOKE); float* TOKW = (float*)(rt + RT_TOKW); int* TOKP = (int*)(rt + RT_TOKP); int* LIST = (int*)(rt + RT_LIST); float* LISTW = (float*)(rt + RT_LISTW);
    for (int t = c.gw; t < NTOK; t += c.ngw) {
        const f32x4* xr = (const f32x4*)(X + (size_t)t * D) + c.lane; const f32x4* gr = (const f32x4*)g + c.lane;
        f32x4 v[4]; float s = 0.f;
#pragma unroll
        for (int j = 0; j < 4; ++j) { v[j] = xr[64 * j]; s += (v[j].x * v[j].x + v[j].y * v[j].y) + (v[j].z * v[j].z + v[j].w * v[j].w); }
        const float r = 1.f / sqrtf(wave_sum(s) * (1.f / D) + EPS);
        u32x2* o8 = (u32x2*)(HN + (size_t)t * D) + c.lane;
#pragma unroll
        for (int j = 0; j < 4; ++j) { const f32x4 gg = gr[64 * j]; v[j].x *= r * gg.x; v[j].y *= r * gg.y; v[j].z *= r * gg.z; v[j].w *= r * gg.w;
            u32x2 w; w.x = pk2(v[j].x, v[j].y); w.y = pk2(v[j].z, v[j].w); o8[64 * j] = w; }
        LAS float* hrow = (LAS float*)(c.lds + c.wave * 16384);
#pragma unroll
        for (int j = 0; j < 4; ++j) *(LAS f32x4*)(hrow + 4 * c.lane + 256 * j) = v[j];
        asm volatile("s_waitcnt lgkmcnt(0)" ::: "memory");
        float lg[4], lr[32];
#pragma unroll
        for (int o = 0; o < 4; ++o) lg[o] = 0.f;
#pragma unroll
        for (int o = 0; o < 32; ++o) lr[o] = 0.f;
#pragma unroll 1
        for (int kk = 0; kk < 16; ++kk) { const int k = c.lane + 64 * kk; const float xv = hrow[k];
            const f32x4 w4 = *(const f32x4*)(wg + (size_t)k * 4);
#pragma unroll
            for (int o = 0; o < 4; ++o) lg[o] += xv * w4[o];
#pragma unroll
            for (int o4 = 0; o4 < 8; ++o4) { const f32x4 w = *(const f32x4*)(wr + (size_t)k * 32 + o4 * 4);
#pragma unroll
                for (int o = 0; o < 4; ++o) lr[o4 * 4 + o] += xv * w[o]; } }
        asm volatile("s_waitcnt lgkmcnt(0)" ::: "memory");
#pragma unroll
        for (int o = 0; o < 4; ++o) lg[o] = wave_sum(lg[o]) + bg[o];
#pragma unroll
        for (int o = 0; o < 32; ++o) lr[o] = wave_sum(lr[o]) + br[o];
        int gi = 0; float gm = lg[0];
#pragma unroll
        for (int o = 1; o < 4; ++o) if (lg[o] > gm) { gm = lg[o]; gi = o; }
        float gs = 0.f;
#pragma unroll
        for (int o = 0; o < 4; ++o) gs += __expf(lg[o] - gm);
        const float ggate = 1.f / gs;
        float el[8];
#pragma unroll
        for (int o = 0; o < 8; ++o) { float x = lr[o];
#pragma unroll
            for (int q = 1; q < 4; ++q) x = (gi == q) ? lr[q * 8 + o] : x;
            el[o] = x; }
        int i0 = 0; float l0 = el[0];
#pragma unroll
        for (int o = 1; o < 8; ++o) if (el[o] > l0) { l0 = el[o]; i0 = o; }
        int i1 = -1; float l1 = -3.0e38f;
#pragma unroll
        for (int o = 0; o < 8; ++o) if (o != i0 && el[o] > l1) { l1 = el[o]; i1 = o; }
        if (i1 < 0) { i1 = (i0 == 0) ? 1 : 0; l1 = el[0]; }
        const float e1 = __expf(l1 - l0), den = 1.f / (1.f + e1);
        const float w0 = den * ggate, w1 = e1 * den * ggate;
        if (c.lane == 0) {
            const int ex0 = gi * 8 + i0, ex1 = gi * 8 + i1;
            const unsigned p0 = atomicAdd(cnt + ex0, 1u), p1 = atomicAdd(cnt + ex1, 1u);
            LIST[ex0 * NTOK + p0] = t; LIST[ex1 * NTOK + p1] = t; LISTW[ex0 * NTOK + p0] = w0; LISTW[ex1 * NTOK + p1] = w1;
            TOKE[2 * t] = ex0; TOKE[2 * t + 1] = ex1; TOKW[2 * t] = w0; TOKW[2 * t + 1] = w1; TOKP[2 * t] = (int)p0; TOKP[2 * t + 1] = (int)p1;
        }
    }
}

__device__ __forceinline__ void route_mfma(const Ctx& c, const float* X, const float* g, const float* WRl, const float* bg, const float* br, bf16* HN, unsigned char* rt, unsigned* cnt) {
    int* TOKE = (int*)(rt + RT_TOKE); float* TOKW = (float*)(rt + RT_TOKW); int* TOKP = (int*)(rt + RT_TOKP); int* LIST = (int*)(rt + RT_LIST); float* LISTW = (float*)(rt + RT_LISTW);
    if (c.wave >= 4) return;
    const int fr = c.lane & 15, fq = c.lane >> 4;
    LAS float* LG = (LAS float*)(c.lds + c.wave * 16384);
    for (int tile = blockIdx.x * 4 + c.wave; tile < NTOK / 16; tile += gridDim.x * 4) {
        const int t0 = tile * 16; const float* xr = X + (size_t)(t0 + fr) * D + 4 * fq; const float* wr = WRl + (size_t)fr * D + 4 * fq;
        f32x4 a0 = {0.f, 0.f, 0.f, 0.f}, a1 = a0, a2 = a0; float ss = 0.f;
#pragma unroll 8
        for (int j = 0; j < 64; ++j) { const f32x4 v = *(const f32x4*)(xr + 16 * j);
            const f32x4 w0 = *(const f32x4*)(wr + 16 * j), w1 = *(const f32x4*)(wr + 16 * D + 16 * j), w2 = *(const f32x4*)(wr + 32 * D + 16 * j);
            ss += (v[0] * v[0] + v[1] * v[1]) + (v[2] * v[2] + v[3] * v[3]);
#pragma unroll
            for (int i = 0; i < 4; ++i) { a0 = __builtin_amdgcn_mfma_f32_16x16x4f32(v[i], w0[i], a0, 0, 0, 0); a1 = __builtin_amdgcn_mfma_f32_16x16x4f32(v[i], w1[i], a1, 0, 0, 0); a2 = __builtin_amdgcn_mfma_f32_16x16x4f32(v[i], w2[i], a2, 0, 0, 0); } }
        ss += __shfl_xor(ss, 16); ss += __shfl_xor(ss, 32);
        const float r = 1.f / sqrtf(ss * (1.f / D) + EPS);
        const float b0 = fr < 4 ? bg[fr] : br[fr - 4], b1 = br[12 + fr], b2 = fr < 4 ? br[28 + fr] : 0.f;
#pragma unroll
        for (int rg = 0; rg < 4; ++rg) { const float rr = __shfl(r, 4 * fq + rg); LAS float* row = LG + (4 * fq + rg) * 48;
            row[fr] = a0[rg] * rr + b0; row[16 + fr] = a1[rg] * rr + b1; row[32 + fr] = a2[rg] * rr + b2; }
        bf16* hrow = HN + (size_t)(t0 + fr) * D + 4 * fq;
#pragma unroll 8
        for (int j = 0; j < 64; ++j) { const f32x4 v = *(const f32x4*)(xr + 16 * j); const f32x4 gg = *(const f32x4*)(g + 16 * j + 4 * fq);
            u32x2 w; w.x = pg8::cvt_pk_bf16(v[0] * r * gg[0], v[1] * r * gg[1]); w.y = pg8::cvt_pk_bf16(v[2] * r * gg[2], v[3] * r * gg[3]); *(u32x2*)(hrow + 16 * j) = w; }
        asm volatile("s_waitcnt lgkmcnt(0)" ::: "memory");
        if (c.lane < 16) { const int t = t0 + c.lane; LAS const float* lrow = LG + c.lane * 48;
            float lg[4], el[8];
#pragma unroll
            for (int o = 0; o < 4; ++o) lg[o] = lrow[o];
            int gi = 0; float gm = lg[0];
#pragma unroll
            for (int o = 1; o < 4; ++o) if (lg[o] > gm) { gm = lg[o]; gi = o; }
            float gs = 0.f;
#pragma unroll
            for (int o = 0; o < 4; ++o) gs += __expf(lg[o] - gm);
            const float ggate = 1.f / gs;
#pragma unroll
            for (int o = 0; o < 8; ++o) el[o] = lrow[4 + gi * 8 + o];
            int i0 = 0; float l0 = el[0];
#pragma unroll
            for (int o = 1; o < 8; ++o) if (el[o] > l0) { l0 = el[o]; i0 = o; }
            int i1 = -1; float l1 = -3.0e38f;
#pragma unroll
            for (int o = 0; o < 8; ++o) if (o != i0 && el[o] > l1) { l1 = el[o]; i1 = o; }
            if (i1 < 0) { i1 = (i0 == 0) ? 1 : 0; l1 = el[0]; }
            const float e1 = __expf(l1 - l0), den = 1.f / (1.f + e1), w0 = den * ggate, w1 = e1 * den * ggate;
            const int ex0 = gi * 8 + i0, ex1 = gi * 8 + i1;
            const unsigned p0 = atomicAdd(cnt + ex0, 1u), p1 = atomicAdd(cnt + ex1, 1u);
            LIST[ex0 * NTOK + p0] = t; LIST[ex1 * NTOK + p1] = t; LISTW[ex0 * NTOK + p0] = w0; LISTW[ex1 * NTOK + p1] = w1;
            TOKE[2 * t] = ex0; TOKE[2 * t + 1] = ex1; TOKW[2 * t] = w0; TOKW[2 * t + 1] = w1; TOKP[2 * t] = (int)p0; TOKP[2 * t + 1] = (int)p1; }
        asm volatile("s_waitcnt lgkmcnt(0)" ::: "memory");
    }
}
__device__ __forceinline__ int pstart_of(const unsigned* cnt, int e) { int s = 0; for (int i = 0; i < e; ++i) s += ((int)cnt[i] + 255) & ~255; return s; }
__device__ __forceinline__ bool row_lookup(const unsigned* cnt, int R, int& e, int& i, int& n) {
    int s = 0;
    for (int x = 0; x < NEXP; ++x) { const int cn = (int)cnt[x], pc = (cn + 255) & ~255; if (R < s + pc) { e = x; i = R - s; n = cn; return true; } s += pc; }
    return false;
}

__device__ __forceinline__ void combine_phase(const Ctx& c, float* X, const bf16* Y, const unsigned char* rt, const LAS int* tab, const float* g, bf16* XN, float* OUTF, float* XW) {
    const int* TOKE = (const int*)(rt + RT_TOKE); const int* TOKP = (const int*)(rt + RT_TOKP);
    for (int t = c.gw; t < NTOK; t += c.ngw) {
        const int e0 = TOKE[2 * t], e1 = TOKE[2 * t + 1];
        const int R0 = tab[e0] * 256 + TOKP[2 * t], R1 = tab[e1] * 256 + TOKP[2 * t + 1];
        f32x4* xr = (f32x4*)(X + (size_t)t * D) + c.lane; const f32x4* gr = (const f32x4*)g + c.lane;
        const u32x2* y0 = (const u32x2*)(Y + (size_t)R0 * D) + c.lane; const u32x2* y1 = (const u32x2*)(Y + (size_t)R1 * D) + c.lane;
        f32x4 v[4]; float s = 0.f;
#pragma unroll
        for (int j = 0; j < 4; ++j) { v[j] = xr[64 * j]; const u32x2 a = y0[64 * j], b = y1[64 * j];
            v[j].x += __uint_as_float(a.x << 16) + __uint_as_float(b.x << 16); v[j].y += __uint_as_float(a.x & 0xffff0000u) + __uint_as_float(b.x & 0xffff0000u);
            v[j].z += __uint_as_float(a.y << 16) + __uint_as_float(b.y << 16); v[j].w += __uint_as_float(a.y & 0xffff0000u) + __uint_as_float(b.y & 0xffff0000u);
            s += (v[j].x * v[j].x + v[j].y * v[j].y) + (v[j].z * v[j].z + v[j].w * v[j].w); }
        const float r = 1.f / sqrtf(wave_sum(s) * (1.f / D) + EPS);
        if (XN) {
            u32x2* o8 = (u32x2*)(XN + (size_t)t * D) + c.lane;
            f32x4* xw = (f32x4*)(XW + (size_t)t * D) + c.lane;
#pragma unroll
            for (int j = 0; j < 4; ++j) { xw[64 * j] = v[j]; const f32x4 gg = gr[64 * j]; u32x2 w; w.x = pk2(v[j].x * r * gg.x, v[j].y * r * gg.y); w.y = pk2(v[j].z * r * gg.z, v[j].w * r * gg.w); o8[64 * j] = w; }
        } else {
            f32x4* o = (f32x4*)(OUTF + (size_t)t * D) + c.lane;
#pragma unroll
            for (int j = 0; j < 4; ++j) { const f32x4 gg = gr[64 * j]; f32x4 w; w.x = v[j].x * r * gg.x; w.y = v[j].y * r * gg.y; w.z = v[j].z * r * gg.z; w.w = v[j].w * r * gg.w; o[64 * j] = w; }
        }
    }
}

__device__ __forceinline__ void gla_decay(const Ctx& c, const bf16* U, const float* gup, const float* gbias, float* DECA) {
    const long total = (long)NTOK * 2 * GLA_KD;
    for (long idx = GTID; idx < total; idx += GSIZE) {
        const int cc = (int)(idx % GLA_KD), dir = (int)((idx / GLA_KD) % 2), t = (int)(idx / (2 * GLA_KD));
        const bf16* r = U + (size_t)t * LDU1 + 2304 + dir * 16;
        float z = gbias[dir * GLA_KD + cc];
#pragma unroll
        for (int k = 0; k < 16; ++k) z += bf2f(r[k]) * gup[(dir * 16 + k) * GLA_KD + cc];
        const float ls = fminf(z, 0.f) - log1pf(__expf(-fabsf(z)));
        DECA[idx] = __expf(ls * (1.f / 16.f));
    }
}
__device__ __forceinline__ void gla_recur(const Ctx& c, const bf16* U, const float* DECA, float* OF) {
    const long total = (long)NBATCH * GLA_H * GLA_DV * 2;
    const float qs = 0.10206207261596577f;
    for (long idx = GTID; idx < total; idx += GSIZE) {
        const int half = (int)(idx & 1), dv = (int)((idx >> 1) % GLA_DV), h = (int)(((idx >> 1) / GLA_DV) % GLA_H), b = (int)((idx >> 1) / (GLA_DV * GLA_H));
        float S[48];
        for (int dir = 0; dir < 2; ++dir) {
#pragma unroll
            for (int d = 0; d < 48; ++d) S[d] = 0.f;
            for (int s = 0; s < SEQ; ++s) {
                const int p = dir ? (SEQ - 1 - s) : s, t = b * SEQ + p;
#if GLA_INTRA_ONLY
                if ((s & 63) == 0) {
#pragma unroll
                    for (int d = 0; d < 48; ++d) S[d] = 0.f; }
#endif
                const bf16* row = U + (size_t)t * LDU1;
                const float vv = bf2f(row[768 + h * GLA_DV + dv]);
                const float* a = DECA + ((size_t)t * 2 + dir) * GLA_KD + h * GLA_DK + half * 48;
                const u32x4* q4 = (const u32x4*)(row + h * GLA_DK + half * 48); const u32x4* k4 = (const u32x4*)(row + 384 + h * GLA_DK + half * 48);
                float o = 0.f;
#pragma unroll
                for (int d8 = 0; d8 < 6; ++d8) { const u32x4 qq = q4[d8], kk = k4[d8]; const f32x4 a0 = *(const f32x4*)(a + d8 * 8), a1 = *(const f32x4*)(a + d8 * 8 + 4);
#pragma unroll
                    for (int e = 0; e < 4; ++e) { const float aa0 = e < 2 ? a0[2 * e] : a1[2 * e - 4], aa1 = e < 2 ? a0[2 * e + 1] : a1[2 * e - 3];
                        const float s0 = aa0 * S[d8 * 8 + 2 * e] + __uint_as_float(kk[e] << 16) * vv; S[d8 * 8 + 2 * e] = s0; o += __uint_as_float(qq[e] << 16) * s0;
                        const float s1 = aa1 * S[d8 * 8 + 2 * e + 1] + __uint_as_float(kk[e] & 0xffff0000u) * vv; S[d8 * 8 + 2 * e + 1] = s1; o += __uint_as_float(qq[e] & 0xffff0000u) * s1; } }
                o += __shfl_xor(o, 1);
                float* dst = OF + (size_t)t * MIX + h * GLA_DV + dv;
                if (half == 0) { if (dir == 0) *dst = o * qs; else *dst += o * qs; }
            }
        }
    }
}
__device__ __forceinline__ void gla_norm_gate(const Ctx& c, const float* OF, const bf16* U, const float* onorm, bf16* CAT) {
    for (int it = c.gw; it < NTOK * GLA_H; it += c.ngw) {
        const int h = it % GLA_H, t = it / GLA_H;
        const float* o = OF + (size_t)t * MIX + h * GLA_DV;
        float v[3]; float s = 0.f;
#pragma unroll
        for (int j = 0; j < 3; ++j) { v[j] = o[c.lane + 64 * j]; s += v[j] * v[j]; }
        const float r = 1.f / sqrtf(wave_sum(s) * (1.f / GLA_DV) + EPS);
#pragma unroll
        for (int j = 0; j < 3; ++j) { const int dv = c.lane + 64 * j; const float gg = bf2f(U[(size_t)t * LDU1 + 1536 + h * GLA_DV + dv]);
            CAT[(size_t)t * D + h * GLA_DV + dv] = (bf16)f2bf(v[j] * r * onorm[dv] * silu(gg)); }
    }
}


namespace gla {
typedef short bf16x8 __attribute__((ext_vector_type(8)));
typedef short s16x4 __attribute__((ext_vector_type(4)));
constexpr int LB_OFF = 0, LB_LD = 97;
constexpr int QG_OFF = 25600, KG_OFF = 38912, QS_OFF = 52224, X_LD = 104;
constexpr int VS_OFF = 65536, V_LD = 200;
constexpr int AM_OFF = 91136, AM_LD = 72;
constexpr int TOT_OFF = 100352;
constexpr int RS_OFF = 102400;
constexpr int OS_OFF = 0, OS_LD = 196;
__device__ __forceinline__ s16x4 tr_read(LAS const unsigned char* p) { return __builtin_amdgcn_ds_read_tr16_b64_v4i16((LAS s16x4*)p); }
__device__ __forceinline__ float bflo(unsigned w) { return __uint_as_float(w << 16); }
__device__ __forceinline__ float bfhi(unsigned w) { return __uint_as_float(w & 0xffff0000u); }

__device__ __forceinline__ void prep(const Ctx& c, const bf16* U, const float* gup, const float* gbias, int t0, int h, int dir) {
    LAS float* LB = (LAS float*)(c.lds + LB_OFF); LAS float* TOT = (LAS float*)(c.lds + TOT_OFF);
    for (int idx = c.tid; idx < 64 * 96; idx += 512) { const int t = idx / 96, d = idx % 96;
        const u32x4* r4 = (const u32x4*)(U + (size_t)(t0 + t) * LDU1 + 2304 + dir * 16); const u32x4 ra = r4[0], rb = r4[1];
        const float* g = gup + (size_t)(dir * 16) * GLA_KD + h * GLA_DK + d;
        float z = gbias[dir * GLA_KD + h * GLA_DK + d];
#pragma unroll
        for (int k = 0; k < 4; ++k) { z += bflo(ra[k]) * g[(2 * k) * GLA_KD] + bfhi(ra[k]) * g[(2 * k + 1) * GLA_KD]; z += bflo(rb[k]) * g[(8 + 2 * k) * GLA_KD] + bfhi(rb[k]) * g[(9 + 2 * k) * GLA_KD]; }
        LB[t * LB_LD + d] = (fminf(z, 0.f) - __logf(1.f + __expf(-fabsf(z)))) * (1.f / 16.f); }
    __syncthreads();
    if (c.tid < 384) { const int d = c.tid % 96, seg = c.tid / 96; float run = 0.f;
#pragma unroll 4
        for (int i = 0; i < 16; ++i) { const int s = seg * 16 + i, t = dir ? 63 - s : s; run += LB[t * LB_LD + d]; LB[t * LB_LD + d] = run; }
        TOT[seg * 96 + d] = run; }
    __syncthreads();
    if (c.tid < 384) { const int d = c.tid % 96, seg = c.tid / 96; float off = 0.f;
        for (int s2 = 0; s2 < seg; ++s2) off += TOT[s2 * 96 + d];
        if (seg > 0) {
#pragma unroll 4
            for (int i = 0; i < 16; ++i) { const int s = seg * 16 + i, t = dir ? 63 - s : s; LB[t * LB_LD + d] += off; } }
        if (seg == 3) TOT[4 * 96 + d] = off + TOT[3 * 96 + d]; }
    __syncthreads();
}
__device__ __forceinline__ void stage_v(const Ctx& c, const bf16* U, int t0, int h) {
    for (int idx = c.tid; idx < 64 * 24; idx += 512) { const int t = idx / 24, ch = idx % 24;
        *(LAS u32x4*)(c.lds + VS_OFF + (t * V_LD + ch * 8) * 2) = *(const u32x4*)(U + (size_t)(t0 + t) * LDU1 + 768 + h * GLA_DV + ch * 8); }
}

__device__ __forceinline__ void local_phase(const Ctx& c, const bf16* U, const float* gup, const float* gbias, bf16* SU, float* DEC, int vcu, int G, unsigned* dbg) {
    const int fr = c.lane & 15, fq = c.lane >> 4, q = fr >> 2, p = fr & 3;
    for (int item = vcu; item < NBATCH * GLA_H * 2 * 64; item += G) {
        const int n = item & 63, dir = (item >> 6) & 1, h = (item >> 7) & 3, b = item >> 9, t0 = b * SEQ + n * 64;
        __syncthreads();
        stage_v(c, U, t0, h);
        prep(c, U, gup, gbias, t0, h, dir);
        LAS const float* LB = (LAS const float*)(c.lds + LB_OFF); LAS const float* BL = (LAS const float*)(c.lds + TOT_OFF) + 4 * 96;
        for (int idx = c.tid; idx < 64 * 12; idx += 512) { const int t = idx / 12, ch = idx % 12;
            const u32x4 kk = *(const u32x4*)(U + (size_t)(t0 + t) * LDU1 + 384 + h * GLA_DK + ch * 8); u32x4 w;
#pragma unroll
            for (int e = 0; e < 4; ++e) { const int d = ch * 8 + 2 * e; const float f0 = __expf(BL[d] - LB[t * LB_LD + d]), f1 = __expf(BL[d + 1] - LB[t * LB_LD + d + 1]);
                w[e] = pg8::cvt_pk_bf16(bflo(kk[e]) * f0, bfhi(kk[e]) * f1); }
            *(LAS u32x4*)(c.lds + QG_OFF + (t * X_LD + ch * 8) * 2) = w; }
        if (c.tid < 96) DEC[(size_t)item * 96 + c.tid] = __expf(BL[c.tid]);
        __syncthreads();
        bf16* su = SU + (size_t)item * (GLA_DV * GLA_DK);
#pragma unroll 1
        for (int k9 = 0; k9 < 9; ++k9) { const int id = c.wave * 9 + k9, jv = id / 6, i = id % 6;
            f32x4 acc = {0.f, 0.f, 0.f, 0.f};
#pragma unroll
            for (int ks = 0; ks < 2; ++ks) { const int tr = 32 * ks + 8 * fq + q;
                const s16x4 a0 = tr_read(c.lds + QG_OFF + (tr * X_LD + 16 * i + 4 * p) * 2), a1 = tr_read(c.lds + QG_OFF + ((tr + 4) * X_LD + 16 * i + 4 * p) * 2);
                const s16x4 b0 = tr_read(c.lds + VS_OFF + (tr * V_LD + 16 * jv + 4 * p) * 2), b1 = tr_read(c.lds + VS_OFF + ((tr + 4) * V_LD + 16 * jv + 4 * p) * 2);
                const bf16x8 av = {a0[0], a0[1], a0[2], a0[3], a1[0], a1[1], a1[2], a1[3]}, bv = {b0[0], b0[1], b0[2], b0[3], b1[0], b1[1], b1[2], b1[3]};
                acc = __builtin_amdgcn_mfma_f32_16x16x32_bf16(av, bv, acc, 0, 0, 0); }
            u32x2 w; w.x = pg8::cvt_pk_bf16(acc[0], acc[1]); w.y = pg8::cvt_pk_bf16(acc[2], acc[3]);
            *(u32x2*)(su + (size_t)(16 * jv + fr) * GLA_DK + 16 * i + 4 * fq) = w; }
    }
}
__device__ __forceinline__ void scan_phase(const Ctx& c, const bf16* __restrict__ SU, bf16* __restrict__ SS, const float* __restrict__ DEC) {
    const long total = (long)32 * 2304;
    for (long idx = GTID; idx < total; idx += GSIZE) { const int seq = (int)(idx / 2304), ch = (int)(idx % 2304), dk0 = (ch % 12) * 8, dir = seq & 1;
        float s[8];
#pragma unroll
        for (int e = 0; e < 8; ++e) s[e] = 0.f;
        const size_t cs = (size_t)(GLA_DV * GLA_DK);
        const bf16* pu0 = SU + (size_t)(seq * 64) * cs + (size_t)ch * 8; bf16* ps0 = SS + (size_t)(seq * 64) * cs + (size_t)ch * 8; const float* pd0 = DEC + (size_t)(seq * 64) * 96 + dk0;
#pragma unroll 1
        for (int st0 = 0; st0 < 64; st0 += 8) {
            u32x4 uu[8]; f32x4 da[8], db[8];
#pragma unroll
            for (int k = 0; k < 8; ++k) { const int n = dir ? 63 - (st0 + k) : st0 + k; uu[k] = *(const u32x4*)(pu0 + (size_t)n * cs); da[k] = *(const f32x4*)(pd0 + n * 96); db[k] = *(const f32x4*)(pd0 + n * 96 + 4); }
#pragma unroll
            for (int k = 0; k < 8; ++k) { const int n = dir ? 63 - (st0 + k) : st0 + k;
                u32x4 w; w.x = pg8::cvt_pk_bf16(s[0], s[1]); w.y = pg8::cvt_pk_bf16(s[2], s[3]); w.z = pg8::cvt_pk_bf16(s[4], s[5]); w.w = pg8::cvt_pk_bf16(s[6], s[7]);
                *(u32x4*)(ps0 + (size_t)n * cs) = w;
                s[0] = s[0] * da[k][0] + bflo(uu[k][0]); s[1] = s[1] * da[k][1] + bfhi(uu[k][0]); s[2] = s[2] * da[k][2] + bflo(uu[k][1]); s[3] = s[3] * da[k][3] + bfhi(uu[k][1]);
                s[4] = s[4] * db[k][0] + bflo(uu[k][2]); s[5] = s[5] * db[k][1] + bfhi(uu[k][2]); s[6] = s[6] * db[k][2] + bflo(uu[k][3]); s[7] = s[7] * db[k][3] + bfhi(uu[k][3]); }
        }
    }
}
__device__ __forceinline__ void out_phase(const Ctx& c, const bf16* U, const float* gup, const float* gbias, const bf16* SU, const float* onorm, bf16* CAT, int vcu, int G) {
    const int fr = c.lane & 15, fq = c.lane >> 4, q = fr >> 2, p = fr & 3, it = c.wave & 3, cth = c.wave >> 2;
    const float qsc = 0.10206207261596577f;
    for (int item = vcu; item < NBATCH * GLA_H * 64; item += G) {
        const int n = item & 63, h = (item >> 6) & 3, b = item >> 8, t0 = b * SEQ + n * 64;
        f32x4 o[6];
#pragma unroll
        for (int x = 0; x < 6; ++x) o[x] = (f32x4){0.f, 0.f, 0.f, 0.f};
        __syncthreads();
        stage_v(c, U, t0, h);
#pragma unroll 1
        for (int dir = 0; dir < 2; ++dir) {
            prep(c, U, gup, gbias, t0, h, dir);
            LAS const float* LB = (LAS const float*)(c.lds + LB_OFF); const int tmid = dir ? 32 : 31;
            for (int idx = c.tid; idx < 64 * 12; idx += 512) { const int t = idx / 12, ch = idx % 12;
                const u32x4 qq = *(const u32x4*)(U + (size_t)(t0 + t) * LDU1 + h * GLA_DK + ch * 8), kk = *(const u32x4*)(U + (size_t)(t0 + t) * LDU1 + 384 + h * GLA_DK + ch * 8);
                u32x4 wg, wk, ws;
#pragma unroll
                for (int e = 0; e < 4; ++e) { const int d = ch * 8 + 2 * e; const float b0 = LB[t * LB_LD + d], b1 = LB[t * LB_LD + d + 1], m0 = LB[tmid * LB_LD + d], m1 = LB[tmid * LB_LD + d + 1];
                    const float q0 = bflo(qq[e]) * qsc, q1 = bfhi(qq[e]) * qsc;
                    wg[e] = pg8::cvt_pk_bf16(q0 * __expf(b0 - m0), q1 * __expf(b1 - m1)); wk[e] = pg8::cvt_pk_bf16(bflo(kk[e]) * __expf(m0 - b0), bfhi(kk[e]) * __expf(m1 - b1));
                    ws[e] = pg8::cvt_pk_bf16(q0 * __expf(b0), q1 * __expf(b1)); }
                *(LAS u32x4*)(c.lds + QG_OFF + (t * X_LD + ch * 8) * 2) = wg; *(LAS u32x4*)(c.lds + KG_OFF + (t * X_LD + ch * 8) * 2) = wk; *(LAS u32x4*)(c.lds + QS_OFF + (t * X_LD + ch * 8) * 2) = ws; }
            __syncthreads();
#pragma unroll
            for (int jj = 0; jj < 2; ++jj) { const int jt = 2 * cth + jj; f32x4 a = {0.f, 0.f, 0.f, 0.f};
#pragma unroll
                for (int ks = 0; ks < 3; ++ks) { const bf16x8 av = *(const LAS bf16x8*)(c.lds + QG_OFF + ((16 * it + fr) * X_LD + 32 * ks + 8 * fq) * 2), bv = *(const LAS bf16x8*)(c.lds + KG_OFF + ((16 * jt + fr) * X_LD + 32 * ks + 8 * fq) * 2);
                    a = __builtin_amdgcn_mfma_f32_16x16x32_bf16(av, bv, a, 0, 0, 0); }
#pragma unroll
                for (int rg = 0; rg < 4; ++rg) { const int i = 16 * it + 4 * fq + rg, j = 16 * jt + fr; const bool keep = dir ? (j >= i) : (j <= i);
                    *(LAS bf16*)(c.lds + AM_OFF + (i * AM_LD + j) * 2) = (bf16)f2bf(keep ? a[rg] : 0.f); } }
            __syncthreads();
            const bf16* st = SU + ((size_t)(((b * 4 + h) * 2 + dir) * 64 + n)) * (GLA_DV * GLA_DK);
#pragma unroll
            for (int x = 0; x < 6; ++x) { const int ct = cth * 6 + x;
#pragma unroll
                for (int ks = 0; ks < 2; ++ks) { const int tr = 32 * ks + 8 * fq + q;
                    const bf16x8 av = *(const LAS bf16x8*)(c.lds + AM_OFF + ((16 * it + fr) * AM_LD + 32 * ks + 8 * fq) * 2);
                    const s16x4 b0 = tr_read(c.lds + VS_OFF + (tr * V_LD + 16 * ct + 4 * p) * 2), b1 = tr_read(c.lds + VS_OFF + ((tr + 4) * V_LD + 16 * ct + 4 * p) * 2);
                    const bf16x8 bv = {b0[0], b0[1], b0[2], b0[3], b1[0], b1[1], b1[2], b1[3]};
                    o[x] = __builtin_amdgcn_mfma_f32_16x16x32_bf16(av, bv, o[x], 0, 0, 0); }
#if !GLA_INTRA_ONLY
#pragma unroll
                for (int ks = 0; ks < 3; ++ks) { const bf16x8 av = *(const LAS bf16x8*)(c.lds + QS_OFF + ((16 * it + fr) * X_LD + 32 * ks + 8 * fq) * 2);
                    const bf16x8 bv = *(const bf16x8*)(st + (size_t)(16 * ct + fr) * GLA_DK + 32 * ks + 8 * fq);
                    o[x] = __builtin_amdgcn_mfma_f32_16x16x32_bf16(av, bv, o[x], 0, 0, 0); }
#endif
            }
            __syncthreads();
        }
        LAS float* OS = (LAS float*)(c.lds + OS_OFF);
#pragma unroll
        for (int x = 0; x < 6; ++x)
#pragma unroll
            for (int rg = 0; rg < 4; ++rg) OS[(16 * it + 4 * fq + rg) * OS_LD + 16 * (cth * 6 + x) + fr] = o[x][rg];
        __syncthreads();
        { const int t = c.tid >> 3, part = c.tid & 7; float s = 0.f;
#pragma unroll
            for (int e = 0; e < 24; ++e) { const float v = OS[t * OS_LD + part * 24 + e]; s += v * v; }
            s += __shfl_xor(s, 1); s += __shfl_xor(s, 2); s += __shfl_xor(s, 4);
            if (part == 0) ((LAS float*)(c.lds + RS_OFF))[t] = 1.f / sqrtf(s * (1.f / GLA_DV) + EPS); }
        __syncthreads();
        for (int idx = c.tid; idx < 64 * 24; idx += 512) { const int t = idx / 24, ch = idx % 24; const float r = ((LAS const float*)(c.lds + RS_OFF))[t];
            const u32x4 gg = *(const u32x4*)(U + (size_t)(t0 + t) * LDU1 + 1536 + h * GLA_DV + ch * 8); u32x4 w;
#pragma unroll
            for (int e = 0; e < 4; ++e) { const int dv = ch * 8 + 2 * e; const float g0 = bflo(gg[e]), g1 = bfhi(gg[e]);
                w[e] = pg8::cvt_pk_bf16(OS[t * OS_LD + dv] * r * onorm[dv] * (g0 / (1.f + __expf(-g0))), OS[t * OS_LD + dv + 1] * r * onorm[dv + 1] * (g1 / (1.f + __expf(-g1)))); }
            *(u32x4*)(CAT + (size_t)(t0 + t) * D + h * GLA_DV + ch * 8) = w; }
    }
}
}

#define XB_TMO      128
#define XB_XCNT(j)  (256  + 64 * (j))
#define XB_XSUB(j)  (1280 + 64 * (j))
#define XB_XGEN(j)  (2304 + 64 * (j))
#define XB_TOP      3328
#define XB_TOPGEN   3392
#define XCD_BAR_WORDS 3456
#define XB_SPIN_CAP (1u << 22)
__device__ __forceinline__ unsigned xb_ld(unsigned* p)              { return __hip_atomic_load(p, __ATOMIC_RELAXED, __HIP_MEMORY_SCOPE_AGENT); }
__device__ __forceinline__ unsigned xb_add(unsigned* p, unsigned v) { return __hip_atomic_fetch_add(p, v, __ATOMIC_RELAXED, __HIP_MEMORY_SCOPE_AGENT); }
__device__ __forceinline__ unsigned xb_xcc_id() { return (unsigned)__builtin_amdgcn_s_getreg((3 << 11) | 20) & 0xFu; }
#define XB_SPIN(cond, bar) do { unsigned _sp = 0; while (cond) { __builtin_amdgcn_s_sleep(1); \
    if ((++_sp & 255u) == 0u) { if (xb_ld(&(bar)[XB_TMO])) break; if (_sp > XB_SPIN_CAP) { atomicAdd(&(bar)[XB_TMO], 1u); break; } } } } while (0)
struct XcdBarrier { unsigned* bar; unsigned x; volatile LAS unsigned* st; };
__device__ __forceinline__ XcdBarrier xcd_barrier_post(unsigned* bar, volatile LAS unsigned* st) {
    XcdBarrier b; b.bar = bar; b.x = xb_xcc_id(); b.st = st;
    if (threadIdx.x == 0) (void)xb_add(&bar[XB_XCNT(b.x)], 1u);
    return b;
}
__device__ __forceinline__ void xcd_barrier_complete(unsigned* bar, unsigned x, unsigned& nloc, unsigned& nx) {
    const unsigned G = gridDim.x * gridDim.y * gridDim.z;
    unsigned sum, cnt, mine, sp = 0u;
    for (;;) {
        sum = 0u; cnt = 0u; mine = 0u;
#pragma unroll
        for (unsigned j = 0; j < 16; ++j) { const unsigned c = xb_ld(&bar[XB_XCNT(j)]); sum += c; cnt += (c > 0u) ? 1u : 0u; mine = (j == x) ? c : mine; }
        if (sum == G) break;
        __builtin_amdgcn_s_sleep(1);
        if ((++sp & 255u) == 0u) { if (xb_ld(&bar[XB_TMO])) break; if (sp > XB_SPIN_CAP) { atomicAdd(&bar[XB_TMO], 1u); break; } }
    }
    nloc = mine > 0u ? mine : 1u; nx = cnt > 0u ? cnt : 1u;
}
__device__ __forceinline__ void xcd_barrier(const XcdBarrier& b) {
    asm volatile("s_waitcnt vmcnt(0)" ::: "memory");
    __syncthreads();
    if (threadIdx.x == 0) {
        unsigned* bar = b.bar;
        __builtin_amdgcn_s_waitcnt(0);
        const unsigned bx = __builtin_amdgcn_readfirstlane(xb_xcc_id());
        unsigned nloc = b.st[0], nx = b.st[1];
        if (nloc == 0u) { xcd_barrier_complete(bar, bx, nloc, nx); b.st[0] = nloc; b.st[1] = nx; }
        const unsigned old = xb_add(&bar[XB_XSUB(bx)], 1u);
        const unsigned gen = old / nloc;
        if (old + 1u == (gen + 1u) * nloc) {
            __builtin_amdgcn_fence(__ATOMIC_RELEASE, "agent");
            asm volatile("s_waitcnt vmcnt(0)" ::: "memory");
            const unsigned og = xb_add(&bar[XB_TOP], 1u);
            const unsigned tg = og / nx;
            if (og + 1u == (tg + 1u) * nx) xb_add(&bar[XB_TOPGEN], 1u);
            else XB_SPIN(xb_ld(&bar[XB_TOPGEN]) == tg, bar);
            __builtin_amdgcn_fence(__ATOMIC_ACQUIRE, "agent");
            xb_add(&bar[XB_XGEN(bx)], 1u);
            asm volatile("s_waitcnt vmcnt(0)" ::: "memory");
        } else {
            XB_SPIN(xb_ld(&bar[XB_XGEN(bx)]) == gen, bar);
            __builtin_amdgcn_fence(__ATOMIC_ACQUIRE, "agent");
            asm volatile("s_waitcnt vmcnt(0)" ::: "memory");
        }
    }
    __syncthreads();
}

constexpr int NWAVES = 8, NTHREADS = 512, LDS_BYTES = 147456, MISC_OFF = 131072 + 1024;
constexpr int NPHASES = 19;
constexpr int TAB_OFF = 131072 + 2048;
#ifndef USE_MFMA_ROUTE
#define USE_MFMA_ROUTE 1
#endif
#ifndef GLA_EXPERIMENT
#define GLA_EXPERIMENT 0
#endif
#ifndef USE_MFMA_GLA
#define USE_MFMA_GLA 7
#endif
#ifndef USE_MFMA_ATTN
#define USE_MFMA_ATTN 1
#endif
#ifndef USE_PG8
#define USE_PG8 0xF
#endif
__device__ __forceinline__ void build_tab(const Ctx& c, const unsigned* cnt) {
    LAS int* tab = (LAS int*)(c.lds + TAB_OFF);
    __syncthreads();
    if (c.tid < 64) { const int cn = c.tid < 32 ? (int)cnt[c.tid] : 0; int mt = (cn + 255) >> 8, inc = mt;
#pragma unroll
        for (int o = 1; o < 32; o <<= 1) { const int v = __shfl_up(inc, o); if ((c.tid & 31) >= o) inc += v; }
        if (c.tid < 32) { tab[c.tid + 1] = inc; tab[64 + c.tid] = cn; } if (c.tid == 0) tab[0] = 0; }
    __syncthreads();
}

template <int PH_LO, int PH_HI> __global__ void __launch_bounds__(NTHREADS, 2) mk_fwd(Args args) {
    extern __shared__ __attribute__((aligned(16))) unsigned char lds_raw[];
    LAS unsigned char* const ldsp = (LAS unsigned char*)lds_raw;
    Ctx c = fresh_ctx(ldsp);
    const int vcu = (gridDim.x % 8 == 0) ? (int)((blockIdx.x % 8) * (gridDim.x / 8) + blockIdx.x / 8) : (int)blockIdx.x;
    unsigned char* ws = args.ws;
    const float* x = args.in[0]; const float* mem = args.in[1]; const float* mem_norm = args.in[2]; const float* final_norm = args.in[3];
    const float* norm_mix = args.in[4]; const float* norm_ffn = args.in[5]; const float* w_mem_kv = args.in[6]; const float* w_out = args.in[7];
    const float* na_w_in = args.in[8]; const float* na_rpb = args.in[9]; const float* gla_w_in = args.in[10]; const float* gla_gate_up = args.in[11];
    const float* gla_gate_bias = args.in[12]; const float* gla_out_norm = args.in[13]; const float* moe_w_group = args.in[14]; const float* moe_b_group = args.in[15];
    const float* moe_w_router = args.in[16]; const float* moe_b_router = args.in[17]; const float* moe_w1 = args.in[18]; const float* moe_w3 = args.in[19]; const float* moe_w2 = args.in[20];
    float* X = args.out;
    bf16* WIN0 = (bf16*)(ws + WS_WIN0); bf16* WIN1 = (bf16*)(ws + WS_WIN1); bf16* WOUT = (bf16*)(ws + WS_WOUT); bf16* WMKV = (bf16*)(ws + WS_WMKV);
    bf16* MEMN = (bf16*)(ws + WS_MEMN); bf16* MKV = (bf16*)(ws + WS_MKV); bf16* W13 = (bf16*)(ws + WS_W13); bf16* W2 = (bf16*)(ws + WS_W2);
    bf16* XN = (bf16*)(ws + WS_XN); bf16* U = (bf16*)(ws + WS_U); bf16* Y = (bf16*)(ws + WS_Y); bf16* CAT = (bf16*)(ws + WS_CAT); bf16* ACT = (bf16*)(ws + WS_ACT);
    unsigned char* RT = ws + WS_ROUTE; float* DECA = (float*)(ws + WS_S + 74 * MiB); float* OF = (float*)(ws + WS_S + 122 * MiB);
    bf16* SU = (bf16*)(ws + WS_S); float* SDEC = (float*)(ws + WS_S + 73 * MiB); bf16* SS = (bf16*)(ws + WS_S + 74 * MiB);
    float* WR = (float*)(ws + WS_WR);
    unsigned* CTL = (unsigned*)(ws + WS_CTL);
#define IN(k) (PH_LO <= (k) && (k) < PH_HI)
    constexpr bool FUSED = (PH_HI - PH_LO) > 1;
    XcdBarrier bar; bar.bar = CTL + CW_BAR; bar.x = 0; bar.st = nullptr;
    if constexpr (FUSED) {
        volatile LAS unsigned* misc = (volatile LAS unsigned*)(c.lds + MISC_OFF);
        if (c.tid < 64) misc[c.tid] = 0u;
        __syncthreads();
        bar = xcd_barrier_post(CTL + CW_BAR, misc + 8);
        if (PROBE_EN && blockIdx.x == 0 && threadIdx.x == 0) CTL[599] = (unsigned)__builtin_amdgcn_s_memrealtime();
    }
#define GRID_BAR(k) do { if constexpr (FUSED) { if (IN((k) + 1)) xcd_barrier(bar); if (PROBE_EN && blockIdx.x == 0 && threadIdx.x == 0) CTL[600 + (k)] = (unsigned)__builtin_amdgcn_s_memrealtime(); } } while (0)

    if (IN(0)) for (int rep_ = 0; rep_ <= (int)((REPEAT_MASK >> (0)) & 1u); ++rep_) { c = fresh_ctx(ldsp);
        transpose_matrix(c, na_w_in, 1024, NA_IN, WIN0, c.gw, c.ngw);
        transpose_matrix(c, gla_w_in, 1024, GLA_IN, WIN1, c.gw, c.ngw);
        for (long i = GTID; i < (long)(2816 - 2592) * 1024 / 8; i += GSIZE) ((u32x4*)(WIN1 + (size_t)2592 * 1024))[i] = (u32x4){0u, 0u, 0u, 0u};
        for (int l = 0; l < 2; ++l) { transpose_matrix(c, w_out + (size_t)l * D * D, 1024, 1024, WOUT + (size_t)l * D * D, c.gw, c.ngw);
            transpose_matrix(c, w_mem_kv + (size_t)l * D * 512, 1024, 512, WMKV + (size_t)l * 512 * 1024, c.gw, c.ngw); }
        for (long i = GTID; i < (long)2 * 48 * D; i += GSIZE) { const int k = (int)(i % D), col = (int)((i / D) % 48), l = (int)(i / (48 * D)); const float gk = norm_ffn[l * D + k];
            WR[i] = col < 4 ? moe_w_group[((size_t)l * D + k) * 4 + col] * gk : (col < 36 ? moe_w_router[((size_t)l * D + k) * 32 + (col - 4)] * gk : 0.f); }
        for (int m = c.gw; m < NBATCH * NMEM; m += c.ngw) rms_row_to_bf16(mem + (size_t)m * D, mem_norm, MEMN + (size_t)m * D, c.lane);
        for (int m = c.gw; m < NTOK; m += c.ngw) rms_row_to_bf16(x + (size_t)m * D, norm_mix, XN + (size_t)m * D, c.lane);
        GRID_BAR(0);
    }
#pragma unroll
    for (int L = 0; L < 2; ++L) {
        const int pb = 1 + 9 * L;
        const int ldu = L == 0 ? LDU0 : LDU1;
        unsigned* cnt = CTL + CW_CNT + 64 * L;
        if (IN(pb)) for (int rep_ = 0; rep_ <= (int)((REPEAT_MASK >> (pb)) & 1u); ++rep_) { c = fresh_ctx(ldsp);
            if constexpr (USE_PG8 & 1) {
                pg8::StaticOrder S; S.init(XN, L == 0 ? WIN0 : WIN1, NTOK, ldu, D, (int)gridDim.x, (int)blockIdx.x);
                pg8::EpiBf16 E{U, ldu};
                pg8::gemm_phase<pg8::EpiBf16, pg8::StaticOrder, false>(c.lds, D, S, E);
                if (L == 0) { pg8::StaticOrder S2; S2.init(MEMN, WMKV, NBATCH * NMEM, 1024, D, (int)gridDim.x, (int)blockIdx.x);
                    pg8::EpiBf16 E2{MKV, 1024};
                    pg8::gemm_phase<pg8::EpiBf16, pg8::StaticOrder, false>(c.lds, D, S2, E2); }
            } else {
            if (L == 0) {
                naive_gemm(c, NTOK, NA_IN, D, [&](int m) { return XN + (size_t)m * D; }, WIN0, [&](int m, int n, float a) { U[(size_t)m * LDU0 + n] = (bf16)f2bf(a); });
                naive_gemm(c, NBATCH * NMEM, 1024, D, [&](int m) { return MEMN + (size_t)m * D; }, WMKV, [&](int m, int n, float a) { MKV[(size_t)m * 1024 + n] = (bf16)f2bf(a); });
            } else {
                naive_gemm(c, NTOK, LDU1, D, [&](int m) { return XN + (size_t)m * D; }, WIN1, [&](int m, int n, float a) { U[(size_t)m * LDU1 + n] = (bf16)f2bf(a); });
            }
            }
            GRID_BAR(pb);
        }
        if (IN(pb + 1)) for (int rep_ = 0; rep_ <= (int)((REPEAT_MASK >> (pb + 1)) & 1u); ++rep_) { c = fresh_ctx(ldsp);
#if USE_MFMA_ATTN
            if (L == 0) { att::na_phase(c, U, na_rpb, CAT, vcu, (int)gridDim.x); att::mem_phase(c, U, LDU0, 2304, MKV, 0, CAT, vcu, (int)gridDim.x); }
            else { att::mem_phase(c, U, LDU1, 2336, MKV, 1, CAT, vcu, (int)gridDim.x);
                if constexpr (USE_MFMA_GLA & 1) gla::local_phase(c, U, gla_gate_up, gla_gate_bias, SU, SDEC, vcu, (int)gridDim.x, CTL);
                if constexpr (!(USE_MFMA_GLA & 4)) gla_decay(c, U, gla_gate_up, gla_gate_bias, DECA); }
#else
            if (L == 0) { naive_na(c, U, na_rpb, CAT); naive_memattn(c, U, LDU0, 2304, MKV, 0, CAT); }
            else { gla_decay(c, U, gla_gate_up, gla_gate_bias, DECA); naive_memattn(c, U, LDU1, 2336, MKV, 1, CAT); }
#endif
            GRID_BAR(pb + 1);
        }
        if (IN(pb + 2)) for (int rep_ = 0; rep_ <= (int)((REPEAT_MASK >> (pb + 2)) & 1u); ++rep_) { c = fresh_ctx(ldsp);
            if (L == 1) { if constexpr (USE_MFMA_GLA & 2) gla::scan_phase(c, SU, SS, SDEC);
                if constexpr (!(USE_MFMA_GLA & 4)) gla_recur(c, U, DECA, OF);
                GRID_BAR(pb + 2); }
        }
        if (IN(pb + 3)) for (int rep_ = 0; rep_ <= (int)((REPEAT_MASK >> (pb + 3)) & 1u); ++rep_) { c = fresh_ctx(ldsp);
            if (L == 1) {
#if GLA_EXPERIMENT
                gla::out_phase(c, U, gla_gate_up, gla_gate_bias, SS, gla_out_norm, ACT, vcu, (int)gridDim.x);
                gla_norm_gate(c, OF, U, gla_out_norm, CAT);
#else
                if constexpr (USE_MFMA_GLA & 4) gla::out_phase(c, U, gla_gate_up, gla_gate_bias, SS, gla_out_norm, CAT, vcu, (int)gridDim.x);
                else gla_norm_gate(c, OF, U, gla_out_norm, CAT);
#endif
                GRID_BAR(pb + 3); }
        }
        if (IN(pb + 4)) for (int rep_ = 0; rep_ <= (int)((REPEAT_MASK >> (pb + 4)) & 1u); ++rep_) { c = fresh_ctx(ldsp);
            const float* resid = L == 0 ? x : X;
#if GLA_EXPERIMENT
            if (L == 1) { unsigned bad = 0, verybad = 0;
                for (long i = GTID; i < (long)NTOK * MIX; i += GSIZE) { const int t = (int)(i / MIX), cc = (int)(i % MIX); const float a = bf2f(CAT[(size_t)t * D + cc]), bb = bf2f(ACT[(size_t)t * D + cc]);
                    const float df = fabsf(a - bb); if (!(df <= 0.05f + 0.1f * fabsf(a))) ++bad; if (!(fabsf(bb) < 1.0e30f)) ++verybad; }
                unsigned nfs = 0, nfd = 0;
                for (long i = GTID; i < (long)2048 * 18432; i += GSIZE) { const float a = bf2f(SU[i]); if (!(fabsf(a) < 1.0e30f)) ++nfs; }
                for (long i = GTID; i < (long)2048 * 96; i += GSIZE) { const float a = SDEC[i]; if (!(a >= 0.f && a <= 1.0001f)) ++nfd; }
                if (bad) atomicAdd(CTL + 512, bad); if (verybad) atomicAdd(CTL + 513, verybad); if (nfs) atomicAdd(CTL + 514, nfs); if (nfd) atomicAdd(CTL + 515, nfd); }
#endif
            if constexpr (USE_PG8 & 2) {
                pg8::StaticOrder S; S.init(CAT, WOUT + (size_t)L * D * D, NTOK, D, D, (int)gridDim.x, (int)blockIdx.x);
                pg8::EpiResF32 E{resid, X};
                pg8::gemm_phase<pg8::EpiResF32, pg8::StaticOrder, false>(c.lds, D, S, E);
            } else
            naive_gemm(c, NTOK, D, D, [&](int m) { return CAT + (size_t)m * D; }, WOUT + (size_t)L * D * D, [&](int m, int n, float a) { X[(size_t)m * D + n] = resid[(size_t)m * D + n] + a; });
            GRID_BAR(pb + 4);
        }
        if (IN(pb + 5)) for (int rep_ = 0; rep_ <= (int)((REPEAT_MASK >> (pb + 5)) & 1u); ++rep_) { c = fresh_ctx(ldsp);
#if USE_MFMA_ROUTE
            if (rep_ == 0) convert_moe(c, moe_w1 + (size_t)L * NEXP * D * EFF, moe_w3 + (size_t)L * NEXP * D * EFF, moe_w2 + (size_t)L * NEXP * EFF * D, W13, W2, 4);
            route_mfma(c, X, norm_ffn + L * D, WR + (size_t)L * 48 * D, moe_b_group + L * 4, moe_b_router + L * 32, XN, RT, cnt + (rep_ ? 32 : 0));
#else
            route_phase(c, X, norm_ffn + L * D, moe_w_group + (size_t)L * D * 4, moe_b_group + L * 4, moe_w_router + (size_t)L * D * 32, moe_b_router + L * 32, XN, RT, cnt);
#endif
            GRID_BAR(pb + 5);
        }
        if (IN(pb + 6)) for (int rep_ = 0; rep_ <= (int)((REPEAT_MASK >> (pb + 6)) & 1u); ++rep_) { c = fresh_ctx(ldsp);
            const int* LIST = (const int*)(RT + RT_LIST);
            if constexpr (USE_PG8 & 4) {
                build_tab(c, cnt);
                pg8::MoeOrder S{(const LAS int*)(c.lds + TAB_OFF), XN, W13, LIST, D, 4, (int)gridDim.x, vcu, true};
                pg8::EpiSwiGLU E{ACT};
                pg8::gemm_phase<pg8::EpiSwiGLU, pg8::MoeOrder, true>(c.lds, D, S, E);
            } else {
            const long total = (long)MAXROWS * EFF;
            for (long idx = GTID; idx < total; idx += GSIZE) {
                const int R = (int)(idx / EFF), j = (int)(idx % EFF); int e, i, n;
                if (!row_lookup(cnt, R, e, i, n) || i >= n) continue;
                const int t = LIST[e * NTOK + i];
                const u32x4* a4 = (const u32x4*)(XN + (size_t)t * D);
                const int r1 = (j / 128) * 256 + (j % 128);
                const u32x4* b1 = (const u32x4*)(W13 + ((size_t)e * 1024 + r1) * 1024); const u32x4* b3 = (const u32x4*)(W13 + ((size_t)e * 1024 + r1 + 128) * 1024);
                float s1 = 0.f, s3 = 0.f;
                for (int k8 = 0; k8 < D / 8; ++k8) { const u32x4 av = a4[k8]; s1 += dot8(av, b1[k8]); s3 += dot8(av, b3[k8]); }
                ACT[(size_t)R * EFF + j] = (bf16)f2bf(silu(s1) * s3);
            }
            }
            GRID_BAR(pb + 6);
        }
        if (IN(pb + 7)) for (int rep_ = 0; rep_ <= (int)((REPEAT_MASK >> (pb + 7)) & 1u); ++rep_) { c = fresh_ctx(ldsp);
            const int* LIST = (const int*)(RT + RT_LIST); const int* TOKE = (const int*)(RT + RT_TOKE); const float* TOKW = (const float*)(RT + RT_TOKW);
            if constexpr (USE_PG8 & 8) {
                build_tab(c, cnt);
                pg8::MoeOrder S{(const LAS int*)(c.lds + TAB_OFF), ACT, W2, LIST, EFF, 4, (int)gridDim.x, vcu, false};
                pg8::EpiScaleBf16 E{Y, (const float*)(RT + RT_LISTW), (const LAS int*)(c.lds + TAB_OFF)};
                pg8::gemm_phase<pg8::EpiScaleBf16, pg8::MoeOrder, false>(c.lds, EFF, S, E);
            } else {
            const long total = (long)MAXROWS * D;
            for (long idx = GTID; idx < total; idx += GSIZE) {
                const int R = (int)(idx / D), n = (int)(idx % D); int e, i, cn;
                if (!row_lookup(cnt, R, e, i, cn) || i >= cn) continue;
                const int t = LIST[e * NTOK + i];
                const float w = (TOKE[2 * t] == e) ? TOKW[2 * t] : TOKW[2 * t + 1];
                const u32x4* a4 = (const u32x4*)(ACT + (size_t)R * EFF); const u32x4* b4 = (const u32x4*)(W2 + ((size_t)e * 1024 + n) * 512);
                float s = 0.f;
                for (int k8 = 0; k8 < EFF / 8; ++k8) s += dot8(a4[k8], b4[k8]);
                Y[(size_t)R * D + n] = (bf16)f2bf(s * w);
            }
            }
            GRID_BAR(pb + 7);
        }
        if (IN(pb + 8)) for (int rep_ = 0; rep_ <= (int)((REPEAT_MASK >> (pb + 8)) & 1u); ++rep_) { c = fresh_ctx(ldsp);
            build_tab(c, cnt);
            if (L == 0) { const bool dry = ((REPEAT_MASK >> (pb + 8)) & 1u) && rep_ == 0;
                combine_phase(c, X, Y, RT, (const LAS int*)(c.lds + TAB_OFF), norm_mix + D, dry ? (bf16*)(ws + WS_S + 80 * MiB) : XN, nullptr, dry ? (float*)(ws + WS_S) : X); if (dry) { GRID_BAR(pb + 8); continue; }
            }
            else { combine_phase(c, X, Y, RT, (const LAS int*)(c.lds + TAB_OFF), final_norm, nullptr, X, X);
                if (PROBE_EN && blockIdx.x == 0) {
                    __syncthreads();
                    const unsigned now = (unsigned)__builtin_amdgcn_s_memrealtime();
                    const unsigned a0 = CTL[600 + PROBE_A0], a1 = (PROBE_A1 >= 18) ? now : CTL[600 + PROBE_A1], b0 = CTL[600 + PROBE_B0], b1 = (PROBE_B1 >= 18) ? now : CTL[600 + PROBE_B1];
                    const float da = (float)(a1 - a0) * 0.01f, db = (float)(b1 - b0) * 0.01f;
                    for (int kk = c.lane; kk < D; kk += 64) X[(size_t)c.wave * D + kk] += sqrtf(da * 2.f);
                    if (c.tid == 0) X[(size_t)(8 * gridDim.x) * D] = db;
                }
#if GLA_EXPERIMENT
                { const unsigned bad = CTL[512], vb = CTL[513];
                  int k = 0; if (bad > 0u) k = 1; if (bad > 125u) k = 2; if (bad > 1258u) k = 3; if (bad > 12582u) k = 4; if (bad > 125829u) k = 5; if (bad > 1258291u) k = 6;
                  float f = vb > 0u ? 2.f : 1.f + 0.1f * (float)k; if (CTL[514] > 0u) f = 3.f; if (CTL[515] > 0u) f = 4.f; if (CTL[516] > 0u) f = 4.5f; if (CTL[517] > 0u) f = 5.f;
                  if (k > 0 || vb > 0u) { __syncthreads();
                    for (int t = c.gw; t < NTOK; t += c.ngw) for (int kk = c.lane; kk < D; kk += 64) X[(size_t)t * D + kk] *= f; } }
#endif
            }
            if (L == 0) GRID_BAR(pb + 8);
        }
    }
#undef IN
}

template <int P> static void launch_phases(int grid, hipStream_t stream, const Args& a) {
    if constexpr (P < NPHASES) {
        if constexpr (P != 3 && P != 4) {
            static bool attr_done = false;
            if (!attr_done) { (void)hipFuncSetAttribute((const void*)mk_fwd<P, P + 1>, hipFuncAttributeMaxDynamicSharedMemorySize, LDS_BYTES); attr_done = true; }
            hipLaunchKernelGGL((mk_fwd<P, P + 1>), dim3(grid), dim3(NTHREADS), LDS_BYTES, stream, a);
        }
        launch_phases<P + 1>(grid, stream, a);
    }
}
extern "C" void kernel_launch(void* const* d_in, const int* in_sizes, int n_in, void* d_out, int out_size, void* d_ws, size_t ws_size, hipStream_t stream) {
    static int grid = 0;
    if (grid == 0) {
        if (n_in != 21 || out_size != NTOK * D || ws_size < WS_END) { fprintf(stderr, "kernel_launch: unexpected shapes n_in %d out %d ws %zu (need %zu)\n", n_in, out_size, ws_size, (size_t)WS_END); grid = -1; return; }
        int dev = 0, cus = 0;
        if (hipGetDevice(&dev) != hipSuccess || hipDeviceGetAttribute(&cus, hipDeviceAttributeMultiprocessorCount, dev) != hipSuccess) { grid = -1; return; }
        (void)hipGetLastError();
        grid = cus;
    }
    if (grid < 0) return;
    (void)hipMemsetAsync((char*)d_ws + WS_CTL, 0, CTL_ZERO_BYTES, stream);
    Args a{};
    for (int i = 0; i < 21; ++i) a.in[i] = (const float*)d_in[i];
    a.out = (float*)d_out; a.ws = (unsigned char*)d_ws;
#if defined(MK_PER_PHASE)
    launch_phases<0>(grid, stream, a);
#else
    static bool attr_done = false;
    if (!attr_done) { (void)hipFuncSetAttribute((const void*)mk_fwd<0, NPHASES>, hipFuncAttributeMaxDynamicSharedMemorySize, LDS_BYTES); attr_done = true; }
    hipLaunchKernelGGL((mk_fwd<0, NPHASES>), dim3(grid), dim3(NTHREADS), LDS_BYTES, stream, a);
#endif
}
```

```cpp
#include <hip/hip_runtime.h>
#ifndef SPLIT_CONV
#define SPLIT_CONV 0
#endif
#ifndef REPEAT_MASK
#define REPEAT_MASK 0u
#endif
#ifndef PROBE_EN
#define PROBE_EN 0
#define PROBE_A0 -1
#define PROBE_A1 0
#define PROBE_B0 8
#define PROBE_B1 9
#endif
#define GLA_INTRA_ONLY 0
#include <cstdio>
#include <cstdint>

constexpr int D = 1024, NTOK = 16384, SEQ = 4096, NBATCH = 4, NMEM = 256, HD = 64;
constexpr int MIX = 768, MEMD = 256, NA_H = 12, NA_IN = 2560;
constexpr int GLA_H = 4, GLA_DK = 96, GLA_DV = 192, GLA_IN = 2592, GLA_KD = 384;
constexpr int NEXP = 32, EFF = 512;
constexpr int LDU0 = 2560, LDU1 = 2816;
constexpr int MAXROWS = 40960;
constexpr float EPS = 1e-6f;

typedef unsigned short bf16;
typedef float f32x4 __attribute__((ext_vector_type(4)));
typedef unsigned u32x4 __attribute__((ext_vector_type(4)));
typedef unsigned u32x2 __attribute__((ext_vector_type(2)));
#define LAS __attribute__((address_space(3)))

constexpr size_t MiB = 1048576;
constexpr size_t WS_CTL = 0;
constexpr size_t CTL_ZERO_BYTES = 1 * MiB;
constexpr size_t WS_WIN0 = 1 * MiB;
constexpr size_t WS_WIN1 = WS_WIN0 + (size_t)2560 * 1024 * 2;
constexpr size_t WS_WOUT = WS_WIN1 + (size_t)2816 * 1024 * 2;
constexpr size_t WS_WMKV = WS_WOUT + (size_t)2 * 1024 * 1024 * 2;
constexpr size_t WS_MEMN = WS_WMKV + (size_t)1024 * 1024 * 2;
constexpr size_t WS_MKV = WS_MEMN + (size_t)1024 * 1024 * 2;
constexpr size_t WS_WR = 23 * MiB;
constexpr size_t WS_W13 = 24 * MiB;
constexpr size_t WS_W2 = WS_W13 + 64 * MiB;
constexpr size_t WS_XN = WS_W2 + 32 * MiB;
constexpr size_t WS_U = WS_XN + 32 * MiB;
constexpr size_t WS_Y = WS_U;
constexpr size_t WS_CAT = WS_U + 88 * MiB;
constexpr size_t WS_ACT = WS_CAT + 32 * MiB;
constexpr size_t WS_ROUTE = WS_ACT + 40 * MiB;
constexpr size_t WS_S = WS_ROUTE + 8 * MiB;
constexpr size_t WS_END = WS_S + 176 * MiB;
static_assert(WS_MKV + (size_t)1024 * 1024 * 2 <= WS_WR, "ws map");
static_assert(WS_END <= 512 * MiB, "ws map");
constexpr size_t RT_TOKE = 0, RT_TOKW = 131072, RT_TOKP = 262144, RT_LIST = 524288, RT_LISTW = 524288 + 2 * MiB;
constexpr int CW_CNT = 8192, CNT_ST = 64;
constexpr int CW_BAR = 32768;

struct Args {
    const float* in[21]; float* out; unsigned char* ws; int ph_lo, ph_hi;
};

__device__ __forceinline__ float bf2f(bf16 v) { return __uint_as_float(((unsigned)v) << 16); }
__device__ __forceinline__ unsigned f2bf(float f) { unsigned u = __float_as_uint(f); return (u + 0x7fffu + ((u >> 16) & 1u)) >> 16; }
__device__ __forceinline__ unsigned pk2(float lo, float hi) { return f2bf(lo) | (f2bf(hi) << 16); }
__device__ __forceinline__ float wave_sum(float v) {
#pragma unroll
    for (int o = 1; o < 64; o <<= 1) v += __shfl_xor(v, o);
    return v;
}
__device__ __forceinline__ float dot8(u32x4 a, u32x4 b) {
    float s = 0.f;
#pragma unroll
    for (int i = 0; i < 4; ++i) {
        s += __uint_as_float(a[i] << 16) * __uint_as_float(b[i] << 16);
        s += __uint_as_float(a[i] & 0xffff0000u) * __uint_as_float(b[i] & 0xffff0000u);
    }
    return s;
}
__device__ __forceinline__ float silu(float x) { return x / (1.f + __expf(-x)); }

struct Ctx {
    int tid, lane, wave, gw, ngw;
    LAS unsigned char* lds;
};
__device__ __forceinline__ Ctx fresh_ctx(LAS unsigned char* lds) {
    Ctx c; int t = threadIdx.x; asm volatile("" : "+v"(t)); int b = blockIdx.x; asm volatile("" : "+s"(b));
    c.tid = t; c.lane = t & 63; c.wave = __builtin_amdgcn_readfirstlane(t >> 6); c.gw = b * 8 + c.wave; c.ngw = gridDim.x * 8; c.lds = lds; return c;
}
__device__ __forceinline__ long gtid_() { int t = threadIdx.x; asm volatile("" : "+v"(t)); int b = blockIdx.x; asm volatile("" : "+s"(b)); return (long)(b * 512 + t); }
#define GTID gtid_()
#define GSIZE ((long)gridDim.x * 512)

__device__ __forceinline__ void transpose_item(const float* W, int N, int k0, int n0, bf16* dstrow0, int Kd, LAS float* scr, int lane) {
    f32x4 v[8]; const int lr = lane >> 3, lc = (lane & 7) * 4;
#pragma unroll
    for (int i = 0; i < 8; ++i) v[i] = *(const f32x4*)(W + (size_t)(k0 + 8 * i + lr) * N + n0 + lc);
#pragma unroll
    for (int i = 0; i < 8; ++i) { LAS float* s = scr + (8 * i + lr) * 33 + lc; s[0] = v[i][0]; s[1] = v[i][1]; s[2] = v[i][2]; s[3] = v[i][3]; }
    asm volatile("s_waitcnt lgkmcnt(0)" ::: "memory");
    const int c = lane & 7;
#pragma unroll
    for (int j = 0; j < 4; ++j) { const int n = (lane >> 3) + 8 * j; const LAS float* s = scr + (8 * c) * 33 + n;
        u32x4 o; o.x = pk2(s[0 * 33], s[1 * 33]); o.y = pk2(s[2 * 33], s[3 * 33]); o.z = pk2(s[4 * 33], s[5 * 33]); o.w = pk2(s[6 * 33], s[7 * 33]);
        *(u32x4*)(dstrow0 + (size_t)n * Kd + k0 + 8 * c) = o; }
    asm volatile("s_waitcnt lgkmcnt(0)" ::: "memory");
}
__device__ __forceinline__ void transpose_matrix(const Ctx& c, const float* W, int K, int N, bf16* dst, int it0, int itstride) {
    LAS float* scr = (LAS float*)(c.lds + c.wave * 16384);
    const int nblk = N / 32, nit = (K / 64) * nblk;
    for (int it = it0; it < nit; it += itstride) { const int kb = it / nblk, nb = it % nblk;
        transpose_item(W, N, kb * 64, nb * 32, dst + (size_t)(nb * 32) * K, K, scr, c.lane); }
}
struct CvItem { const float* W; int N, k0, n0, Kd; bf16* dst; };
__device__ __forceinline__ CvItem cv_decode(int it, const float* w1, const float* w3, const float* w2, bf16* W13, bf16* W2) {
    const int per_e = 768;
    const int e = it / per_e, r = it % per_e, which = r / 256, q = r % 256; CvItem x;
    if (which < 2) { const int kb = q / 16, nb = q % 16, n0 = nb * 32;
        x.W = (which == 0 ? w1 : w3) + (size_t)e * 1024 * 512; x.N = 512; x.k0 = kb * 64; x.n0 = n0; x.Kd = 1024;
        x.dst = W13 + ((size_t)e * 1024 + (n0 / 128) * 256 + which * 128 + (n0 % 128)) * 1024;
    } else { const int kb = q / 32, nb = q % 32, n0 = nb * 32;
        x.W = w2 + (size_t)e * 512 * 1024; x.N = 1024; x.k0 = kb * 64; x.n0 = n0; x.Kd = 512; x.dst = W2 + ((size_t)e * 1024 + n0) * 512; }
    return x;
}
__device__ __forceinline__ void convert_moe_dyn(const Ctx& c, const float* w1, const float* w3, const float* w2, bf16* W13, bf16* W2, LAS unsigned* ctr) {
    LAS float* scr = (LAS float*)(c.lds + c.wave * 16384);
    const int nit = NEXP * 768, G = (int)gridDim.x, per = (nit + G - 1) / G, lane = c.lane, lr = lane >> 3, lc = (lane & 7) * 4, cc = lane & 7;
#define CV_NEXT(itv) do { unsigned k_ = 0; if (lane == 0) k_ = __hip_atomic_fetch_add(ctr, 1u, __ATOMIC_RELAXED, __HIP_MEMORY_SCOPE_WORKGROUP); k_ = __builtin_amdgcn_readfirstlane(k_); \
        itv = ((int)k_ < per && (int)blockIdx.x * per + (int)k_ < nit) ? (int)blockIdx.x * per + (int)k_ : -1; } while (0)
#define CV_LOAD(x, v) do { _Pragma("unroll") for (int i = 0; i < 8; ++i) v[i] = *(const f32x4*)(x.W + (size_t)(x.k0 + 8 * i + lr) * x.N + x.n0 + lc); } while (0)
    int it; CV_NEXT(it); if (it < 0) return;
    CvItem cur = cv_decode(it, w1, w3, w2, W13, W2); f32x4 v[8], vn[8]; CV_LOAD(cur, v);
    for (;;) {
        int itn; CV_NEXT(itn); CvItem nxt = cur;
        if (itn >= 0) { nxt = cv_decode(itn, w1, w3, w2, W13, W2); CV_LOAD(nxt, vn); }
        __builtin_amdgcn_sched_barrier(0);
#pragma unroll
        for (int i = 0; i < 8; ++i) { LAS float* s = scr + (8 * i + lr) * 33 + lc; s[0] = v[i][0]; s[1] = v[i][1]; s[2] = v[i][2]; s[3] = v[i][3]; }
        asm volatile("s_waitcnt lgkmcnt(0)" ::: "memory");
#pragma unroll
        for (int j = 0; j < 4; ++j) { const int n = (lane >> 3) + 8 * j; const LAS float* s = scr + (8 * cc) * 33 + n;
            u32x4 o; o.x = pk2(s[0 * 33], s[1 * 33]); o.y = pk2(s[2 * 33], s[3 * 33]); o.z = pk2(s[4 * 33], s[5 * 33]); o.w = pk2(s[6 * 33], s[7 * 33]);
            *(u32x4*)(cur.dst + (size_t)n * cur.Kd + cur.k0 + 8 * cc) = o; }
        asm volatile("s_waitcnt lgkmcnt(0)" ::: "memory");
        if (itn < 0) break;
        cur = nxt;
#pragma unroll
        for (int i = 0; i < 8; ++i) v[i] = vn[i];
    }
#undef CV_NEXT
#undef CV_LOAD
}
__device__ __forceinline__ void rms_row_to_bf16(const float* xrow, const float* g, bf16* orow, int lane) {
    const f32x4* xr = (const f32x4*)xrow + lane; const f32x4* gr = (const f32x4*)g + lane;
    f32x4 v[4]; float s = 0.f;
#pragma unroll
    for (int j = 0; j < 4; ++j) { v[j] = xr[64 * j]; s += (v[j].x * v[j].x + v[j].y * v[j].y) + (v[j].z * v[j].z + v[j].w * v[j].w); }
    const float r = 1.f / sqrtf(wave_sum(s) * (1.f / D) + EPS);
    u32x2* o8 = (u32x2*)orow + lane;
#pragma unroll
    for (int j = 0; j < 4; ++j) { const f32x4 gg = gr[64 * j]; u32x2 w; w.x = pk2(v[j].x * r * gg.x, v[j].y * r * gg.y); w.y = pk2(v[j].z * r * gg.z, v[j].w * r * gg.w); o8[64 * j] = w; }
}

template <class RowA, class Epi>
__device__ __forceinline__ void naive_gemm(const Ctx& c, int M, int N, int K, const RowA& rowA, const bf16* Bt, const Epi& epi) {
    const long total = (long)M * N;
    for (long idx = GTID; idx < total; idx += GSIZE) {
        const int m = (int)(idx / N), n = (int)(idx % N);
        const bf16* a = rowA(m);
        if (a == nullptr) continue;
        const u32x4* a4 = (const u32x4*)a; const u32x4* b4 = (const u32x4*)(Bt + (size_t)n * K);
        float acc = 0.f;
        for (int k8 = 0; k8 < K / 8; ++k8) acc += dot8(a4[k8], b4[k8]);
        epi(m, n, acc);
    }
}


namespace pg8 {
typedef short bf16x8 __attribute__((ext_vector_type(8)));
constexpr int BM = 256, BK = 64, HALF = 128, HTB = HALF * BK * 2, STAGE_BYTES = 8 * HTB, NXCD = 8, WGM = 8;
__device__ __forceinline__ int lds_byte(int r, int c) { const int st = (r >> 4) * 2 + (c >> 5), rr = r & 15, cc = c & 31, ob = rr * 64 + cc * 2; return st * 1024 + (ob ^ (((ob >> 9) & 1) << 5)); }
__device__ __forceinline__ void stage_rc(int b, int& R, int& C) { const int st = b / 1024, sb = b % 1024, swz = sb ^ (((sb >> 9) & 1) << 5); R = (st >> 1) * 16 + swz / 64; C = (st & 1) * 32 + (swz % 64) / 2; }
__device__ __forceinline__ int perm32(int rho) { const int n = rho >> 4, i = rho & 15; return 8 * (i >> 2) + 4 * n + (i & 3); }
typedef __bf16 bf16v2_t __attribute__((ext_vector_type(2)));
__device__ __forceinline__ unsigned cvt_pk_bf16(float lo, float hi) { const bf16v2_t v = {(__bf16)lo, (__bf16)hi}; return __builtin_bit_cast(unsigned, v); }

struct Unit { int pm, pn, e, nv; };

struct StaticOrder {
    const bf16* A; const bf16* Bt; int K, nM, nN, nwg, G, c;
    __device__ void init(const bf16* A_, const bf16* Bt_, int M, int N, int K_, int G_, int c_) { A = A_; Bt = Bt_; K = K_; nM = M / BM; nN = N / BM; nwg = nM * nN; G = G_; c = c_; }
    __device__ __forceinline__ bool next(int i, Unit& u) const {
        const long L = (long)i * G + c; if (L >= nwg) return false;
        int wgid = (int)L; { const int q = nwg / NXCD, r = nwg % NXCD, xcd = wgid % NXCD, off = wgid / NXCD; wgid = (xcd < r ? xcd * (q + 1) : r * (q + 1) + (xcd - r) * q) + off; }
        const int nig = WGM * nN, gid = wgid / nig, fm = gid * WGM, gsz = (nM - fm) < WGM ? (nM - fm) : WGM;
        u.pm = fm + ((wgid % nig) % gsz); u.pn = (wgid % nig) / gsz; u.e = 0; u.nv = 256; return true;
    }
    __device__ __forceinline__ const char* a_base(const Unit& u) const { return (const char*)A + (size_t)u.pm * BM * K * 2; }
    __device__ __forceinline__ const char* b_base(const Unit& u) const { return (const char*)Bt + (size_t)u.pn * BM * K * 2; }
    __device__ __forceinline__ const int* rows(const Unit&) const { return nullptr; }
};
struct MoeOrder {
    const LAS int* tab; const bf16* A; const bf16* Bt; const int* list; int K, ntn, G, c; bool gather;
    __device__ __forceinline__ bool next(int i, Unit& u) const {
        const int L = i * G + c, total = tab[32] * ntn; if (L >= total) return false;
        const int T = L / ntn; int e = 0;
        for (int x = 1; x < 32; ++x) e = (tab[x] <= T) ? x : e;
        u.pm = T; u.pn = L % ntn; u.e = e; u.nv = tab[64 + e] - (T - tab[e]) * 256; return true;
    }
    __device__ __forceinline__ const char* a_base(const Unit& u) const { return gather ? (const char*)A : (const char*)A + (size_t)u.pm * BM * K * 2; }
    __device__ __forceinline__ const char* b_base(const Unit& u) const { return (const char*)Bt + ((size_t)u.e * 1024 + (size_t)u.pn * BM) * K * 2; }
    __device__ __forceinline__ const int* rows(const Unit& u) const { return list + (size_t)u.e * NTOK + (u.pm - tab[u.e]) * 256; }
};

struct EpiBf16 {
    static constexpr bool PERM = true;
    bf16* O; int ldc;
    __device__ __forceinline__ void operator()(const f32x4 (&acc)[2][2][4][2], const Unit& u, int wr, int wc, int fr, int fq) const {
        const int row0 = u.pm * BM + wr * 64 + fr, col0 = u.pn * BM + wc * 32 + 8 * fq;
#pragma unroll
        for (int ai = 0; ai < 2; ++ai)
#pragma unroll
            for (int m = 0; m < 4; ++m) { bf16* rowp = O + (size_t)(row0 + ai * HALF + m * 16) * ldc + col0;
#pragma unroll
                for (int bj = 0; bj < 2; ++bj) { const f32x4 v0 = acc[ai][bj][m][0], v1 = acc[ai][bj][m][1];
                    u32x4 w; w.x = cvt_pk_bf16(v0[0], v0[1]); w.y = cvt_pk_bf16(v0[2], v0[3]); w.z = cvt_pk_bf16(v1[0], v1[1]); w.w = cvt_pk_bf16(v1[2], v1[3]);
                    *(u32x4*)(rowp + bj * HALF) = w; } }
    }
};
struct EpiResF32 {
    static constexpr bool PERM = false;
    const float* R; float* C;
    __device__ __forceinline__ void operator()(const f32x4 (&acc)[2][2][4][2], const Unit& u, int wr, int wc, int fr, int fq) const {
        const int row0 = u.pm * BM + wr * 64 + fr, col0 = u.pn * BM + wc * 32 + 4 * fq;
#pragma unroll
        for (int ai = 0; ai < 2; ++ai)
#pragma unroll
            for (int m = 0; m < 4; ++m) { const size_t off = (size_t)(row0 + ai * HALF + m * 16) * D + col0;
#pragma unroll
                for (int bj = 0; bj < 2; ++bj)
#pragma unroll
                    for (int n = 0; n < 2; ++n) { const f32x4 rv = *(const f32x4*)(R + off + bj * HALF + n * 16); *(f32x4*)(C + off + bj * HALF + n * 16) = rv + acc[ai][bj][m][n]; }
                asm volatile("" ::: "memory"); }
    }
};
struct EpiSwiGLU {
    static constexpr bool PERM = true;
    bf16* O;
    __device__ __forceinline__ void operator()(const f32x4 (&acc)[2][2][4][2], const Unit& u, int wr, int wc, int fr, int fq) const {
        const int row0 = u.pm * BM + wr * 64 + fr, col0 = u.pn * 128 + wc * 32 + 8 * fq;
#pragma unroll
        for (int ai = 0; ai < 2; ++ai)
#pragma unroll
            for (int m = 0; m < 4; ++m) { float o[8];
#pragma unroll
                for (int n = 0; n < 2; ++n)
#pragma unroll
                    for (int i = 0; i < 4; ++i) { const float a = acc[ai][0][m][n][i], b = acc[ai][1][m][n][i]; o[n * 4 + i] = a * b * __builtin_amdgcn_rcpf(1.f + __expf(-a)); }
                u32x4 w; w.x = cvt_pk_bf16(o[0], o[1]); w.y = cvt_pk_bf16(o[2], o[3]); w.z = cvt_pk_bf16(o[4], o[5]); w.w = cvt_pk_bf16(o[6], o[7]);
                *(u32x4*)(O + (size_t)(row0 + ai * HALF + m * 16) * EFF + col0) = w; }
    }
};
struct EpiScaleBf16 {
    static constexpr bool PERM = true;
    bf16* O; const float* listw; const LAS int* tab;
    __device__ __forceinline__ void operator()(const f32x4 (&acc)[2][2][4][2], const Unit& u, int wr, int wc, int fr, int fq) const {
        const int rl0 = wr * 64 + fr, col0 = u.pn * BM + wc * 32 + 8 * fq;
        const float* lw = listw + (size_t)u.e * NTOK + (u.pm - tab[u.e]) * 256;
        float wv[2][4];
#pragma unroll
        for (int ai = 0; ai < 2; ++ai)
#pragma unroll
            for (int m = 0; m < 4; ++m) { const int rl = rl0 + ai * HALF + m * 16; wv[ai][m] = rl < u.nv ? lw[rl] : 0.f; }
#pragma unroll
        for (int ai = 0; ai < 2; ++ai)
#pragma unroll
            for (int m = 0; m < 4; ++m) { bf16* rowp = O + (size_t)(u.pm * BM + rl0 + ai * HALF + m * 16) * D + col0; const float s = wv[ai][m];
#pragma unroll
                for (int bj = 0; bj < 2; ++bj) { const f32x4 v0 = acc[ai][bj][m][0] * s, v1 = acc[ai][bj][m][1] * s;
                    u32x4 w; w.x = cvt_pk_bf16(v0[0], v0[1]); w.y = cvt_pk_bf16(v0[2], v0[3]); w.z = cvt_pk_bf16(v1[0], v1[1]); w.w = cvt_pk_bf16(v1[2], v1[3]);
                    *(u32x4*)(rowp + bj * HALF) = w; } }
    }
};

template <class Epi, class Sched, bool GATHER>
__device__ __forceinline__ void gemm_phase(LAS unsigned char* lds, const int K, const Sched& S, const Epi& E) {
    int tid_ = threadIdx.x; asm volatile("" : "+v"(tid_));
    const int tid = tid_, wid = __builtin_amdgcn_readfirstlane(tid >> 6), lane = tid & 63, wr = wid >> 2, wc = wid & 3, fr = lane & 15, fq = lane >> 4;
    const int nt = K / BK;
    int Rr[2], Cc[2]; unsigned voffB[2];
#pragma unroll
    for (int i = 0; i < 2; ++i) { int R, C; stage_rc(tid * 16 + i * 8192, R, C); Rr[i] = R; Cc[i] = C; const int Rb = Epi::PERM ? ((R & ~31) + perm32(R & 31)) : R; voffB[i] = (unsigned)(Rb * K + C) * 2u; }
    const size_t kstep = (size_t)(BK * 2);
    const size_t hstep = (size_t)HALF * K * 2;
    const size_t hstepA = GATHER ? 0 : hstep;
    const unsigned ldsw = (unsigned)wid * 1024u;
    const int aoff = lds_byte(wr * 64 + fr, fq * 8), boff = lds_byte(wc * 32 + fr, fq * 8);
#define PG8_SA(b, h) (((b) * 2 + (h)) * HTB)
#define PG8_SB(b, h) ((4 + (b) * 2 + (h)) * HTB)
#define PG8_STAGE(bufoff, gbase, voff) do { _Pragma("unroll") for (int _i = 0; _i < 2; ++_i) \
        __builtin_amdgcn_global_load_lds((const unsigned*)((const char*)(gbase) + (voff)[_i]), (LAS unsigned*)(lds + (bufoff) + ldsw + _i * 8192), 16, 0, 0); } while (0)
#define PG8_LDA(dst, b, h) do { _Pragma("unroll") for (int m = 0; m < 4; ++m) _Pragma("unroll") for (int k = 0; k < 2; ++k) dst[m][k] = *(const LAS bf16x8*)(lds + PG8_SA(b, h) + aoff + m * 2048 + k * 1024); } while (0)
#define PG8_LDB(dst, b, h) do { _Pragma("unroll") for (int n = 0; n < 2; ++n) _Pragma("unroll") for (int k = 0; k < 2; ++k) dst[n][k] = *(const LAS bf16x8*)(lds + PG8_SB(b, h) + boff + n * 2048 + k * 1024); } while (0)
#define PG8_MMA(ai, bj, At, Bt) do { __builtin_amdgcn_s_setprio(1); _Pragma("unroll") for (int m = 0; m < 4; ++m) _Pragma("unroll") for (int n = 0; n < 2; ++n) _Pragma("unroll") for (int k = 0; k < 2; ++k) \
        acc[ai][bj][m][n] = __builtin_amdgcn_mfma_f32_16x16x32_bf16(Bt[n][k], At[m][k], acc[ai][bj][m][n], 0, 0, 0); __builtin_amdgcn_s_setprio(0); } while (0)
#define PG8_WAIT_V(n) asm volatile("s_waitcnt vmcnt(" #n ")" ::: "memory")
#define PG8_WAIT_L(n) asm volatile("s_waitcnt lgkmcnt(" #n ")" ::: "memory")
#define PG8_BAR __builtin_amdgcn_s_barrier()
#define PG8_SCHED __builtin_amdgcn_sched_barrier(0)
#define PG8_VOFFA(u, v0, v1) do { if constexpr (GATHER) { const int* _rw = S.rows(u); _Pragma("unroll") for (int _i = 0; _i < 2; ++_i) { \
            const int _r0 = Rr[_i], _r1 = Rr[_i] + HALF; const int _t0 = _rw[_r0 < (u).nv ? _r0 : 0], _t1 = _rw[_r1 < (u).nv ? _r1 : 0]; \
            v0[_i] = (unsigned)(_t0 * K + Cc[_i]) * 2u; v1[_i] = (unsigned)(_t1 * K + Cc[_i]) * 2u; } } \
        else { _Pragma("unroll") for (int _i = 0; _i < 2; ++_i) { v0[_i] = (unsigned)(Rr[_i] * K + Cc[_i]) * 2u; v1[_i] = v0[_i]; } } } while (0)
    Unit cur, nxt; int ui = 0;
    if (!S.next(0, cur)) return;
    f32x4 acc[2][2][4][2];
#pragma unroll
    for (int a = 0; a < 2; ++a)
#pragma unroll
        for (int b = 0; b < 2; ++b)
#pragma unroll
            for (int m = 0; m < 4; ++m)
#pragma unroll
                for (int n = 0; n < 2; ++n) acc[a][b][m][n] = (f32x4){0.f, 0.f, 0.f, 0.f};
    bf16x8 At[4][2], B0[2][2], B1[2][2];
    const char* cA = S.a_base(cur); const char* cB = S.b_base(cur);
    unsigned cv0[2], cv1[2], nv0[2], nv1[2];
    PG8_VOFFA(cur, cv0, cv1);
    PG8_STAGE(PG8_SB(0, 0), cB, voffB); PG8_STAGE(PG8_SB(0, 1), cB + hstep, voffB); PG8_STAGE(PG8_SA(0, 0), cA, cv0); PG8_STAGE(PG8_SA(0, 1), cA + hstepA, cv1);
    if (wr == 1) PG8_BAR;
    PG8_WAIT_V(2); PG8_BAR;
    PG8_STAGE(PG8_SB(1, 0), cB + kstep, voffB); PG8_STAGE(PG8_SA(1, 0), cA + kstep, cv0); PG8_STAGE(PG8_SB(1, 1), cB + hstep + kstep, voffB);
    PG8_WAIT_V(6); PG8_BAR;
    for (;;) {
        const bool has_next = S.next(ui + 1, nxt);
        const char* nA = has_next ? S.a_base(nxt) : cA; const char* nB = has_next ? S.b_base(nxt) : cB;
        if (has_next) { PG8_VOFFA(nxt, nv0, nv1); } else {
#pragma unroll
            for (int i = 0; i < 2; ++i) { nv0[i] = cv0[i]; nv1[i] = cv1[i]; } }
        for (int t = 0; t < nt; t += 2) {
            const bool last = (t == nt - 2);
            const char* a1 = cA + (size_t)(t + 1) * kstep;
            const char* a2 = last ? nA : cA + (size_t)(t + 2) * kstep; const char* b2 = last ? nB : cB + (size_t)(t + 2) * kstep;
            const char* a3 = a2 + kstep; const char* b3 = b2 + kstep;
            unsigned s0[2], s1[2];
#pragma unroll
            for (int i = 0; i < 2; ++i) { s0[i] = last ? nv0[i] : cv0[i]; s1[i] = last ? nv1[i] : cv1[i]; }
            PG8_LDB(B0, 0, 0); PG8_LDB(B1, 0, 1); PG8_SCHED; PG8_LDA(At, 0, 0); PG8_STAGE(PG8_SA(1, 1), a1 + hstepA, cv1);
            PG8_WAIT_V(8); PG8_WAIT_L(0); PG8_BAR; PG8_MMA(0, 0, At, B0); PG8_MMA(0, 1, At, B1); PG8_BAR; PG8_SCHED;
            PG8_LDA(At, 0, 1); PG8_STAGE(PG8_SB(0, 0), b2, voffB); PG8_STAGE(PG8_SB(0, 1), b2 + hstep, voffB); PG8_STAGE(PG8_SA(0, 0), a2, s0);
            PG8_WAIT_V(8); PG8_WAIT_L(0); PG8_BAR; PG8_MMA(1, 0, At, B0); PG8_MMA(1, 1, At, B1); PG8_BAR; PG8_SCHED;
            PG8_LDB(B0, 1, 0); PG8_LDB(B1, 1, 1); PG8_SCHED; PG8_LDA(At, 1, 0); PG8_STAGE(PG8_SA(0, 1), a2 + hstepA, s1);
            PG8_WAIT_V(8); PG8_WAIT_L(0); PG8_BAR; PG8_MMA(0, 0, At, B0); PG8_MMA(0, 1, At, B1); PG8_BAR; PG8_SCHED;
            PG8_LDA(At, 1, 1); PG8_STAGE(PG8_SB(1, 0), b3, voffB); PG8_STAGE(PG8_SB(1, 1), b3 + hstep, voffB); PG8_STAGE(PG8_SA(1, 0), a3, s0);
            PG8_WAIT_V(8); PG8_WAIT_L(0); PG8_BAR; PG8_MMA(1, 0, At, B0); PG8_MMA(1, 1, At, B1); PG8_BAR; PG8_SCHED;
        }
        if (wr == 0) PG8_BAR;
        E(acc, cur, wr, wc, fr, fq);
        if (!has_next) break;
#pragma unroll
        for (int a = 0; a < 2; ++a)
#pragma unroll
            for (int b = 0; b < 2; ++b)
#pragma unroll
                for (int m = 0; m < 4; ++m)
#pragma unroll
                    for (int n = 0; n < 2; ++n) acc[a][b][m][n] = (f32x4){0.f, 0.f, 0.f, 0.f};
        cur = nxt; cA = nA; cB = nB; ++ui;
#pragma unroll
        for (int i = 0; i < 2; ++i) { cv0[i] = nv0[i]; cv1[i] = nv1[i]; }
        if (wr == 1) PG8_BAR;
    }
    PG8_WAIT_V(0);
    PG8_BAR;
#undef PG8_SA
#undef PG8_SB
#undef PG8_STAGE
#undef PG8_LDA
#undef PG8_LDB
#undef PG8_MMA
#undef PG8_WAIT_V
#undef PG8_WAIT_L
#undef PG8_BAR
#undef PG8_SCHED
#undef PG8_VOFFA
}
}

__device__ __forceinline__ void naive_na(const Ctx& c, const bf16* U, const float* rpb, bf16* CAT) {
    const long total = (long)NTOK * NA_H;
    for (long idx = GTID; idx < total; idx += GSIZE) {
        const int h = (int)(idx % NA_H), t = (int)(idx / NA_H);
        const int b = t / SEQ, p = t % SEQ, r = p / 64, cc = p % 64;
        const int rs = min(max(r - 4, 0), 56), cs = min(max(cc - 8, 0), 48);
        const u32x4* q4 = (const u32x4*)(U + (size_t)t * LDU0 + h * 64);
        float acc[64];
#pragma unroll
        for (int i = 0; i < 64; ++i) acc[i] = 0.f;
        float mx = -1e30f, l = 0.f;
        for (int i = 0; i < 8; ++i) for (int j = 0; j < 16; ++j) {
            const int kr = rs + i, kc = cs + j, kt = b * SEQ + kr * 64 + kc;
            const u32x4* k4 = (const u32x4*)(U + (size_t)kt * LDU0 + 768 + h * 64);
            float s = 0.f;
#pragma unroll
            for (int d8 = 0; d8 < 8; ++d8) s += dot8(q4[d8], k4[d8]);
            s = s * 0.125f + rpb[(h * 15 + (kr - r + 7)) * 31 + (kc - cc + 15)];
            const float mn = fmaxf(mx, s), alpha = __expf(mx - mn), pp = __expf(s - mn);
            l = l * alpha + pp; mx = mn;
            const u32x4* v4 = (const u32x4*)(U + (size_t)kt * LDU0 + 1536 + h * 64);
#pragma unroll
            for (int d8 = 0; d8 < 8; ++d8) { const u32x4 vv = v4[d8];
#pragma unroll
                for (int e = 0; e < 4; ++e) { acc[d8 * 8 + 2 * e] = acc[d8 * 8 + 2 * e] * alpha + pp * __uint_as_float(vv[e] << 16);
                    acc[d8 * 8 + 2 * e + 1] = acc[d8 * 8 + 2 * e + 1] * alpha + pp * __uint_as_float(vv[e] & 0xffff0000u); } }
        }
        const float inv = 1.f / l;
        u32x4* o4 = (u32x4*)(CAT + (size_t)t * D + h * 64);
#pragma unroll
        for (int d8 = 0; d8 < 8; ++d8) { u32x4 w; w.x = pk2(acc[d8 * 8] * inv, acc[d8 * 8 + 1] * inv); w.y = pk2(acc[d8 * 8 + 2] * inv, acc[d8 * 8 + 3] * inv);
            w.z = pk2(acc[d8 * 8 + 4] * inv, acc[d8 * 8 + 5] * inv); w.w = pk2(acc[d8 * 8 + 6] * inv, acc[d8 * 8 + 7] * inv); o4[d8] = w; }
    }
}
__device__ __forceinline__ void naive_memattn(const Ctx& c, const bf16* U, int ldu, int mqcol, const bf16* MKV, int lay, bf16* CAT) {
    const long total = (long)NTOK * 4;
    for (long idx = GTID; idx < total; idx += GSIZE) {
        const int h = (int)(idx % 4), t = (int)(idx / 4), b = t / SEQ;
        const u32x4* q4 = (const u32x4*)(U + (size_t)t * ldu + mqcol + h * 64);
        float acc[64];
#pragma unroll
        for (int i = 0; i < 64; ++i) acc[i] = 0.f;
        float mx = -1e30f, l = 0.f;
        for (int m = 0; m < NMEM; ++m) {
            const bf16* row = MKV + (size_t)(b * NMEM + m) * 1024 + lay * 512;
            const u32x4* k4 = (const u32x4*)(row + h * 64);
            float s = 0.f;
#pragma unroll
            for (int d8 = 0; d8 < 8; ++d8) s += dot8(q4[d8], k4[d8]);
            s *= 0.125f;
            const float mn = fmaxf(mx, s), alpha = __expf(mx - mn), pp = __expf(s - mn);
            l = l * alpha + pp; mx = mn;
            const u32x4* v4 = (const u32x4*)(row + 256 + h * 64);
#pragma unroll
            for (int d8 = 0; d8 < 8; ++d8) { const u32x4 vv = v4[d8];
#pragma unroll
                for (int e = 0; e < 4; ++e) { acc[d8 * 8 + 2 * e] = acc[d8 * 8 + 2 * e] * alpha + pp * __uint_as_float(vv[e] << 16);
                    acc[d8 * 8 + 2 * e + 1] = acc[d8 * 8 + 2 * e + 1] * alpha + pp * __uint_as_float(vv[e] & 0xffff0000u); } }
        }
        const float inv = 1.f / l;
        u32x4* o4 = (u32x4*)(CAT + (size_t)t * D + MIX + h * 64);
#pragma unroll
        for (int d8 = 0; d8 < 8; ++d8) { u32x4 w; w.x = pk2(acc[d8 * 8] * inv, acc[d8 * 8 + 1] * inv); w.y = pk2(acc[d8 * 8 + 2] * inv, acc[d8 * 8 + 3] * inv);
            w.z = pk2(acc[d8 * 8 + 4] * inv, acc[d8 * 8 + 5] * inv); w.w = pk2(acc[d8 * 8 + 6] * inv, acc[d8 * 8 + 7] * inv); o4[d8] = w; }
    }
}


namespace att {
typedef short bf16x8 __attribute__((ext_vector_type(8)));
typedef short s16x4 __attribute__((ext_vector_type(4)));
__device__ __forceinline__ s16x4 tr_read(LAS const unsigned char* p) { return __builtin_amdgcn_ds_read_tr16_b64_v4i16((LAS s16x4*)p); }
template <bool NA_MODE, class KRow, class Bias>
__device__ __forceinline__ void attn16x256(const bf16* qrow, const KRow& krow, unsigned koff, LAS const unsigned char* vlane, int xs, const Bias& bias, bf16* orow, int fr, int fq) {
    const int p = fr & 3, ph = p >> 1, pl8 = (p & 1) * 8;
    const bf16x8 q0 = *(const bf16x8*)(qrow + 8 * fq), q1 = *(const bf16x8*)(qrow + 32 + 8 * fq);
    f32x4 s[16];
    {   bf16x8 ka[8], kb[8];
#pragma unroll
        for (int kt = 0; kt < 8; ++kt) { const char* kr = krow(kt); ka[kt] = *(const bf16x8*)(kr + koff); kb[kt] = *(const bf16x8*)(kr + koff + 64); }
        __builtin_amdgcn_sched_barrier(0);
#pragma unroll
        for (int kt = 0; kt < 8; ++kt) { f32x4 a = {0.f, 0.f, 0.f, 0.f};
            a = __builtin_amdgcn_mfma_f32_16x16x32_bf16(ka[kt], q0, a, 0, 0, 0);
            a = __builtin_amdgcn_mfma_f32_16x16x32_bf16(kb[kt], q1, a, 0, 0, 0);
            s[kt] = a;
            __builtin_amdgcn_sched_barrier(0);
            const char* kr = krow(8 + kt); ka[kt] = *(const bf16x8*)(kr + koff); kb[kt] = *(const bf16x8*)(kr + koff + 64);
            __builtin_amdgcn_sched_barrier(0); }
#pragma unroll
        for (int kt = 0; kt < 8; ++kt) { f32x4 a = {0.f, 0.f, 0.f, 0.f};
            a = __builtin_amdgcn_mfma_f32_16x16x32_bf16(ka[kt], q0, a, 0, 0, 0);
            a = __builtin_amdgcn_mfma_f32_16x16x32_bf16(kb[kt], q1, a, 0, 0, 0);
            s[8 + kt] = a; }
    }
    float mx = -3.0e38f;
#pragma unroll
    for (int kt = 0; kt < 16; ++kt)
#pragma unroll
        for (int r = 0; r < 4; ++r) { const float v = bias(kt, r, s[kt][r]); s[kt][r] = v; mx = fmaxf(mx, v); }
    mx = fmaxf(mx, __shfl_xor(mx, 16)); mx = fmaxf(mx, __shfl_xor(mx, 32));
    float l = 0.f;
#pragma unroll
    for (int kt = 0; kt < 16; ++kt)
#pragma unroll
        for (int r = 0; r < 4; ++r) { const float pv = __expf(s[kt][r] - mx); s[kt][r] = pv; l += pv; }
    l += __shfl_xor(l, 16); l += __shfl_xor(l, 32);
    LAS const unsigned char* vb[4];
#pragma unroll
    for (int dt = 0; dt < 4; ++dt) vb[dt] = vlane + (((2 * dt + ph) ^ xs) << 4) + pl8;
    f32x4 o[4];
#pragma unroll
    for (int dt = 0; dt < 4; ++dt) o[dt] = (f32x4){0.f, 0.f, 0.f, 0.f};
#pragma unroll
    for (int j = 0; j < 8; ++j) {
        u32x4 pw; pw.x = pg8::cvt_pk_bf16(s[2 * j][0], s[2 * j][1]); pw.y = pg8::cvt_pk_bf16(s[2 * j][2], s[2 * j][3]);
        pw.z = pg8::cvt_pk_bf16(s[2 * j + 1][0], s[2 * j + 1][1]); pw.w = pg8::cvt_pk_bf16(s[2 * j + 1][2], s[2 * j + 1][3]);
        const bf16x8 pb = __builtin_bit_cast(bf16x8, pw);
        constexpr int dummy = 0; (void)dummy;
        const int c0 = NA_MODE ? (((2 * j) >> 1) * 64 + 16 * ((2 * j) & 1)) : 16 * (2 * j);
        const int c1 = NA_MODE ? (((2 * j + 1) >> 1) * 64 + 16 * ((2 * j + 1) & 1)) : 16 * (2 * j + 1);
#pragma unroll
        for (int dt = 0; dt < 4; ++dt) {
            const s16x4 lo = tr_read(vb[dt] + c0 * 128), hi = tr_read(vb[dt] + c1 * 128);
            const bf16x8 va = {lo[0], lo[1], lo[2], lo[3], hi[0], hi[1], hi[2], hi[3]};
            o[dt] = __builtin_amdgcn_mfma_f32_16x16x32_bf16(va, pb, o[dt], 0, 0, 0);
        }
    }
    const float inv = 1.f / l;
#pragma unroll
    for (int dt = 0; dt < 4; ++dt) { u32x2 w; w.x = pg8::cvt_pk_bf16(o[dt][0] * inv, o[dt][1] * inv); w.y = pg8::cvt_pk_bf16(o[dt][2] * inv, o[dt][3] * inv);
        *(u32x2*)(orow + 16 * dt + 4 * fq) = w; }
}

__device__ __forceinline__ void na_phase(const Ctx& c, const bf16* U, const float* rpb, bf16* CAT, int vcu, int G) {
    const int fr = c.lane & 15, fq = c.lane >> 4, j = c.wave & 3, hs = c.wave >> 2;
    for (int u = vcu; u < NBATCH * 6 * 64; u += G) {
        const int r = u & 63, hp = (u >> 6) % 6, b = u / 384, rs = min(max(r - 4, 0), 56);
        __syncthreads();
        { u32x4 vv[16];
#pragma unroll
            for (int it = 0; it < 16; ++it) { const int idx = c.tid + 512 * it, hsel = idx >> 12, rem = idx & 4095, key = rem >> 3, ch = rem & 7;
                vv[it] = *(const u32x4*)(U + (size_t)(b * SEQ + (rs + (key >> 6)) * 64 + (key & 63)) * LDU0 + 1536 + (2 * hp + hsel) * 64 + ch * 8); }
            __builtin_amdgcn_sched_barrier(0);
#pragma unroll
            for (int it = 0; it < 16; ++it) { const int idx = c.tid + 512 * it, hsel = idx >> 12, rem = idx & 4095, key = rem >> 3, ch = rem & 7;
                *(LAS u32x4*)(c.lds + hsel * 65536 + key * 128 + ((ch ^ (key & 7)) << 4)) = vv[it]; } }
        __syncthreads();
        const int h = 2 * hp + hs, cq = 16 * j + fr, cs = min(max(cq - 8, 0), 48), kc0 = min(max(16 * j - 8, 0), 32);
        const int tq = b * SEQ + r * 64 + cq;
        const bf16* qrow = U + (size_t)tq * LDU0 + h * 64;
        const char* kbase = (const char*)(U + (size_t)(b * SEQ + rs * 64 + kc0) * LDU0 + 768 + h * 64); const unsigned koff = (unsigned)(fr * LDU0 + 8 * fq) * 2u;
        const int rowb = kc0 + 4 * fq + (fr >> 2);
        LAS const unsigned char* vlane = c.lds + hs * 65536 + rowb * 128;
        const float* rp = rpb + (size_t)(h * 15 + (rs - r + 7)) * 31;
        attn16x256<true>(qrow, [&](int kt) { return kbase + (size_t)((kt >> 1) * 64 + 16 * (kt & 1)) * LDU0 * 2; }, koff, vlane, rowb & 7,
            [&](int kt, int rg, float sv) { const int kcol = kc0 + 16 * (kt & 1) + 4 * fq + rg; const bool ok = (kcol >= cs) && (kcol < cs + 16);
                const int dc = min(max(kcol - cq + 15, 0), 30); const float bv = rp[(kt >> 1) * 31 + dc]; return ok ? sv * 0.125f + bv : -1.0e30f; },
            CAT + (size_t)tq * D + h * 64, fr, fq);
    }
}
__device__ __forceinline__ void mem_phase(const Ctx& c, const bf16* U, int ldu, int mqcol, const bf16* MKV, int lay, bf16* CAT, int vcu, int G) {
    const int fr = c.lane & 15, fq = c.lane >> 4;
    for (int u = vcu; u < NBATCH * 4 * 16; u += G) {
        const int tt = u & 15, h = (u >> 4) & 3, b = u >> 6;
        __syncthreads();
#pragma unroll
        for (int it = 0; it < 4; ++it) { const int idx = c.tid + 512 * it, key = idx >> 3, ch = idx & 7;
            const u32x4 v = *(const u32x4*)(MKV + (size_t)(b * NMEM + key) * 1024 + lay * 512 + 256 + h * 64 + ch * 8);
            *(LAS u32x4*)(c.lds + key * 128 + ((ch ^ (key & 7)) << 4)) = v; }
        __syncthreads();
        const char* kbase = (const char*)(MKV + (size_t)(b * NMEM) * 1024 + lay * 512 + h * 64); const unsigned koff = (unsigned)(fr * 1024 + 8 * fq) * 2u;
        const int rowb = 4 * fq + (fr >> 2);
        LAS const unsigned char* vlane = c.lds + rowb * 128;
#pragma unroll 1
        for (int it = 0; it < 2; ++it) {
            const int tq = b * SEQ + tt * 256 + c.wave * 32 + it * 16 + fr;
            attn16x256<false>(U + (size_t)tq * ldu + mqcol + h * 64, [&](int kt) { return kbase + (size_t)(16 * kt) * 1024 * 2; }, koff, vlane, rowb & 7,
                [&](int, int, float sv) { return sv * 0.125f; }, CAT + (size_t)tq * D + MIX + h * 64, fr, fq);
        }
    }
}
}

__device__ __forceinline__ void route_phase(const Ctx& c, const float* X, const float* g, const float* wg, const float* bg, const float* wr, const float* br,
                                            bf16* HN, unsigned char* rt, unsigned* cnt) {
    int* TOKE = (int*)(rt + RT_TOKE); float* TOKW = (float*)(rt + RT_TOKW); int* TOKP = (int*)(rt + RT_TOKP); int* LIST = (int*)(rt + RT_LIST); float* LISTW = (float*)(rt + RT_LISTW);
    for (int t = c.gw; t < NTOK; t += c.ngw) {
        const f32x4* xr = (const f32x4*)(X + (size_t)t * D) + c.lane; const f32x4* gr = (const f32x4*)g + c.lane;
        f32x4 v[4]; float s = 0.f;
#pragma unroll
        for (int j = 0; j < 4; ++j) { v[j] = xr[64 * j]; s += (v[j].x * v[j].x + v[j].y * v[j].y) + (v[j].z * v[j].z + v[j].w * v[j].w); }
        const float r = 1.f / sqrtf(wave_sum(s) * (1.f / D) + EPS);
        u32x2* o8 = (u32x2*)(HN + (size_t)t * D) + c.lane;
#pragma unroll
        for (int j = 0; j < 4; ++j) { const f32x4 gg = gr[64 * j]; v[j].x *= r * gg.x; v[j].y *= r * gg.y; v[j].z *= r * gg.z; v[j].w *= r * gg.w;
            u32x2 w; w.x = pk2(v[j].x, v[j].y); w.y = pk2(v[j].z, v[j].w); o8[64 * j] = w; }
        LAS float* hrow = (LAS float*)(c.lds + c.wave * 16384);
#pragma unroll
        for (int j = 0; j < 4; ++j) *(LAS f32x4*)(hrow + 4 * c.lane + 256 * j) = v[j];
        asm volatile("s_waitcnt lgkmcnt(0)" ::: "memory");
        float lg[4], lr[32];
#pragma unroll
        for (int o = 0; o < 4; ++o) lg[o] = 0.f;
#pragma unroll
        for (int o = 0; o < 32; ++o) lr[o] = 0.f;
#pragma unroll 1
        for (int kk = 0; kk < 16; ++kk) { const int k = c.lane + 64 * kk; const float xv = hrow[k];
            const f32x4 w4 = *(const f32x4*)(wg + (size_t)k * 4);
#pragma unroll
            for (int o = 0; o < 4; ++o) lg[o] += xv * w4[o];
#pragma unroll
            for (int o4 = 0; o4 < 8; ++o4) { const f32x4 w = *(const f32x4*)(wr + (size_t)k * 32 + o4 * 4);
#pragma unroll
                for (int o = 0; o < 4; ++o) lr[o4 * 4 + o] += xv * w[o]; } }
        asm volatile("s_waitcnt lgkmcnt(0)" ::: "memory");
#pragma unroll
        for (int o = 0; o < 4; ++o) lg[o] = wave_sum(lg[o]) + bg[o];
#pragma unroll
        for (int o = 0; o < 32; ++o) lr[o] = wave_sum(lr[o]) + br[o];
        int gi = 0; float gm = lg[0];
#pragma unroll
        for (int o = 1; o < 4; ++o) if (lg[o] > gm) { gm = lg[o]; gi = o; }
        float gs = 0.f;
#pragma unroll
        for (int o = 0; o < 4; ++o) gs += __expf(lg[o] - gm);
        const float ggate = 1.f / gs;
        float el[8];
#pragma unroll
        for (int o = 0; o < 8; ++o) { float x = lr[o];
#pragma unroll
            for (int q = 1; q < 4; ++q) x = (gi == q) ? lr[q * 8 + o] : x;
            el[o] = x; }
        int i0 = 0; float l0 = el[0];
#pragma unroll
        for (int o = 1; o < 8; ++o) if (el[o] > l0) { l0 = el[o]; i0 = o; }
        int i1 = -1; float l1 = -3.0e38f;
#pragma unroll
        for (int o = 0; o < 8; ++o) if (o != i0 && el[o] > l1) { l1 = el[o]; i1 = o; }
        if (i1 < 0) { i1 = (i0 == 0) ? 1 : 0; l1 = el[0]; }
        const float e1 = __expf(l1 - l0), den = 1.f / (1.f + e1);
        const float w0 = den * ggate, w1 = e1 * den * ggate;
        if (c.lane == 0) {
            const int ex0 = gi * 8 + i0, ex1 = gi * 8 + i1;
            const unsigned p0 = atomicAdd(cnt + ex0 * CNT_ST, 1u), p1 = atomicAdd(cnt + ex1 * CNT_ST, 1u);
            LIST[ex0 * NTOK + p0] = t; LIST[ex1 * NTOK + p1] = t; LISTW[ex0 * NTOK + p0] = w0; LISTW[ex1 * NTOK + p1] = w1;
            TOKE[2 * t] = ex0; TOKE[2 * t + 1] = ex1; TOKW[2 * t] = w0; TOKW[2 * t + 1] = w1; TOKP[2 * t] = (int)p0; TOKP[2 * t + 1] = (int)p1;
        }
    }
}

__device__ __forceinline__ void route_mfma(const Ctx& c, const float* X, const float* g, const float* WRl, const float* bg, const float* br, bf16* HN, unsigned char* rt, unsigned* cnt) {
    int* TOKE = (int*)(rt + RT_TOKE); float* TOKW = (float*)(rt + RT_TOKW); int* TOKP = (int*)(rt + RT_TOKP); int* LIST = (int*)(rt + RT_LIST); float* LISTW = (float*)(rt + RT_LISTW);
    if (c.wave >= 4) return;
    const int fr = c.lane & 15, fq = c.lane >> 4, lr = c.lane >> 5, lc = (c.lane & 31) * 4;
    LAS float* XS = (LAS float*)(c.lds + c.wave * 16384);
    LAS float* LG = XS + 16 * 132;
    const float* w3 = WRl + c.lane * 4;
    for (int tile = blockIdx.x * 4 + c.wave; tile < NTOK / 16; tile += gridDim.x * 4) {
        const int t0 = tile * 16; const float* xp = X + (size_t)(t0 + lr) * D + lc;
        f32x4 a0 = {0.f, 0.f, 0.f, 0.f}, a1 = a0, a2 = a0; float ss = 0.f;
        f32x4 pre[8], wa0[4], wa1[4], wa2[4], wb0[4], wb1[4], wb2[4];
#define RT_LOADX(ch) do { _Pragma("unroll") for (int i_ = 0; i_ < 8; ++i_) pre[i_] = *(const f32x4*)(xp + (size_t)(2 * i_) * D + 128 * (ch)); } while (0)
#define RT_PUTX() do { _Pragma("unroll") for (int i_ = 0; i_ < 8; ++i_) *(LAS f32x4*)(XS + (2 * i_ + lr) * 132 + lc) = pre[i_]; } while (0)
#define RT_LOADW(W0_, W1_, W2_, Q) do { _Pragma("unroll") for (int q_ = 0; q_ < 4; ++q_) { const int j_ = (Q) * 4 + q_; W0_[q_] = *(const f32x4*)(w3 + (j_ * 3 + 0) * 256); \
            W1_[q_] = *(const f32x4*)(w3 + (j_ * 3 + 1) * 256); W2_[q_] = *(const f32x4*)(w3 + (j_ * 3 + 2) * 256); } } while (0)
#define RT_MMA(W0_, W1_, W2_, HALF) do { _Pragma("unroll") for (int q_ = 0; q_ < 4; ++q_) { const f32x4 v = *(LAS const f32x4*)(XS + fr * 132 + 16 * ((HALF) * 4 + q_) + 4 * fq); \
            ss += (v[0] * v[0] + v[1] * v[1]) + (v[2] * v[2] + v[3] * v[3]); \
            _Pragma("unroll") for (int i = 0; i < 4; ++i) { a0 = __builtin_amdgcn_mfma_f32_16x16x4f32(v[i], W0_[q_][i], a0, 0, 0, 0); a1 = __builtin_amdgcn_mfma_f32_16x16x4f32(v[i], W1_[q_][i], a1, 0, 0, 0); \
                a2 = __builtin_amdgcn_mfma_f32_16x16x4f32(v[i], W2_[q_][i], a2, 0, 0, 0); } } } while (0)
        RT_LOADX(0); RT_LOADW(wa0, wa1, wa2, 0);
#pragma unroll 1
        for (int ch = 0; ch < 8; ++ch) {
            RT_PUTX();
            if (ch < 7) RT_LOADX(ch + 1);
            RT_LOADW(wb0, wb1, wb2, 2 * ch + 1);
            __builtin_amdgcn_sched_barrier(0);
            RT_MMA(wa0, wa1, wa2, 0);
            __builtin_amdgcn_sched_barrier(0);
            if (ch < 7) RT_LOADW(wa0, wa1, wa2, 2 * ch + 2);
            __builtin_amdgcn_sched_barrier(0);
            RT_MMA(wb0, wb1, wb2, 1);
            __builtin_amdgcn_sched_barrier(0);
        }
#undef RT_LOADX
#undef RT_PUTX
#undef RT_LOADW
#undef RT_MMA
        ss += __shfl_xor(ss, 16); ss += __shfl_xor(ss, 32);
        const float r = 1.f / sqrtf(ss * (1.f / D) + EPS);
        const float b0 = fr < 4 ? bg[fr] : br[fr - 4], b1 = br[12 + fr], b2 = fr < 4 ? br[28 + fr] : 0.f;
#pragma unroll
        for (int rg = 0; rg < 4; ++rg) { const float rr = __shfl(r, 4 * fq + rg); LAS float* row = LG + (4 * fq + rg) * 48;
            row[fr] = a0[rg] * rr + b0; row[16 + fr] = a1[rg] * rr + b1; row[32 + fr] = a2[rg] * rr + b2; }
        f32x4 gv[8];
#pragma unroll
        for (int ch = 0; ch < 8; ++ch) gv[ch] = *(const f32x4*)(g + 128 * ch + lc);
#pragma unroll 1
        for (int i = 0; i < 8; ++i) { const float rr = __shfl(r, 2 * i + lr); f32x4 xv[8];
#pragma unroll
            for (int ch = 0; ch < 8; ++ch) xv[ch] = *(const f32x4*)(xp + (size_t)(2 * i) * D + 128 * ch);
            __builtin_amdgcn_sched_barrier(0);
            bf16* hp = HN + (size_t)(t0 + 2 * i + lr) * D + lc;
#pragma unroll
            for (int ch = 0; ch < 8; ++ch) { const f32x4 v = xv[ch], gg = gv[ch];
                u32x2 w; w.x = pg8::cvt_pk_bf16(v[0] * rr * gg[0], v[1] * rr * gg[1]); w.y = pg8::cvt_pk_bf16(v[2] * rr * gg[2], v[3] * rr * gg[3]); *(u32x2*)(hp + 128 * ch) = w; }
            __builtin_amdgcn_sched_barrier(0); }
        asm volatile("s_waitcnt lgkmcnt(0)" ::: "memory");
        if (c.lane < 16) { const int t = t0 + c.lane; LAS const float* lrow = LG + c.lane * 48;
            float lg[4], el[8];
#pragma unroll
            for (int o = 0; o < 4; ++o) lg[o] = lrow[o];
            int gi = 0; float gm = lg[0];
#pragma unroll
            for (int o = 1; o < 4; ++o) if (lg[o] > gm) { gm = lg[o]; gi = o; }
            float gs = 0.f;
#pragma unroll
            for (int o = 0; o < 4; ++o) gs += __expf(lg[o] - gm);
            const float ggate = 1.f / gs;
#pragma unroll
            for (int o = 0; o < 8; ++o) el[o] = lrow[4 + gi * 8 + o];
            int i0 = 0; float l0 = el[0];
#pragma unroll
            for (int o = 1; o < 8; ++o) if (el[o] > l0) { l0 = el[o]; i0 = o; }
            int i1 = -1; float l1 = -3.0e38f;
#pragma unroll
            for (int o = 0; o < 8; ++o) if (o != i0 && el[o] > l1) { l1 = el[o]; i1 = o; }
            if (i1 < 0) { i1 = (i0 == 0) ? 1 : 0; l1 = el[0]; }
            const float e1 = __expf(l1 - l0), den = 1.f / (1.f + e1), w0 = den * ggate, w1 = e1 * den * ggate;
            const int ex0 = gi * 8 + i0, ex1 = gi * 8 + i1;
            const unsigned p0 = atomicAdd(cnt + ex0 * CNT_ST, 1u), p1 = atomicAdd(cnt + ex1 * CNT_ST, 1u);
            LIST[ex0 * NTOK + p0] = t; LIST[ex1 * NTOK + p1] = t; LISTW[ex0 * NTOK + p0] = w0; LISTW[ex1 * NTOK + p1] = w1;
            TOKE[2 * t] = ex0; TOKE[2 * t + 1] = ex1; TOKW[2 * t] = w0; TOKW[2 * t + 1] = w1; TOKP[2 * t] = (int)p0; TOKP[2 * t + 1] = (int)p1; }
        asm volatile("s_waitcnt lgkmcnt(0)" ::: "memory");
    }
}
__device__ __forceinline__ int pstart_of(const unsigned* cnt, int e) { int s = 0; for (int i = 0; i < e; ++i) s += ((int)cnt[i * CNT_ST] + 255) & ~255; return s; }
__device__ __forceinline__ bool row_lookup(const unsigned* cnt, int R, int& e, int& i, int& n) {
    int s = 0;
    for (int x = 0; x < NEXP; ++x) { const int cn = (int)cnt[x * CNT_ST], pc = (cn + 255) & ~255; if (R < s + pc) { e = x; i = R - s; n = cn; return true; } s += pc; }
    return false;
}

__device__ __forceinline__ void combine_phase(const Ctx& c, float* X, const bf16* Y, const unsigned char* rt, const LAS int* tab, const float* g, bf16* XN, float* OUTF, float* XW) {
    const int* TOKE = (const int*)(rt + RT_TOKE); const int* TOKP = (const int*)(rt + RT_TOKP);
    for (int t = c.gw; t < NTOK; t += c.ngw) {
        const int e0 = TOKE[2 * t], e1 = TOKE[2 * t + 1];
        const int R0 = tab[e0] * 256 + TOKP[2 * t], R1 = tab[e1] * 256 + TOKP[2 * t + 1];
        f32x4* xr = (f32x4*)(X + (size_t)t * D) + c.lane; const f32x4* gr = (const f32x4*)g + c.lane;
        const u32x2* y0 = (const u32x2*)(Y + (size_t)R0 * D) + c.lane; const u32x2* y1 = (const u32x2*)(Y + (size_t)R1 * D) + c.lane;
        f32x4 v[4]; float s = 0.f;
#pragma unroll
        for (int j = 0; j < 4; ++j) { v[j] = xr[64 * j]; const u32x2 a = y0[64 * j], b = y1[64 * j];
            v[j].x += __uint_as_float(a.x << 16) + __uint_as_float(b.x << 16); v[j].y += __uint_as_float(a.x & 0xffff0000u) + __uint_as_float(b.x & 0xffff0000u);
            v[j].z += __uint_as_float(a.y << 16) + __uint_as_float(b.y << 16); v[j].w += __uint_as_float(a.y & 0xffff0000u) + __uint_as_float(b.y & 0xffff0000u);
            s += (v[j].x * v[j].x + v[j].y * v[j].y) + (v[j].z * v[j].z + v[j].w * v[j].w); }
        const float r = 1.f / sqrtf(wave_sum(s) * (1.f / D) + EPS);
        if (XN) {
            u32x2* o8 = (u32x2*)(XN + (size_t)t * D) + c.lane;
            f32x4* xw = (f32x4*)(XW + (size_t)t * D) + c.lane;
#pragma unroll
            for (int j = 0; j < 4; ++j) { xw[64 * j] = v[j]; const f32x4 gg = gr[64 * j]; u32x2 w; w.x = pk2(v[j].x * r * gg.x, v[j].y * r * gg.y); w.y = pk2(v[j].z * r * gg.z, v[j].w * r * gg.w); o8[64 * j] = w; }
        } else {
            f32x4* o = (f32x4*)(OUTF + (size_t)t * D) + c.lane;
#pragma unroll
            for (int j = 0; j < 4; ++j) { const f32x4 gg = gr[64 * j]; f32x4 w; w.x = v[j].x * r * gg.x; w.y = v[j].y * r * gg.y; w.z = v[j].z * r * gg.z; w.w = v[j].w * r * gg.w; o[64 * j] = w; }
        }
    }
}

__device__ __forceinline__ void gla_decay(const Ctx& c, const bf16* U, const float* gup, const float* gbias, float* DECA) {
    const long total = (long)NTOK * 2 * GLA_KD;
    for (long idx = GTID; idx < total; idx += GSIZE) {
        const int cc = (int)(idx % GLA_KD), dir = (int)((idx / GLA_KD) % 2), t = (int)(idx / (2 * GLA_KD));
        const bf16* r = U + (size_t)t * LDU1 + 2304 + dir * 16;
        float z = gbias[dir * GLA_KD + cc];
#pragma unroll
        for (int k = 0; k < 16; ++k) z += bf2f(r[k]) * gup[(dir * 16 + k) * GLA_KD + cc];
        const float ls = fminf(z, 0.f) - log1pf(__expf(-fabsf(z)));
        DECA[idx] = __expf(ls * (1.f / 16.f));
    }
}
__device__ __forceinline__ void gla_recur(const Ctx& c, const bf16* U, const float* DECA, float* OF) {
    const long total = (long)NBATCH * GLA_H * GLA_DV * 2;
    const float qs = 0.10206207261596577f;
    for (long idx = GTID; idx < total; idx += GSIZE) {
        const int half = (int)(idx & 1), dv = (int)((idx >> 1) % GLA_DV), h = (int)(((idx >> 1) / GLA_DV) % GLA_H), b = (int)((idx >> 1) / (GLA_DV * GLA_H));
        float S[48];
        for (int dir = 0; dir < 2; ++dir) {
#pragma unroll
            for (int d = 0; d < 48; ++d) S[d] = 0.f;
            for (int s = 0; s < SEQ; ++s) {
                const int p = dir ? (SEQ - 1 - s) : s, t = b * SEQ + p;
#if GLA_INTRA_ONLY
                if ((s & 63) == 0) {
#pragma unroll
                    for (int d = 0; d < 48; ++d) S[d] = 0.f; }
#endif
                const bf16* row = U + (size_t)t * LDU1;
                const float vv = bf2f(row[768 + h * GLA_DV + dv]);
                const float* a = DECA + ((size_t)t * 2 + dir) * GLA_KD + h * GLA_DK + half * 48;
                const u32x4* q4 = (const u32x4*)(row + h * GLA_DK + half * 48); const u32x4* k4 = (const u32x4*)(row + 384 + h * GLA_DK + half * 48);
                float o = 0.f;
#pragma unroll
                for (int d8 = 0; d8 < 6; ++d8) { const u32x4 qq = q4[d8], kk = k4[d8]; const f32x4 a0 = *(const f32x4*)(a + d8 * 8), a1 = *(const f32x4*)(a + d8 * 8 + 4);
#pragma unroll
                    for (int e = 0; e < 4; ++e) { const float aa0 = e < 2 ? a0[2 * e] : a1[2 * e - 4], aa1 = e < 2 ? a0[2 * e + 1] : a1[2 * e - 3];
                        const float s0 = aa0 * S[d8 * 8 + 2 * e] + __uint_as_float(kk[e] << 16) * vv; S[d8 * 8 + 2 * e] = s0; o += __uint_as_float(qq[e] << 16) * s0;
                        const float s1 = aa1 * S[d8 * 8 + 2 * e + 1] + __uint_as_float(kk[e] & 0xffff0000u) * vv; S[d8 * 8 + 2 * e + 1] = s1; o += __uint_as_float(qq[e] & 0xffff0000u) * s1; } }
                o += __shfl_xor(o, 1);
                float* dst = OF + (size_t)t * MIX + h * GLA_DV + dv;
                if (half == 0) { if (dir == 0) *dst = o * qs; else *dst += o * qs; }
            }
        }
    }
}
__device__ __forceinline__ void gla_norm_gate(const Ctx& c, const float* OF, const bf16* U, const float* onorm, bf16* CAT) {
    for (int it = c.gw; it < NTOK * GLA_H; it += c.ngw) {
        const int h = it % GLA_H, t = it / GLA_H;
        const float* o = OF + (size_t)t * MIX + h * GLA_DV;
        float v[3]; float s = 0.f;
#pragma unroll
        for (int j = 0; j < 3; ++j) { v[j] = o[c.lane + 64 * j]; s += v[j] * v[j]; }
        const float r = 1.f / sqrtf(wave_sum(s) * (1.f / GLA_DV) + EPS);
#pragma unroll
        for (int j = 0; j < 3; ++j) { const int dv = c.lane + 64 * j; const float gg = bf2f(U[(size_t)t * LDU1 + 1536 + h * GLA_DV + dv]);
            CAT[(size_t)t * D + h * GLA_DV + dv] = (bf16)f2bf(v[j] * r * onorm[dv] * silu(gg)); }
    }
}


namespace gla {
typedef short bf16x8 __attribute__((ext_vector_type(8)));
typedef short s16x4 __attribute__((ext_vector_type(4)));
constexpr int LB_OFF = 0, LB_LD = 97;
constexpr int QG_OFF = 25600, KG_OFF = 38912, QS_OFF = 52224, X_LD = 104;
constexpr int VS_OFF = 65536, V_LD = 200;
constexpr int AM_OFF = 91136, AM_LD = 72;
constexpr int TOT_OFF = 100352;
constexpr int RS_OFF = 102400;
constexpr int OS_OFF = 0, OS_LD = 196;
__device__ __forceinline__ s16x4 tr_read(LAS const unsigned char* p) { return __builtin_amdgcn_ds_read_tr16_b64_v4i16((LAS s16x4*)p); }
__device__ __forceinline__ float bflo(unsigned w) { return __uint_as_float(w << 16); }
__device__ __forceinline__ float bfhi(unsigned w) { return __uint_as_float(w & 0xffff0000u); }

constexpr int RR_OFF = RS_OFF + 1024;
__device__ __forceinline__ void prep(const Ctx& c, const bf16* U, const float* gup, const float* gbias, int t0, int h, int dir) {
    LAS float* LB = (LAS float*)(c.lds + LB_OFF); LAS float* TOT = (LAS float*)(c.lds + TOT_OFF); LAS float* RR = (LAS float*)(c.lds + RR_OFF);
    if (c.tid < 128) { const int t = c.tid >> 1, hf = c.tid & 1; const u32x4 ra = *(const u32x4*)(U + (size_t)(t0 + t) * LDU1 + 2304 + dir * 16 + hf * 8);
        f32x4 lo = {bflo(ra[0]), bfhi(ra[0]), bflo(ra[1]), bfhi(ra[1])}, hi = {bflo(ra[2]), bfhi(ra[2]), bflo(ra[3]), bfhi(ra[3])};
        *(LAS f32x4*)(RR + t * 16 + hf * 8) = lo; *(LAS f32x4*)(RR + t * 16 + hf * 8 + 4) = hi; }
    const int d = c.tid % 96, seg = c.tid / 96;
    float gw[16], bs = 0.f;
    if (c.tid < 384) { bs = gbias[dir * GLA_KD + h * GLA_DK + d];
#pragma unroll
        for (int k = 0; k < 16; ++k) gw[k] = gup[(size_t)(dir * 16 + k) * GLA_KD + h * GLA_DK + d]; }
    __syncthreads();
    if (c.tid < 384) { float run = 0.f;
#pragma unroll 4
        for (int i = 0; i < 16; ++i) { const int s = seg * 16 + i, t = dir ? 63 - s : s;
            const f32x4 r0 = *(LAS const f32x4*)(RR + t * 16), r1 = *(LAS const f32x4*)(RR + t * 16 + 4), r2 = *(LAS const f32x4*)(RR + t * 16 + 8), r3 = *(LAS const f32x4*)(RR + t * 16 + 12);
            float z = bs;
#pragma unroll
            for (int k = 0; k < 4; ++k) { z += r0[k] * gw[k]; z += r1[k] * gw[4 + k]; z += r2[k] * gw[8 + k]; z += r3[k] * gw[12 + k]; }
            run += (fminf(z, 0.f) - __logf(1.f + __expf(-fabsf(z)))) * (1.f / 16.f);
            LB[t * LB_LD + d] = run; }
        TOT[seg * 96 + d] = run; }
    __syncthreads();
    if (c.tid < 384) { float off = 0.f;
        for (int s2 = 0; s2 < seg; ++s2) off += TOT[s2 * 96 + d];
        if (seg > 0) {
#pragma unroll 4
            for (int i = 0; i < 16; ++i) { const int s = seg * 16 + i, t = dir ? 63 - s : s; LB[t * LB_LD + d] += off; } }
        if (seg == 3) TOT[4 * 96 + d] = off + TOT[3 * 96 + d]; }
    __syncthreads();
}
__device__ __forceinline__ void stage_v(const Ctx& c, const bf16* U, int t0, int h) {
    for (int idx = c.tid; idx < 64 * 24; idx += 512) { const int t = idx / 24, ch = idx % 24;
        *(LAS u32x4*)(c.lds + VS_OFF + (t * V_LD + ch * 8) * 2) = *(const u32x4*)(U + (size_t)(t0 + t) * LDU1 + 768 + h * GLA_DV + ch * 8); }
}

__device__ __forceinline__ void local_phase(const Ctx& c, const bf16* U, const float* gup, const float* gbias, bf16* SU, float* DEC, int vcu, int G, unsigned* dbg) {
    const int fr = c.lane & 15, fq = c.lane >> 4, q = fr >> 2, p = fr & 3;
    for (int item = vcu; item < NBATCH * GLA_H * 2 * 64; item += G) {
        const int n = item & 63, dir = (item >> 6) & 1, h = (item >> 7) & 3, b = item >> 9, t0 = b * SEQ + n * 64;
        __syncthreads();
        stage_v(c, U, t0, h);
        prep(c, U, gup, gbias, t0, h, dir);
        LAS const float* LB = (LAS const float*)(c.lds + LB_OFF); LAS const float* BL = (LAS const float*)(c.lds + TOT_OFF) + 4 * 96;
        for (int idx = c.tid; idx < 64 * 12; idx += 512) { const int t = idx / 12, ch = idx % 12;
            const u32x4 kk = *(const u32x4*)(U + (size_t)(t0 + t) * LDU1 + 384 + h * GLA_DK + ch * 8); u32x4 w;
#pragma unroll
            for (int e = 0; e < 4; ++e) { const int d = ch * 8 + 2 * e; const float f0 = __expf(BL[d] - LB[t * LB_LD + d]), f1 = __expf(BL[d + 1] - LB[t * LB_LD + d + 1]);
                w[e] = pg8::cvt_pk_bf16(bflo(kk[e]) * f0, bfhi(kk[e]) * f1); }
            *(LAS u32x4*)(c.lds + QG_OFF + (t * X_LD + ch * 8) * 2) = w; }
        if (c.tid < 96) DEC[(size_t)item * 96 + c.tid] = __expf(BL[c.tid]);
        __syncthreads();
        bf16* su = SU + (size_t)item * (GLA_DV * GLA_DK);
#pragma unroll 1
        for (int k9 = 0; k9 < 9; ++k9) { const int id = c.wave * 9 + k9, jv = id / 6, i = id % 6;
            f32x4 acc = {0.f, 0.f, 0.f, 0.f};
#pragma unroll
            for (int ks = 0; ks < 2; ++ks) { const int tr = 32 * ks + 8 * fq + q;
                const s16x4 a0 = tr_read(c.lds + QG_OFF + (tr * X_LD + 16 * i + 4 * p) * 2), a1 = tr_read(c.lds + QG_OFF + ((tr + 4) * X_LD + 16 * i + 4 * p) * 2);
                const s16x4 b0 = tr_read(c.lds + VS_OFF + (tr * V_LD + 16 * jv + 4 * p) * 2), b1 = tr_read(c.lds + VS_OFF + ((tr + 4) * V_LD + 16 * jv + 4 * p) * 2);
                const bf16x8 av = {a0[0], a0[1], a0[2], a0[3], a1[0], a1[1], a1[2], a1[3]}, bv = {b0[0], b0[1], b0[2], b0[3], b1[0], b1[1], b1[2], b1[3]};
                acc = __builtin_amdgcn_mfma_f32_16x16x32_bf16(av, bv, acc, 0, 0, 0); }
            u32x2 w; w.x = pg8::cvt_pk_bf16(acc[0], acc[1]); w.y = pg8::cvt_pk_bf16(acc[2], acc[3]);
            *(u32x2*)(su + (size_t)(16 * jv + fr) * GLA_DK + 16 * i + 4 * fq) = w; }
    }
}
__device__ __forceinline__ void scan_phase(const Ctx& c, const bf16* __restrict__ SU, bf16* __restrict__ SS, const float* __restrict__ DEC) {
    const long total = (long)32 * 2304;
    for (long idx = GTID; idx < total; idx += GSIZE) { const int seq = (int)(idx / 2304), ch = (int)(idx % 2304), dk0 = (ch % 12) * 8, dir = seq & 1;
        float s[8];
#pragma unroll
        for (int e = 0; e < 8; ++e) s[e] = 0.f;
        const size_t cs = (size_t)(GLA_DV * GLA_DK);
        const bf16* pu0 = SU + (size_t)(seq * 64) * cs + (size_t)ch * 8; bf16* ps0 = SS + (size_t)(seq * 64) * cs + (size_t)ch * 8; const float* pd0 = DEC + (size_t)(seq * 64) * 96 + dk0;
#pragma unroll 1
        for (int st0 = 0; st0 < 64; st0 += 8) {
            u32x4 uu[8]; f32x4 da[8], db[8];
#pragma unroll
            for (int k = 0; k < 8; ++k) { const int n = dir ? 63 - (st0 + k) : st0 + k; uu[k] = *(const u32x4*)(pu0 + (size_t)n * cs); da[k] = *(const f32x4*)(pd0 + n * 96); db[k] = *(const f32x4*)(pd0 + n * 96 + 4); }
#pragma unroll
            for (int k = 0; k < 8; ++k) { const int n = dir ? 63 - (st0 + k) : st0 + k;
                u32x4 w; w.x = pg8::cvt_pk_bf16(s[0], s[1]); w.y = pg8::cvt_pk_bf16(s[2], s[3]); w.z = pg8::cvt_pk_bf16(s[4], s[5]); w.w = pg8::cvt_pk_bf16(s[6], s[7]);
                *(u32x4*)(ps0 + (size_t)n * cs) = w;
                s[0] = s[0] * da[k][0] + bflo(uu[k][0]); s[1] = s[1] * da[k][1] + bfhi(uu[k][0]); s[2] = s[2] * da[k][2] + bflo(uu[k][1]); s[3] = s[3] * da[k][3] + bfhi(uu[k][1]);
                s[4] = s[4] * db[k][0] + bflo(uu[k][2]); s[5] = s[5] * db[k][1] + bfhi(uu[k][2]); s[6] = s[6] * db[k][2] + bflo(uu[k][3]); s[7] = s[7] * db[k][3] + bfhi(uu[k][3]); }
        }
    }
}
__device__ __forceinline__ void out_phase(const Ctx& c, const bf16* U, const float* gup, const float* gbias, const bf16* SU, const float* onorm, bf16* CAT, int vcu, int G) {
    const int fr = c.lane & 15, fq = c.lane >> 4, q = fr >> 2, p = fr & 3, it = c.wave & 3, cth = c.wave >> 2;
    const float qsc = 0.10206207261596577f;
    for (int item = vcu; item < NBATCH * GLA_H * 64; item += G) {
        const int n = item & 63, h = (item >> 6) & 3, b = item >> 8, t0 = b * SEQ + n * 64;
        f32x4 o[6];
#pragma unroll
        for (int x = 0; x < 6; ++x) o[x] = (f32x4){0.f, 0.f, 0.f, 0.f};
        __syncthreads();
        stage_v(c, U, t0, h);
#pragma unroll 1
        for (int dir = 0; dir < 2; ++dir) {
            prep(c, U, gup, gbias, t0, h, dir);
            LAS const float* LB = (LAS const float*)(c.lds + LB_OFF); const int tmid = dir ? 32 : 31;
            for (int idx = c.tid; idx < 64 * 12; idx += 512) { const int t = idx / 12, ch = idx % 12;
                const u32x4 qq = *(const u32x4*)(U + (size_t)(t0 + t) * LDU1 + h * GLA_DK + ch * 8), kk = *(const u32x4*)(U + (size_t)(t0 + t) * LDU1 + 384 + h * GLA_DK + ch * 8);
                u32x4 wg, wk, ws;
#pragma unroll
                for (int e = 0; e < 4; ++e) { const int d = ch * 8 + 2 * e; const float b0 = LB[t * LB_LD + d], b1 = LB[t * LB_LD + d + 1], m0 = LB[tmid * LB_LD + d], m1 = LB[tmid * LB_LD + d + 1];
                    const float q0 = bflo(qq[e]) * qsc, q1 = bfhi(qq[e]) * qsc;
                    wg[e] = pg8::cvt_pk_bf16(q0 * __expf(b0 - m0), q1 * __expf(b1 - m1)); wk[e] = pg8::cvt_pk_bf16(bflo(kk[e]) * __expf(m0 - b0), bfhi(kk[e]) * __expf(m1 - b1));
                    ws[e] = pg8::cvt_pk_bf16(q0 * __expf(b0), q1 * __expf(b1)); }
                *(LAS u32x4*)(c.lds + QG_OFF + (t * X_LD + ch * 8) * 2) = wg; *(LAS u32x4*)(c.lds + KG_OFF + (t * X_LD + ch * 8) * 2) = wk; *(LAS u32x4*)(c.lds + QS_OFF + (t * X_LD + ch * 8) * 2) = ws; }
            __syncthreads();
#pragma unroll
            for (int jj = 0; jj < 2; ++jj) { const int jt = 2 * cth + jj; f32x4 a = {0.f, 0.f, 0.f, 0.f};
#pragma unroll
                for (int ks = 0; ks < 3; ++ks) { const bf16x8 av = *(const LAS bf16x8*)(c.lds + QG_OFF + ((16 * it + fr) * X_LD + 32 * ks + 8 * fq) * 2), bv = *(const LAS bf16x8*)(c.lds + KG_OFF + ((16 * jt + fr) * X_LD + 32 * ks + 8 * fq) * 2);
                    a = __builtin_amdgcn_mfma_f32_16x16x32_bf16(av, bv, a, 0, 0, 0); }
#pragma unroll
                for (int rg = 0; rg < 4; ++rg) { const int i = 16 * it + 4 * fq + rg, j = 16 * jt + fr; const bool keep = dir ? (j >= i) : (j <= i);
                    *(LAS bf16*)(c.lds + AM_OFF + (i * AM_LD + j) * 2) = (bf16)f2bf(keep ? a[rg] : 0.f); } }
            __syncthreads();
            const bf16* st = SU + ((size_t)(((b * 4 + h) * 2 + dir) * 64 + n)) * (GLA_DV * GLA_DK);
#pragma unroll
            for (int x = 0; x < 6; ++x) { const int ct = cth * 6 + x;
#pragma unroll
                for (int ks = 0; ks < 2; ++ks) { const int tr = 32 * ks + 8 * fq + q;
                    const bf16x8 av = *(const LAS bf16x8*)(c.lds + AM_OFF + ((16 * it + fr) * AM_LD + 32 * ks + 8 * fq) * 2);
                    const s16x4 b0 = tr_read(c.lds + VS_OFF + (tr * V_LD + 16 * ct + 4 * p) * 2), b1 = tr_read(c.lds + VS_OFF + ((tr + 4) * V_LD + 16 * ct + 4 * p) * 2);
                    const bf16x8 bv = {b0[0], b0[1], b0[2], b0[3], b1[0], b1[1], b1[2], b1[3]};
                    o[x] = __builtin_amdgcn_mfma_f32_16x16x32_bf16(av, bv, o[x], 0, 0, 0); }
#if !GLA_INTRA_ONLY
#pragma unroll
                for (int ks = 0; ks < 3; ++ks) { const bf16x8 av = *(const LAS bf16x8*)(c.lds + QS_OFF + ((16 * it + fr) * X_LD + 32 * ks + 8 * fq) * 2);
                    const bf16x8 bv = *(const bf16x8*)(st + (size_t)(16 * ct + fr) * GLA_DK + 32 * ks + 8 * fq);
                    o[x] = __builtin_amdgcn_mfma_f32_16x16x32_bf16(av, bv, o[x], 0, 0, 0); }
#endif
            }
            __syncthreads();
        }
        LAS float* OS = (LAS float*)(c.lds + OS_OFF);
#pragma unroll
        for (int x = 0; x < 6; ++x)
#pragma unroll
            for (int rg = 0; rg < 4; ++rg) OS[(16 * it + 4 * fq + rg) * OS_LD + 16 * (cth * 6 + x) + fr] = o[x][rg];
        __syncthreads();
        { const int t = c.tid >> 3, part = c.tid & 7; float s = 0.f;
#pragma unroll
            for (int e = 0; e < 24; ++e) { const float v = OS[t * OS_LD + part * 24 + e]; s += v * v; }
            s += __shfl_xor(s, 1); s += __shfl_xor(s, 2); s += __shfl_xor(s, 4);
            if (part == 0) ((LAS float*)(c.lds + RS_OFF))[t] = 1.f / sqrtf(s * (1.f / GLA_DV) + EPS); }
        __syncthreads();
        for (int idx = c.tid; idx < 64 * 24; idx += 512) { const int t = idx / 24, ch = idx % 24; const float r = ((LAS const float*)(c.lds + RS_OFF))[t];
            const u32x4 gg = *(const u32x4*)(U + (size_t)(t0 + t) * LDU1 + 1536 + h * GLA_DV + ch * 8); u32x4 w;
#pragma unroll
            for (int e = 0; e < 4; ++e) { const int dv = ch * 8 + 2 * e; const float g0 = bflo(gg[e]), g1 = bfhi(gg[e]);
                w[e] = pg8::cvt_pk_bf16(OS[t * OS_LD + dv] * r * onorm[dv] * (g0 / (1.f + __expf(-g0))), OS[t * OS_LD + dv + 1] * r * onorm[dv + 1] * (g1 / (1.f + __expf(-g1)))); }
            *(u32x4*)(CAT + (size_t)(t0 + t) * D + h * GLA_DV + ch * 8) = w; }
    }
}
}

#define XB_TMO      128
#define XB_XCNT(j)  (256  + 64 * (j))
#define XB_XSUB(j)  (1280 + 64 * (j))
#define XB_XGEN(j)  (2304 + 64 * (j))
#define XB_TOP      3328
#define XB_TOPGEN   3392
#define XCD_BAR_WORDS 3456
#define XB_SPIN_CAP (1u << 22)
__device__ __forceinline__ unsigned xb_ld(unsigned* p)              { return __hip_atomic_load(p, __ATOMIC_RELAXED, __HIP_MEMORY_SCOPE_AGENT); }
__device__ __forceinline__ unsigned xb_add(unsigned* p, unsigned v) { return __hip_atomic_fetch_add(p, v, __ATOMIC_RELAXED, __HIP_MEMORY_SCOPE_AGENT); }
__device__ __forceinline__ unsigned xb_xcc_id() { return (unsigned)__builtin_amdgcn_s_getreg((3 << 11) | 20) & 0xFu; }
#define XB_SPIN(cond, bar) do { unsigned _sp = 0; while (cond) { __builtin_amdgcn_s_sleep(1); \
    if ((++_sp & 255u) == 0u) { if (xb_ld(&(bar)[XB_TMO])) break; if (_sp > XB_SPIN_CAP) { atomicAdd(&(bar)[XB_TMO], 1u); break; } } } } while (0)
struct XcdBarrier { unsigned* bar; unsigned x; volatile LAS unsigned* st; };
__device__ __forceinline__ XcdBarrier xcd_barrier_post(unsigned* bar, volatile LAS unsigned* st) {
    XcdBarrier b; b.bar = bar; b.x = xb_xcc_id(); b.st = st;
    if (threadIdx.x == 0) (void)xb_add(&bar[XB_XCNT(b.x)], 1u);
    return b;
}
__device__ __forceinline__ void xcd_barrier_complete(unsigned* bar, unsigned x, unsigned& nloc, unsigned& nx) {
    const unsigned G = gridDim.x * gridDim.y * gridDim.z;
    unsigned sum, cnt, mine, sp = 0u;
    for (;;) {
        sum = 0u; cnt = 0u; mine = 0u;
#pragma unroll
        for (unsigned j = 0; j < 16; ++j) { const unsigned c = xb_ld(&bar[XB_XCNT(j)]); sum += c; cnt += (c > 0u) ? 1u : 0u; mine = (j == x) ? c : mine; }
        if (sum == G) break;
        __builtin_amdgcn_s_sleep(1);
        if ((++sp & 255u) == 0u) { if (xb_ld(&bar[XB_TMO])) break; if (sp > XB_SPIN_CAP) { atomicAdd(&bar[XB_TMO], 1u); break; } }
    }
    nloc = mine > 0u ? mine : 1u; nx = cnt > 0u ? cnt : 1u;
}
__device__ __forceinline__ void xcd_barrier(const XcdBarrier& b) {
    asm volatile("s_waitcnt vmcnt(0)" ::: "memory");
    __syncthreads();
    if (threadIdx.x == 0) {
        unsigned* bar = b.bar;
        __builtin_amdgcn_s_waitcnt(0);
        const unsigned bx = __builtin_amdgcn_readfirstlane(xb_xcc_id());
        unsigned nloc = b.st[0], nx = b.st[1];
        if (nloc == 0u) { xcd_barrier_complete(bar, bx, nloc, nx); b.st[0] = nloc; b.st[1] = nx; }
        const unsigned old = xb_add(&bar[XB_XSUB(bx)], 1u);
        const unsigned gen = old / nloc;
        if (old + 1u == (gen + 1u) * nloc) {
            __builtin_amdgcn_fence(__ATOMIC_RELEASE, "agent");
            asm volatile("s_waitcnt vmcnt(0)" ::: "memory");
            const unsigned og = xb_add(&bar[XB_TOP], 1u);
            const unsigned tg = og / nx;
            if (og + 1u == (tg + 1u) * nx) xb_add(&bar[XB_TOPGEN], 1u);
            else XB_SPIN(xb_ld(&bar[XB_TOPGEN]) == tg, bar);
            __builtin_amdgcn_fence(__ATOMIC_ACQUIRE, "agent");
            xb_add(&bar[XB_XGEN(bx)], 1u);
            asm volatile("s_waitcnt vmcnt(0)" ::: "memory");
        } else {
            XB_SPIN(xb_ld(&bar[XB_XGEN(bx)]) == gen, bar);
            __builtin_amdgcn_fence(__ATOMIC_ACQUIRE, "agent");
            asm volatile("s_waitcnt vmcnt(0)" ::: "memory");
        }
    }
    __syncthreads();
}

constexpr int NWAVES = 8, NTHREADS = 512, LDS_BYTES = 147456, MISC_OFF = 131072 + 1024;
constexpr int NPHASES = 19;
constexpr int TAB_OFF = 131072 + 2048;
#ifndef USE_MFMA_ROUTE
#define USE_MFMA_ROUTE 1
#endif
#ifndef GLA_EXPERIMENT
#define GLA_EXPERIMENT 0
#endif
#ifndef USE_MFMA_GLA
#define USE_MFMA_GLA 7
#endif
#ifndef USE_MFMA_ATTN
#define USE_MFMA_ATTN 1
#endif
#ifndef USE_PG8
#define USE_PG8 0xF
#endif
__device__ __forceinline__ void build_tab(const Ctx& c, const unsigned* cnt) {
    LAS int* tab = (LAS int*)(c.lds + TAB_OFF);
    __syncthreads();
    if (c.tid < 64) { const int cn = c.tid < 32 ? (int)cnt[c.tid * CNT_ST] : 0; int mt = (cn + 255) >> 8, inc = mt;
#pragma unroll
        for (int o = 1; o < 32; o <<= 1) { const int v = __shfl_up(inc, o); if ((c.tid & 31) >= o) inc += v; }
        if (c.tid < 32) { tab[c.tid + 1] = inc; tab[64 + c.tid] = cn; } if (c.tid == 0) tab[0] = 0; }
    __syncthreads();
}

template <int PH_LO, int PH_HI> __global__ void __launch_bounds__(NTHREADS, 2) mk_fwd(Args args) {
    extern __shared__ __attribute__((aligned(16))) unsigned char lds_raw[];
    LAS unsigned char* const ldsp = (LAS unsigned char*)lds_raw;
    Ctx c = fresh_ctx(ldsp);
    const int vcu = (gridDim.x % 8 == 0) ? (int)((blockIdx.x % 8) * (gridDim.x / 8) + blockIdx.x / 8) : (int)blockIdx.x;
    unsigned char* ws = args.ws;
    const float* x = args.in[0]; const float* mem = args.in[1]; const float* mem_norm = args.in[2]; const float* final_norm = args.in[3];
    const float* norm_mix = args.in[4]; const float* norm_ffn = args.in[5]; const float* w_mem_kv = args.in[6]; const float* w_out = args.in[7];
    const float* na_w_in = args.in[8]; const float* na_rpb = args.in[9]; const float* gla_w_in = args.in[10]; const float* gla_gate_up = args.in[11];
    const float* gla_gate_bias = args.in[12]; const float* gla_out_norm = args.in[13]; const float* moe_w_group = args.in[14]; const float* moe_b_group = args.in[15];
    const float* moe_w_router = args.in[16]; const float* moe_b_router = args.in[17]; const float* moe_w1 = args.in[18]; const float* moe_w3 = args.in[19]; const float* moe_w2 = args.in[20];
    float* X = args.out;
    bf16* WIN0 = (bf16*)(ws + WS_WIN0); bf16* WIN1 = (bf16*)(ws + WS_WIN1); bf16* WOUT = (bf16*)(ws + WS_WOUT); bf16* WMKV = (bf16*)(ws + WS_WMKV);
    bf16* MEMN = (bf16*)(ws + WS_MEMN); bf16* MKV = (bf16*)(ws + WS_MKV); bf16* W13 = (bf16*)(ws + WS_W13); bf16* W2 = (bf16*)(ws + WS_W2);
    bf16* XN = (bf16*)(ws + WS_XN); bf16* U = (bf16*)(ws + WS_U); bf16* Y = (bf16*)(ws + WS_Y); bf16* CAT = (bf16*)(ws + WS_CAT); bf16* ACT = (bf16*)(ws + WS_ACT);
    unsigned char* RT = ws + WS_ROUTE; float* DECA = (float*)(ws + WS_S + 74 * MiB); float* OF = (float*)(ws + WS_S + 122 * MiB);
    bf16* SU = (bf16*)(ws + WS_S); float* SDEC = (float*)(ws + WS_S + 73 * MiB); bf16* SS = (bf16*)(ws + WS_S + 74 * MiB);
    float* WR = (float*)(ws + WS_WR);
    unsigned* CTL = (unsigned*)(ws + WS_CTL);
#define IN(k) (PH_LO <= (k) && (k) < PH_HI)
    constexpr bool FUSED = (PH_HI - PH_LO) > 1;
    XcdBarrier bar; bar.bar = CTL + CW_BAR; bar.x = 0; bar.st = nullptr;
    if constexpr (FUSED) {
        volatile LAS unsigned* misc = (volatile LAS unsigned*)(c.lds + MISC_OFF);
        if (c.tid < 64) misc[c.tid] = 0u;
        __syncthreads();
        bar = xcd_barrier_post(CTL + CW_BAR, misc + 8);
        if (PROBE_EN && blockIdx.x == 0 && threadIdx.x == 0) CTL[599] = (unsigned)__builtin_amdgcn_s_memrealtime();
    }
#define GRID_BAR(k) do { if constexpr (FUSED) { if (IN((k) + 1)) xcd_barrier(bar); if (PROBE_EN && blockIdx.x == 0 && threadIdx.x == 0) CTL[600 + (k)] = (unsigned)__builtin_amdgcn_s_memrealtime(); } } while (0)

    if (IN(0)) for (int rep_ = 0; rep_ <= (int)((REPEAT_MASK >> (0)) & 1u); ++rep_) { c = fresh_ctx(ldsp);
        transpose_matrix(c, na_w_in, 1024, NA_IN, WIN0, c.gw, c.ngw);
        transpose_matrix(c, gla_w_in, 1024, GLA_IN, WIN1, c.gw, c.ngw);
        for (long i = GTID; i < (long)(2816 - 2592) * 1024 / 8; i += GSIZE) ((u32x4*)(WIN1 + (size_t)2592 * 1024))[i] = (u32x4){0u, 0u, 0u, 0u};
        for (int l = 0; l < 2; ++l) { transpose_matrix(c, w_out + (size_t)l * D * D, 1024, 1024, WOUT + (size_t)l * D * D, c.gw, c.ngw);
            transpose_matrix(c, w_mem_kv + (size_t)l * D * 512, 1024, 512, WMKV + (size_t)l * 512 * 1024, c.gw, c.ngw); }
        for (long i = GTID; i < (long)2 * 48 * D; i += GSIZE) { const int k = (int)(i % D), col = (int)((i / D) % 48), l = (int)(i / (48 * D)); const float gk = norm_ffn[l * D + k];
            WR[(size_t)l * 48 * D + (((((size_t)(k >> 4) * 3 + (col >> 4)) * 4 + ((k >> 2) & 3)) * 16 + (col & 15)) * 4) + (k & 3)] = col < 4 ? moe_w_group[((size_t)l * D + k) * 4 + col] * gk : (col < 36 ? moe_w_router[((size_t)l * D + k) * 32 + (col - 4)] * gk : 0.f); }
        for (int m = c.gw; m < NBATCH * NMEM; m += c.ngw) rms_row_to_bf16(mem + (size_t)m * D, mem_norm, MEMN + (size_t)m * D, c.lane);
        for (int m = c.gw; m < NTOK; m += c.ngw) rms_row_to_bf16(x + (size_t)m * D, norm_mix, XN + (size_t)m * D, c.lane);
        GRID_BAR(0);
    }
#pragma unroll
    for (int L = 0; L < 2; ++L) {
        const int pb = 1 + 9 * L;
        const int ldu = L == 0 ? LDU0 : LDU1;
        unsigned* cnt = CTL + CW_CNT + 4096 * L;
        if (IN(pb)) for (int rep_ = 0; rep_ <= (int)((REPEAT_MASK >> (pb)) & 1u); ++rep_) { c = fresh_ctx(ldsp);
            if constexpr (USE_PG8 & 1) {
                pg8::StaticOrder S; S.init(XN, L == 0 ? WIN0 : WIN1, NTOK, ldu, D, (int)gridDim.x, (int)blockIdx.x);
                pg8::EpiBf16 E{U, ldu};
                pg8::gemm_phase<pg8::EpiBf16, pg8::StaticOrder, false>(c.lds, D, S, E);
                if (L == 0) { pg8::StaticOrder S2; S2.init(MEMN, WMKV, NBATCH * NMEM, 1024, D, (int)gridDim.x, (int)blockIdx.x);
                    pg8::EpiBf16 E2{MKV, 1024};
                    pg8::gemm_phase<pg8::EpiBf16, pg8::StaticOrder, false>(c.lds, D, S2, E2); }
            } else {
            if (L == 0) {
                naive_gemm(c, NTOK, NA_IN, D, [&](int m) { return XN + (size_t)m * D; }, WIN0, [&](int m, int n, float a) { U[(size_t)m * LDU0 + n] = (bf16)f2bf(a); });
                naive_gemm(c, NBATCH * NMEM, 1024, D, [&](int m) { return MEMN + (size_t)m * D; }, WMKV, [&](int m, int n, float a) { MKV[(size_t)m * 1024 + n] = (bf16)f2bf(a); });
            } else {
                naive_gemm(c, NTOK, LDU1, D, [&](int m) { return XN + (size_t)m * D; }, WIN1, [&](int m, int n, float a) { U[(size_t)m * LDU1 + n] = (bf16)f2bf(a); });
            }
            }
            GRID_BAR(pb);
        }
        if (IN(pb + 1)) for (int rep_ = 0; rep_ <= (int)((REPEAT_MASK >> (pb + 1)) & 1u); ++rep_) { c = fresh_ctx(ldsp);
#if USE_MFMA_ATTN
            if (L == 0) { att::na_phase(c, U, na_rpb, CAT, vcu, (int)gridDim.x); att::mem_phase(c, U, LDU0, 2304, MKV, 0, CAT, vcu, (int)gridDim.x); }
            else { att::mem_phase(c, U, LDU1, 2336, MKV, 1, CAT, vcu, (int)gridDim.x);
                if constexpr (USE_MFMA_GLA & 1) gla::local_phase(c, U, gla_gate_up, gla_gate_bias, SU, SDEC, vcu, (int)gridDim.x, CTL);
                if constexpr (!(USE_MFMA_GLA & 4)) gla_decay(c, U, gla_gate_up, gla_gate_bias, DECA); }
#else
            if (L == 0) { naive_na(c, U, na_rpb, CAT); naive_memattn(c, U, LDU0, 2304, MKV, 0, CAT); }
            else { gla_decay(c, U, gla_gate_up, gla_gate_bias, DECA); naive_memattn(c, U, LDU1, 2336, MKV, 1, CAT); }
#endif
            GRID_BAR(pb + 1);
        }
        if (IN(pb + 2)) for (int rep_ = 0; rep_ <= (int)((REPEAT_MASK >> (pb + 2)) & 1u); ++rep_) { c = fresh_ctx(ldsp);
            if (L == 1) { if constexpr (USE_MFMA_GLA & 2) gla::scan_phase(c, SU, SS, SDEC);
                if constexpr (!(USE_MFMA_GLA & 4)) gla_recur(c, U, DECA, OF);
                GRID_BAR(pb + 2); }
        }
        if (IN(pb + 3)) for (int rep_ = 0; rep_ <= (int)((REPEAT_MASK >> (pb + 3)) & 1u); ++rep_) { c = fresh_ctx(ldsp);
            if (L == 1) {
#if GLA_EXPERIMENT
                gla::out_phase(c, U, gla_gate_up, gla_gate_bias, SS, gla_out_norm, ACT, vcu, (int)gridDim.x);
                gla_norm_gate(c, OF, U, gla_out_norm, CAT);
#else
                if constexpr (USE_MFMA_GLA & 4) gla::out_phase(c, U, gla_gate_up, gla_gate_bias, SS, gla_out_norm, CAT, vcu, (int)gridDim.x);
                else gla_norm_gate(c, OF, U, gla_out_norm, CAT);
#endif
                GRID_BAR(pb + 3); }
        }
        if (IN(pb + 4)) for (int rep_ = 0; rep_ <= (int)((REPEAT_MASK >> (pb + 4)) & 1u); ++rep_) { c = fresh_ctx(ldsp);
            const float* resid = L == 0 ? x : X;
#if GLA_EXPERIMENT
            if (L == 1) { unsigned bad = 0, verybad = 0;
                for (long i = GTID; i < (long)NTOK * MIX; i += GSIZE) { const int t = (int)(i / MIX), cc = (int)(i % MIX); const float a = bf2f(CAT[(size_t)t * D + cc]), bb = bf2f(ACT[(size_t)t * D + cc]);
                    const float df = fabsf(a - bb); if (!(df <= 0.05f + 0.1f * fabsf(a))) ++bad; if (!(fabsf(bb) < 1.0e30f)) ++verybad; }
                unsigned nfs = 0, nfd = 0;
                for (long i = GTID; i < (long)2048 * 18432; i += GSIZE) { const float a = bf2f(SU[i]); if (!(fabsf(a) < 1.0e30f)) ++nfs; }
                for (long i = GTID; i < (long)2048 * 96; i += GSIZE) { const float a = SDEC[i]; if (!(a >= 0.f && a <= 1.0001f)) ++nfd; }
                if (bad) atomicAdd(CTL + 512, bad); if (verybad) atomicAdd(CTL + 513, verybad); if (nfs) atomicAdd(CTL + 514, nfs); if (nfd) atomicAdd(CTL + 515, nfd); }
#endif
            if constexpr (USE_PG8 & 2) {
                pg8::StaticOrder S; S.init(CAT, WOUT + (size_t)L * D * D, NTOK, D, D, (int)gridDim.x, (int)blockIdx.x);
                pg8::EpiResF32 E{resid, X};
                pg8::gemm_phase<pg8::EpiResF32, pg8::StaticOrder, false>(c.lds, D, S, E);
            } else
            naive_gemm(c, NTOK, D, D, [&](int m) { return CAT + (size_t)m * D; }, WOUT + (size_t)L * D * D, [&](int m, int n, float a) { X[(size_t)m * D + n] = resid[(size_t)m * D + n] + a; });
            GRID_BAR(pb + 4);
        }
        if (IN(pb + 5)) for (int rep_ = 0; rep_ <= (int)((REPEAT_MASK >> (pb + 5)) & 1u); ++rep_) { c = fresh_ctx(ldsp);
#if USE_MFMA_ROUTE
            LAS unsigned* cvctr = (LAS unsigned*)(c.lds + MISC_OFF + 128);
            if (c.tid == 0) *cvctr = 0u;
            __syncthreads();
            if (!SPLIT_CONV && rep_ == 0 && c.wave >= 4) convert_moe_dyn(c, moe_w1 + (size_t)L * NEXP * D * EFF, moe_w3 + (size_t)L * NEXP * D * EFF, moe_w2 + (size_t)L * NEXP * EFF * D, W13, W2, cvctr);
            route_mfma(c, X, norm_ffn + L * D, WR + (size_t)L * 48 * D, moe_b_group + L * 4, moe_b_router + L * 32, XN, RT, cnt + (rep_ ? 2048 : 0));
            if (!SPLIT_CONV && rep_ == 0 && c.wave < 4) convert_moe_dyn(c, moe_w1 + (size_t)L * NEXP * D * EFF, moe_w3 + (size_t)L * NEXP * D * EFF, moe_w2 + (size_t)L * NEXP * EFF * D, W13, W2, cvctr);
#else
            route_phase(c, X, norm_ffn + L * D, moe_w_group + (size_t)L * D * 4, moe_b_group + L * 4, moe_w_router + (size_t)L * D * 32, moe_b_router + L * 32, XN, RT, cnt);
#endif
            GRID_BAR(pb + 5);
        }
        if (IN(pb + 6)) for (int rep_ = 0; rep_ <= (int)((REPEAT_MASK >> (pb + 6)) & 1u); ++rep_) { c = fresh_ctx(ldsp);
            const int* LIST = (const int*)(RT + RT_LIST);
            if constexpr (USE_PG8 & 4) {
                build_tab(c, cnt);
                pg8::MoeOrder S{(const LAS int*)(c.lds + TAB_OFF), XN, W13, LIST, D, 4, (int)gridDim.x, vcu, true};
                pg8::EpiSwiGLU E{ACT};
                pg8::gemm_phase<pg8::EpiSwiGLU, pg8::MoeOrder, true>(c.lds, D, S, E);
            } else {
            const long total = (long)MAXROWS * EFF;
            for (long idx = GTID; idx < total; idx += GSIZE) {
                const int R = (int)(idx / EFF), j = (int)(idx % EFF); int e, i, n;
                if (!row_lookup(cnt, R, e, i, n) || i >= n) continue;
                const int t = LIST[e * NTOK + i];
                const u32x4* a4 = (const u32x4*)(XN + (size_t)t * D);
                const int r1 = (j / 128) * 256 + (j % 128);
                const u32x4* b1 = (const u32x4*)(W13 + ((size_t)e * 1024 + r1) * 1024); const u32x4* b3 = (const u32x4*)(W13 + ((size_t)e * 1024 + r1 + 128) * 1024);
                float s1 = 0.f, s3 = 0.f;
                for (int k8 = 0; k8 < D / 8; ++k8) { const u32x4 av = a4[k8]; s1 += dot8(av, b1[k8]); s3 += dot8(av, b3[k8]); }
                ACT[(size_t)R * EFF + j] = (bf16)f2bf(silu(s1) * s3);
            }
            }
            GRID_BAR(pb + 6);
        }
        if (IN(pb + 7)) for (int rep_ = 0; rep_ <= (int)((REPEAT_MASK >> (pb + 7)) & 1u); ++rep_) { c = fresh_ctx(ldsp);
            const int* LIST = (const int*)(RT + RT_LIST); const int* TOKE = (const int*)(RT + RT_TOKE); const float* TOKW = (const float*)(RT + RT_TOKW);
            if constexpr (USE_PG8 & 8) {
                build_tab(c, cnt);
                pg8::MoeOrder S{(const LAS int*)(c.lds + TAB_OFF), ACT, W2, LIST, EFF, 4, (int)gridDim.x, vcu, false};
                pg8::EpiScaleBf16 E{Y, (const float*)(RT + RT_LISTW), (const LAS int*)(c.lds + TAB_OFF)};
                pg8::gemm_phase<pg8::EpiScaleBf16, pg8::MoeOrder, false>(c.lds, EFF, S, E);
            } else {
            const long total = (long)MAXROWS * D;
            for (long idx = GTID; idx < total; idx += GSIZE) {
                const int R = (int)(idx / D), n = (int)(idx % D); int e, i, cn;
                if (!row_lookup(cnt, R, e, i, cn) || i >= cn) continue;
                const int t = LIST[e * NTOK + i];
                const float w = (TOKE[2 * t] == e) ? TOKW[2 * t] : TOKW[2 * t + 1];
                const u32x4* a4 = (const u32x4*)(ACT + (size_t)R * EFF); const u32x4* b4 = (const u32x4*)(W2 + ((size_t)e * 1024 + n) * 512);
                float s = 0.f;
                for (int k8 = 0; k8 < EFF / 8; ++k8) s += dot8(a4[k8], b4[k8]);
                Y[(size_t)R * D + n] = (bf16)f2bf(s * w);
            }
            }
            GRID_BAR(pb + 7);
        }
        if (IN(pb + 8)) for (int rep_ = 0; rep_ <= (int)((REPEAT_MASK >> (pb + 8)) & 1u); ++rep_) { c = fresh_ctx(ldsp);
            build_tab(c, cnt);
            if (L == 0) { const bool dry = ((REPEAT_MASK >> (pb + 8)) & 1u) && rep_ == 0;
                combine_phase(c, X, Y, RT, (const LAS int*)(c.lds + TAB_OFF), norm_mix + D, dry ? (bf16*)(ws + WS_S + 80 * MiB) : XN, nullptr, dry ? (float*)(ws + WS_S) : X); if (dry) { GRID_BAR(pb + 8); continue; }
            }
            else { combine_phase(c, X, Y, RT, (const LAS int*)(c.lds + TAB_OFF), final_norm, nullptr, X, X);
                if (PROBE_EN && blockIdx.x == 0) {
                    __syncthreads();
                    const unsigned now = (unsigned)__builtin_amdgcn_s_memrealtime();
                    const unsigned a0 = CTL[600 + PROBE_A0], a1 = (PROBE_A1 >= 18) ? now : CTL[600 + PROBE_A1], b0 = CTL[600 + PROBE_B0], b1 = (PROBE_B1 >= 18) ? now : CTL[600 + PROBE_B1];
                    const float da = (float)(a1 - a0) * 0.01f, db = (float)(b1 - b0) * 0.01f;
                    for (int kk = c.lane; kk < D; kk += 64) X[(size_t)c.wave * D + kk] += sqrtf(da * 2.f);
                    if (c.tid == 0) X[(size_t)(8 * gridDim.x) * D] = db;
                }
#if GLA_EXPERIMENT
                { const unsigned bad = CTL[512], vb = CTL[513];
                  int k = 0; if (bad > 0u) k = 1; if (bad > 125u) k = 2; if (bad > 1258u) k = 3; if (bad > 12582u) k = 4; if (bad > 125829u) k = 5; if (bad > 1258291u) k = 6;
                  float f = vb > 0u ? 2.f : 1.f + 0.1f * (float)k; if (CTL[514] > 0u) f = 3.f; if (CTL[515] > 0u) f = 4.f; if (CTL[516] > 0u) f = 4.5f; if (CTL[517] > 0u) f = 5.f;
                  if (k > 0 || vb > 0u) { __syncthreads();
                    for (int t = c.gw; t < NTOK; t += c.ngw) for (int kk = c.lane; kk < D; kk += 64) X[(size_t)t * D + kk] *= f; } }
#endif
            }
            if (L == 0) GRID_BAR(pb + 8);
        }
    }
    if (PH_LO == 19 || PH_LO == 20) { const int L = PH_LO - 19; c = fresh_ctx(ldsp);
        LAS unsigned* cvctr = (LAS unsigned*)(c.lds + MISC_OFF + 128); if (c.tid == 0) *cvctr = 0u; __syncthreads();
        convert_moe_dyn(c, moe_w1 + (size_t)L * NEXP * D * EFF, moe_w3 + (size_t)L * NEXP * D * EFF, moe_w2 + (size_t)L * NEXP * EFF * D, W13, W2, cvctr); }
#undef IN
}

template <int P> static void launch_phases(int grid, hipStream_t stream, const Args& a) {
    if constexpr (P < NPHASES) {
        if constexpr (P != 3 && P != 4) {
            static bool attr_done = false;
            if (!attr_done) { (void)hipFuncSetAttribute((const void*)mk_fwd<P, P + 1>, hipFuncAttributeMaxDynamicSharedMemorySize, LDS_BYTES); attr_done = true; }
            hipLaunchKernelGGL((mk_fwd<P, P + 1>), dim3(grid), dim3(NTHREADS), LDS_BYTES, stream, a);
#ifdef HOST_REPEAT
            if (P == HOST_REPEAT) { if (P == 6 || P == 15) (void)hipMemsetAsync((char*)a.ws + WS_CTL + (CW_CNT + (P == 6 ? 0 : 4096)) * 4, 0, 8192, stream);
                hipLaunchKernelGGL((mk_fwd<P, P + 1>), dim3(grid), dim3(NTHREADS), LDS_BYTES, stream, a); }
#endif
#if SPLIT_CONV
            if (P == 6 || P == 15) { constexpr int Q = P == 6 ? 19 : 20; (void)hipFuncSetAttribute((const void*)mk_fwd<Q, Q + 1>, hipFuncAttributeMaxDynamicSharedMemorySize, LDS_BYTES);
                hipLaunchKernelGGL((mk_fwd<Q, Q + 1>), dim3(grid), dim3(NTHREADS), LDS_BYTES, stream, a);
#ifdef HOST_REPEAT
                if (HOST_REPEAT == Q) hipLaunchKernelGGL((mk_fwd<Q, Q + 1>), dim3(grid), dim3(NTHREADS), LDS_BYTES, stream, a);
#endif
            }
#endif
        }
        launch_phases<P + 1>(grid, stream, a);
    }
}
extern "C" void kernel_launch(void* const* d_in, const int* in_sizes, int n_in, void* d_out, int out_size, void* d_ws, size_t ws_size, hipStream_t stream) {
    static int grid = 0;
    if (grid == 0) {
        if (n_in != 21 || out_size != NTOK * D || ws_size < WS_END) { fprintf(stderr, "kernel_launch: unexpected shapes n_in %d out %d ws %zu (need %zu)\n", n_in, out_size, ws_size, (size_t)WS_END); grid = -1; return; }
        int dev = 0, cus = 0;
        if (hipGetDevice(&dev) != hipSuccess || hipDeviceGetAttribute(&cus, hipDeviceAttributeMultiprocessorCount, dev) != hipSuccess) { grid = -1; return; }
        (void)hipGetLastError();
        grid = cus;
    }
    if (grid < 0) return;
    (void)hipMemsetAsync((char*)d_ws + WS_CTL, 0, CTL_ZERO_BYTES, stream);
    Args a{};
    for (int i = 0; i < 21; ++i) a.in[i] = (const float*)d_in[i];
    a.out = (float*)d_out; a.ws = (unsigned char*)d_ws;
#if defined(MK_PER_PHASE)
    launch_phases<0>(grid, stream, a);
#else
    static bool attr_done = false;
    if (!attr_done) { (void)hipFuncSetAttribute((const void*)mk_fwd<0, NPHASES>, hipFuncAttributeMaxDynamicSharedMemorySize, LDS_BYTES); attr_done = true; }
    hipLaunchKernelGGL((mk_fwd<0, NPHASES>), dim3(grid), dim3(NTHREADS), LDS_BYTES, stream, a);
#endif
}
```

```cpp
#include <hip/hip_runtime.h>
#ifndef SPLIT_CONV
#define SPLIT_CONV 0
#endif
#ifndef REPEAT_MASK
#define REPEAT_MASK 0u
#endif
#ifndef PROBE_EN
#define PROBE_EN 0
#define PROBE_A0 -1
#define PROBE_A1 0
#define PROBE_B0 8
#define PROBE_B1 9
#endif
#define GLA_INTRA_ONLY 0
#include <cstdio>
#include <cstdint>

constexpr int D = 1024, NTOK = 16384, SEQ = 4096, NBATCH = 4, NMEM = 256, HD = 64;
constexpr int MIX = 768, MEMD = 256, NA_H = 12, NA_IN = 2560;
constexpr int GLA_H = 4, GLA_DK = 96, GLA_DV = 192, GLA_IN = 2592, GLA_KD = 384;
constexpr int NEXP = 32, EFF = 512;
constexpr int LDU0 = 2560, LDU1 = 2816;
constexpr int MAXROWS = 40960;
constexpr float EPS = 1e-6f;

typedef unsigned short bf16;
typedef float f32x4 __attribute__((ext_vector_type(4)));
typedef unsigned u32x4 __attribute__((ext_vector_type(4)));
typedef unsigned u32x2 __attribute__((ext_vector_type(2)));
#define LAS __attribute__((address_space(3)))

constexpr size_t MiB = 1048576;
constexpr size_t WS_CTL = 0;
constexpr size_t CTL_ZERO_BYTES = 1 * MiB;
constexpr size_t WS_WIN0 = 1 * MiB;
constexpr size_t WS_WIN1 = WS_WIN0 + (size_t)2560 * 1024 * 2;
constexpr size_t WS_WOUT = WS_WIN1 + (size_t)2816 * 1024 * 2;
constexpr size_t WS_WMKV = WS_WOUT + (size_t)2 * 1024 * 1024 * 2;
constexpr size_t WS_MEMN = WS_WMKV + (size_t)1024 * 1024 * 2;
constexpr size_t WS_MKV = WS_MEMN + (size_t)1024 * 1024 * 2;
constexpr size_t WS_WR = 23 * MiB;
constexpr size_t WS_W13 = 24 * MiB;
constexpr size_t WS_W2 = WS_W13 + 64 * MiB;
constexpr size_t WS_XN = WS_W2 + 32 * MiB;
constexpr size_t WS_U = WS_XN + 32 * MiB;
constexpr size_t WS_Y = WS_U;
constexpr size_t WS_CAT = WS_U + 88 * MiB;
constexpr size_t WS_ACT = WS_CAT + 32 * MiB;
constexpr size_t WS_ROUTE = WS_ACT + 40 * MiB;
constexpr size_t WS_S = WS_ROUTE + 8 * MiB;
constexpr size_t WS_END = WS_S + 176 * MiB;
static_assert(WS_MKV + (size_t)1024 * 1024 * 2 <= WS_WR, "ws map");
static_assert(WS_END <= 512 * MiB, "ws map");
constexpr size_t RT_TOKE = 0, RT_TOKW = 131072, RT_TOKP = 262144, RT_LIST = 524288, RT_LISTW = 524288 + 2 * MiB, RT_LISTR = 524288 + 4 * MiB, RT_RN = 524288 + 6 * MiB;
constexpr int CW_CNT = 8192, CNT_ST = 64;
constexpr int CW_BAR = 32768;

struct Args {
    const float* in[21]; float* out; unsigned char* ws; int ph_lo, ph_hi;
};

__device__ __forceinline__ float bf2f(bf16 v) { return __uint_as_float(((unsigned)v) << 16); }
__device__ __forceinline__ unsigned f2bf(float f) { unsigned u = __float_as_uint(f); return (u + 0x7fffu + ((u >> 16) & 1u)) >> 16; }
__device__ __forceinline__ unsigned pk2(float lo, float hi) { return f2bf(lo) | (f2bf(hi) << 16); }
__device__ __forceinline__ float wave_sum(float v) {
#pragma unroll
    for (int o = 1; o < 64; o <<= 1) v += __shfl_xor(v, o);
    return v;
}
__device__ __forceinline__ float dot8(u32x4 a, u32x4 b) {
    float s = 0.f;
#pragma unroll
    for (int i = 0; i < 4; ++i) {
        s += __uint_as_float(a[i] << 16) * __uint_as_float(b[i] << 16);
        s += __uint_as_float(a[i] & 0xffff0000u) * __uint_as_float(b[i] & 0xffff0000u);
    }
    return s;
}
__device__ __forceinline__ float silu(float x) { return x / (1.f + __expf(-x)); }

struct Ctx {
    int tid, lane, wave, gw, ngw;
    LAS unsigned char* lds;
};
__device__ __forceinline__ Ctx fresh_ctx(LAS unsigned char* lds) {
    Ctx c; int t = threadIdx.x; asm volatile("" : "+v"(t)); int b = blockIdx.x; asm volatile("" : "+s"(b));
    c.tid = t; c.lane = t & 63; c.wave = __builtin_amdgcn_readfirstlane(t >> 6); c.gw = b * 8 + c.wave; c.ngw = gridDim.x * 8; c.lds = lds; return c;
}
__device__ __forceinline__ long gtid_() { int t = threadIdx.x; asm volatile("" : "+v"(t)); int b = blockIdx.x; asm volatile("" : "+s"(b)); return (long)(b * 512 + t); }
#define GTID gtid_()
#define GSIZE ((long)gridDim.x * 512)

__device__ __forceinline__ void transpose_item(const float* W, int N, int k0, int n0, bf16* dstrow0, int Kd, LAS float* scr, int lane, const float* gk = nullptr) {
    f32x4 v[8]; const int lr = lane >> 3, lc = (lane & 7) * 4;
#pragma unroll
    for (int i = 0; i < 8; ++i) v[i] = *(const f32x4*)(W + (size_t)(k0 + 8 * i + lr) * N + n0 + lc);
    if (gk) {
#pragma unroll
        for (int i = 0; i < 8; ++i) v[i] = v[i] * gk[k0 + 8 * i + lr]; }
#pragma unroll
    for (int i = 0; i < 8; ++i) { LAS float* s = scr + (8 * i + lr) * 33 + lc; s[0] = v[i][0]; s[1] = v[i][1]; s[2] = v[i][2]; s[3] = v[i][3]; }
    asm volatile("s_waitcnt lgkmcnt(0)" ::: "memory");
    const int c = lane & 7;
#pragma unroll
    for (int j = 0; j < 4; ++j) { const int n = (lane >> 3) + 8 * j; const LAS float* s = scr + (8 * c) * 33 + n;
        u32x4 o; o.x = pk2(s[0 * 33], s[1 * 33]); o.y = pk2(s[2 * 33], s[3 * 33]); o.z = pk2(s[4 * 33], s[5 * 33]); o.w = pk2(s[6 * 33], s[7 * 33]);
        *(u32x4*)(dstrow0 + (size_t)n * Kd + k0 + 8 * c) = o; }
    asm volatile("s_waitcnt lgkmcnt(0)" ::: "memory");
}
__device__ __forceinline__ void transpose_matrix(const Ctx& c, const float* W, int K, int N, bf16* dst, int it0, int itstride, const float* gk = nullptr) {
    LAS float* scr = (LAS float*)(c.lds + c.wave * 16384);
    const int nblk = N / 32, nit = (K / 64) * nblk;
    for (int it = it0; it < nit; it += itstride) { const int kb = it / nblk, nb = it % nblk;
        transpose_item(W, N, kb * 64, nb * 32, dst + (size_t)(nb * 32) * K, K, scr, c.lane, gk); }
}
struct CvItem { const float* W; const float* g; int N, k0, n0, Kd; bf16* dst; };
__device__ __forceinline__ CvItem cv_decode(int it, const float* w1, const float* w3, const float* w2, bf16* W13, bf16* W2, const float* gffn) {
    const int per_e = 768;
    const int e = it / per_e, r = it % per_e, which = r / 256, q = r % 256; CvItem x;
    if (which < 2) { const int kb = q / 16, nb = q % 16, n0 = nb * 32;
        x.W = (which == 0 ? w1 : w3) + (size_t)e * 1024 * 512; x.g = gffn; x.N = 512; x.k0 = kb * 64; x.n0 = n0; x.Kd = 1024;
        x.dst = W13 + ((size_t)e * 1024 + (n0 / 128) * 256 + which * 128 + (n0 % 128)) * 1024;
    } else { const int kb = q / 32, nb = q % 32, n0 = nb * 32;
        x.W = w2 + (size_t)e * 512 * 1024; x.g = nullptr; x.N = 1024; x.k0 = kb * 64; x.n0 = n0; x.Kd = 512; x.dst = W2 + ((size_t)e * 1024 + n0) * 512; }
    return x;
}
__device__ __forceinline__ void convert_moe_dyn(const Ctx& c, const float* w1, const float* w3, const float* w2, bf16* W13, bf16* W2, LAS unsigned* ctr, const float* gffn) {
    LAS float* scr = (LAS float*)(c.lds + c.wave * 16384);
    const int nit = NEXP * 768, G = (int)gridDim.x, per = (nit + G - 1) / G, lane = c.lane, lr = lane >> 3, lc = (lane & 7) * 4, cc = lane & 7;
#define CV_NEXT(itv) do { unsigned k_ = 0; if (lane == 0) k_ = __hip_atomic_fetch_add(ctr, 1u, __ATOMIC_RELAXED, __HIP_MEMORY_SCOPE_WORKGROUP); k_ = __builtin_amdgcn_readfirstlane(k_); \
        itv = ((int)k_ < per && (int)blockIdx.x * per + (int)k_ < nit) ? (int)blockIdx.x * per + (int)k_ : -1; } while (0)
#define CV_LOAD(x, v) do { _Pragma("unroll") for (int i = 0; i < 8; ++i) { v[i] = *(const f32x4*)(x.W + (size_t)(x.k0 + 8 * i + lr) * x.N + x.n0 + lc); if (x.g) v[i] = v[i] * x.g[x.k0 + 8 * i + lr]; } } while (0)
    int it; CV_NEXT(it); if (it < 0) return;
    CvItem cur = cv_decode(it, w1, w3, w2, W13, W2, gffn); f32x4 v[8], vn[8]; CV_LOAD(cur, v);
    for (;;) {
        int itn; CV_NEXT(itn); CvItem nxt = cur;
        if (itn >= 0) { nxt = cv_decode(itn, w1, w3, w2, W13, W2, gffn); CV_LOAD(nxt, vn); }
        __builtin_amdgcn_sched_barrier(0);
#pragma unroll
        for (int i = 0; i < 8; ++i) { LAS float* s = scr + (8 * i + lr) * 33 + lc; s[0] = v[i][0]; s[1] = v[i][1]; s[2] = v[i][2]; s[3] = v[i][3]; }
        asm volatile("s_waitcnt lgkmcnt(0)" ::: "memory");
#pragma unroll
        for (int j = 0; j < 4; ++j) { const int n = (lane >> 3) + 8 * j; const LAS float* s = scr + (8 * cc) * 33 + n;
            u32x4 o; o.x = pk2(s[0 * 33], s[1 * 33]); o.y = pk2(s[2 * 33], s[3 * 33]); o.z = pk2(s[4 * 33], s[5 * 33]); o.w = pk2(s[6 * 33], s[7 * 33]);
            *(u32x4*)(cur.dst + (size_t)n * cur.Kd + cur.k0 + 8 * cc) = o; }
        asm volatile("s_waitcnt lgkmcnt(0)" ::: "memory");
        if (itn < 0) break;
        cur = nxt;
#pragma unroll
        for (int i = 0; i < 8; ++i) v[i] = vn[i];
    }
#undef CV_NEXT
#undef CV_LOAD
}
__device__ __forceinline__ void rms_row_to_bf16(const float* xrow, const float* g, bf16* orow, int lane) {
    const f32x4* xr = (const f32x4*)xrow + lane; const f32x4* gr = (const f32x4*)g + lane;
    f32x4 v[4]; float s = 0.f;
#pragma unroll
    for (int j = 0; j < 4; ++j) { v[j] = xr[64 * j]; s += (v[j].x * v[j].x + v[j].y * v[j].y) + (v[j].z * v[j].z + v[j].w * v[j].w); }
    const float r = 1.f / sqrtf(wave_sum(s) * (1.f / D) + EPS);
    u32x2* o8 = (u32x2*)orow + lane;
#pragma unroll
    for (int j = 0; j < 4; ++j) { const f32x4 gg = gr[64 * j]; u32x2 w; w.x = pk2(v[j].x * r * gg.x, v[j].y * r * gg.y); w.y = pk2(v[j].z * r * gg.z, v[j].w * r * gg.w); o8[64 * j] = w; }
}

__device__ __forceinline__ void xb_row(const float* xrow, bf16* orow, float* rn, int lane) {
    const f32x4* xr = (const f32x4*)xrow + lane; f32x4 v[4]; float s = 0.f;
#pragma unroll
    for (int j = 0; j < 4; ++j) { v[j] = xr[64 * j]; s += (v[j].x * v[j].x + v[j].y * v[j].y) + (v[j].z * v[j].z + v[j].w * v[j].w); }
    const float r = 1.f / sqrtf(wave_sum(s) * (1.f / D) + EPS);
    u32x2* o8 = (u32x2*)orow + lane;
#pragma unroll
    for (int j = 0; j < 4; ++j) { u32x2 w; w.x = pk2(v[j].x, v[j].y); w.y = pk2(v[j].z, v[j].w); o8[64 * j] = w; }
    if (lane == 0) *rn = r;
}

template <class RowA, class Epi>
__device__ __forceinline__ void naive_gemm(const Ctx& c, int M, int N, int K, const RowA& rowA, const bf16* Bt, const Epi& epi) {
    const long total = (long)M * N;
    for (long idx = GTID; idx < total; idx += GSIZE) {
        const int m = (int)(idx / N), n = (int)(idx % N);
        const bf16* a = rowA(m);
        if (a == nullptr) continue;
        const u32x4* a4 = (const u32x4*)a; const u32x4* b4 = (const u32x4*)(Bt + (size_t)n * K);
        float acc = 0.f;
        for (int k8 = 0; k8 < K / 8; ++k8) acc += dot8(a4[k8], b4[k8]);
        epi(m, n, acc);
    }
}


namespace pg8 {
typedef short bf16x8 __attribute__((ext_vector_type(8)));
constexpr int BM = 256, BK = 64, HALF = 128, HTB = HALF * BK * 2, STAGE_BYTES = 8 * HTB, NXCD = 8, WGM = 8;
__device__ __forceinline__ int lds_byte(int r, int c) { const int st = (r >> 4) * 2 + (c >> 5), rr = r & 15, cc = c & 31, ob = rr * 64 + cc * 2; return st * 1024 + (ob ^ (((ob >> 9) & 1) << 5)); }
__device__ __forceinline__ void stage_rc(int b, int& R, int& C) { const int st = b / 1024, sb = b % 1024, swz = sb ^ (((sb >> 9) & 1) << 5); R = (st >> 1) * 16 + swz / 64; C = (st & 1) * 32 + (swz % 64) / 2; }
__device__ __forceinline__ int perm32(int rho) { const int n = rho >> 4, i = rho & 15; return 8 * (i >> 2) + 4 * n + (i & 3); }
typedef __bf16 bf16v2_t __attribute__((ext_vector_type(2)));
__device__ __forceinline__ unsigned cvt_pk_bf16(float lo, float hi) { const bf16v2_t v = {(__bf16)lo, (__bf16)hi}; return __builtin_bit_cast(unsigned, v); }

struct Unit { int pm, pn, e, nv; };

struct StaticOrder {
    const bf16* A; const bf16* Bt; int K, nM, nN, nwg, G, c;
    __device__ void init(const bf16* A_, const bf16* Bt_, int M, int N, int K_, int G_, int c_) { A = A_; Bt = Bt_; K = K_; nM = M / BM; nN = N / BM; nwg = nM * nN; G = G_; c = c_; }
    __device__ __forceinline__ bool next(int i, Unit& u) const {
        const long L = (long)i * G + c; if (L >= nwg) return false;
        int wgid = (int)L; { const int q = nwg / NXCD, r = nwg % NXCD, xcd = wgid % NXCD, off = wgid / NXCD; wgid = (xcd < r ? xcd * (q + 1) : r * (q + 1) + (xcd - r) * q) + off; }
        const int nig = WGM * nN, gid = wgid / nig, fm = gid * WGM, gsz = (nM - fm) < WGM ? (nM - fm) : WGM;
        u.pm = fm + ((wgid % nig) % gsz); u.pn = (wgid % nig) / gsz; u.e = 0; u.nv = 256; return true;
    }
    __device__ __forceinline__ const char* a_base(const Unit& u) const { return (const char*)A + (size_t)u.pm * BM * K * 2; }
    __device__ __forceinline__ const char* b_base(const Unit& u) const { return (const char*)Bt + (size_t)u.pn * BM * K * 2; }
    __device__ __forceinline__ const int* rows(const Unit&) const { return nullptr; }
};
struct MoeOrder {
    const LAS int* tab; const bf16* A; const bf16* Bt; const int* list; int K, ntn, G, c; bool gather;
    __device__ __forceinline__ bool next(int i, Unit& u) const {
        const int L = i * G + c, total = tab[32] * ntn; if (L >= total) return false;
        const int T = L / ntn; int e = 0;
        for (int x = 1; x < 32; ++x) e = (tab[x] <= T) ? x : e;
        u.pm = T; u.pn = L % ntn; u.e = e; u.nv = tab[64 + e] - (T - tab[e]) * 256; return true;
    }
    __device__ __forceinline__ const char* a_base(const Unit& u) const { return gather ? (const char*)A : (const char*)A + (size_t)u.pm * BM * K * 2; }
    __device__ __forceinline__ const char* b_base(const Unit& u) const { return (const char*)Bt + ((size_t)u.e * 1024 + (size_t)u.pn * BM) * K * 2; }
    __device__ __forceinline__ const int* rows(const Unit& u) const { return list + (size_t)u.e * NTOK + (u.pm - tab[u.e]) * 256; }
};

struct EpiBf16 {
    static constexpr bool PERM = true;
    bf16* O; int ldc; const float* rs;
    __device__ __forceinline__ void operator()(const f32x4 (&acc)[2][2][4][2], const Unit& u, int wr, int wc, int fr, int fq) const {
        const int row0 = u.pm * BM + wr * 64 + fr, col0 = u.pn * BM + wc * 32 + 8 * fq;
        float sc[2][4];
#pragma unroll
        for (int ai = 0; ai < 2; ++ai)
#pragma unroll
            for (int m = 0; m < 4; ++m) sc[ai][m] = rs ? rs[row0 + ai * HALF + m * 16] : 1.f;
#pragma unroll
        for (int ai = 0; ai < 2; ++ai)
#pragma unroll
            for (int m = 0; m < 4; ++m) { bf16* rowp = O + (size_t)(row0 + ai * HALF + m * 16) * ldc + col0;
#pragma unroll
                for (int bj = 0; bj < 2; ++bj) { const f32x4 v0 = acc[ai][bj][m][0] * sc[ai][m], v1 = acc[ai][bj][m][1] * sc[ai][m];
                    u32x4 w; w.x = cvt_pk_bf16(v0[0], v0[1]); w.y = cvt_pk_bf16(v0[2], v0[3]); w.z = cvt_pk_bf16(v1[0], v1[1]); w.w = cvt_pk_bf16(v1[2], v1[3]);
                    *(u32x4*)(rowp + bj * HALF) = w; } }
    }
};
struct EpiResBf16 {
    static constexpr bool PERM = true;
    bf16* XB;
    __device__ __forceinline__ void operator()(const f32x4 (&acc)[2][2][4][2], const Unit& u, int wr, int wc, int fr, int fq) const {
        const int row0 = u.pm * BM + wr * 64 + fr, col0 = u.pn * BM + wc * 32 + 8 * fq;
#pragma unroll
        for (int ai = 0; ai < 2; ++ai)
#pragma unroll
            for (int m = 0; m < 4; ++m) { bf16* rowp = XB + (size_t)(row0 + ai * HALF + m * 16) * D + col0;
                u32x4 rv[2];
#pragma unroll
                for (int bj = 0; bj < 2; ++bj) rv[bj] = *(const u32x4*)(rowp + bj * HALF);
#pragma unroll
                for (int bj = 0; bj < 2; ++bj) { const f32x4 v0 = acc[ai][bj][m][0], v1 = acc[ai][bj][m][1]; const u32x4 r = rv[bj];
                    u32x4 w; w.x = cvt_pk_bf16(__uint_as_float(r.x << 16) + v0[0], __uint_as_float(r.x & 0xffff0000u) + v0[1]); w.y = cvt_pk_bf16(__uint_as_float(r.y << 16) + v0[2], __uint_as_float(r.y & 0xffff0000u) + v0[3]);
                    w.z = cvt_pk_bf16(__uint_as_float(r.z << 16) + v1[0], __uint_as_float(r.z & 0xffff0000u) + v1[1]); w.w = cvt_pk_bf16(__uint_as_float(r.w << 16) + v1[2], __uint_as_float(r.w & 0xffff0000u) + v1[3]);
                    *(u32x4*)(rowp + bj * HALF) = w; }
                asm volatile("" ::: "memory"); }
    }
};
struct EpiSwiGLU {
    static constexpr bool PERM = true;
    bf16* O; const float* listr; const LAS int* tab;
    __device__ __forceinline__ void operator()(const f32x4 (&acc)[2][2][4][2], const Unit& u, int wr, int wc, int fr, int fq) const {
        const int rl0 = wr * 64 + fr, row0 = u.pm * BM + rl0, col0 = u.pn * 128 + wc * 32 + 8 * fq;
        const float* lrp = listr + (size_t)u.e * NTOK + (u.pm - tab[u.e]) * 256;
        float sc[2][4];
#pragma unroll
        for (int ai = 0; ai < 2; ++ai)
#pragma unroll
            for (int m = 0; m < 4; ++m) { const int rl = rl0 + ai * HALF + m * 16; sc[ai][m] = rl < u.nv ? lrp[rl] : 0.f; }
#pragma unroll
        for (int ai = 0; ai < 2; ++ai)
#pragma unroll
            for (int m = 0; m < 4; ++m) { float o[8]; const float s = sc[ai][m];
#pragma unroll
                for (int n = 0; n < 2; ++n)
#pragma unroll
                    for (int i = 0; i < 4; ++i) { const float a = acc[ai][0][m][n][i] * s, b = acc[ai][1][m][n][i] * s; o[n * 4 + i] = a * b * __builtin_amdgcn_rcpf(1.f + __expf(-a)); }
                u32x4 w; w.x = cvt_pk_bf16(o[0], o[1]); w.y = cvt_pk_bf16(o[2], o[3]); w.z = cvt_pk_bf16(o[4], o[5]); w.w = cvt_pk_bf16(o[6], o[7]);
                *(u32x4*)(O + (size_t)(row0 + ai * HALF + m * 16) * EFF + col0) = w; }
    }
};
struct EpiScaleBf16 {
    static constexpr bool PERM = true;
    bf16* O; const float* listw; const LAS int* tab;
    __device__ __forceinline__ void operator()(const f32x4 (&acc)[2][2][4][2], const Unit& u, int wr, int wc, int fr, int fq) const {
        const int rl0 = wr * 64 + fr, col0 = u.pn * BM + wc * 32 + 8 * fq;
        const float* lw = listw + (size_t)u.e * NTOK + (u.pm - tab[u.e]) * 256;
        float wv[2][4];
#pragma unroll
        for (int ai = 0; ai < 2; ++ai)
#pragma unroll
            for (int m = 0; m < 4; ++m) { const int rl = rl0 + ai * HALF + m * 16; wv[ai][m] = rl < u.nv ? lw[rl] : 0.f; }
#pragma unroll
        for (int ai = 0; ai < 2; ++ai)
#pragma unroll
            for (int m = 0; m < 4; ++m) { bf16* rowp = O + (size_t)(u.pm * BM + rl0 + ai * HALF + m * 16) * D + col0; const float s = wv[ai][m];
#pragma unroll
                for (int bj = 0; bj < 2; ++bj) { const f32x4 v0 = acc[ai][bj][m][0] * s, v1 = acc[ai][bj][m][1] * s;
                    u32x4 w; w.x = cvt_pk_bf16(v0[0], v0[1]); w.y = cvt_pk_bf16(v0[2], v0[3]); w.z = cvt_pk_bf16(v1[0], v1[1]); w.w = cvt_pk_bf16(v1[2], v1[3]);
                    *(u32x4*)(rowp + bj * HALF) = w; } }
    }
};

template <class Epi, class Sched, bool GATHER>
__device__ __forceinline__ void gemm_phase(LAS unsigned char* lds, const int K, const Sched& S, const Epi& E) {
    int tid_ = threadIdx.x; asm volatile("" : "+v"(tid_));
    const int tid = tid_, wid = __builtin_amdgcn_readfirstlane(tid >> 6), lane = tid & 63, wr = wid >> 2, wc = wid & 3, fr = lane & 15, fq = lane >> 4;
    const int nt = K / BK;
    int Rr[2], Cc[2]; unsigned voffB[2];
#pragma unroll
    for (int i = 0; i < 2; ++i) { int R, C; stage_rc(tid * 16 + i * 8192, R, C); Rr[i] = R; Cc[i] = C; const int Rb = Epi::PERM ? ((R & ~31) + perm32(R & 31)) : R; voffB[i] = (unsigned)(Rb * K + C) * 2u; }
    const size_t kstep = (size_t)(BK * 2);
    const size_t hstep = (size_t)HALF * K * 2;
    const size_t hstepA = GATHER ? 0 : hstep;
    const unsigned ldsw = (unsigned)wid * 1024u;
    const int aoff = lds_byte(wr * 64 + fr, fq * 8), boff = lds_byte(wc * 32 + fr, fq * 8);
#define PG8_SA(b, h) (((b) * 2 + (h)) * HTB)
#define PG8_SB(b, h) ((4 + (b) * 2 + (h)) * HTB)
#define PG8_STAGE(bufoff, gbase, voff) do { _Pragma("unroll") for (int _i = 0; _i < 2; ++_i) \
        __builtin_amdgcn_global_load_lds((const unsigned*)((const char*)(gbase) + (voff)[_i]), (LAS unsigned*)(lds + (bufoff) + ldsw + _i * 8192), 16, 0, 0); } while (0)
#define PG8_LDA(dst, b, h) do { _Pragma("unroll") for (int m = 0; m < 4; ++m) _Pragma("unroll") for (int k = 0; k < 2; ++k) dst[m][k] = *(const LAS bf16x8*)(lds + PG8_SA(b, h) + aoff + m * 2048 + k * 1024); } while (0)
#define PG8_LDB(dst, b, h) do { _Pragma("unroll") for (int n = 0; n < 2; ++n) _Pragma("unroll") for (int k = 0; k < 2; ++k) dst[n][k] = *(const LAS bf16x8*)(lds + PG8_SB(b, h) + boff + n * 2048 + k * 1024); } while (0)
#define PG8_MMA(ai, bj, At, Bt) do { __builtin_amdgcn_s_setprio(1); _Pragma("unroll") for (int m = 0; m < 4; ++m) _Pragma("unroll") for (int n = 0; n < 2; ++n) _Pragma("unroll") for (int k = 0; k < 2; ++k) \
        acc[ai][bj][m][n] = __builtin_amdgcn_mfma_f32_16x16x32_bf16(Bt[n][k], At[m][k], acc[ai][bj][m][n], 0, 0, 0); __builtin_amdgcn_s_setprio(0); } while (0)
#define PG8_WAIT_V(n) asm volatile("s_waitcnt vmcnt(" #n ")" ::: "memory")
#define PG8_WAIT_L(n) asm volatile("s_waitcnt lgkmcnt(" #n ")" ::: "memory")
#define PG8_BAR __builtin_amdgcn_s_barrier()
#define PG8_SCHED __builtin_amdgcn_sched_barrier(0)
#define PG8_VOFFA(u, v0, v1) do { if constexpr (GATHER) { const int* _rw = S.rows(u); _Pragma("unroll") for (int _i = 0; _i < 2; ++_i) { \
            const int _r0 = Rr[_i], _r1 = Rr[_i] + HALF; const int _t0 = _rw[_r0 < (u).nv ? _r0 : 0], _t1 = _rw[_r1 < (u).nv ? _r1 : 0]; \
            v0[_i] = (unsigned)(_t0 * K + Cc[_i]) * 2u; v1[_i] = (unsigned)(_t1 * K + Cc[_i]) * 2u; } } \
        else { _Pragma("unroll") for (int _i = 0; _i < 2; ++_i) { v0[_i] = (unsigned)(Rr[_i] * K + Cc[_i]) * 2u; v1[_i] = v0[_i]; } } } while (0)
    Unit cur, nxt; int ui = 0;
    if (!S.next(0, cur)) return;
    f32x4 acc[2][2][4][2];
#pragma unroll
    for (int a = 0; a < 2; ++a)
#pragma unroll
        for (int b = 0; b < 2; ++b)
#pragma unroll
            for (int m = 0; m < 4; ++m)
#pragma unroll
                for (int n = 0; n < 2; ++n) acc[a][b][m][n] = (f32x4){0.f, 0.f, 0.f, 0.f};
    bf16x8 At[4][2], B0[2][2], B1[2][2];
    const char* cA = S.a_base(cur); const char* cB = S.b_base(cur);
    unsigned cv0[2], cv1[2], nv0[2], nv1[2];
    PG8_VOFFA(cur, cv0, cv1);
    PG8_STAGE(PG8_SB(0, 0), cB, voffB); PG8_STAGE(PG8_SB(0, 1), cB + hstep, voffB); PG8_STAGE(PG8_SA(0, 0), cA, cv0); PG8_STAGE(PG8_SA(0, 1), cA + hstepA, cv1);
    if (wr == 1) PG8_BAR;
    PG8_WAIT_V(2); PG8_BAR;
    PG8_STAGE(PG8_SB(1, 0), cB + kstep, voffB); PG8_STAGE(PG8_SA(1, 0), cA + kstep, cv0); PG8_STAGE(PG8_SB(1, 1), cB + hstep + kstep, voffB);
    PG8_WAIT_V(6); PG8_BAR;
    for (;;) {
        const bool has_next = S.next(ui + 1, nxt);
        const char* nA = has_next ? S.a_base(nxt) : cA; const char* nB = has_next ? S.b_base(nxt) : cB;
        if (has_next) { PG8_VOFFA(nxt, nv0, nv1); } else {
#pragma unroll
            for (int i = 0; i < 2; ++i) { nv0[i] = cv0[i]; nv1[i] = cv1[i]; } }
        for (int t = 0; t < nt; t += 2) {
            const bool last = (t == nt - 2);
            const char* a1 = cA + (size_t)(t + 1) * kstep;
            const char* a2 = last ? nA : cA + (size_t)(t + 2) * kstep; const char* b2 = last ? nB : cB + (size_t)(t + 2) * kstep;
            const char* a3 = a2 + kstep; const char* b3 = b2 + kstep;
            unsigned s0[2], s1[2];
#pragma unroll
            for (int i = 0; i < 2; ++i) { s0[i] = last ? nv0[i] : cv0[i]; s1[i] = last ? nv1[i] : cv1[i]; }
            PG8_LDB(B0, 0, 0); PG8_LDB(B1, 0, 1); PG8_SCHED; PG8_LDA(At, 0, 0); PG8_STAGE(PG8_SA(1, 1), a1 + hstepA, cv1);
            PG8_WAIT_V(8); PG8_WAIT_L(0); PG8_BAR; PG8_MMA(0, 0, At, B0); PG8_MMA(0, 1, At, B1); PG8_BAR; PG8_SCHED;
            PG8_LDA(At, 0, 1); PG8_STAGE(PG8_SB(0, 0), b2, voffB); PG8_STAGE(PG8_SB(0, 1), b2 + hstep, voffB); PG8_STAGE(PG8_SA(0, 0), a2, s0);
            PG8_WAIT_V(8); PG8_WAIT_L(0); PG8_BAR; PG8_MMA(1, 0, At, B0); PG8_MMA(1, 1, At, B1); PG8_BAR; PG8_SCHED;
            PG8_LDB(B0, 1, 0); PG8_LDB(B1, 1, 1); PG8_SCHED; PG8_LDA(At, 1, 0); PG8_STAGE(PG8_SA(0, 1), a2 + hstepA, s1);
            PG8_WAIT_V(8); PG8_WAIT_L(0); PG8_BAR; PG8_MMA(0, 0, At, B0); PG8_MMA(0, 1, At, B1); PG8_BAR; PG8_SCHED;
            PG8_LDA(At, 1, 1); PG8_STAGE(PG8_SB(1, 0), b3, voffB); PG8_STAGE(PG8_SB(1, 1), b3 + hstep, voffB); PG8_STAGE(PG8_SA(1, 0), a3, s0);
            PG8_WAIT_V(8); PG8_WAIT_L(0); PG8_BAR; PG8_MMA(1, 0, At, B0); PG8_MMA(1, 1, At, B1); PG8_BAR; PG8_SCHED;
        }
        if (wr == 0) PG8_BAR;
        E(acc, cur, wr, wc, fr, fq);
        if (!has_next) break;
#pragma unroll
        for (int a = 0; a < 2; ++a)
#pragma unroll
            for (int b = 0; b < 2; ++b)
#pragma unroll
                for (int m = 0; m < 4; ++m)
#pragma unroll
                    for (int n = 0; n < 2; ++n) acc[a][b][m][n] = (f32x4){0.f, 0.f, 0.f, 0.f};
        cur = nxt; cA = nA; cB = nB; ++ui;
#pragma unroll
        for (int i = 0; i < 2; ++i) { cv0[i] = nv0[i]; cv1[i] = nv1[i]; }
        if (wr == 1) PG8_BAR;
    }
    PG8_WAIT_V(0);
    PG8_BAR;
#undef PG8_SA
#undef PG8_SB
#undef PG8_STAGE
#undef PG8_LDA
#undef PG8_LDB
#undef PG8_MMA
#undef PG8_WAIT_V
#undef PG8_WAIT_L
#undef PG8_BAR
#undef PG8_SCHED
#undef PG8_VOFFA
}
}

__device__ __forceinline__ void naive_na(const Ctx& c, const bf16* U, const float* rpb, bf16* CAT) {
    const long total = (long)NTOK * NA_H;
    for (long idx = GTID; idx < total; idx += GSIZE) {
        const int h = (int)(idx % NA_H), t = (int)(idx / NA_H);
        const int b = t / SEQ, p = t % SEQ, r = p / 64, cc = p % 64;
        const int rs = min(max(r - 4, 0), 56), cs = min(max(cc - 8, 0), 48);
        const u32x4* q4 = (const u32x4*)(U + (size_t)t * LDU0 + h * 64);
        float acc[64];
#pragma unroll
        for (int i = 0; i < 64; ++i) acc[i] = 0.f;
        float mx = -1e30f, l = 0.f;
        for (int i = 0; i < 8; ++i) for (int j = 0; j < 16; ++j) {
            const int kr = rs + i, kc = cs + j, kt = b * SEQ + kr * 64 + kc;
            const u32x4* k4 = (const u32x4*)(U + (size_t)kt * LDU0 + 768 + h * 64);
            float s = 0.f;
#pragma unroll
            for (int d8 = 0; d8 < 8; ++d8) s += dot8(q4[d8], k4[d8]);
            s = s * 0.125f + rpb[(h * 15 + (kr - r + 7)) * 31 + (kc - cc + 15)];
            const float mn = fmaxf(mx, s), alpha = __expf(mx - mn), pp = __expf(s - mn);
            l = l * alpha + pp; mx = mn;
            const u32x4* v4 = (const u32x4*)(U + (size_t)kt * LDU0 + 1536 + h * 64);
#pragma unroll
            for (int d8 = 0; d8 < 8; ++d8) { const u32x4 vv = v4[d8];
#pragma unroll
                for (int e = 0; e < 4; ++e) { acc[d8 * 8 + 2 * e] = acc[d8 * 8 + 2 * e] * alpha + pp * __uint_as_float(vv[e] << 16);
                    acc[d8 * 8 + 2 * e + 1] = acc[d8 * 8 + 2 * e + 1] * alpha + pp * __uint_as_float(vv[e] & 0xffff0000u); } }
        }
        const float inv = 1.f / l;
        u32x4* o4 = (u32x4*)(CAT + (size_t)t * D + h * 64);
#pragma unroll
        for (int d8 = 0; d8 < 8; ++d8) { u32x4 w; w.x = pk2(acc[d8 * 8] * inv, acc[d8 * 8 + 1] * inv); w.y = pk2(acc[d8 * 8 + 2] * inv, acc[d8 * 8 + 3] * inv);
            w.z = pk2(acc[d8 * 8 + 4] * inv, acc[d8 * 8 + 5] * inv); w.w = pk2(acc[d8 * 8 + 6] * inv, acc[d8 * 8 + 7] * inv); o4[d8] = w; }
    }
}
__device__ __forceinline__ void naive_memattn(const Ctx& c, const bf16* U, int ldu, int mqcol, const bf16* MKV, int lay, bf16* CAT) {
    const long total = (long)NTOK * 4;
    for (long idx = GTID; idx < total; idx += GSIZE) {
        const int h = (int)(idx % 4), t = (int)(idx / 4), b = t / SEQ;
        const u32x4* q4 = (const u32x4*)(U + (size_t)t * ldu + mqcol + h * 64);
        float acc[64];
#pragma unroll
        for (int i = 0; i < 64; ++i) acc[i] = 0.f;
        float mx = -1e30f, l = 0.f;
        for (int m = 0; m < NMEM; ++m) {
            const bf16* row = MKV + (size_t)(b * NMEM + m) * 1024 + lay * 512;
            const u32x4* k4 = (const u32x4*)(row + h * 64);
            float s = 0.f;
#pragma unroll
            for (int d8 = 0; d8 < 8; ++d8) s += dot8(q4[d8], k4[d8]);
            s *= 0.125f;
            const float mn = fmaxf(mx, s), alpha = __expf(mx - mn), pp = __expf(s - mn);
            l = l * alpha + pp; mx = mn;
            const u32x4* v4 = (const u32x4*)(row + 256 + h * 64);
#pragma unroll
            for (int d8 = 0; d8 < 8; ++d8) { const u32x4 vv = v4[d8];
#pragma unroll
                for (int e = 0; e < 4; ++e) { acc[d8 * 8 + 2 * e] = acc[d8 * 8 + 2 * e] * alpha + pp * __uint_as_float(vv[e] << 16);
                    acc[d8 * 8 + 2 * e + 1] = acc[d8 * 8 + 2 * e + 1] * alpha + pp * __uint_as_float(vv[e] & 0xffff0000u); } }
        }
        const float inv = 1.f / l;
        u32x4* o4 = (u32x4*)(CAT + (size_t)t * D + MIX + h * 64);
#pragma unroll
        for (int d8 = 0; d8 < 8; ++d8) { u32x4 w; w.x = pk2(acc[d8 * 8] * inv, acc[d8 * 8 + 1] * inv); w.y = pk2(acc[d8 * 8 + 2] * inv, acc[d8 * 8 + 3] * inv);
            w.z = pk2(acc[d8 * 8 + 4] * inv, acc[d8 * 8 + 5] * inv); w.w = pk2(acc[d8 * 8 + 6] * inv, acc[d8 * 8 + 7] * inv); o4[d8] = w; }
    }
}


namespace att {
typedef short bf16x8 __attribute__((ext_vector_type(8)));
typedef short s16x4 __attribute__((ext_vector_type(4)));
__device__ __forceinline__ s16x4 tr_read(LAS const unsigned char* p) { return __builtin_amdgcn_ds_read_tr16_b64_v4i16((LAS s16x4*)p); }
template <bool NA_MODE, class KRow, class Bias>
__device__ __forceinline__ void attn16x256(const bf16* qrow, const KRow& krow, unsigned koff, LAS const unsigned char* vlane, int xs, const Bias& bias, bf16* orow, int fr, int fq) {
    const int p = fr & 3, ph = p >> 1, pl8 = (p & 1) * 8;
    const bf16x8 q0 = *(const bf16x8*)(qrow + 8 * fq), q1 = *(const bf16x8*)(qrow + 32 + 8 * fq);
    f32x4 s[16];
    {   bf16x8 ka[8], kb[8];
#pragma unroll
        for (int kt = 0; kt < 8; ++kt) { const char* kr = krow(kt); ka[kt] = *(const bf16x8*)(kr + koff); kb[kt] = *(const bf16x8*)(kr + koff + 64); }
        __builtin_amdgcn_sched_barrier(0);
#pragma unroll
        for (int kt = 0; kt < 8; ++kt) { f32x4 a = {0.f, 0.f, 0.f, 0.f};
            a = __builtin_amdgcn_mfma_f32_16x16x32_bf16(ka[kt], q0, a, 0, 0, 0);
            a = __builtin_amdgcn_mfma_f32_16x16x32_bf16(kb[kt], q1, a, 0, 0, 0);
            s[kt] = a;
            __builtin_amdgcn_sched_barrier(0);
            const char* kr = krow(8 + kt); ka[kt] = *(const bf16x8*)(kr + koff); kb[kt] = *(const bf16x8*)(kr + koff + 64);
            __builtin_amdgcn_sched_barrier(0); }
#pragma unroll
        for (int kt = 0; kt < 8; ++kt) { f32x4 a = {0.f, 0.f, 0.f, 0.f};
            a = __builtin_amdgcn_mfma_f32_16x16x32_bf16(ka[kt], q0, a, 0, 0, 0);
            a = __builtin_amdgcn_mfma_f32_16x16x32_bf16(kb[kt], q1, a, 0, 0, 0);
            s[8 + kt] = a; }
    }
    float mx = -3.0e38f;
#pragma unroll
    for (int kt = 0; kt < 16; ++kt)
#pragma unroll
        for (int r = 0; r < 4; ++r) { const float v = bias(kt, r, s[kt][r]); s[kt][r] = v; mx = fmaxf(mx, v); }
    mx = fmaxf(mx, __shfl_xor(mx, 16)); mx = fmaxf(mx, __shfl_xor(mx, 32));
    float l = 0.f;
#pragma unroll
    for (int kt = 0; kt < 16; ++kt)
#pragma unroll
        for (int r = 0; r < 4; ++r) { const float pv = __expf(s[kt][r] - mx); s[kt][r] = pv; l += pv; }
    l += __shfl_xor(l, 16); l += __shfl_xor(l, 32);
    LAS const unsigned char* vb[4];
#pragma unroll
    for (int dt = 0; dt < 4; ++dt) vb[dt] = vlane + (((2 * dt + ph) ^ xs) << 4) + pl8;
    f32x4 o[4];
#pragma unroll
    for (int dt = 0; dt < 4; ++dt) o[dt] = (f32x4){0.f, 0.f, 0.f, 0.f};
#pragma unroll
    for (int j = 0; j < 8; ++j) {
        u32x4 pw; pw.x = pg8::cvt_pk_bf16(s[2 * j][0], s[2 * j][1]); pw.y = pg8::cvt_pk_bf16(s[2 * j][2], s[2 * j][3]);
        pw.z = pg8::cvt_pk_bf16(s[2 * j + 1][0], s[2 * j + 1][1]); pw.w = pg8::cvt_pk_bf16(s[2 * j + 1][2], s[2 * j + 1][3]);
        const bf16x8 pb = __builtin_bit_cast(bf16x8, pw);
        constexpr int dummy = 0; (void)dummy;
        const int c0 = NA_MODE ? (((2 * j) >> 1) * 64 + 16 * ((2 * j) & 1)) : 16 * (2 * j);
        const int c1 = NA_MODE ? (((2 * j + 1) >> 1) * 64 + 16 * ((2 * j + 1) & 1)) : 16 * (2 * j + 1);
#pragma unroll
        for (int dt = 0; dt < 4; ++dt) {
            const s16x4 lo = tr_read(vb[dt] + c0 * 128), hi = tr_read(vb[dt] + c1 * 128);
            const bf16x8 va = {lo[0], lo[1], lo[2], lo[3], hi[0], hi[1], hi[2], hi[3]};
            o[dt] = __builtin_amdgcn_mfma_f32_16x16x32_bf16(va, pb, o[dt], 0, 0, 0);
        }
    }
    const float inv = 1.f / l;
#pragma unroll
    for (int dt = 0; dt < 4; ++dt) { u32x2 w; w.x = pg8::cvt_pk_bf16(o[dt][0] * inv, o[dt][1] * inv); w.y = pg8::cvt_pk_bf16(o[dt][2] * inv, o[dt][3] * inv);
        *(u32x2*)(orow + 16 * dt + 4 * fq) = w; }
}

__device__ __forceinline__ void na_phase(const Ctx& c, const bf16* U, const float* rpb, bf16* CAT, int vcu, int G) {
    const int fr = c.lane & 15, fq = c.lane >> 4, j = c.wave & 3, hs = c.wave >> 2;
    for (int u = vcu; u < NBATCH * 6 * 64; u += G) {
        const int r = u & 63, hp = (u >> 6) % 6, b = u / 384, rs = min(max(r - 4, 0), 56);
        __syncthreads();
        { u32x4 vv[16];
#pragma unroll
            for (int it = 0; it < 16; ++it) { const int idx = c.tid + 512 * it, hsel = idx >> 12, rem = idx & 4095, key = rem >> 3, ch = rem & 7;
                vv[it] = *(const u32x4*)(U + (size_t)(b * SEQ + (rs + (key >> 6)) * 64 + (key & 63)) * LDU0 + 1536 + (2 * hp + hsel) * 64 + ch * 8); }
            __builtin_amdgcn_sched_barrier(0);
#pragma unroll
            for (int it = 0; it < 16; ++it) { const int idx = c.tid + 512 * it, hsel = idx >> 12, rem = idx & 4095, key = rem >> 3, ch = rem & 7;
                *(LAS u32x4*)(c.lds + hsel * 65536 + key * 128 + ((ch ^ (key & 7)) << 4)) = vv[it]; } }
        __syncthreads();
        const int h = 2 * hp + hs, cq = 16 * j + fr, cs = min(max(cq - 8, 0), 48), kc0 = min(max(16 * j - 8, 0), 32);
        const int tq = b * SEQ + r * 64 + cq;
        const bf16* qrow = U + (size_t)tq * LDU0 + h * 64;
        const char* kbase = (const char*)(U + (size_t)(b * SEQ + rs * 64 + kc0) * LDU0 + 768 + h * 64); const unsigned koff = (unsigned)(fr * LDU0 + 8 * fq) * 2u;
        const int rowb = kc0 + 4 * fq + (fr >> 2);
        LAS const unsigned char* vlane = c.lds + hs * 65536 + rowb * 128;
        const float* rp = rpb + (size_t)(h * 15 + (rs - r + 7)) * 31;
        attn16x256<true>(qrow, [&](int kt) { return kbase + (size_t)((kt >> 1) * 64 + 16 * (kt & 1)) * LDU0 * 2; }, koff, vlane, rowb & 7,
            [&](int kt, int rg, float sv) { const int kcol = kc0 + 16 * (kt & 1) + 4 * fq + rg; const bool ok = (kcol >= cs) && (kcol < cs + 16);
                const int dc = min(max(kcol - cq + 15, 0), 30); const float bv = rp[(kt >> 1) * 31 + dc]; return ok ? sv * 0.125f + bv : -1.0e30f; },
            CAT + (size_t)tq * D + h * 64, fr, fq);
    }
}
__device__ __forceinline__ void mem_phase(const Ctx& c, const bf16* U, int ldu, int mqcol, const bf16* MKV, int lay, bf16* CAT, int vcu, int G) {
    const int fr = c.lane & 15, fq = c.lane >> 4;
    for (int u = vcu; u < NBATCH * 4 * 16; u += G) {
        const int tt = u & 15, h = (u >> 4) & 3, b = u >> 6;
        __syncthreads();
#pragma unroll
        for (int it = 0; it < 4; ++it) { const int idx = c.tid + 512 * it, key = idx >> 3, ch = idx & 7;
            const u32x4 v = *(const u32x4*)(MKV + (size_t)(b * NMEM + key) * 1024 + lay * 512 + 256 + h * 64 + ch * 8);
            *(LAS u32x4*)(c.lds + key * 128 + ((ch ^ (key & 7)) << 4)) = v; }
        __syncthreads();
        const char* kbase = (const char*)(MKV + (size_t)(b * NMEM) * 1024 + lay * 512 + h * 64); const unsigned koff = (unsigned)(fr * 1024 + 8 * fq) * 2u;
        const int rowb = 4 * fq + (fr >> 2);
        LAS const unsigned char* vlane = c.lds + rowb * 128;
#pragma unroll 1
        for (int it = 0; it < 2; ++it) {
            const int tq = b * SEQ + tt * 256 + c.wave * 32 + it * 16 + fr;
            attn16x256<false>(U + (size_t)tq * ldu + mqcol + h * 64, [&](int kt) { return kbase + (size_t)(16 * kt) * 1024 * 2; }, koff, vlane, rowb & 7,
                [&](int, int, float sv) { return sv * 0.125f; }, CAT + (size_t)tq * D + MIX + h * 64, fr, fq);
        }
    }
}
}


__device__ __forceinline__ void na_ring_phase(const Ctx& c, const bf16* U, const float* rpb, bf16* CAT, int vcu) {
    if (vcu >= NBATCH * NA_H * 4) return;
    int item_ = vcu; asm volatile("" : "+s"(item_));
    const int item = item_, seg = item & 3, h = (item >> 2) % NA_H, b = item / (4 * NA_H), r0 = 16 * seg;
    const int fr = c.lane & 15, fq = c.lane >> 4, j = c.wave & 3; const bool loader = c.wave >= 4;
    const int rs0 = min(max(r0 - 4, 0), 56);
    __syncthreads();
    { u32x4 vv[16];
#pragma unroll
        for (int it = 0; it < 16; ++it) { const int idx = c.tid + 512 * it, kv = idx >> 12, rem = idx & 4095, i = rem >> 9, col = (rem >> 3) & 63, ch = rem & 7;
            vv[it] = *(const u32x4*)(U + (size_t)(b * SEQ + (rs0 + i) * 64 + col) * LDU0 + (kv ? 1536 : 768) + h * 64 + ch * 8); }
        __builtin_amdgcn_sched_barrier(0);
#pragma unroll
        for (int it = 0; it < 16; ++it) { const int idx = c.tid + 512 * it, kv = idx >> 12, rem = idx & 4095, i = rem >> 9, col = (rem >> 3) & 63, ch = rem & 7;
            *(LAS u32x4*)(c.lds + kv * 65536 + (((rs0 + i) & 7) * 64 + col) * 128 + ((ch ^ (col & 7)) << 4)) = vv[it]; } }
    LAS float* RPB = (LAS float*)(c.lds + 131072 + 4096);
    if (c.tid < 465) RPB[c.tid] = rpb[(size_t)h * 465 + c.tid];
    __syncthreads();
    const int cq = 16 * j + fr, cs = min(max(cq - 8, 0), 48), kc0 = min(max(16 * j - 8, 0), 32);
    const int p = fr & 3, ph = p >> 1, pl8 = (p & 1) * 8, qd = fr >> 2;
    const int ksw = (kc0 + fr) & 7, klane = (kc0 + fr) * 128;
    const int vrow = kc0 + 4 * fq + qd, vsw = vrow & 7;
    int vb[4];
#pragma unroll
    for (int dt = 0; dt < 4; ++dt) vb[dt] = 65536 + vrow * 128 + (((2 * dt + ph) ^ vsw) << 4) + pl8;
    att::bf16x8 q0 = {}, q1 = {};
    if (!loader) { const bf16* qrow = U + (size_t)(b * SEQ + r0 * 64 + cq) * LDU0 + h * 64; q0 = *(const att::bf16x8*)(qrow + 8 * fq); q1 = *(const att::bf16x8*)(qrow + 32 + 8 * fq); }
#pragma unroll 1
    for (int step = 0; step < 16; ++step) {
        const int r = r0 + step, rs = min(max(r - 4, 0), 56), rsn = min(max(r - 3, 0), 56); const bool need_new = (step < 15) && (rsn > rs); const int new_row = rs + 8;
        u32x4 nv[4];
        if (loader) { if (need_new) { const int lt = c.tid - 256;
#pragma unroll
                for (int it = 0; it < 4; ++it) { const int idx = lt + 256 * it, kv = idx >> 9, col = (idx >> 3) & 63, ch = idx & 7;
                    nv[it] = *(const u32x4*)(U + (size_t)(b * SEQ + new_row * 64 + col) * LDU0 + (kv ? 1536 : 768) + h * 64 + ch * 8); } }
        } else {
            const int tq = b * SEQ + r * 64 + cq; const bf16* qnx = U + (size_t)(tq + (step < 15 ? 64 : 0)) * LDU0 + h * 64;
            const att::bf16x8 qn0 = *(const att::bf16x8*)(qnx + 8 * fq), qn1 = *(const att::bf16x8*)(qnx + 32 + 8 * fq);
            LAS const float* rp = RPB + (rs - r + 7) * 31;
            f32x4 s[16];
#pragma unroll
            for (int kt = 0; kt < 16; ++kt) { const int so = (((rs + (kt >> 1)) & 7) * 64) * 128 + 2048 * (kt & 1) + klane;
                const att::bf16x8 k0 = *(LAS const att::bf16x8*)(c.lds + so + ((fq ^ ksw) << 4)), k1 = *(LAS const att::bf16x8*)(c.lds + so + (((fq + 4) ^ ksw) << 4));
                f32x4 a = {0.f, 0.f, 0.f, 0.f};
                a = __builtin_amdgcn_mfma_f32_16x16x32_bf16(k0, q0, a, 0, 0, 0); a = __builtin_amdgcn_mfma_f32_16x16x32_bf16(k1, q1, a, 0, 0, 0); s[kt] = a; }
            float mx = -3.0e38f;
#pragma unroll
            for (int kt = 0; kt < 16; ++kt)
#pragma unroll
                for (int rg = 0; rg < 4; ++rg) { const int kcol = kc0 + 16 * (kt & 1) + 4 * fq + rg; const bool ok = (kcol >= cs) && (kcol < cs + 16);
                    const int dc = min(max(kcol - cq + 15, 0), 30); const float bv = rp[(kt >> 1) * 31 + dc]; const float v = ok ? s[kt][rg] * 0.125f + bv : -1.0e30f; s[kt][rg] = v; mx = fmaxf(mx, v); }
            mx = fmaxf(mx, __shfl_xor(mx, 16)); mx = fmaxf(mx, __shfl_xor(mx, 32));
            float l = 0.f;
#pragma unroll
            for (int kt = 0; kt < 16; ++kt)
#pragma unroll
                for (int rg = 0; rg < 4; ++rg) { const float pv = __expf(s[kt][rg] - mx); s[kt][rg] = pv; l += pv; }
            l += __shfl_xor(l, 16); l += __shfl_xor(l, 32);
            f32x4 o[4];
#pragma unroll
            for (int dt = 0; dt < 4; ++dt) o[dt] = (f32x4){0.f, 0.f, 0.f, 0.f};
#pragma unroll
            for (int i = 0; i < 8; ++i) {
                u32x4 pw; pw.x = pg8::cvt_pk_bf16(s[2 * i][0], s[2 * i][1]); pw.y = pg8::cvt_pk_bf16(s[2 * i][2], s[2 * i][3]);
                pw.z = pg8::cvt_pk_bf16(s[2 * i + 1][0], s[2 * i + 1][1]); pw.w = pg8::cvt_pk_bf16(s[2 * i + 1][2], s[2 * i + 1][3]);
                const att::bf16x8 pb = __builtin_bit_cast(att::bf16x8, pw);
                const int so = (((rs + i) & 7) * 64) * 128;
#pragma unroll
                for (int dt = 0; dt < 4; ++dt) { const att::s16x4 lo = att::tr_read(c.lds + so + vb[dt]), hi = att::tr_read(c.lds + so + vb[dt] + 2048);
                    const att::bf16x8 va = {lo[0], lo[1], lo[2], lo[3], hi[0], hi[1], hi[2], hi[3]};
                    o[dt] = __builtin_amdgcn_mfma_f32_16x16x32_bf16(va, pb, o[dt], 0, 0, 0); } }
            const float inv = 1.f / l; bf16* orow = CAT + (size_t)tq * D + h * 64;
#pragma unroll
            for (int dt = 0; dt < 4; ++dt) { u32x2 w; w.x = pg8::cvt_pk_bf16(o[dt][0] * inv, o[dt][1] * inv); w.y = pg8::cvt_pk_bf16(o[dt][2] * inv, o[dt][3] * inv); *(u32x2*)(orow + 16 * dt + 4 * fq) = w; }
            q0 = qn0; q1 = qn1;
        }
        __syncthreads();
        if (loader && need_new) { const int lt = c.tid - 256;
#pragma unroll
            for (int it = 0; it < 4; ++it) { const int idx = lt + 256 * it, kv = idx >> 9, col = (idx >> 3) & 63, ch = idx & 7;
                *(LAS u32x4*)(c.lds + kv * 65536 + ((new_row & 7) * 64 + col) * 128 + ((ch ^ (col & 7)) << 4)) = nv[it]; } }
        __syncthreads();
    }
}

__device__ __forceinline__ void route_phase(const Ctx& c, const float* X, const float* g, const float* wg, const float* bg, const float* wr, const float* br,
                                            bf16* HN, unsigned char* rt, unsigned* cnt) {
    int* TOKE = (int*)(rt + RT_TOKE); float* TOKW = (float*)(rt + RT_TOKW); int* TOKP = (int*)(rt + RT_TOKP); int* LIST = (int*)(rt + RT_LIST); float* LISTW = (float*)(rt + RT_LISTW);
    for (int t = c.gw; t < NTOK; t += c.ngw) {
        const f32x4* xr = (const f32x4*)(X + (size_t)t * D) + c.lane; const f32x4* gr = (const f32x4*)g + c.lane;
        f32x4 v[4]; float s = 0.f;
#pragma unroll
        for (int j = 0; j < 4; ++j) { v[j] = xr[64 * j]; s += (v[j].x * v[j].x + v[j].y * v[j].y) + (v[j].z * v[j].z + v[j].w * v[j].w); }
        const float r = 1.f / sqrtf(wave_sum(s) * (1.f / D) + EPS);
        u32x2* o8 = (u32x2*)(HN + (size_t)t * D) + c.lane;
#pragma unroll
        for (int j = 0; j < 4; ++j) { const f32x4 gg = gr[64 * j]; v[j].x *= r * gg.x; v[j].y *= r * gg.y; v[j].z *= r * gg.z; v[j].w *= r * gg.w;
            u32x2 w; w.x = pk2(v[j].x, v[j].y); w.y = pk2(v[j].z, v[j].w); o8[64 * j] = w; }
        LAS float* hrow = (LAS float*)(c.lds + c.wave * 16384);
#pragma unroll
        for (int j = 0; j < 4; ++j) *(LAS f32x4*)(hrow + 4 * c.lane + 256 * j) = v[j];
        asm volatile("s_waitcnt lgkmcnt(0)" ::: "memory");
        float lg[4], lr[32];
#pragma unroll
        for (int o = 0; o < 4; ++o) lg[o] = 0.f;
#pragma unroll
        for (int o = 0; o < 32; ++o) lr[o] = 0.f;
#pragma unroll 1
        for (int kk = 0; kk < 16; ++kk) { const int k = c.lane + 64 * kk; const float xv = hrow[k];
            const f32x4 w4 = *(const f32x4*)(wg + (size_t)k * 4);
#pragma unroll
            for (int o = 0; o < 4; ++o) lg[o] += xv * w4[o];
#pragma unroll
            for (int o4 = 0; o4 < 8; ++o4) { const f32x4 w = *(const f32x4*)(wr + (size_t)k * 32 + o4 * 4);
#pragma unroll
                for (int o = 0; o < 4; ++o) lr[o4 * 4 + o] += xv * w[o]; } }
        asm volatile("s_waitcnt lgkmcnt(0)" ::: "memory");
#pragma unroll
        for (int o = 0; o < 4; ++o) lg[o] = wave_sum(lg[o]) + bg[o];
#pragma unroll
        for (int o = 0; o < 32; ++o) lr[o] = wave_sum(lr[o]) + br[o];
        int gi = 0; float gm = lg[0];
#pragma unroll
        for (int o = 1; o < 4; ++o) if (lg[o] > gm) { gm = lg[o]; gi = o; }
        float gs = 0.f;
#pragma unroll
        for (int o = 0; o < 4; ++o) gs += __expf(lg[o] - gm);
        const float ggate = 1.f / gs;
        float el[8];
#pragma unroll
        for (int o = 0; o < 8; ++o) { float x = lr[o];
#pragma unroll
            for (int q = 1; q < 4; ++q) x = (gi == q) ? lr[q * 8 + o] : x;
            el[o] = x; }
        int i0 = 0; float l0 = el[0];
#pragma unroll
        for (int o = 1; o < 8; ++o) if (el[o] > l0) { l0 = el[o]; i0 = o; }
        int i1 = -1; float l1 = -3.0e38f;
#pragma unroll
        for (int o = 0; o < 8; ++o) if (o != i0 && el[o] > l1) { l1 = el[o]; i1 = o; }
        if (i1 < 0) { i1 = (i0 == 0) ? 1 : 0; l1 = el[0]; }
        const float e1 = __expf(l1 - l0), den = 1.f / (1.f + e1);
        const float w0 = den * ggate, w1 = e1 * den * ggate;
        if (c.lane == 0) {
            const int ex0 = gi * 8 + i0, ex1 = gi * 8 + i1;
            const unsigned p0 = atomicAdd(cnt + ex0 * CNT_ST, 1u), p1 = atomicAdd(cnt + ex1 * CNT_ST, 1u);
            LIST[ex0 * NTOK + p0] = t; LIST[ex1 * NTOK + p1] = t; LISTW[ex0 * NTOK + p0] = w0; LISTW[ex1 * NTOK + p1] = w1;
            TOKE[2 * t] = ex0; TOKE[2 * t + 1] = ex1; TOKW[2 * t] = w0; TOKW[2 * t + 1] = w1; TOKP[2 * t] = (int)p0; TOKP[2 * t + 1] = (int)p1;
        }
    }
}

__device__ __forceinline__ void route_mfma(const Ctx& c, const bf16* X, const float* WRl, const float* bg, const float* br, unsigned char* rt, unsigned* cnt) {
    int* TOKE = (int*)(rt + RT_TOKE); float* TOKW = (float*)(rt + RT_TOKW); int* TOKP = (int*)(rt + RT_TOKP); int* LIST = (int*)(rt + RT_LIST); float* LISTW = (float*)(rt + RT_LISTW); float* LISTR = (float*)(rt + RT_LISTR);
    if (c.wave >= 4) return;
    const int fr = c.lane & 15, fq = c.lane >> 4, lr = c.lane >> 5, lc = (c.lane & 31) * 4;
    LAS float* XS = (LAS float*)(c.lds + c.wave * 16384);
    LAS float* LG = XS + 16 * 132;
    const float* w3 = WRl + c.lane * 4;
    for (int tile = blockIdx.x * 4 + c.wave; tile < NTOK / 16; tile += gridDim.x * 4) {
        const int t0 = tile * 16; const bf16* xp = X + (size_t)(t0 + lr) * D + lc;
        f32x4 a0 = {0.f, 0.f, 0.f, 0.f}, a1 = a0, a2 = a0; float ss = 0.f;
        u32x2 pre[8]; f32x4 wa0[4], wa1[4], wa2[4], wb0[4], wb1[4], wb2[4];
#define RT_LOADX(ch) do { _Pragma("unroll") for (int i_ = 0; i_ < 8; ++i_) pre[i_] = *(const u32x2*)(xp + (size_t)(2 * i_) * D + 128 * (ch)); } while (0)
#define RT_PUTX() do { _Pragma("unroll") for (int i_ = 0; i_ < 8; ++i_) { const u32x2 p_ = pre[i_]; \
            *(LAS f32x4*)(XS + (2 * i_ + lr) * 132 + lc) = (f32x4){__uint_as_float(p_.x << 16), __uint_as_float(p_.x & 0xffff0000u), __uint_as_float(p_.y << 16), __uint_as_float(p_.y & 0xffff0000u)}; } } while (0)
#define RT_LOADW(W0_, W1_, W2_, Q) do { _Pragma("unroll") for (int q_ = 0; q_ < 4; ++q_) { const int j_ = (Q) * 4 + q_; W0_[q_] = *(const f32x4*)(w3 + (j_ * 3 + 0) * 256); \
            W1_[q_] = *(const f32x4*)(w3 + (j_ * 3 + 1) * 256); W2_[q_] = *(const f32x4*)(w3 + (j_ * 3 + 2) * 256); } } while (0)
#define RT_MMA(W0_, W1_, W2_, HALF) do { _Pragma("unroll") for (int q_ = 0; q_ < 4; ++q_) { const f32x4 v = *(LAS const f32x4*)(XS + fr * 132 + 16 * ((HALF) * 4 + q_) + 4 * fq); \
            ss += (v[0] * v[0] + v[1] * v[1]) + (v[2] * v[2] + v[3] * v[3]); \
            _Pragma("unroll") for (int i = 0; i < 4; ++i) { a0 = __builtin_amdgcn_mfma_f32_16x16x4f32(v[i], W0_[q_][i], a0, 0, 0, 0); a1 = __builtin_amdgcn_mfma_f32_16x16x4f32(v[i], W1_[q_][i], a1, 0, 0, 0); \
                a2 = __builtin_amdgcn_mfma_f32_16x16x4f32(v[i], W2_[q_][i], a2, 0, 0, 0); } } } while (0)
        RT_LOADX(0); RT_LOADW(wa0, wa1, wa2, 0);
#pragma unroll 1
        for (int ch = 0; ch < 8; ++ch) {
            RT_PUTX();
            if (ch < 7) RT_LOADX(ch + 1);
            RT_LOADW(wb0, wb1, wb2, 2 * ch + 1);
            __builtin_amdgcn_sched_barrier(0);
            RT_MMA(wa0, wa1, wa2, 0);
            __builtin_amdgcn_sched_barrier(0);
            if (ch < 7) RT_LOADW(wa0, wa1, wa2, 2 * ch + 2);
            __builtin_amdgcn_sched_barrier(0);
            RT_MMA(wb0, wb1, wb2, 1);
            __builtin_amdgcn_sched_barrier(0);
        }
#undef RT_LOADX
#undef RT_PUTX
#undef RT_LOADW
#undef RT_MMA
        ss += __shfl_xor(ss, 16); ss += __shfl_xor(ss, 32);
        const float r = 1.f / sqrtf(ss * (1.f / D) + EPS);
        const float b0 = fr < 4 ? bg[fr] : br[fr - 4], b1 = br[12 + fr], b2 = fr < 4 ? br[28 + fr] : 0.f;
#pragma unroll
        for (int rg = 0; rg < 4; ++rg) { const float rr = __shfl(r, 4 * fq + rg); LAS float* row = LG + (4 * fq + rg) * 48;
            row[fr] = a0[rg] * rr + b0; row[16 + fr] = a1[rg] * rr + b1; row[32 + fr] = a2[rg] * rr + b2; }
        const float rtok = r;
        asm volatile("s_waitcnt lgkmcnt(0)" ::: "memory");
        if (c.lane < 16) { const int t = t0 + c.lane; LAS const float* lrow = LG + c.lane * 48;
            float lg[4], el[8];
#pragma unroll
            for (int o = 0; o < 4; ++o) lg[o] = lrow[o];
            int gi = 0; float gm = lg[0];
#pragma unroll
            for (int o = 1; o < 4; ++o) if (lg[o] > gm) { gm = lg[o]; gi = o; }
            float gs = 0.f;
#pragma unroll
            for (int o = 0; o < 4; ++o) gs += __expf(lg[o] - gm);
            const float ggate = 1.f / gs;
#pragma unroll
            for (int o = 0; o < 8; ++o) el[o] = lrow[4 + gi * 8 + o];
            int i0 = 0; float l0 = el[0];
#pragma unroll
            for (int o = 1; o < 8; ++o) if (el[o] > l0) { l0 = el[o]; i0 = o; }
            int i1 = -1; float l1 = -3.0e38f;
#pragma unroll
            for (int o = 0; o < 8; ++o) if (o != i0 && el[o] > l1) { l1 = el[o]; i1 = o; }
            if (i1 < 0) { i1 = (i0 == 0) ? 1 : 0; l1 = el[0]; }
            const float e1 = __expf(l1 - l0), den = 1.f / (1.f + e1), w0 = den * ggate, w1 = e1 * den * ggate;
            const int ex0 = gi * 8 + i0, ex1 = gi * 8 + i1;
            const unsigned p0 = atomicAdd(cnt + ex0 * CNT_ST, 1u), p1 = atomicAdd(cnt + ex1 * CNT_ST, 1u);
            LIST[ex0 * NTOK + p0] = t; LIST[ex1 * NTOK + p1] = t; LISTW[ex0 * NTOK + p0] = w0; LISTW[ex1 * NTOK + p1] = w1; LISTR[ex0 * NTOK + p0] = rtok; LISTR[ex1 * NTOK + p1] = rtok;
            TOKE[2 * t] = ex0; TOKE[2 * t + 1] = ex1; TOKW[2 * t] = w0; TOKW[2 * t + 1] = w1; TOKP[2 * t] = (int)p0; TOKP[2 * t + 1] = (int)p1; }
        asm volatile("s_waitcnt lgkmcnt(0)" ::: "memory");
    }
}
__device__ __forceinline__ int pstart_of(const unsigned* cnt, int e) { int s = 0; for (int i = 0; i < e; ++i) s += ((int)cnt[i * CNT_ST] + 255) & ~255; return s; }
__device__ __forceinline__ bool row_lookup(const unsigned* cnt, int R, int& e, int& i, int& n) {
    int s = 0;
    for (int x = 0; x < NEXP; ++x) { const int cn = (int)cnt[x * CNT_ST], pc = (cn + 255) & ~255; if (R < s + pc) { e = x; i = R - s; n = cn; return true; } s += pc; }
    return false;
}

__device__ __forceinline__ void combine_phase(const Ctx& c, bf16* XB, const bf16* Y, const unsigned char* rt, const LAS int* tab, const float* g, float* RN, float* OUTF) {
    const int* TOKE = (const int*)(rt + RT_TOKE); const int* TOKP = (const int*)(rt + RT_TOKP);
    for (int t = c.gw; t < NTOK; t += c.ngw) {
        const int e0 = TOKE[2 * t], e1 = TOKE[2 * t + 1];
        const int R0 = tab[e0] * 256 + TOKP[2 * t], R1 = tab[e1] * 256 + TOKP[2 * t + 1];
        u32x2* xr = (u32x2*)(XB + (size_t)t * D) + c.lane;
        const u32x2* y0 = (const u32x2*)(Y + (size_t)R0 * D) + c.lane; const u32x2* y1 = (const u32x2*)(Y + (size_t)R1 * D) + c.lane;
        f32x4 v[4]; float s = 0.f;
#pragma unroll
        for (int j = 0; j < 4; ++j) { const u32x2 x = xr[64 * j], a = y0[64 * j], b = y1[64 * j];
            v[j].x = __uint_as_float(x.x << 16) + __uint_as_float(a.x << 16) + __uint_as_float(b.x << 16); v[j].y = __uint_as_float(x.x & 0xffff0000u) + __uint_as_float(a.x & 0xffff0000u) + __uint_as_float(b.x & 0xffff0000u);
            v[j].z = __uint_as_float(x.y << 16) + __uint_as_float(a.y << 16) + __uint_as_float(b.y << 16); v[j].w = __uint_as_float(x.y & 0xffff0000u) + __uint_as_float(a.y & 0xffff0000u) + __uint_as_float(b.y & 0xffff0000u);
            s += (v[j].x * v[j].x + v[j].y * v[j].y) + (v[j].z * v[j].z + v[j].w * v[j].w); }
        const float r = 1.f / sqrtf(wave_sum(s) * (1.f / D) + EPS);
        if (OUTF == nullptr) {
#pragma unroll
            for (int j = 0; j < 4; ++j) { u32x2 w; w.x = pk2(v[j].x, v[j].y); w.y = pk2(v[j].z, v[j].w); xr[64 * j] = w; }
            if (c.lane == 0) RN[t] = r;
        } else {
            f32x4* o = (f32x4*)(OUTF + (size_t)t * D) + c.lane; const f32x4* gr = (const f32x4*)g + c.lane;
#pragma unroll
            for (int j = 0; j < 4; ++j) { const f32x4 gg = gr[64 * j]; f32x4 w; w.x = v[j].x * r * gg.x; w.y = v[j].y * r * gg.y; w.z = v[j].z * r * gg.z; w.w = v[j].w * r * gg.w; o[64 * j] = w; }
        }
    }
}

__device__ __forceinline__ void gla_decay(const Ctx& c, const bf16* U, const float* gup, const float* gbias, float* DECA) {
    const long total = (long)NTOK * 2 * GLA_KD;
    for (long idx = GTID; idx < total; idx += GSIZE) {
        const int cc = (int)(idx % GLA_KD), dir = (int)((idx / GLA_KD) % 2), t = (int)(idx / (2 * GLA_KD));
        const bf16* r = U + (size_t)t * LDU1 + 2304 + dir * 16;
        float z = gbias[dir * GLA_KD + cc];
#pragma unroll
        for (int k = 0; k < 16; ++k) z += bf2f(r[k]) * gup[(dir * 16 + k) * GLA_KD + cc];
        const float ls = fminf(z, 0.f) - log1pf(__expf(-fabsf(z)));
        DECA[idx] = __expf(ls * (1.f / 16.f));
    }
}
__device__ __forceinline__ void gla_recur(const Ctx& c, const bf16* U, const float* DECA, float* OF) {
    const long total = (long)NBATCH * GLA_H * GLA_DV * 2;
    const float qs = 0.10206207261596577f;
    for (long idx = GTID; idx < total; idx += GSIZE) {
        const int half = (int)(idx & 1), dv = (int)((idx >> 1) % GLA_DV), h = (int)(((idx >> 1) / GLA_DV) % GLA_H), b = (int)((idx >> 1) / (GLA_DV * GLA_H));
        float S[48];
        for (int dir = 0; dir < 2; ++dir) {
#pragma unroll
            for (int d = 0; d < 48; ++d) S[d] = 0.f;
            for (int s = 0; s < SEQ; ++s) {
                const int p = dir ? (SEQ - 1 - s) : s, t = b * SEQ + p;
#if GLA_INTRA_ONLY
                if ((s & 63) == 0) {
#pragma unroll
                    for (int d = 0; d < 48; ++d) S[d] = 0.f; }
#endif
                const bf16* row = U + (size_t)t * LDU1;
                const float vv = bf2f(row[768 + h * GLA_DV + dv]);
                const float* a = DECA + ((size_t)t * 2 + dir) * GLA_KD + h * GLA_DK + half * 48;
                const u32x4* q4 = (const u32x4*)(row + h * GLA_DK + half * 48); const u32x4* k4 = (const u32x4*)(row + 384 + h * GLA_DK + half * 48);
                float o = 0.f;
#pragma unroll
                for (int d8 = 0; d8 < 6; ++d8) { const u32x4 qq = q4[d8], kk = k4[d8]; const f32x4 a0 = *(const f32x4*)(a + d8 * 8), a1 = *(const f32x4*)(a + d8 * 8 + 4);
#pragma unroll
                    for (int e = 0; e < 4; ++e) { const float aa0 = e < 2 ? a0[2 * e] : a1[2 * e - 4], aa1 = e < 2 ? a0[2 * e + 1] : a1[2 * e - 3];
                        const float s0 = aa0 * S[d8 * 8 + 2 * e] + __uint_as_float(kk[e] << 16) * vv; S[d8 * 8 + 2 * e] = s0; o += __uint_as_float(qq[e] << 16) * s0;
                        const float s1 = aa1 * S[d8 * 8 + 2 * e + 1] + __uint_as_float(kk[e] & 0xffff0000u) * vv; S[d8 * 8 + 2 * e + 1] = s1; o += __uint_as_float(qq[e] & 0xffff0000u) * s1; } }
                o += __shfl_xor(o, 1);
                float* dst = OF + (size_t)t * MIX + h * GLA_DV + dv;
                if (half == 0) { if (dir == 0) *dst = o * qs; else *dst += o * qs; }
            }
        }
    }
}
__device__ __forceinline__ void gla_norm_gate(const Ctx& c, const float* OF, const bf16* U, const float* onorm, bf16* CAT) {
    for (int it = c.gw; it < NTOK * GLA_H; it += c.ngw) {
        const int h = it % GLA_H, t = it / GLA_H;
        const float* o = OF + (size_t)t * MIX + h * GLA_DV;
        float v[3]; float s = 0.f;
#pragma unroll
        for (int j = 0; j < 3; ++j) { v[j] = o[c.lane + 64 * j]; s += v[j] * v[j]; }
        const float r = 1.f / sqrtf(wave_sum(s) * (1.f / GLA_DV) + EPS);
#pragma unroll
        for (int j = 0; j < 3; ++j) { const int dv = c.lane + 64 * j; const float gg = bf2f(U[(size_t)t * LDU1 + 1536 + h * GLA_DV + dv]);
            CAT[(size_t)t * D + h * GLA_DV + dv] = (bf16)f2bf(v[j] * r * onorm[dv] * silu(gg)); }
    }
}


namespace gla {
typedef short bf16x8 __attribute__((ext_vector_type(8)));
typedef short s16x4 __attribute__((ext_vector_type(4)));
constexpr int LB_OFF = 0, LB_LD = 97;
constexpr int QG_OFF = 25600, KG_OFF = 38912, QS_OFF = 52224, X_LD = 104;
constexpr int VS_OFF = 65536, V_LD = 200;
constexpr int AM_OFF = 91136, AM_LD = 72;
constexpr int TOT_OFF = 100352;
constexpr int RS_OFF = 102400;
constexpr int OS_OFF = 0, OS_LD = 196;
__device__ __forceinline__ s16x4 tr_read(LAS const unsigned char* p) { return __builtin_amdgcn_ds_read_tr16_b64_v4i16((LAS s16x4*)p); }
__device__ __forceinline__ float bflo(unsigned w) { return __uint_as_float(w << 16); }
__device__ __forceinline__ float bfhi(unsigned w) { return __uint_as_float(w & 0xffff0000u); }

constexpr int RR_OFF = RS_OFF + 1024;
__device__ __forceinline__ void prep(const Ctx& c, const bf16* U, const float* gup, const float* gbias, int t0, int h, int dir) {
    LAS float* LB = (LAS float*)(c.lds + LB_OFF); LAS float* TOT = (LAS float*)(c.lds + TOT_OFF); LAS float* RR = (LAS float*)(c.lds + RR_OFF);
    if (c.tid < 128) { const int t = c.tid >> 1, hf = c.tid & 1; const u32x4 ra = *(const u32x4*)(U + (size_t)(t0 + t) * LDU1 + 2304 + dir * 16 + hf * 8);
        f32x4 lo = {bflo(ra[0]), bfhi(ra[0]), bflo(ra[1]), bfhi(ra[1])}, hi = {bflo(ra[2]), bfhi(ra[2]), bflo(ra[3]), bfhi(ra[3])};
        *(LAS f32x4*)(RR + t * 16 + hf * 8) = lo; *(LAS f32x4*)(RR + t * 16 + hf * 8 + 4) = hi; }
    const int d = c.tid % 96, seg = c.tid / 96;
    float gw[16], bs = 0.f;
    if (c.tid < 384) { bs = gbias[dir * GLA_KD + h * GLA_DK + d];
#pragma unroll
        for (int k = 0; k < 16; ++k) gw[k] = gup[(size_t)(dir * 16 + k) * GLA_KD + h * GLA_DK + d]; }
    __syncthreads();
    if (c.tid < 384) { float run = 0.f;
#pragma unroll 4
        for (int i = 0; i < 16; ++i) { const int s = seg * 16 + i, t = dir ? 63 - s : s;
            const f32x4 r0 = *(LAS const f32x4*)(RR + t * 16), r1 = *(LAS const f32x4*)(RR + t * 16 + 4), r2 = *(LAS const f32x4*)(RR + t * 16 + 8), r3 = *(LAS const f32x4*)(RR + t * 16 + 12);
            float z = bs;
#pragma unroll
            for (int k = 0; k < 4; ++k) { z += r0[k] * gw[k]; z += r1[k] * gw[4 + k]; z += r2[k] * gw[8 + k]; z += r3[k] * gw[12 + k]; }
            run += (fminf(z, 0.f) - __logf(1.f + __expf(-fabsf(z)))) * (1.f / 16.f);
            LB[t * LB_LD + d] = run; }
        TOT[seg * 96 + d] = run; }
    __syncthreads();
    if (c.tid < 384) { float off = 0.f;
        for (int s2 = 0; s2 < seg; ++s2) off += TOT[s2 * 96 + d];
        if (seg > 0) {
#pragma unroll 4
            for (int i = 0; i < 16; ++i) { const int s = seg * 16 + i, t = dir ? 63 - s : s; LB[t * LB_LD + d] += off; } }
        if (seg == 3) TOT[4 * 96 + d] = off + TOT[3 * 96 + d]; }
    __syncthreads();
}
__device__ __forceinline__ void stage_v(const Ctx& c, const bf16* U, int t0, int h) {
    for (int idx = c.tid; idx < 64 * 24; idx += 512) { const int t = idx / 24, ch = idx % 24;
        *(LAS u32x4*)(c.lds + VS_OFF + (t * V_LD + ch * 8) * 2) = *(const u32x4*)(U + (size_t)(t0 + t) * LDU1 + 768 + h * GLA_DV + ch * 8); }
}

__device__ __forceinline__ void local_phase(const Ctx& c, const bf16* U, const float* gup, const float* gbias, bf16* SU, float* DEC, int vcu, int G, unsigned* dbg) {
    const int fr = c.lane & 15, fq = c.lane >> 4, q = fr >> 2, p = fr & 3;
    for (int item = vcu; item < NBATCH * GLA_H * 2 * 64; item += G) {
        const int n = item & 63, dir = (item >> 6) & 1, h = (item >> 7) & 3, b = item >> 9, t0 = b * SEQ + n * 64;
        __syncthreads();
        stage_v(c, U, t0, h);
        prep(c, U, gup, gbias, t0, h, dir);
        LAS const float* LB = (LAS const float*)(c.lds + LB_OFF); LAS const float* BL = (LAS const float*)(c.lds + TOT_OFF) + 4 * 96;
        for (int idx = c.tid; idx < 64 * 12; idx += 512) { const int t = idx / 12, ch = idx % 12;
            const u32x4 kk = *(const u32x4*)(U + (size_t)(t0 + t) * LDU1 + 384 + h * GLA_DK + ch * 8); u32x4 w;
#pragma unroll
            for (int e = 0; e < 4; ++e) { const int d = ch * 8 + 2 * e; const float f0 = __expf(BL[d] - LB[t * LB_LD + d]), f1 = __expf(BL[d + 1] - LB[t * LB_LD + d + 1]);
                w[e] = pg8::cvt_pk_bf16(bflo(kk[e]) * f0, bfhi(kk[e]) * f1); }
            *(LAS u32x4*)(c.lds + QG_OFF + (t * X_LD + ch * 8) * 2) = w; }
        if (c.tid < 96) DEC[(size_t)item * 96 + c.tid] = __expf(BL[c.tid]);
        __syncthreads();
        bf16* su = SU + (size_t)item * (GLA_DV * GLA_DK);
#pragma unroll 1
        for (int k9 = 0; k9 < 9; ++k9) { const int id = c.wave * 9 + k9, jv = id / 6, i = id % 6;
            f32x4 acc = {0.f, 0.f, 0.f, 0.f};
#pragma unroll
            for (int ks = 0; ks < 2; ++ks) { const int tr = 32 * ks + 8 * fq + q;
                const s16x4 a0 = tr_read(c.lds + QG_OFF + (tr * X_LD + 16 * i + 4 * p) * 2), a1 = tr_read(c.lds + QG_OFF + ((tr + 4) * X_LD + 16 * i + 4 * p) * 2);
                const s16x4 b0 = tr_read(c.lds + VS_OFF + (tr * V_LD + 16 * jv + 4 * p) * 2), b1 = tr_read(c.lds + VS_OFF + ((tr + 4) * V_LD + 16 * jv + 4 * p) * 2);
                const bf16x8 av = {a0[0], a0[1], a0[2], a0[3], a1[0], a1[1], a1[2], a1[3]}, bv = {b0[0], b0[1], b0[2], b0[3], b1[0], b1[1], b1[2], b1[3]};
                acc = __builtin_amdgcn_mfma_f32_16x16x32_bf16(av, bv, acc, 0, 0, 0); }
            u32x2 w; w.x = pg8::cvt_pk_bf16(acc[0], acc[1]); w.y = pg8::cvt_pk_bf16(acc[2], acc[3]);
            *(u32x2*)(su + (size_t)(16 * jv + fr) * GLA_DK + 16 * i + 4 * fq) = w; }
    }
}
__device__ __forceinline__ void scan_phase(const Ctx& c, const bf16* __restrict__ SU, bf16* __restrict__ SS, const float* __restrict__ DEC) {
    const long total = (long)32 * 2304;
    for (long idx = GTID; idx < total; idx += GSIZE) { const int seq = (int)(idx / 2304), ch = (int)(idx % 2304), dk0 = (ch % 12) * 8, dir = seq & 1;
        float s[8];
#pragma unroll
        for (int e = 0; e < 8; ++e) s[e] = 0.f;
        const size_t cs = (size_t)(GLA_DV * GLA_DK);
        const bf16* pu0 = SU + (size_t)(seq * 64) * cs + (size_t)ch * 8; bf16* ps0 = SS + (size_t)(seq * 64) * cs + (size_t)ch * 8; const float* pd0 = DEC + (size_t)(seq * 64) * 96 + dk0;
#pragma unroll 1
        for (int st0 = 0; st0 < 64; st0 += 8) {
            u32x4 uu[8]; f32x4 da[8], db[8];
#pragma unroll
            for (int k = 0; k < 8; ++k) { const int n = dir ? 63 - (st0 + k) : st0 + k; uu[k] = *(const u32x4*)(pu0 + (size_t)n * cs); da[k] = *(const f32x4*)(pd0 + n * 96); db[k] = *(const f32x4*)(pd0 + n * 96 + 4); }
#pragma unroll
            for (int k = 0; k < 8; ++k) { const int n = dir ? 63 - (st0 + k) : st0 + k;
                u32x4 w; w.x = pg8::cvt_pk_bf16(s[0], s[1]); w.y = pg8::cvt_pk_bf16(s[2], s[3]); w.z = pg8::cvt_pk_bf16(s[4], s[5]); w.w = pg8::cvt_pk_bf16(s[6], s[7]);
                *(u32x4*)(ps0 + (size_t)n * cs) = w;
                s[0] = s[0] * da[k][0] + bflo(uu[k][0]); s[1] = s[1] * da[k][1] + bfhi(uu[k][0]); s[2] = s[2] * da[k][2] + bflo(uu[k][1]); s[3] = s[3] * da[k][3] + bfhi(uu[k][1]);
                s[4] = s[4] * db[k][0] + bflo(uu[k][2]); s[5] = s[5] * db[k][1] + bfhi(uu[k][2]); s[6] = s[6] * db[k][2] + bflo(uu[k][3]); s[7] = s[7] * db[k][3] + bfhi(uu[k][3]); }
        }
    }
}
__device__ __forceinline__ void out_phase(const Ctx& c, const bf16* U, const float* gup, const float* gbias, const bf16* SU, const float* onorm, bf16* CAT, int vcu, int G) {
    const int fr = c.lane & 15, fq = c.lane >> 4, q = fr >> 2, p = fr & 3, it = c.wave & 3, cth = c.wave >> 2;
    const float qsc = 0.10206207261596577f;
    for (int item = vcu; item < NBATCH * GLA_H * 64; item += G) {
        const int n = item & 63, h = (item >> 6) & 3, b = item >> 8, t0 = b * SEQ + n * 64;
        f32x4 o[6];
#pragma unroll
        for (int x = 0; x < 6; ++x) o[x] = (f32x4){0.f, 0.f, 0.f, 0.f};
        __syncthreads();
        stage_v(c, U, t0, h);
#pragma unroll 1
        for (int dir = 0; dir < 2; ++dir) {
            prep(c, U, gup, gbias, t0, h, dir);
            LAS const float* LB = (LAS const float*)(c.lds + LB_OFF); const int tmid = dir ? 32 : 31;
            for (int idx = c.tid; idx < 64 * 12; idx += 512) { const int t = idx / 12, ch = idx % 12;
                const u32x4 qq = *(const u32x4*)(U + (size_t)(t0 + t) * LDU1 + h * GLA_DK + ch * 8), kk = *(const u32x4*)(U + (size_t)(t0 + t) * LDU1 + 384 + h * GLA_DK + ch * 8);
                u32x4 wg, wk, ws;
#pragma unroll
                for (int e = 0; e < 4; ++e) { const int d = ch * 8 + 2 * e; const float b0 = LB[t * LB_LD + d], b1 = LB[t * LB_LD + d + 1], m0 = LB[tmid * LB_LD + d], m1 = LB[tmid * LB_LD + d + 1];
                    const float q0 = bflo(qq[e]) * qsc, q1 = bfhi(qq[e]) * qsc;
                    wg[e] = pg8::cvt_pk_bf16(q0 * __expf(b0 - m0), q1 * __expf(b1 - m1)); wk[e] = pg8::cvt_pk_bf16(bflo(kk[e]) * __expf(m0 - b0), bfhi(kk[e]) * __expf(m1 - b1));
                    ws[e] = pg8::cvt_pk_bf16(q0 * __expf(b0), q1 * __expf(b1)); }
                *(LAS u32x4*)(c.lds + QG_OFF + (t * X_LD + ch * 8) * 2) = wg; *(LAS u32x4*)(c.lds + KG_OFF + (t * X_LD + ch * 8) * 2) = wk; *(LAS u32x4*)(c.lds + QS_OFF + (t * X_LD + ch * 8) * 2) = ws; }
            __syncthreads();
#pragma unroll
            for (int jj = 0; jj < 2; ++jj) { const int jt = 2 * cth + jj; f32x4 a = {0.f, 0.f, 0.f, 0.f};
#pragma unroll
                for (int ks = 0; ks < 3; ++ks) { const bf16x8 av = *(const LAS bf16x8*)(c.lds + QG_OFF + ((16 * it + fr) * X_LD + 32 * ks + 8 * fq) * 2), bv = *(const LAS bf16x8*)(c.lds + KG_OFF + ((16 * jt + fr) * X_LD + 32 * ks + 8 * fq) * 2);
                    a = __builtin_amdgcn_mfma_f32_16x16x32_bf16(av, bv, a, 0, 0, 0); }
#pragma unroll
                for (int rg = 0; rg < 4; ++rg) { const int i = 16 * it + 4 * fq + rg, j = 16 * jt + fr; const bool keep = dir ? (j >= i) : (j <= i);
                    *(LAS bf16*)(c.lds + AM_OFF + (i * AM_LD + j) * 2) = (bf16)f2bf(keep ? a[rg] : 0.f); } }
            __syncthreads();
            const bf16* st = SU + ((size_t)(((b * 4 + h) * 2 + dir) * 64 + n)) * (GLA_DV * GLA_DK);
#pragma unroll
            for (int x = 0; x < 6; ++x) { const int ct = cth * 6 + x;
#pragma unroll
                for (int ks = 0; ks < 2; ++ks) { const int tr = 32 * ks + 8 * fq + q;
                    const bf16x8 av = *(const LAS bf16x8*)(c.lds + AM_OFF + ((16 * it + fr) * AM_LD + 32 * ks + 8 * fq) * 2);
                    const s16x4 b0 = tr_read(c.lds + VS_OFF + (tr * V_LD + 16 * ct + 4 * p) * 2), b1 = tr_read(c.lds + VS_OFF + ((tr + 4) * V_LD + 16 * ct + 4 * p) * 2);
                    const bf16x8 bv = {b0[0], b0[1], b0[2], b0[3], b1[0], b1[1], b1[2], b1[3]};
                    o[x] = __builtin_amdgcn_mfma_f32_16x16x32_bf16(av, bv, o[x], 0, 0, 0); }
#if !GLA_INTRA_ONLY
#pragma unroll
                for (int ks = 0; ks < 3; ++ks) { const bf16x8 av = *(const LAS bf16x8*)(c.lds + QS_OFF + ((16 * it + fr) * X_LD + 32 * ks + 8 * fq) * 2);
                    const bf16x8 bv = *(const bf16x8*)(st + (size_t)(16 * ct + fr) * GLA_DK + 32 * ks + 8 * fq);
                    o[x] = __builtin_amdgcn_mfma_f32_16x16x32_bf16(av, bv, o[x], 0, 0, 0); }
#endif
            }
            __syncthreads();
        }
        LAS float* OS = (LAS float*)(c.lds + OS_OFF);
#pragma unroll
        for (int x = 0; x < 6; ++x)
#pragma unroll
            for (int rg = 0; rg < 4; ++rg) OS[(16 * it + 4 * fq + rg) * OS_LD + 16 * (cth * 6 + x) + fr] = o[x][rg];
        __syncthreads();
        { const int t = c.tid >> 3, part = c.tid & 7; float s = 0.f;
#pragma unroll
            for (int e = 0; e < 24; ++e) { const float v = OS[t * OS_LD + part * 24 + e]; s += v * v; }
            s += __shfl_xor(s, 1); s += __shfl_xor(s, 2); s += __shfl_xor(s, 4);
            if (part == 0) ((LAS float*)(c.lds + RS_OFF))[t] = 1.f / sqrtf(s * (1.f / GLA_DV) + EPS); }
        __syncthreads();
        for (int idx = c.tid; idx < 64 * 24; idx += 512) { const int t = idx / 24, ch = idx % 24; const float r = ((LAS const float*)(c.lds + RS_OFF))[t];
            const u32x4 gg = *(const u32x4*)(U + (size_t)(t0 + t) * LDU1 + 1536 + h * GLA_DV + ch * 8); u32x4 w;
#pragma unroll
            for (int e = 0; e < 4; ++e) { const int dv = ch * 8 + 2 * e; const float g0 = bflo(gg[e]), g1 = bfhi(gg[e]);
                w[e] = pg8::cvt_pk_bf16(OS[t * OS_LD + dv] * r * onorm[dv] * (g0 / (1.f + __expf(-g0))), OS[t * OS_LD + dv + 1] * r * onorm[dv + 1] * (g1 / (1.f + __expf(-g1)))); }
            *(u32x4*)(CAT + (size_t)(t0 + t) * D + h * GLA_DV + ch * 8) = w; }
    }
}
}

#define XB_TMO      128
#define XB_XCNT(j)  (256  + 64 * (j))
#define XB_XSUB(j)  (1280 + 64 * (j))
#define XB_XGEN(j)  (2304 + 64 * (j))
#define XB_TOP      3328
#define XB_TOPGEN   3392
#define XCD_BAR_WORDS 3456
#define XB_SPIN_CAP (1u << 22)
__device__ __forceinline__ unsigned xb_ld(unsigned* p)              { return __hip_atomic_load(p, __ATOMIC_RELAXED, __HIP_MEMORY_SCOPE_AGENT); }
__device__ __forceinline__ unsigned xb_add(unsigned* p, unsigned v) { return __hip_atomic_fetch_add(p, v, __ATOMIC_RELAXED, __HIP_MEMORY_SCOPE_AGENT); }
__device__ __forceinline__ unsigned xb_xcc_id() { return (unsigned)__builtin_amdgcn_s_getreg((3 << 11) | 20) & 0xFu; }
#define XB_SPIN(cond, bar) do { unsigned _sp = 0; while (cond) { __builtin_amdgcn_s_sleep(1); \
    if ((++_sp & 255u) == 0u) { if (xb_ld(&(bar)[XB_TMO])) break; if (_sp > XB_SPIN_CAP) { atomicAdd(&(bar)[XB_TMO], 1u); break; } } } } while (0)
struct XcdBarrier { unsigned* bar; unsigned x; volatile LAS unsigned* st; };
__device__ __forceinline__ XcdBarrier xcd_barrier_post(unsigned* bar, volatile LAS unsigned* st) {
    XcdBarrier b; b.bar = bar; b.x = xb_xcc_id(); b.st = st;
    if (threadIdx.x == 0) (void)xb_add(&bar[XB_XCNT(b.x)], 1u);
    return b;
}
__device__ __forceinline__ void xcd_barrier_complete(unsigned* bar, unsigned x, unsigned& nloc, unsigned& nx) {
    const unsigned G = gridDim.x * gridDim.y * gridDim.z;
    unsigned sum, cnt, mine, sp = 0u;
    for (;;) {
        sum = 0u; cnt = 0u; mine = 0u;
#pragma unroll
        for (unsigned j = 0; j < 16; ++j) { const unsigned c = xb_ld(&bar[XB_XCNT(j)]); sum += c; cnt += (c > 0u) ? 1u : 0u; mine = (j == x) ? c : mine; }
        if (sum == G) break;
        __builtin_amdgcn_s_sleep(1);
        if ((++sp & 255u) == 0u) { if (xb_ld(&bar[XB_TMO])) break; if (sp > XB_SPIN_CAP) { atomicAdd(&bar[XB_TMO], 1u); break; } }
    }
    nloc = mine > 0u ? mine : 1u; nx = cnt > 0u ? cnt : 1u;
}
__device__ __forceinline__ void xcd_barrier(const XcdBarrier& b) {
    asm volatile("s_waitcnt vmcnt(0)" ::: "memory");
    __syncthreads();
    if (threadIdx.x == 0) {
        unsigned* bar = b.bar;
        __builtin_amdgcn_s_waitcnt(0);
        const unsigned bx = __builtin_amdgcn_readfirstlane(xb_xcc_id());
        unsigned nloc = b.st[0], nx = b.st[1];
        if (nloc == 0u) { xcd_barrier_complete(bar, bx, nloc, nx); b.st[0] = nloc; b.st[1] = nx; }
        const unsigned old = xb_add(&bar[XB_XSUB(bx)], 1u);
        const unsigned gen = old / nloc;
        if (old + 1u == (gen + 1u) * nloc) {
            __builtin_amdgcn_fence(__ATOMIC_RELEASE, "agent");
            asm volatile("s_waitcnt vmcnt(0)" ::: "memory");
            const unsigned og = xb_add(&bar[XB_TOP], 1u);
            const unsigned tg = og / nx;
            if (og + 1u == (tg + 1u) * nx) xb_add(&bar[XB_TOPGEN], 1u);
            else XB_SPIN(xb_ld(&bar[XB_TOPGEN]) == tg, bar);
            __builtin_amdgcn_fence(__ATOMIC_ACQUIRE, "agent");
            xb_add(&bar[XB_XGEN(bx)], 1u);
            asm volatile("s_waitcnt vmcnt(0)" ::: "memory");
        } else {
            XB_SPIN(xb_ld(&bar[XB_XGEN(bx)]) == gen, bar);
            __builtin_amdgcn_fence(__ATOMIC_ACQUIRE, "agent");
            asm volatile("s_waitcnt vmcnt(0)" ::: "memory");
        }
    }
    __syncthreads();
}

constexpr int NWAVES = 8, NTHREADS = 512, LDS_BYTES = 147456, MISC_OFF = 131072 + 1024;
constexpr int NPHASES = 19;
constexpr int TAB_OFF = 131072 + 2048;
#ifndef USE_NA_RING
#define USE_NA_RING 1
#endif
#ifndef USE_MFMA_ROUTE
#define USE_MFMA_ROUTE 1
#endif
#ifndef GLA_EXPERIMENT
#define GLA_EXPERIMENT 0
#endif
#ifndef USE_MFMA_GLA
#define USE_MFMA_GLA 7
#endif
#ifndef USE_MFMA_ATTN
#define USE_MFMA_ATTN 1
#endif
#ifndef USE_PG8
#define USE_PG8 0xF
#endif
__device__ __forceinline__ void build_tab(const Ctx& c, const unsigned* cnt) {
    LAS int* tab = (LAS int*)(c.lds + TAB_OFF);
    __syncthreads();
    if (c.tid < 64) { const int cn = c.tid < 32 ? (int)cnt[c.tid * CNT_ST] : 0; int mt = (cn + 255) >> 8, inc = mt;
#pragma unroll
        for (int o = 1; o < 32; o <<= 1) { const int v = __shfl_up(inc, o); if ((c.tid & 31) >= o) inc += v; }
        if (c.tid < 32) { tab[c.tid + 1] = inc; tab[64 + c.tid] = cn; } if (c.tid == 0) tab[0] = 0; }
    __syncthreads();
}

template <int PH_LO, int PH_HI> __global__ void __launch_bounds__(NTHREADS, 2) mk_fwd(Args args) {
    extern __shared__ __attribute__((aligned(16))) unsigned char lds_raw[];
    LAS unsigned char* const ldsp = (LAS unsigned char*)lds_raw;
    Ctx c = fresh_ctx(ldsp);
    const int vcu = (gridDim.x % 8 == 0) ? (int)((blockIdx.x % 8) * (gridDim.x / 8) + blockIdx.x / 8) : (int)blockIdx.x;
    unsigned char* ws = args.ws;
    const float* x = args.in[0]; const float* mem = args.in[1]; const float* mem_norm = args.in[2]; const float* final_norm = args.in[3];
    const float* norm_mix = args.in[4]; const float* norm_ffn = args.in[5]; const float* w_mem_kv = args.in[6]; const float* w_out = args.in[7];
    const float* na_w_in = args.in[8]; const float* na_rpb = args.in[9]; const float* gla_w_in = args.in[10]; const float* gla_gate_up = args.in[11];
    const float* gla_gate_bias = args.in[12]; const float* gla_out_norm = args.in[13]; const float* moe_w_group = args.in[14]; const float* moe_b_group = args.in[15];
    const float* moe_w_router = args.in[16]; const float* moe_b_router = args.in[17]; const float* moe_w1 = args.in[18]; const float* moe_w3 = args.in[19]; const float* moe_w2 = args.in[20];
    bf16* WIN0 = (bf16*)(ws + WS_WIN0); bf16* WIN1 = (bf16*)(ws + WS_WIN1); bf16* WOUT = (bf16*)(ws + WS_WOUT); bf16* WMKV = (bf16*)(ws + WS_WMKV);
    bf16* MEMN = (bf16*)(ws + WS_MEMN); bf16* MKV = (bf16*)(ws + WS_MKV); bf16* W13 = (bf16*)(ws + WS_W13); bf16* W2 = (bf16*)(ws + WS_W2);
    bf16* XB = (bf16*)(ws + WS_XN); bf16* U = (bf16*)(ws + WS_U); bf16* Y = (bf16*)(ws + WS_Y); bf16* CAT = (bf16*)(ws + WS_CAT); bf16* ACT = (bf16*)(ws + WS_ACT);
    unsigned char* RT = ws + WS_ROUTE; float* RN = (float*)(RT + RT_RN); float* DECA = (float*)(ws + WS_S + 74 * MiB); float* OF = (float*)(ws + WS_S + 122 * MiB);
    bf16* SU = (bf16*)(ws + WS_S); float* SDEC = (float*)(ws + WS_S + 73 * MiB); bf16* SS = (bf16*)(ws + WS_S + 74 * MiB);
    float* WR = (float*)(ws + WS_WR);
    unsigned* CTL = (unsigned*)(ws + WS_CTL);
#define IN(k) (PH_LO <= (k) && (k) < PH_HI)
    constexpr bool FUSED = (PH_HI - PH_LO) > 1;
    XcdBarrier bar; bar.bar = CTL + CW_BAR; bar.x = 0; bar.st = nullptr;
    if constexpr (FUSED) {
        volatile LAS unsigned* misc = (volatile LAS unsigned*)(c.lds + MISC_OFF);
        if (c.tid < 64) misc[c.tid] = 0u;
        __syncthreads();
        bar = xcd_barrier_post(CTL + CW_BAR, misc + 8);
        if (PROBE_EN && blockIdx.x == 0 && threadIdx.x == 0) CTL[599] = (unsigned)__builtin_amdgcn_s_memrealtime();
    }
#define GRID_BAR(k) do { if constexpr (FUSED) { if (IN((k) + 1)) xcd_barrier(bar); if (PROBE_EN && blockIdx.x == 0 && threadIdx.x == 0) CTL[600 + (k)] = (unsigned)__builtin_amdgcn_s_memrealtime(); } } while (0)

    if (IN(0)) { c = fresh_ctx(ldsp);
        transpose_matrix(c, na_w_in, 1024, NA_IN, WIN0, c.gw, c.ngw, norm_mix);
        transpose_matrix(c, gla_w_in, 1024, GLA_IN, WIN1, c.gw, c.ngw, norm_mix + D);
        for (long i = GTID; i < (long)(2816 - 2592) * 1024 / 8; i += GSIZE) ((u32x4*)(WIN1 + (size_t)2592 * 1024))[i] = (u32x4){0u, 0u, 0u, 0u};
        for (int l = 0; l < 2; ++l) { transpose_matrix(c, w_out + (size_t)l * D * D, 1024, 1024, WOUT + (size_t)l * D * D, c.gw, c.ngw);
            transpose_matrix(c, w_mem_kv + (size_t)l * D * 512, 1024, 512, WMKV + (size_t)l * 512 * 1024, c.gw, c.ngw); }
        for (long i = GTID; i < (long)2 * 48 * D; i += GSIZE) { const int k = (int)(i % D), col = (int)((i / D) % 48), l = (int)(i / (48 * D)); const float gk = norm_ffn[l * D + k];
            WR[(size_t)l * 48 * D + (((((size_t)(k >> 4) * 3 + (col >> 4)) * 4 + ((k >> 2) & 3)) * 16 + (col & 15)) * 4) + (k & 3)] = col < 4 ? moe_w_group[((size_t)l * D + k) * 4 + col] * gk : (col < 36 ? moe_w_router[((size_t)l * D + k) * 32 + (col - 4)] * gk : 0.f); }
        for (int m = c.gw; m < NBATCH * NMEM; m += c.ngw) rms_row_to_bf16(mem + (size_t)m * D, mem_norm, MEMN + (size_t)m * D, c.lane);
        for (int m = c.gw; m < NTOK; m += c.ngw) xb_row(x + (size_t)m * D, XB + (size_t)m * D, RN + m, c.lane);
        GRID_BAR(0);
    }
#pragma unroll
    for (int L = 0; L < 2; ++L) {
        const int pb = 1 + 9 * L;
        const int ldu = L == 0 ? LDU0 : LDU1;
        unsigned* cnt = CTL + CW_CNT + 4096 * L;
        const int* LIST = (const int*)(RT + RT_LIST);
        if (IN(pb)) { c = fresh_ctx(ldsp);
            pg8::StaticOrder S; S.init(XB, L == 0 ? WIN0 : WIN1, NTOK, ldu, D, (int)gridDim.x, (int)blockIdx.x);
            pg8::EpiBf16 E{U, ldu, RN};
            pg8::gemm_phase<pg8::EpiBf16, pg8::StaticOrder, false>(c.lds, D, S, E);
            if (L == 0) { pg8::StaticOrder S2; S2.init(MEMN, WMKV, NBATCH * NMEM, 1024, D, (int)gridDim.x, (int)blockIdx.x);
                pg8::EpiBf16 E2{MKV, 1024, nullptr};
                pg8::gemm_phase<pg8::EpiBf16, pg8::StaticOrder, false>(c.lds, D, S2, E2); }
            GRID_BAR(pb);
        }
        if (IN(pb + 1)) { c = fresh_ctx(ldsp);
            if (L == 0) { const int nna = NBATCH * NA_H * 4, G = (int)gridDim.x;
                na_ring_phase(c, U, na_rpb, CAT, vcu);
                if (G > nna) att::mem_phase(c, U, LDU0, 2304, MKV, 0, CAT, vcu >= nna ? vcu - nna : 1 << 20, G - nna); else att::mem_phase(c, U, LDU0, 2304, MKV, 0, CAT, vcu, G); }
            else { att::mem_phase(c, U, LDU1, 2336, MKV, 1, CAT, vcu, (int)gridDim.x);
                gla::local_phase(c, U, gla_gate_up, gla_gate_bias, SU, SDEC, vcu, (int)gridDim.x, CTL); }
            GRID_BAR(pb + 1);
        }
        if (IN(pb + 2)) { c = fresh_ctx(ldsp);
            if (L == 1) { gla::scan_phase(c, SU, SS, SDEC); GRID_BAR(pb + 2); }
        }
        if (IN(pb + 3)) { c = fresh_ctx(ldsp);
            if (L == 1) { gla::out_phase(c, U, gla_gate_up, gla_gate_bias, SS, gla_out_norm, CAT, vcu, (int)gridDim.x); GRID_BAR(pb + 3); }
        }
        if (IN(pb + 4)) { c = fresh_ctx(ldsp);
            pg8::StaticOrder S; S.init(CAT, WOUT + (size_t)L * D * D, NTOK, D, D, (int)gridDim.x, (int)blockIdx.x);
            pg8::EpiResBf16 E{XB};
            pg8::gemm_phase<pg8::EpiResBf16, pg8::StaticOrder, false>(c.lds, D, S, E);
            GRID_BAR(pb + 4);
        }
        if (IN(pb + 5)) { c = fresh_ctx(ldsp);
            const float* w1l = moe_w1 + (size_t)L * NEXP * D * EFF; const float* w3l = moe_w3 + (size_t)L * NEXP * D * EFF; const float* w2l = moe_w2 + (size_t)L * NEXP * EFF * D;
            LAS unsigned* cvctr = (LAS unsigned*)(c.lds + MISC_OFF + 128);
            if (c.tid == 0) *cvctr = 0u;
            __syncthreads();
            if (!SPLIT_CONV && c.wave >= 4) convert_moe_dyn(c, w1l, w3l, w2l, W13, W2, cvctr, norm_ffn + L * D);
            route_mfma(c, XB, WR + (size_t)L * 48 * D, moe_b_group + L * 4, moe_b_router + L * 32, RT, cnt);
            if (!SPLIT_CONV && c.wave < 4) convert_moe_dyn(c, w1l, w3l, w2l, W13, W2, cvctr, norm_ffn + L * D);
            GRID_BAR(pb + 5);
        }
        if (IN(pb + 6)) { c = fresh_ctx(ldsp);
            build_tab(c, cnt);
            pg8::MoeOrder S{(const LAS int*)(c.lds + TAB_OFF), XB, W13, LIST, D, 4, (int)gridDim.x, vcu, true};
            pg8::EpiSwiGLU E{ACT, (const float*)(RT + RT_LISTR), (const LAS int*)(c.lds + TAB_OFF)};
            pg8::gemm_phase<pg8::EpiSwiGLU, pg8::MoeOrder, true>(c.lds, D, S, E);
            GRID_BAR(pb + 6);
        }
        if (IN(pb + 7)) { c = fresh_ctx(ldsp);
            build_tab(c, cnt);
            pg8::MoeOrder S{(const LAS int*)(c.lds + TAB_OFF), ACT, W2, LIST, EFF, 4, (int)gridDim.x, vcu, false};
            pg8::EpiScaleBf16 E{Y, (const float*)(RT + RT_LISTW), (const LAS int*)(c.lds + TAB_OFF)};
            pg8::gemm_phase<pg8::EpiScaleBf16, pg8::MoeOrder, false>(c.lds, EFF, S, E);
            GRID_BAR(pb + 7);
        }
        if (IN(pb + 8)) { c = fresh_ctx(ldsp);
            build_tab(c, cnt);
            if (L == 0) { combine_phase(c, XB, Y, RT, (const LAS int*)(c.lds + TAB_OFF), nullptr, RN, nullptr); GRID_BAR(pb + 8); }
            else combine_phase(c, XB, Y, RT, (const LAS int*)(c.lds + TAB_OFF), final_norm, nullptr, args.out);
        }
    }
    if (PH_LO == 19 || PH_LO == 20) { const int L = PH_LO - 19; c = fresh_ctx(ldsp);
        LAS unsigned* cvctr = (LAS unsigned*)(c.lds + MISC_OFF + 128); if (c.tid == 0) *cvctr = 0u; __syncthreads();
        convert_moe_dyn(c, moe_w1 + (size_t)L * NEXP * D * EFF, moe_w3 + (size_t)L * NEXP * D * EFF, moe_w2 + (size_t)L * NEXP * EFF * D, W13, W2, cvctr, norm_ffn + L * D); }
#undef IN
}

template <int P> static void launch_phases(int grid, hipStream_t stream, const Args& a) {
    if constexpr (P < NPHASES) {
        if constexpr (P != 3 && P != 4) {
            static bool attr_done = false;
            if (!attr_done) { (void)hipFuncSetAttribute((const void*)mk_fwd<P, P + 1>, hipFuncAttributeMaxDynamicSharedMemorySize, LDS_BYTES); attr_done = true; }
            hipLaunchKernelGGL((mk_fwd<P, P + 1>), dim3(grid), dim3(NTHREADS), LDS_BYTES, stream, a);
#ifdef HOST_REPEAT
            if (P == HOST_REPEAT) { if (P == 6 || P == 15) (void)hipMemsetAsync((char*)a.ws + WS_CTL + (CW_CNT + (P == 6 ? 0 : 4096)) * 4, 0, 8192, stream);
                hipLaunchKernelGGL((mk_fwd<P, P + 1>), dim3(grid), dim3(NTHREADS), LDS_BYTES, stream, a); }
#endif
#if SPLIT_CONV
            if (P == 6 || P == 15) { constexpr int Q = P == 6 ? 19 : 20; (void)hipFuncSetAttribute((const void*)mk_fwd<Q, Q + 1>, hipFuncAttributeMaxDynamicSharedMemorySize, LDS_BYTES);
                hipLaunchKernelGGL((mk_fwd<Q, Q + 1>), dim3(grid), dim3(NTHREADS), LDS_BYTES, stream, a);
#ifdef HOST_REPEAT
                if (HOST_REPEAT == Q) hipLaunchKernelGGL((mk_fwd<Q, Q + 1>), dim3(grid), dim3(NTHREADS), LDS_BYTES, stream, a);
#endif
            }
#endif
        }
        launch_phases<P + 1>(grid, stream, a);
    }
}
extern "C" void kernel_launch(void* const* d_in, const int* in_sizes, int n_in, void* d_out, int out_size, void* d_ws, size_t ws_size, hipStream_t stream) {
    static int grid = 0;
    if (grid == 0) {
        if (n_in != 21 || out_size != NTOK * D || ws_size < WS_END) { fprintf(stderr, "kernel_launch: unexpected shapes n_in %d out %d ws %zu (need %zu)\n", n_in, out_size, ws_size, (size_t)WS_END); grid = -1; return; }
        int dev = 0, cus = 0;
        if (hipGetDevice(&dev) != hipSuccess || hipDeviceGetAttribute(&cus, hipDeviceAttributeMultiprocessorCount, dev) != hipSuccess) { grid = -1; return; }
        (void)hipGetLastError();
        grid = cus;
    }
    if (grid < 0) return;
    (void)hipMemsetAsync((char*)d_ws + WS_CTL, 0, CTL_ZERO_BYTES, stream);
    Args a{};
    for (int i = 0; i < 21; ++i) a.in[i] = (const float*)d_in[i];
    a.out = (float*)d_out; a.ws = (unsigned char*)d_ws;
#if defined(MK_PER_PHASE)
    launch_phases<0>(grid, stream, a);
#else
    static bool attr_done = false;
    if (!attr_done) { (void)hipFuncSetAttribute((const void*)mk_fwd<0, NPHASES>, hipFuncAttributeMaxDynamicSharedMemorySize, LDS_BYTES); attr_done = true; }
    hipLaunchKernelGGL((mk_fwd<0, NPHASES>), dim3(grid), dim3(NTHREADS), LDS_BYTES, stream, a);
#endif
}
```
